# Optimizing an MI355X kernel written in HIP

```python
import jax
import jax.numpy as jnp
from jax import lax
import numpy as np

D_MODEL = 1024
BATCH = 8
SEQ = 4096
DEPTH = 4

CTX_LEN = 256
GRID_W = 64
NORM_EPS = 1e-6
N_MOD = 6

MIX_WIDTH = D_MODEL
SC_WIDTH = MIX_WIDTH // 2
SC_CONV = 3
SC_PAD_LEFT = 1
GLA_HEADS = 4
GLA_VALUE = MIX_WIDTH // 2
GLA_DV = GLA_VALUE // GLA_HEADS
GLA_DK = GLA_DV // 2
GLA_KEY = GLA_HEADS * GLA_DK
GLA_RANK = 16
GLA_TAU = 16.0
GLA_CHUNK = 64
EVEN_SIZES = (SC_WIDTH, SC_WIDTH, SC_WIDTH, GLA_KEY, GLA_VALUE)
EVEN_KV_SIZES = (GLA_KEY, GLA_VALUE, GLA_RANK, GLA_RANK)
EVEN_KV_START = 3 * SC_WIDTH + GLA_KEY + GLA_VALUE
EVEN_IN = EVEN_KV_START + GLA_KEY + GLA_VALUE + 2 * GLA_RANK
EVEN_OUT = SC_WIDTH + GLA_VALUE
LRU_WIDTH = MIX_WIDTH // 2
LRU_HEADS = 4
LRU_HEAD_DIM = LRU_WIDTH // LRU_HEADS
LRU_CONV = 4
LRU_PAD_LEFT = 2
LRU_C = 8.0
SG_WIDTH = MIX_WIDTH // 2
SG_GROUPS = 4
SG_GROUP_DIM = SG_WIDTH // SG_GROUPS
SG_CHUNK = 128
ODD_SIZES = (LRU_WIDTH, LRU_WIDTH, SG_WIDTH, SG_WIDTH)
ODD_IN = 2 * LRU_WIDTH + 2 * SG_WIDTH
ODD_OUT = LRU_WIDTH + SG_WIDTH
N_EXPERTS = 16
EXPERT_HIDDEN = D_MODEL
EC_CAPACITY = 2

kernel_name = 'hybrid_diffusion_conv_gla_rglru_sgmlp_ec'


def _split(z, sizes):
    return jnp.split(z, [int(s) for s in np.cumsum(sizes)[:-1]], axis=-1)


def rmsnorm(x, g):
    xf = x.astype(jnp.float32)
    y = xf * lax.rsqrt(jnp.mean(xf * xf, axis=-1, keepdims=True) + NORM_EPS)
    return (y * g.astype(jnp.float32)).astype(x.dtype)


def layernorm(x, g):
    xf = x.astype(jnp.float32)
    xc = xf - jnp.mean(xf, axis=-1, keepdims=True)
    y = xc * lax.rsqrt(jnp.mean(xc * xc, axis=-1, keepdims=True) + NORM_EPS)
    return (y * g.astype(jnp.float32)).astype(x.dtype)


def modulate(h, shift, scale):
    return h * (1 + scale) + shift


def dwconv(x, w, b, pad_left):
    width = w.shape[0]
    length = x.shape[-2]
    pad = [(0, 0)] * (x.ndim - 2) + [(pad_left, width - 1 - pad_left), (0, 0)]
    xp = jnp.pad(x, pad)
    y = b
    for j in range(width):
        y = y + w[j] * xp[..., j:j + length, :]
    return y


def _heads(t, n):
    bsz, length, _ = t.shape
    return t.reshape(bsz, length, n, -1).transpose(0, 2, 1, 3)


def gla_chunk_scan(q, k, v, la, s0):
    bsz, heads, length, _ = k.shape
    n = length // GLA_CHUNK

    def blocks(t):
        return t.reshape(bsz, heads, n, GLA_CHUNK, t.shape[-1])

    k, v, la = blocks(k), blocks(v), blocks(la)
    b = jnp.cumsum(la, axis=3)
    b_last = b[:, :, :, -1:, :]
    ds = jnp.einsum('bhncd,bhnce->nbhde', k * jnp.exp(b_last - b), v)
    decay = jnp.moveaxis(jnp.exp(b_last[:, :, :, 0, :]), 2, 0)
    with_out = q is not None

    def step(s, inp):
        dec, d = inp
        return dec[..., None] * s + d, (s if with_out else None)

    s_last, s_in = lax.scan(step, s0, (decay, ds))
    if not with_out:
        return None, s_last
    q_d = blocks(q) * jnp.exp(b)
    att = jnp.einsum('bhnid,bhnjd->bhnij', q_d, k * jnp.exp(-b))
    att = jnp.where(jnp.tril(jnp.ones((GLA_CHUNK, GLA_CHUNK), bool)), att, 0.0)
    o = jnp.einsum('bhnij,bhnje->bhnie', att, v) + jnp.einsum('bhncd,nbhde->bhnce', q_d, s_in)
    return o.reshape(bsz, heads, length, v.shape[-1]), s_last


def gla_bidir(q, k, v, la_f, la_b, s0_f, s0_b):
    def flip(t):
        return None if t is None else jnp.flip(t, axis=2)

    o_f, s_f = gla_chunk_scan(q, k, v, la_f, s0_f)
    o_b, s_b = gla_chunk_scan(flip(q), flip(k), flip(v), flip(la_b), s0_b)
    o = None if q is None else o_f + jnp.flip(o_b, axis=2)
    return o, s_f, s_b


def gla_readout(o, g, norm_g):
    bsz, heads, length, dv = o.shape
    o = o * lax.rsqrt(jnp.mean(o * o, axis=-1, keepdims=True) + NORM_EPS)
    o = o.transpose(0, 2, 1, 3).reshape(bsz, length, heads * dv)
    return (o * norm_g.astype(jnp.float32) * jax.nn.silu(g.astype(jnp.float32))).astype(g.dtype)


def _lin_combine(earlier, later):
    a1, b1 = earlier
    a2, b2 = later
    return a1 * a2, a2 * b1 + b2


def linear_scan(a, b, h0, reverse):
    if reverse:
        a, b = jnp.flip(a, axis=1), jnp.flip(b, axis=1)
    b = b.at[:, 0].add(a[:, 0] * h0)
    _, h = lax.associative_scan(_lin_combine, (a, b), axis=1)
    h_last = h[:, -1]
    if reverse:
        h = jnp.flip(h, axis=1)
    return h, h_last


def _blockdiag(x, w, b):
    bsz, length, _ = x.shape
    y = jnp.einsum('bthi,hij->bthj', x.reshape(bsz, length, LRU_HEADS, LRU_HEAD_DIM), w.astype(jnp.float32))
    return y.reshape(bsz, length, LRU_WIDTH) + b.astype(jnp.float32)


def even_mixer(h_lat, h_ctx, w_in, conv_w, conv_b, decay_up, decay_b, norm_g, w_out, need_ctx_out):
    f32 = jnp.float32
    bsz, seq, _ = h_lat.shape
    rows = seq // GRID_W
    scale = GLA_DK ** -0.5

    def kv_decay(zkv):
        k, v, lr_f, lr_b = _split(zkv, EVEN_KV_SIZES)
        la_f = jax.nn.log_sigmoid(lr_f.astype(f32) @ decay_up[0].astype(f32) + decay_b[0].astype(f32)) / GLA_TAU
        la_b = jax.nn.log_sigmoid(lr_b.astype(f32) @ decay_up[1].astype(f32) + decay_b[1].astype(f32)) / GLA_TAU
        return (_heads(k.astype(f32), GLA_HEADS), _heads(v.astype(f32), GLA_HEADS),
                _heads(la_f, GLA_HEADS), _heads(la_b, GLA_HEADS))

    zero = jnp.zeros((bsz, GLA_HEADS, GLA_DK, GLA_DV), f32)
    if need_ctx_out:
        zc = h_ctx @ w_in
        bg_c, cg_c, xa_c, q_c, g_c = _split(zc[..., :EVEN_KV_START], EVEN_SIZES)
        kv_c = kv_decay(zc[..., EVEN_KV_START:])
        qh_c = _heads(q_c.astype(f32), GLA_HEADS) * scale
    else:
        kv_c = kv_decay(h_ctx @ w_in[:, EVEN_KV_START:])
        qh_c = None
    o_c, s_f, s_b = gla_bidir(qh_c, *kv_c, zero, zero)

    z = h_lat @ w_in
    bg, cg, xa, q, g = _split(z[..., :EVEN_KV_START], EVEN_SIZES)
    o, _, _ = gla_bidir(_heads(q.astype(f32), GLA_HEADS) * scale, *kv_decay(z[..., EVEN_KV_START:]), s_f, s_b)
    conv = dwconv((cg * xa).reshape(bsz, rows, GRID_W, SC_WIDTH), conv_w, conv_b, SC_PAD_LEFT)
    conv = conv.reshape(bsz, seq, SC_WIDTH)
    y_lat = jnp.concatenate([bg * conv, gla_readout(o, g, norm_g)], axis=-1) @ w_out
    y_ctx = None
    if need_ctx_out:
        conv_c = dwconv(cg_c * xa_c, conv_w, conv_b, SC_PAD_LEFT)
        y_ctx = jnp.concatenate([bg_c * conv_c, gla_readout(o_c, g_c, norm_g)], axis=-1) @ w_out
    return y_lat, y_ctx


def odd_mixer(h_lat, h_ctx, w_in, conv_w, conv_b, gate_a_w, gate_a_b, gate_x_w, gate_x_b, lam,
              sg_norm_g, sg_w, sg_b, w_out, need_ctx_out):
    f32 = jnp.float32
    bsz = h_lat.shape[0]

    def lru_coeffs(xc, d):
        xf = xc.astype(f32)
        r = jax.nn.sigmoid(_blockdiag(xf, gate_a_w[d], gate_a_b[d]))
        i = jax.nn.sigmoid(_blockdiag(xf, gate_x_w[d], gate_x_b[d]))
        log_a = -LRU_C * r * jax.nn.softplus(-lam[d].astype(f32))
        return jnp.exp(log_a), jnp.sqrt(-jnp.expm1(2.0 * log_a)) * (i * xf)

    def spatial_gate(u, v):
        b, length, _ = u.shape
        n = length // SG_CHUNK
        vb = layernorm(jax.nn.gelu(v), sg_norm_g).reshape(b, n, SG_CHUNK, SG_GROUPS, SG_GROUP_DIM)
        mixed = jnp.einsum('gij,bnjgc->bnigc', sg_w, vb) + sg_b.T[:, :, None]
        return jax.nn.gelu(u) * mixed.reshape(b, length, SG_WIDTH)

    if need_ctx_out:
        xb_c, gb_c, u_c, v_c = _split(h_ctx @ w_in, ODD_SIZES)
    else:
        xb_c = h_ctx @ w_in[:, :LRU_WIDTH]
    xc_c = dwconv(xb_c, conv_w, conv_b, LRU_PAD_LEFT)
    xb, gb, u, v = _split(h_lat @ w_in, ODD_SIZES)
    xc = dwconv(xb, conv_w, conv_b, LRU_PAD_LEFT)
    zero = jnp.zeros((bsz, LRU_WIDTH), f32)
    h_lat_dirs, h_ctx_dirs = [], []
    for d, reverse in enumerate((False, True)):
        h_c, h_c_last = linear_scan(*lru_coeffs(xc_c, d), zero, reverse)
        h_l, _ = linear_scan(*lru_coeffs(xc, d), h_c_last, reverse)
        h_lat_dirs.append(h_l)
        h_ctx_dirs.append(h_c)
    y_rec = (h_lat_dirs[0] + h_lat_dirs[1]).astype(gb.dtype) * jax.nn.gelu(gb)
    y_lat = jnp.concatenate([y_rec, spatial_gate(u, v)], axis=-1) @ w_out
    y_ctx = None
    if need_ctx_out:
        y_rec_c = (h_ctx_dirs[0] + h_ctx_dirs[1]).astype(gb_c.dtype) * jax.nn.gelu(gb_c)
        y_ctx = jnp.concatenate([y_rec_c, spatial_gate(u_c, v_c)], axis=-1) @ w_out
    return y_lat, y_ctx


def ec_moe(h, w_router, w_gate, w_up, w_down):
    bsz, length, dim = h.shape
    cap = EC_CAPACITY * length // N_EXPERTS
    aff = jax.nn.softmax((h @ w_router).astype(jnp.float32), axis=-1)
    g, idx = lax.top_k(jnp.swapaxes(aff, 1, 2), cap)
    xg = jax.vmap(lambda hb, ib: hb[ib])(h, idx)
    hid = jax.nn.silu(jnp.einsum('becd,edf->becf', xg, w_gate)) * jnp.einsum('becd,edf->becf', xg, w_up)
    out = jnp.einsum('becf,efd->becd', hid, w_down) * g.astype(h.dtype)[..., None]
    return jax.vmap(lambda ib, ob: jnp.zeros((length, dim), ob.dtype).at[ib.reshape(-1)].add(ob.reshape(-1, dim)))(idx, out)


def setup_inputs(seed: int = 0) -> dict:
    key = jax.random.key(seed)
    keys = [k for k in jax.random.split(key, 48)]

    def nrm(shape, scale):
        return jax.random.normal(keys.pop(), shape, jnp.float32) * scale

    d = D_MODEL
    ne, no = (DEPTH + 1) // 2, DEPTH // 2
    u = jax.random.uniform(keys.pop(), (no, 2, LRU_WIDTH), jnp.float32, 0.9, 0.999)
    a = u ** (1.0 / LRU_C)
    lam = jnp.log(a) - jnp.log1p(-a)
    return {
        'x': nrm((BATCH, SEQ, d), 1.0),
        'c': nrm((BATCH, d), 1.0),
        'ctx': nrm((BATCH, CTX_LEN, d), 1.0),
        'c_ctx': nrm((d,), 1.0),
        'ada_w': nrm((DEPTH, d, N_MOD * d), 0.5 * d ** -0.5),
        'ada_b': nrm((DEPTH, N_MOD * d), 0.02),
        'norm_mix_g': 1.0 + nrm((DEPTH, d), 0.02),
        'norm_ffn_g': 1.0 + nrm((DEPTH, d), 0.02),
        'norm_final_g': 1.0 + nrm((d,), 0.02),
        'ev_w_in': nrm((ne, d, EVEN_IN), d ** -0.5),
        'ev_conv_w': nrm((ne, SC_CONV, SC_WIDTH), SC_CONV ** -0.5),
        'ev_conv_b': nrm((ne, SC_WIDTH), 0.02),
        'ev_decay_up': nrm((ne, 2, GLA_RANK, GLA_KEY), GLA_RANK ** -0.5),
        'ev_decay_b': 1.0 + nrm((ne, 2, GLA_KEY), 0.5),
        'ev_norm_g': 1.0 + nrm((ne, GLA_VALUE), 0.02),
        'ev_w_out': nrm((ne, EVEN_OUT, d), EVEN_OUT ** -0.5),
        'od_w_in': nrm((no, d, ODD_IN), d ** -0.5),
        'od_conv_w': nrm((no, LRU_CONV, LRU_WIDTH), LRU_CONV ** -0.5),
        'od_conv_b': nrm((no, LRU_WIDTH), 0.02),
        'od_gate_a_w': nrm((no, 2, LRU_HEADS, LRU_HEAD_DIM, LRU_HEAD_DIM), LRU_HEAD_DIM ** -0.5),
        'od_gate_a_b': nrm((no, 2, LRU_WIDTH), 0.02),
        'od_gate_x_w': nrm((no, 2, LRU_HEADS, LRU_HEAD_DIM, LRU_HEAD_DIM), LRU_HEAD_DIM ** -0.5),
        'od_gate_x_b': nrm((no, 2, LRU_WIDTH), 0.02),
        'od_lambda': lam,
        'od_sg_norm_g': 1.0 + nrm((no, SG_WIDTH), 0.02),
        'od_sg_w': nrm((no, SG_GROUPS, SG_CHUNK, SG_CHUNK), SG_CHUNK ** -0.5),
        'od_sg_b': 1.0 + nrm((no, SG_GROUPS, SG_CHUNK), 0.1),
        'od_w_out': nrm((no, ODD_OUT, d), ODD_OUT ** -0.5),
        'moe_router': nrm((DEPTH, d, N_EXPERTS), d ** -0.5),
        'moe_w_gate': nrm((DEPTH, N_EXPERTS, d, EXPERT_HIDDEN), d ** -0.5),
        'moe_w_up': nrm((DEPTH, N_EXPERTS, d, EXPERT_HIDDEN), d ** -0.5),
        'moe_w_down': nrm((DEPTH, N_EXPERTS, EXPERT_HIDDEN, d), EXPERT_HIDDEN ** -0.5),
    }


def reference(x, c, ctx, c_ctx, ada_w, ada_b, norm_mix_g, norm_ffn_g, norm_final_g,
              ev_w_in, ev_conv_w, ev_conv_b, ev_decay_up, ev_decay_b, ev_norm_g, ev_w_out,
              od_w_in, od_conv_w, od_conv_b, od_gate_a_w, od_gate_a_b, od_gate_x_w, od_gate_x_b,
              od_lambda, od_sg_norm_g, od_sg_w, od_sg_b, od_w_out,
              moe_router, moe_w_gate, moe_w_up, moe_w_down):
    x_lat, x_ctx = x, ctx
    s_lat = jax.nn.silu(c)
    s_ctx = jax.nn.silu(c_ctx)
    for l in range(DEPTH):
        last = l == DEPTH - 1
        mod = jnp.split((s_lat @ ada_w[l] + ada_b[l])[:, None, :], N_MOD, axis=-1)
        mod_c = jnp.split(s_ctx @ ada_w[l] + ada_b[l], N_MOD, axis=-1)
        h_lat = modulate(rmsnorm(x_lat, norm_mix_g[l]), mod[0], mod[1])
        h_ctx = modulate(rmsnorm(x_ctx, norm_mix_g[l]), mod_c[0], mod_c[1])
        i = l // 2
        if l % 2 == 0:
            y_lat, y_ctx = even_mixer(h_lat, h_ctx, ev_w_in[i], ev_conv_w[i], ev_conv_b[i], ev_decay_up[i],
                                      ev_decay_b[i], ev_norm_g[i], ev_w_out[i], not last)
        else:
            y_lat, y_ctx = odd_mixer(h_lat, h_ctx, od_w_in[i], od_conv_w[i], od_conv_b[i], od_gate_a_w[i],
                                     od_gate_a_b[i], od_gate_x_w[i], od_gate_x_b[i], od_lambda[i],
                                     od_sg_norm_g[i], od_sg_w[i], od_sg_b[i], od_w_out[i], not last)
        x_lat = x_lat + mod[2] * y_lat
        h_lat = modulate(rmsnorm(x_lat, norm_ffn_g[l]), mod[3], mod[4])
        x_lat = x_lat + mod[5] * ec_moe(h_lat, moe_router[l], moe_w_gate[l], moe_w_up[l], moe_w_down[l])
        if not last:
            x_ctx = x_ctx + mod_c[2] * y_ctx
            h_ctx = modulate(rmsnorm(x_ctx, norm_ffn_g[l]), mod_c[3], mod_c[4])
            x_ctx = x_ctx + mod_c[5] * ec_moe(h_ctx, moe_router[l], moe_w_gate[l], moe_w_up[l], moe_w_down[l])
    return rmsnorm(x_lat, norm_final_g)
```

```cpp
#ifndef CPU_EMU
#include <hip/hip_runtime.h>
#include <cstdio>
#define DEV __device__ __forceinline__
#else
#define DEV inline
#endif
#include <cstdint>
#include <cstddef>

#ifndef D_MODEL
#define D_MODEL 1024
#define BATCH 8
#define SEQ 4096
#define CTXL 256
#endif

typedef unsigned short bf16_t;
constexpr int D = D_MODEL, NB = BATCH, T = SEQ, TC = CTXL, DEPTH = 4;
constexpr int RL = NB * T, RC = NB * TC, R = RL + RC;
constexpr int W2 = D / 2;
constexpr int GH = 4, DV = W2 / GH, DK = DV / 2, KEY = GH * DK, RANK = 16, CH = 64, GRIDW = 64;
constexpr int EV_IN = 3 * W2 + KEY + W2 + KEY + W2 + 2 * RANK;
constexpr int NZE = ((EV_IN + 255) / 256) * 256, NZO = 4 * W2;
constexpr int E_BG = 0, E_CG = W2, E_XA = 2 * W2, E_Q = 3 * W2, E_G = E_Q + KEY, E_K = E_G + W2, E_V = E_K + KEY, E_LRF = E_V + W2, E_LRB = E_LRF + RANK;
constexpr int O_XB = 0, O_GB = W2, O_U = 2 * W2, O_V = 3 * W2;
constexpr int NE = 16, CAPL = 2 * T / NE, CAPC = 2 * TC / NE, SLOTS_E = NB * (CAPL + CAPC), SLOTS = NE * SLOTS_E;
constexpr int SEQ_ALL = TC + T, NCH = SEQ_ALL / CH, NCHC = TC / CH;
constexpr int SGC = 128, HD = W2 / 4;
constexpr float EPS = 1e-6f;
constexpr int MODW = 6 * D;

struct Params {
    const float *x, *c, *ctx, *c_ctx, *ada_w, *ada_b, *norm_mix_g, *norm_ffn_g, *norm_final_g;
    const float *ev_w_in, *ev_conv_w, *ev_conv_b, *ev_decay_up, *ev_decay_b, *ev_norm_g, *ev_w_out;
    const float *od_w_in, *od_conv_w, *od_conv_b, *od_gate_a_w, *od_gate_a_b, *od_gate_x_w, *od_gate_x_b, *od_lambda, *od_sg_norm_g, *od_sg_w, *od_sg_b, *od_w_out;
    const float *moe_router, *moe_w_gate, *moe_w_up, *moe_w_down;
    float* xlat;
    float *xctx, *mod, *sbuf, *rinv, *aff, *logit, *sel_g;
    int *sel_row, *inv;
    bf16_t *wt_ev_in, *wt_od_in, *wt_ev_out, *wt_od_out, *wt_gu, *wt_dn, *h;
    bf16_t *z, *m;
    float *bcum, *S, *att, *o;
    float *xc, *A, *Bc, *sgstat, *vb;
    bf16_t *xg, *hid, *outslot;
    unsigned* bar;
};

DEV float bf2f(bf16_t v) { union { unsigned u; float f; } c; c.u = (unsigned)v << 16; return c.f; }
DEV bf16_t f2bf(float f) { union { unsigned u; float f; } c; c.f = f; unsigned u = c.u; u += 0x7fffu + ((u >> 16) & 1u); return (bf16_t)(u >> 16); }
DEV float sigmoidf_(float x) { return 1.0f / (1.0f + expf(-x)); }
DEV float siluf_(float x) { return x / (1.0f + expf(-x)); }
DEV float softplusf_(float x) { return fmaxf(x, 0.0f) + log1pf(expf(-fabsf(x))); }
DEV float logsigmoidf_(float x) { return fminf(x, 0.0f) - log1pf(expf(-fabsf(x))); }
DEV float geluf_(float x) { return 0.5f * x * (1.0f + tanhf(0.7978845608028654f * (x + 0.044715f * x * x * x))); }
DEV float rsq_(float x) { return 1.0f / sqrtf(x); }

DEV const float* xsrc_row(const Params& P, int l, int r) {
    if (l == 0) return r < RL ? P.x + (size_t)r * D : P.ctx + (size_t)(r - RL) * D;
    return r < RL ? P.xlat + (size_t)r * D : P.xctx + (size_t)(r - RL) * D;
}
DEV float* x_row(const Params& P, int r) { return r < RL ? P.xlat + (size_t)r * D : P.xctx + (size_t)(r - RL) * D; }
DEV int row_bb(int r) { return r < RL ? r / T : NB; }
DEV int seqrow(int b, int s) { return s < TC ? RL + b * TC + s : b * T + (s - TC); }
DEV const float* modrow(const Params& P, int l, int bb) { return P.mod + ((size_t)l * (NB + 1) + bb) * MODW; }

#define GSL(i, n) for (long i = (long)blockIdx.x * blockDim.x + threadIdx.x; i < (long)(n); i += (long)gridDim.x * blockDim.x)

enum {
    ST_SILU = 0, ST_MOD, ST_WCONV,
    ST_NORM_STATS_MIX, ST_NORM_APPLY_MIX, ST_GEMM_IN,
    ST_E_LA, ST_E_DS, ST_E_SCAN, ST_E_ATT, ST_E_O, ST_E_READOUT, ST_E_CONV,
    ST_O_XC, ST_O_COEF, ST_O_SCAN, ST_O_YREC, ST_O_SGSTAT, ST_O_VB, ST_O_SGMIX,
    ST_GEMM_OUT,
    ST_NORM_STATS_FFN, ST_NORM_APPLY_FFN, ST_ROUTER_LOGIT, ST_ROUTER_SOFTMAX, ST_MOE_WCONV, ST_SELECT, ST_GATHER, ST_GEMM_GU, ST_GEMM_DOWN, ST_COMBINE,
    ST_FINAL_STATS, ST_FINAL_APPLY, ST_COUNT
};

struct EpiZ {
    bf16_t* z; int ldz;
    DEV void elem(int row, int col, float v) const { z[(size_t)row * ldz + col] = f2bf(v); }
};
struct EpiWout {
    const Params* P; int l;
    DEV void elem(int row, int col, float v) const {
        const float* mr = modrow(*P, l, row_bb(row));
        x_row(*P, row)[col] = xsrc_row(*P, l, row)[col] + mr[2 * D + col] * v;
    }
};
struct EpiGU {
    bf16_t* hid;
    DEV void pair(int row, int j, float g, float u) const { hid[(size_t)row * D + j] = f2bf(siluf_(g) * u); }
};
struct EpiDown {
    bf16_t* out; const float* selg;
    DEV void elem(int row, int col, float v) const { out[(size_t)row * D + col] = f2bf(v * selg[row]); }
};

#ifdef CPU_EMU
template <bool PAIR, class Epi>
void gemm_stage(const bf16_t* A, const bf16_t* Bt, int G, int Mg, int N, int K, const Epi& epi) {
    GSL(i, (long)G * Mg) {
        const int g = (int)(i / Mg); const int row = (int)i;
        const bf16_t* a = A + (size_t)row * K;
        if (!PAIR) {
            for (int n = 0; n < N; ++n) { const bf16_t* b = Bt + ((size_t)g * N + n) * K; float s = 0.f; for (int k = 0; k < K; ++k) s += bf2f(a[k]) * bf2f(b[k]); epi.elem(row, n, s); }
        } else {
            for (int j = 0; j < N / 2; ++j) {
                const int cg = (j / 32) * 64 + (j % 32), cu = cg + 32;
                const bf16_t* bg = Bt + ((size_t)g * N + cg) * K; const bf16_t* bu = Bt + ((size_t)g * N + cu) * K;
                float sg = 0.f, su = 0.f; for (int k = 0; k < K; ++k) { sg += bf2f(a[k]) * bf2f(bg[k]); su += bf2f(a[k]) * bf2f(bu[k]); }
                epi.pair_(row, j, sg, su);
            }
        }
    }
}
#else
typedef short bf16x8 __attribute__((ext_vector_type(8)));
typedef float f32x4 __attribute__((ext_vector_type(4)));
constexpr int G_BM = 128, G_BK = 32, G_HT = G_BM * G_BK;
constexpr int GEMM_LDS_BYTES = 2 * G_HT * 2;
template <bool PAIR, class Epi>
__device__ __forceinline__ void gemm_stage(const bf16_t* A, const bf16_t* Bt, int G, int Mg, int N, int K, const Epi& epi, bf16_t* shm) {
    const int tm_n = Mg / G_BM, tn_n = N / G_BM, tiles = G * tm_n * tn_n;
    const int wid = threadIdx.x >> 6, lane = threadIdx.x & 63, wr = wid >> 1, wc = wid & 1, fr = lane & 15, fq = lane >> 4;
    bf16_t* SA = shm; bf16_t* SB = shm + G_HT;
    for (int tile = blockIdx.x; tile < tiles; tile += gridDim.x) {
        const int g = tile / (tm_n * tn_n), rem = tile % (tm_n * tn_n), tm = rem / tn_n, tn = rem % tn_n;
        const int brow = g * Mg + tm * G_BM, bcol = tn * G_BM;
        const bf16_t* Ag = A + (size_t)brow * K; const bf16_t* Bg = Bt + ((size_t)g * N + bcol) * K;
        f32x4 acc[4][4];
#pragma unroll
        for (int m = 0; m < 4; ++m)
#pragma unroll
            for (int n = 0; n < 4; ++n) acc[m][n] = (f32x4){0.f, 0.f, 0.f, 0.f};
        for (int t = 0; t < K / G_BK; ++t) {
#pragma unroll
            for (int i = 0; i < 2; ++i) {
                const int b = threadIdx.x * 16 + i * 4096, r = b / 64, c = (b % 64) / 2;
                __builtin_amdgcn_global_load_lds((const unsigned*)(Ag + (size_t)r * K + t * G_BK + c), (__attribute__((address_space(3))) unsigned*)((char*)SA + b), 16, 0, 0);
                __builtin_amdgcn_global_load_lds((const unsigned*)(Bg + (size_t)r * K + t * G_BK + c), (__attribute__((address_space(3))) unsigned*)((char*)SB + b), 16, 0, 0);
            }
            asm volatile("s_waitcnt vmcnt(0)" ::: "memory");
            __syncthreads();
            bf16x8 At[4], Bl[4];
#pragma unroll
            for (int m = 0; m < 4; ++m) At[m] = *reinterpret_cast<const bf16x8*>((const char*)SA + (wr * 64 + m * 16 + fr) * G_BK * 2 + fq * 16);
#pragma unroll
            for (int n = 0; n < 4; ++n) Bl[n] = *reinterpret_cast<const bf16x8*>((const char*)SB + (wc * 64 + n * 16 + fr) * G_BK * 2 + fq * 16);
#pragma unroll
            for (int m = 0; m < 4; ++m)
#pragma unroll
                for (int n = 0; n < 4; ++n) acc[m][n] = __builtin_amdgcn_mfma_f32_16x16x32_bf16(At[m], Bl[n], acc[m][n], 0, 0, 0);
            __syncthreads();
        }
#pragma unroll
        for (int m = 0; m < 4; ++m)
#pragma unroll
            for (int j = 0; j < 4; ++j) {
                const int row = brow + wr * 64 + m * 16 + fq * 4 + j;
                if (!PAIR) {
#pragma unroll
                    for (int n = 0; n < 4; ++n) epi.elem(row, bcol + wc * 64 + n * 16 + fr, acc[m][n][j]);
                } else {
                    const int jb = ((bcol + wc * 64) / 64) * 32;
#pragma unroll
                    for (int n = 0; n < 2; ++n) epi.pair_(row, jb + n * 16 + fr, acc[m][n][j], acc[m][n + 2][j]);
                }
            }
    }
}
#endif

struct EpiZ_ : EpiZ { DEV void pair_(int, int, float, float) const {} };
struct EpiWout_ : EpiWout { DEV void pair_(int, int, float, float) const {} };
struct EpiDown_ : EpiDown { DEV void pair_(int, int, float, float) const {} };
struct EpiGU_ : EpiGU { DEV void elem(int, int, float) const {} DEV void pair_(int r, int j, float g, float u) const { pair(r, j, g, u); } };

#ifdef CPU_EMU
#define GEMM_CALL(PAIR, A, Bt, G, Mg, N, K, epi) gemm_stage<PAIR>(A, Bt, G, Mg, N, K, epi)
DEV void do_stage(const Params& P, int l, int st) {
#else
#define GEMM_CALL(PAIR, A, Bt, G, Mg, N, K, epi) gemm_stage<PAIR>(A, Bt, G, Mg, N, K, epi, shm)
__device__ __forceinline__ void do_stage(const Params& P, int l, int st, bf16_t* shm) {
#endif
    const int li = l >> 1;
    const bool even = (l & 1) == 0;
    const int ldz = even ? NZE : NZO;
    switch (st) {
    case ST_SILU: {
        GSL(i, (NB + 1) * D) { const int bb = (int)(i / D), k = (int)(i % D); const float v = bb < NB ? P.c[(size_t)bb * D + k] : P.c_ctx[k]; P.sbuf[i] = siluf_(v); }
    } break;
    case ST_MOD: {
        GSL(i, DEPTH * MODW) {
            const int ll = (int)(i / MODW), j = (int)(i % MODW);
            float acc[NB + 1];
#pragma unroll
            for (int bb = 0; bb <= NB; ++bb) acc[bb] = P.ada_b[(size_t)ll * MODW + j];
            const float* w = P.ada_w + (size_t)ll * D * MODW + j;
            for (int k = 0; k < D; ++k) { const float wv = w[(size_t)k * MODW];
#pragma unroll
                for (int bb = 0; bb <= NB; ++bb) acc[bb] += P.sbuf[bb * D + k] * wv; }
#pragma unroll
            for (int bb = 0; bb <= NB; ++bb) P.mod[((size_t)ll * (NB + 1) + bb) * MODW + j] = acc[bb];
        }
    } break;
    case ST_WCONV: {
        GSL(i, 2L * NZE * D) { const int q = (int)(i / ((long)NZE * D)), n = (int)((i / D) % NZE), k = (int)(i % D);
            P.wt_ev_in[i] = n < EV_IN ? f2bf(P.ev_w_in[((size_t)q * D + k) * EV_IN + n]) : (bf16_t)0; }
        GSL(i, 2L * NZO * D) { const int q = (int)(i / ((long)NZO * D)), n = (int)((i / D) % NZO), k = (int)(i % D);
            P.wt_od_in[i] = f2bf(P.od_w_in[((size_t)q * D + k) * NZO + n]); }
        GSL(i, 2L * D * D) { const int q = (int)(i / ((long)D * D)), n = (int)((i / D) % D), k = (int)(i % D);
            P.wt_ev_out[i] = f2bf(P.ev_w_out[((size_t)q * D + k) * D + n]);
            P.wt_od_out[i] = f2bf(P.od_w_out[((size_t)q * D + k) * D + n]); }
    } break;
    case ST_NORM_STATS_MIX: case ST_NORM_STATS_FFN: case ST_FINAL_STATS: {
        const int nrows = st == ST_FINAL_STATS ? RL : R;
        GSL(r, nrows) { const float* xr = st == ST_NORM_STATS_MIX ? xsrc_row(P, l, (int)r) : x_row(P, (int)r);
            float ss = 0.f; for (int j = 0; j < D; ++j) ss += xr[j] * xr[j];
            P.rinv[r] = rsq_(ss / D + EPS); }
    } break;
    case ST_NORM_APPLY_MIX: case ST_NORM_APPLY_FFN: {
        const bool mix = st == ST_NORM_APPLY_MIX;
        const float* g = (mix ? P.norm_mix_g : P.norm_ffn_g) + (size_t)l * D;
        GSL(i, (long)R * D) { const int r = (int)(i / D), j = (int)(i % D);
            const float* mr = modrow(P, l, row_bb(r));
            const float xv = mix ? xsrc_row(P, l, r)[j] : x_row(P, r)[j];
            const float hv = (xv * P.rinv[r] * g[j]) * (1.0f + mr[(mix ? 1 : 4) * D + j]) + mr[(mix ? 0 : 3) * D + j];
            P.h[i] = f2bf(hv); }
    } break;
    case ST_GEMM_IN: {
        EpiZ_ e; e.z = P.z; e.ldz = ldz;
        if (even) GEMM_CALL(false, P.h, P.wt_ev_in + (size_t)li * NZE * D, 1, R, NZE, D, e);
        else GEMM_CALL(false, P.h, P.wt_od_in + (size_t)li * NZO * D, 1, R, NZO, D, e);
    } break;
    case ST_E_LA: {
        GSL(i, 2L * NB * NCH * KEY) {
            const int col = (int)(i % KEY), c = (int)((i / KEY) % NCH), b = (int)((i / ((long)KEY * NCH)) % NB), dir = (int)(i / ((long)KEY * NCH * NB));
            const float* up = P.ev_decay_up + ((size_t)li * 2 + dir) * RANK * KEY;
            const float bias = P.ev_decay_b[((size_t)li * 2 + dir) * KEY + col];
            float acc = 0.f;
            for (int s = 0; s < CH; ++s) {
                const int sp = dir == 0 ? s : CH - 1 - s;
                const int row = seqrow(b, c * CH + sp);
                const bf16_t* lr = P.z + (size_t)row * ldz + (dir == 0 ? E_LRF : E_LRB);
                float xx = bias;
                for (int rr = 0; rr < RANK; ++rr) xx += bf2f(lr[rr]) * up[(size_t)rr * KEY + col];
                acc += logsigmoidf_(xx) * (1.0f / 16.0f);
                P.bcum[((size_t)dir * R + row) * KEY + col] = acc;
            }
        }
    } break;
    case ST_E_DS: {
        GSL(i, 2L * NB * GH * NCH * DK * DV) {
            const int e = (int)(i % DV), d = (int)((i / DV) % DK), c = (int)((i / ((long)DV * DK)) % NCH), hh = (int)((i / ((long)DV * DK * NCH)) % GH),
                      b = (int)((i / ((long)DV * DK * NCH * GH)) % NB), dir = (int)(i / ((long)DV * DK * NCH * GH * NB));
            const int rend = seqrow(b, c * CH + (dir == 0 ? CH - 1 : 0));
            const float bend = P.bcum[((size_t)dir * R + rend) * KEY + hh * DK + d];
            float acc = 0.f;
            for (int j = 0; j < CH; ++j) { const int row = seqrow(b, c * CH + j);
                const float kk = bf2f(P.z[(size_t)row * ldz + E_K + hh * DK + d]), vv = bf2f(P.z[(size_t)row * ldz + E_V + hh * DV + e]);
                acc += kk * expf(bend - P.bcum[((size_t)dir * R + row) * KEY + hh * DK + d]) * vv; }
            P.S[i] = acc;
        }
    } break;
    case ST_E_SCAN: {
        GSL(i, 2L * NB * GH * DK * DV) {
            const int e = (int)(i % DV), d = (int)((i / DV) % DK), hh = (int)((i / ((long)DV * DK)) % GH), b = (int)((i / ((long)DV * DK * GH)) % NB), dir = (int)(i / ((long)DV * DK * GH * NB));
            float s = 0.f;
            for (int step = 0; step < NCH; ++step) {
                const int c = dir == 0 ? step : (step < NCHC ? NCHC - 1 - step : NCH - 1 - (step - NCHC));
                const size_t idx = (((((size_t)dir * NB + b) * GH + hh) * NCH + c) * DK + d) * DV + e;
                const int rend = seqrow(b, c * CH + (dir == 0 ? CH - 1 : 0));
                const float dec = expf(P.bcum[((size_t)dir * R + rend) * KEY + hh * DK + d]);
                const float tmp = P.S[idx]; P.S[idx] = s; s = dec * s + tmp;
            }
        }
    } break;
    case ST_E_ATT: {
        const float scale = 1.0f / sqrtf((float)DK);
        GSL(i, 2L * NB * GH * NCH * CH * CH) {
            const int j = (int)(i % CH), ii = (int)((i / CH) % CH), c = (int)((i / ((long)CH * CH)) % NCH), hh = (int)((i / ((long)CH * CH * NCH)) % GH),
                      b = (int)((i / ((long)CH * CH * NCH * GH)) % NB), dir = (int)(i / ((long)CH * CH * NCH * GH * NB));
            float acc = 0.f;
            if (dir == 0 ? (j <= ii) : (j >= ii)) {
                const int ri = seqrow(b, c * CH + ii), rj = seqrow(b, c * CH + j);
                for (int d = 0; d < DK; ++d) {
                    const float qq = bf2f(P.z[(size_t)ri * ldz + E_Q + hh * DK + d]) * scale, kk = bf2f(P.z[(size_t)rj * ldz + E_K + hh * DK + d]);
                    acc += qq * kk * expf(P.bcum[((size_t)dir * R + ri) * KEY + hh * DK + d] - P.bcum[((size_t)dir * R + rj) * KEY + hh * DK + d]); }
            }
            P.att[i] = acc;
        }
    } break;
    case ST_E_O: {
        const float scale = 1.0f / sqrtf((float)DK);
        GSL(i, (long)NB * GH * NCH * CH * DV) {
            const int e = (int)(i % DV), ii = (int)((i / DV) % CH), c = (int)((i / ((long)DV * CH)) % NCH), hh = (int)((i / ((long)DV * CH * NCH)) % GH), b = (int)(i / ((long)DV * CH * NCH * GH));
            const int ri = seqrow(b, c * CH + ii);
            float acc = 0.f;
            for (int dir = 0; dir < 2; ++dir) {
                const size_t cb = ((((size_t)dir * NB + b) * GH + hh) * NCH + c);
                const float* at = P.att + (cb * CH + ii) * CH;
                for (int j = 0; j < CH; ++j) { const int rj = seqrow(b, c * CH + j); acc += at[j] * bf2f(P.z[(size_t)rj * ldz + E_V + hh * DV + e]); }
                const float* Sin = P.S + cb * DK * DV;
                for (int d = 0; d < DK; ++d) {
                    const float qq = bf2f(P.z[(size_t)ri * ldz + E_Q + hh * DK + d]) * scale;
                    acc += qq * expf(P.bcum[((size_t)dir * R + ri) * KEY + hh * DK + d]) * Sin[(size_t)d * DV + e]; }
            }
            P.o[(size_t)ri * W2 + hh * DV + e] = acc;
        }
    } break;
    case ST_E_READOUT: {
        const float* ng = P.ev_norm_g + (size_t)li * W2;
        GSL(i, (long)R * GH) { const int row = (int)(i / GH), hh = (int)(i % GH);
            const float* orow = P.o + (size_t)row * W2 + hh * DV;
            float ss = 0.f; for (int e = 0; e < DV; ++e) ss += orow[e] * orow[e];
            const float rinv = rsq_(ss / DV + EPS);
            for (int e = 0; e < DV; ++e) { const float g = bf2f(P.z[(size_t)row * ldz + E_G + hh * DV + e]);
                P.m[(size_t)row * D + W2 + hh * DV + e] = f2bf(orow[e] * rinv * ng[hh * DV + e] * siluf_(g)); }
        }
    } break;
    case ST_E_CONV: {
        const float* cw = P.ev_conv_w + (size_t)li * 3 * W2; const float* cb = P.ev_conv_b + (size_t)li * W2;
        GSL(i, (long)R * W2) { const int row = (int)(i / W2), col = (int)(i % W2);
            bool lv, rv;
            if (row < RL) { const int pos = (row % T) % GRIDW; lv = pos > 0; rv = pos < GRIDW - 1; }
            else { const int t = (row - RL) % TC; lv = t > 0; rv = t < TC - 1; }
            const bf16_t* zr = P.z + (size_t)row * ldz;
            float acc = cb[col] + cw[W2 + col] * (bf2f(zr[E_CG + col]) * bf2f(zr[E_XA + col]));
            if (lv) acc += cw[col] * (bf2f(zr[E_CG + col - ldz]) * bf2f(zr[E_XA + col - ldz]));
            if (rv) acc += cw[2 * W2 + col] * (bf2f(zr[E_CG + col + ldz]) * bf2f(zr[E_XA + col + ldz]));
            P.m[(size_t)row * D + col] = f2bf(bf2f(zr[E_BG + col]) * acc); }
    } break;
    case ST_O_XC: {
        const float* cw = P.od_conv_w + (size_t)li * 4 * W2; const float* cb = P.od_conv_b + (size_t)li * W2;
        GSL(i, (long)R * W2) { const int row = (int)(i / W2), col = (int)(i % W2);
            int t, len; if (row < RL) { t = row % T; len = T; } else { t = (row - RL) % TC; len = TC; }
            float acc = cb[col];
            for (int j = 0; j < 4; ++j) { const int tt = t - 2 + j; if (tt >= 0 && tt < len) acc += cw[j * W2 + col] * bf2f(P.z[(size_t)(row - 2 + j) * ldz + O_XB + col]); }
            P.xc[i] = acc; }
    } break;
    case ST_O_COEF: {
        GSL(i, 2L * R * W2) { const int col = (int)(i % W2), row = (int)((i / W2) % R), dir = (int)(i / ((long)W2 * R));
            const int hh = col / HD, jj = col % HD;
            const float* wa = P.od_gate_a_w + ((((size_t)li * 2 + dir) * 4 + hh) * HD) * HD + jj;
            const float* wx = P.od_gate_x_w + ((((size_t)li * 2 + dir) * 4 + hh) * HD) * HD + jj;
            const float* xr = P.xc + (size_t)row * W2 + hh * HD;
            float ra = P.od_gate_a_b[((size_t)li * 2 + dir) * W2 + col], rx = P.od_gate_x_b[((size_t)li * 2 + dir) * W2 + col];
            for (int k = 0; k < HD; ++k) { ra += xr[k] * wa[(size_t)k * HD]; rx += xr[k] * wx[(size_t)k * HD]; }
            const float rg = sigmoidf_(ra), ig = sigmoidf_(rx);
            const float log_a = -8.0f * rg * softplusf_(-P.od_lambda[((size_t)li * 2 + dir) * W2 + col]);
            P.A[i] = expf(log_a);
            P.Bc[i] = sqrtf(-expm1f(2.0f * log_a)) * (ig * P.xc[(size_t)row * W2 + col]); }
    } break;
    case ST_O_SCAN: {
        GSL(i, 2L * NB * W2) { const int col = (int)(i % W2), b = (int)((i / W2) % NB), dir = (int)(i / ((long)W2 * NB));
            float hc = 0.f;
            for (int step = 0; step < SEQ_ALL; ++step) {
                const int s = dir == 0 ? step : (step < TC ? TC - 1 - step : TC + (T - 1 - (step - TC)));
                const size_t idx = ((size_t)dir * R + seqrow(b, s)) * W2 + col;
                hc = P.A[idx] * hc + P.Bc[idx]; P.Bc[idx] = hc; }
        }
    } break;
    case ST_O_YREC: {
        GSL(i, (long)R * W2) { const int row = (int)(i / W2), col = (int)(i % W2);
            const float gb = bf2f(P.z[(size_t)row * ldz + O_GB + col]);
            P.m[(size_t)row * D + col] = f2bf((P.Bc[i] + P.Bc[(size_t)R * W2 + i]) * geluf_(gb)); }
    } break;
    case ST_O_SGSTAT: {
        GSL(r, R) { const bf16_t* vr = P.z + (size_t)r * ldz + O_V;
            float s = 0.f; for (int j = 0; j < W2; ++j) s += geluf_(bf2f(vr[j]));
            const float mean = s / W2; float vs = 0.f;
            for (int j = 0; j < W2; ++j) { const float dlt = geluf_(bf2f(vr[j])) - mean; vs += dlt * dlt; }
            P.sgstat[2 * r] = mean; P.sgstat[2 * r + 1] = rsq_(vs / W2 + EPS); }
    } break;
    case ST_O_VB: {
        const float* gn = P.od_sg_norm_g + (size_t)li * W2;
        GSL(i, (long)R * W2) { const int row = (int)(i / W2), col = (int)(i % W2);
            P.vb[i] = (geluf_(bf2f(P.z[(size_t)row * ldz + O_V + col])) - P.sgstat[2 * row]) * P.sgstat[2 * row + 1] * gn[col]; }
    } break;
    case ST_O_SGMIX: {
        GSL(i, (long)R * W2) { const int row = (int)(i / W2), col = (int)(i % W2);
            const int t = row < RL ? row % T : (row - RL) % TC;
            const int ii = t % SGC, base = row - ii, g = col / HD;
            const float* w = P.od_sg_w + (((size_t)li * 4 + g) * SGC + ii) * SGC;
            float acc = P.od_sg_b[((size_t)li * 4 + g) * SGC + ii];
            for (int j = 0; j < SGC; ++j) acc += w[j] * P.vb[(size_t)(base + j) * W2 + col];
            P.m[(size_t)row * D + W2 + col] = f2bf(geluf_(bf2f(P.z[(size_t)row * ldz + O_U + col])) * acc); }
    } break;
    case ST_GEMM_OUT: {
        EpiWout_ e; e.P = &P; e.l = l;
        GEMM_CALL(false, P.m, (even ? P.wt_ev_out : P.wt_od_out) + (size_t)li * D * D, 1, R, D, D, e);
    } break;
    case ST_ROUTER_LOGIT: {
        const float* g = P.norm_ffn_g + (size_t)l * D; const float* wr = P.moe_router + (size_t)l * D * NE;
        GSL(i, (long)R * NE) { const int r = (int)(i / NE), e = (int)(i % NE);
            const float* mr = modrow(P, l, row_bb(r)); const float* xr = x_row(P, r); const float ri = P.rinv[r];
            float acc = 0.f;
            for (int j = 0; j < D; ++j) acc += ((xr[j] * ri * g[j]) * (1.0f + mr[4 * D + j]) + mr[3 * D + j]) * wr[(size_t)j * NE + e];
            P.logit[i] = acc; }
    } break;
    case ST_ROUTER_SOFTMAX: {
        GSL(r, R) { const float* lg = P.logit + (size_t)r * NE; float mx = lg[0]; for (int e = 1; e < NE; ++e) mx = fmaxf(mx, lg[e]);
            float ex[NE]; float s = 0.f;
#pragma unroll
            for (int e = 0; e < NE; ++e) { ex[e] = expf(lg[e] - mx); s += ex[e]; }
#pragma unroll
            for (int e = 0; e < NE; ++e) P.aff[(size_t)r * NE + e] = ex[e] / s; }
    } break;
    case ST_MOE_WCONV: {
        const float* wg = P.moe_w_gate + (size_t)l * NE * D * D; const float* wu = P.moe_w_up + (size_t)l * NE * D * D; const float* wd = P.moe_w_down + (size_t)l * NE * D * D;
        GSL(i, (long)NE * 2 * D * D) { const int e = (int)(i / (2L * D * D)), cv = (int)((i / D) % (2 * D)), k = (int)(i % D);
            const int w = cv % 64, j = (cv / 64) * 32 + (w % 32);
            P.wt_gu[i] = f2bf((w >= 32 ? wu : wg)[((size_t)e * D + k) * D + j]); }
        GSL(i, (long)NE * D * D) { const int e = (int)(i / ((long)D * D)), n = (int)((i / D) % D), k = (int)(i % D);
            P.wt_dn[i] = f2bf(wd[((size_t)e * D + k) * D + n]); }
    } break;
    case ST_SELECT: {
        GSL(i, (long)R * NE) { const int e = (int)(i / R), r = (int)(i % R);
            int base, n, cap, slot0;
            if (r < RL) { const int b = r / T; base = b * T; n = T; cap = CAPL; slot0 = b * CAPL; }
            else { const int b = (r - RL) / TC; base = RL + b * TC; n = TC; cap = CAPC; slot0 = NB * CAPL + b * CAPC; }
            const float a = P.aff[(size_t)r * NE + e];
            int rank = 0;
            for (int t = 0; t < n; ++t) { const float o = P.aff[(size_t)(base + t) * NE + e]; rank += (o > a || (o == a && base + t < r)) ? 1 : 0; }
            if (rank < cap) { const int slot = e * SLOTS_E + slot0 + rank; P.sel_row[slot] = r; P.sel_g[slot] = a; P.inv[(size_t)r * NE + e] = slot; }
            else P.inv[(size_t)r * NE + e] = -1; }
    } break;
    case ST_GATHER: {
        GSL(i, (long)SLOTS * D) { const int slot = (int)(i / D), j = (int)(i % D); P.xg[i] = P.h[(size_t)P.sel_row[slot] * D + j]; }
    } break;
    case ST_GEMM_GU: {
        EpiGU_ e; e.hid = P.hid;
        GEMM_CALL(true, P.xg, P.wt_gu, NE, SLOTS_E, 2 * D, D, e);
    } break;
    case ST_GEMM_DOWN: {
        EpiDown_ e; e.out = P.outslot; e.selg = P.sel_g;
        GEMM_CALL(false, P.hid, P.wt_dn, NE, SLOTS_E, D, D, e);
    } break;
    case ST_COMBINE: {
        GSL(i, (long)R * D) { const int r = (int)(i / D), j = (int)(i % D);
            float s = 0.f;
            for (int e = 0; e < NE; ++e) { const int sl = P.inv[(size_t)r * NE + e]; if (sl >= 0) s += bf2f(P.outslot[(size_t)sl * D + j]); }
            float* xr = x_row(P, r); xr[j] += modrow(P, l, row_bb(r))[5 * D + j] * s; }
    } break;
    case ST_FINAL_APPLY: {
        GSL(i, (long)RL * D) { const int r = (int)(i / D), j = (int)(i % D); P.xlat[i] = P.xlat[i] * P.rinv[r] * P.norm_final_g[j]; }
    } break;
    default: break;
    }
}

template <class F> inline void stage_program(F&& run) {
    run(0, ST_SILU); run(0, ST_MOD); run(0, ST_WCONV);
    for (int l = 0; l < DEPTH; ++l) {
        run(l, ST_NORM_STATS_MIX); run(l, ST_NORM_APPLY_MIX); run(l, ST_GEMM_IN);
        if ((l & 1) == 0) { run(l, ST_E_LA); run(l, ST_E_DS); run(l, ST_E_SCAN); run(l, ST_E_ATT); run(l, ST_E_O); run(l, ST_E_READOUT); run(l, ST_E_CONV); }
        else { run(l, ST_O_XC); run(l, ST_O_COEF); run(l, ST_O_SCAN); run(l, ST_O_YREC); run(l, ST_O_SGSTAT); run(l, ST_O_VB); run(l, ST_O_SGMIX); }
        run(l, ST_GEMM_OUT);
        run(l, ST_NORM_STATS_FFN); run(l, ST_NORM_APPLY_FFN); run(l, ST_ROUTER_LOGIT); run(l, ST_ROUTER_SOFTMAX); run(l, ST_MOE_WCONV);
        run(l, ST_SELECT); run(l, ST_GATHER); run(l, ST_GEMM_GU); run(l, ST_GEMM_DOWN); run(l, ST_COMBINE);
    }
    run(0, ST_FINAL_STATS); run(0, ST_FINAL_APPLY);
}

struct Carver { char* base; size_t off; template <class Tp> Tp* take(size_t n) { off = (off + 255) & ~(size_t)255; Tp* p = (Tp*)(base + off); off += n * sizeof(Tp); return p; } };
inline size_t carve(Params& p, void* d_ws) {
    Carver cv{(char*)d_ws, 0};
    p.bar = cv.take<unsigned>(4096);
    p.mod = cv.take<float>((size_t)DEPTH * (NB + 1) * MODW); p.sbuf = cv.take<float>((size_t)(NB + 1) * D); p.xctx = cv.take<float>((size_t)RC * D);
    p.rinv = cv.take<float>(R); p.aff = cv.take<float>((size_t)R * NE); p.logit = cv.take<float>((size_t)R * NE); p.sel_g = cv.take<float>(SLOTS);
    p.sel_row = cv.take<int>(SLOTS); p.inv = cv.take<int>((size_t)R * NE);
    p.wt_ev_in = cv.take<bf16_t>(2ull * NZE * D); p.wt_od_in = cv.take<bf16_t>(2ull * NZO * D); p.wt_ev_out = cv.take<bf16_t>(2ull * D * D); p.wt_od_out = cv.take<bf16_t>(2ull * D * D);
    p.wt_gu = cv.take<bf16_t>((size_t)NE * 2 * D * D); p.wt_dn = cv.take<bf16_t>((size_t)NE * D * D); p.h = cv.take<bf16_t>((size_t)R * D);
    const size_t u0 = (cv.off + 255) & ~(size_t)255;
    p.z = cv.take<bf16_t>((size_t)R * NZE); p.m = cv.take<bf16_t>((size_t)R * D);
    const size_t u1 = cv.off;
    p.bcum = cv.take<float>(2ull * R * KEY); p.S = cv.take<float>(2ull * NB * GH * NCH * DK * DV); p.att = cv.take<float>(2ull * NB * GH * NCH * CH * CH); p.o = cv.take<float>((size_t)R * W2);
    size_t end = cv.off;
    cv.off = u1;
    p.xc = cv.take<float>((size_t)R * W2); p.A = cv.take<float>(2ull * R * W2); p.Bc = cv.take<float>(2ull * R * W2); p.sgstat = cv.take<float>(2ull * R); p.vb = cv.take<float>((size_t)R * W2);
    if (cv.off > end) end = cv.off;
    cv.off = u0;
    p.xg = cv.take<bf16_t>((size_t)SLOTS * D); p.hid = cv.take<bf16_t>((size_t)SLOTS * D); p.outslot = cv.take<bf16_t>((size_t)SLOTS * D);
    if (cv.off > end) end = cv.off;
    return end;
}
inline void fill_inputs(Params& p, void* const* d_in, void* d_out) {
    const float* const* in = (const float* const*)d_in;
    p.x = in[0]; p.c = in[1]; p.ctx = in[2]; p.c_ctx = in[3]; p.ada_w = in[4]; p.ada_b = in[5]; p.norm_mix_g = in[6]; p.norm_ffn_g = in[7]; p.norm_final_g = in[8];
    p.ev_w_in = in[9]; p.ev_conv_w = in[10]; p.ev_conv_b = in[11]; p.ev_decay_up = in[12]; p.ev_decay_b = in[13]; p.ev_norm_g = in[14]; p.ev_w_out = in[15];
    p.od_w_in = in[16]; p.od_conv_w = in[17]; p.od_conv_b = in[18]; p.od_gate_a_w = in[19]; p.od_gate_a_b = in[20]; p.od_gate_x_w = in[21]; p.od_gate_x_b = in[22];
    p.od_lambda = in[23]; p.od_sg_norm_g = in[24]; p.od_sg_w = in[25]; p.od_sg_b = in[26]; p.od_w_out = in[27];
    p.moe_router = in[28]; p.moe_w_gate = in[29]; p.moe_w_up = in[30]; p.moe_w_down = in[31];
    p.xlat = (float*)d_out;
}

#ifndef CPU_EMU
__global__ void __launch_bounds__(256, 2) k_stage(Params P, int l, int st) {
    extern __shared__ __attribute__((aligned(16))) bf16_t shm[];
    do_stage(P, l, st, shm);
}

extern "C" void kernel_launch(void* const* d_in, const int* in_sizes, int n_in, void* d_out, int out_size, void* d_ws, size_t ws_size, hipStream_t stream) {
    Params p{};
    fill_inputs(p, d_in, d_out);
    const size_t need = carve(p, d_ws);
    if (need > ws_size) { fprintf(stderr, "workspace too small: need %zu have %zu\n", need, ws_size); return; }
    stage_program([&](int l, int st) {
        hipLaunchKernelGGL(k_stage, dim3(2048), dim3(256), GEMM_LDS_BYTES, stream, p, l, st);
    });
}
#endif
```

```cpp
#ifndef CPU_EMU
#include <hip/hip_runtime.h>
#include <cstdio>
#include <cstring>
#define DEV __device__ __forceinline__
#else
#define DEV inline
#endif
#include <cstdint>
#include <cstddef>

#ifndef D_MODEL
#define D_MODEL 1024
#define BATCH 8
#define SEQ 4096
#define CTXL 256
#endif

#ifndef PROBE_SET
#define PROBE_SET 0
#endif
typedef unsigned short bf16_t;
constexpr int D = D_MODEL, NB = BATCH, T = SEQ, TC = CTXL, DEPTH = 4;
constexpr int RL = NB * T, RC = NB * TC, R = RL + RC;
constexpr int W2 = D / 2;
constexpr int GH = 4, DV = W2 / GH, DK = DV / 2, KEY = GH * DK, RANK = 16, CH = 64, GRIDW = 64;
constexpr int EV_IN = 3 * W2 + KEY + W2 + KEY + W2 + 2 * RANK;
constexpr int NZE = ((EV_IN + 255) / 256) * 256, NZO = 4 * W2;
constexpr int E_BG = 0, E_CG = W2, E_XA = 2 * W2, E_Q = 3 * W2, E_G = E_Q + KEY, E_K = E_G + W2, E_V = E_K + KEY, E_LRF = E_V + W2, E_LRB = E_LRF + RANK;
constexpr int O_XB = 0, O_GB = W2, O_U = 2 * W2, O_V = 3 * W2;
constexpr int NE = 16, CAPL = 2 * T / NE, CAPC = 2 * TC / NE, SLOTS_E = NB * (CAPL + CAPC), SLOTS = NE * SLOTS_E;
constexpr int SEQ_ALL = TC + T, NCH = SEQ_ALL / CH, NCHC = TC / CH;
constexpr int SGC = 128, HD = W2 / 4;
constexpr float EPS = 1e-6f;
constexpr int MODW = 6 * D;

struct Params {
    const float *x, *c, *ctx, *c_ctx, *ada_w, *ada_b, *norm_mix_g, *norm_ffn_g, *norm_final_g;
    const float *ev_w_in, *ev_conv_w, *ev_conv_b, *ev_decay_up, *ev_decay_b, *ev_norm_g, *ev_w_out;
    const float *od_w_in, *od_conv_w, *od_conv_b, *od_gate_a_w, *od_gate_a_b, *od_gate_x_w, *od_gate_x_b, *od_lambda, *od_sg_norm_g, *od_sg_w, *od_sg_b, *od_w_out;
    const float *moe_router, *moe_w_gate, *moe_w_up, *moe_w_down;
    float* xlat;
    float *xctx, *mod, *sbuf, *rinv, *aff, *logit, *sel_g;
    int *sel_row, *inv;
    bf16_t *wt_ev_in, *wt_od_in, *wt_ev_out, *wt_od_out, *wt_gu, *wt_dn, *h, *gwT, *sgw;
    float *sumA, *sumB, *decv, *hinb, *ssqp;
    bf16_t *z, *m;
    float *bcum, *S, *att, *o;
    float *xc, *A, *Bc, *sgstat, *vb;
    bf16_t *xg, *hid, *outslot;
    bf16_t *SinB, *Sd;
    bf16_t* xb;
    unsigned* bar; unsigned* wq;
};

DEV float bf2f(bf16_t v) { union { unsigned u; float f; } c; c.u = (unsigned)v << 16; return c.f; }
DEV bf16_t f2bf(float f) { union { unsigned u; float f; } c; c.f = f; unsigned u = c.u; u += 0x7fffu + ((u >> 16) & 1u); return (bf16_t)(u >> 16); }
DEV float sigmoidf_(float x) { return 1.0f / (1.0f + expf(-x)); }
DEV float siluf_(float x) { return x / (1.0f + expf(-x)); }
DEV float softplusf_(float x) { return fmaxf(x, 0.0f) + log1pf(expf(-fabsf(x))); }
DEV float logsigmoidf_(float x) { return fminf(x, 0.0f) - log1pf(expf(-fabsf(x))); }
DEV float geluf_(float x) { return 0.5f * x * (1.0f + tanhf(0.7978845608028654f * (x + 0.044715f * x * x * x))); }
DEV float rsq_(float x) { return 1.0f / sqrtf(x); }

DEV const float* xsrc_row(const Params& P, int l, int r) {
    if (l == 0) return r < RL ? P.x + (size_t)r * D : P.ctx + (size_t)(r - RL) * D;
    return r < RL ? P.xlat + (size_t)r * D : P.xctx + (size_t)(r - RL) * D;
}
DEV float* x_row(const Params& P, int r) { return r < RL ? P.xlat + (size_t)r * D : P.xctx + (size_t)(r - RL) * D; }
DEV int row_bb(int r) { return r < RL ? r / T : NB; }
DEV int seqrow(int b, int s) { return s < TC ? RL + b * TC + s : b * T + (s - TC); }
DEV const float* modrow(const Params& P, int l, int bb) { return P.mod + ((size_t)l * (NB + 1) + bb) * MODW; }

#define GSL(i, n) for (long i = (long)blockIdx.x * blockDim.x + tid_; i < (long)(n); i += (long)gridDim.x * blockDim.x)

enum {
    ST_SILU = 0, ST_MOD, ST_WCONV,
    ST_NORM_STATS_MIX, ST_NORM_APPLY_MIX, ST_GEMM_IN,
    ST_E_LA, ST_E_DS, ST_E_SCAN, ST_E_ATT, ST_E_O, ST_E_READOUT, ST_E_CONV,
    ST_O_XC, ST_O_COEF, ST_O_SCAN, ST_O_YREC, ST_O_SGSTAT, ST_O_VB, ST_O_SGMIX,
    ST_GEMM_OUT,
    ST_NORM_STATS_FFN, ST_NORM_APPLY_FFN, ST_ROUTER_LOGIT, ST_ROUTER_SOFTMAX, ST_MOE_WCONV, ST_SELECT, ST_GATHER, ST_GEMM_GU, ST_GEMM_DOWN, ST_COMBINE,
    ST_FINAL_STATS, ST_FINAL_APPLY,
    ST_ROW_MIX, ST_ROW_FFN, ST_ROW_FINAL, ST_SELECT_WCONV, ST_GATHER2, ST_ODD1, ST_ODD3, ST_EVEN1, ST_EVEN2, ST_EVEN3, ST_ODD2, ST_COUNT
};

struct EpiZ {
    bf16_t* z; int ldz;
    DEV void elem(int row, int col, float v) const { z[(size_t)row * ldz + col] = f2bf(v); }
};
struct EpiWout {
    const Params* P; int l;
    DEV void elem(int row, int col, float v) const {
        const float* mr = modrow(*P, l, row_bb(row));
        x_row(*P, row)[col] = xsrc_row(*P, l, row)[col] + mr[2 * D + col] * v;
    }
};
struct EpiGU {
    bf16_t* hid;
    DEV void pair(int row, int j, float g, float u) const { hid[(size_t)row * D + j] = f2bf(siluf_(g) * u); }
};
struct EpiDown {
    bf16_t* out; const float* selg;
    DEV void elem(int row, int col, float v) const { out[(size_t)row * D + col] = f2bf(v * selg[row]); }
};

#ifdef CPU_EMU
template <bool PAIR, class Epi>
void gemm_stage(const bf16_t* A, const bf16_t* Bt, int G, int Mg, int N, int K, const Epi& epi) {
    const int tid_ = threadIdx.x;
    GSL(i, (long)G * Mg) {
        const int g = (int)(i / Mg); const int row = (int)i;
        const bf16_t* a = A + (size_t)row * K;
        if (!PAIR) {
            for (int n = 0; n < N; ++n) { const bf16_t* b = Bt + ((size_t)g * N + n) * K; float s = 0.f; for (int k = 0; k < K; ++k) s += bf2f(a[k]) * bf2f(b[k]); epi.elem(row, n, s); }
        } else {
            for (int j = 0; j < N / 2; ++j) {
                const int cg = (j / 128) * 256 + (j % 128), cu = cg + 128;
                const bf16_t* bg = Bt + ((size_t)g * N + cg) * K; const bf16_t* bu = Bt + ((size_t)g * N + cu) * K;
                float sg = 0.f, su = 0.f; for (int k = 0; k < K; ++k) { sg += bf2f(a[k]) * bf2f(bg[k]); su += bf2f(a[k]) * bf2f(bu[k]); }
                epi.pair_(row, j, sg, su);
            }
        }
    }
}
#else
namespace pg8 {
#define PG8_LAS __attribute__((address_space(3)))
typedef short bf16x8 __attribute__((ext_vector_type(8)));
typedef float f32x4 __attribute__((ext_vector_type(4)));
typedef unsigned u32x4 __attribute__((ext_vector_type(4)));
constexpr int BM = 256, BK = 64, HALF = 128, HTB = HALF * BK * 2, STAGE_BYTES = 8 * HTB, NXCD = 8, WGM = 8;
__host__ __device__ __forceinline__ int lds_byte(int r, int c) { const int st = (r >> 4) * 2 + (c >> 5), rr = r & 15, cc = c & 31, ob = rr * 64 + cc * 2; return st * 1024 + (ob ^ (((ob >> 9) & 1) << 5)); }
__host__ __device__ __forceinline__ void stage_rc(int b, int& R_, int& C_) { const int st = b / 1024, sb = b % 1024, swz = sb ^ (((sb >> 9) & 1) << 5); R_ = (st >> 1) * 16 + swz / 64; C_ = (st & 1) * 32 + (swz % 64) / 2; }
__host__ __device__ __forceinline__ int perm32(int rho) { const int n = rho >> 4, i = rho & 15; return 8 * (i >> 2) + 4 * n + (i & 3); }
struct Unit { int pm, pn; };
struct Gemm { const bf16_t* A; const bf16_t* Bt; int K; };
struct StaticOrder {
    int nM, nN, nwg, G, c;
    __device__ __forceinline__ void init(int M, int N, int G_, int c_) { nM = M / BM; nN = N / BM; nwg = nM * nN; G = G_; c = c_; }
    __device__ __forceinline__ bool next(int i, Unit& u) const {
        const long L = (long)i * G + c; if (L >= nwg) return false;
        int wgid = (int)L; { const int q = nwg / NXCD, r = nwg % NXCD, xcd = wgid % NXCD, off = wgid / NXCD; wgid = (xcd < r ? xcd * (q + 1) : r * (q + 1) + (xcd - r) * q) + off; }
        const int nig = WGM * nN, gid = wgid / nig, fm = gid * WGM, gsz = (nM - fm) < WGM ? (nM - fm) : WGM;
        u.pm = fm + ((wgid % nig) % gsz); u.pn = (wgid % nig) / gsz; return true;
    }
    __device__ __forceinline__ void a_ready(const Unit&) const {}
    __device__ __forceinline__ void done(const Unit&) const {}
};
struct GroupedOrder {
    int nMg, nMs, nN, total, G, c;
    __device__ __forceinline__ void init(int Mg_used, int Mg_stride, int N, int groups, int G_, int c_) { nMg = Mg_used / BM; nMs = Mg_stride / BM; nN = N / BM; total = groups * nMg * nN; G = G_; c = c_; }
    __device__ __forceinline__ bool next(int i, Unit& u) const {
        const long L = (long)i * G + c; if (L >= total) return false;
        int wgid = (int)L; { const int q = total / NXCD, r = total % NXCD, xcd = wgid % NXCD, off = wgid / NXCD; wgid = (xcd < r ? xcd * (q + 1) : r * (q + 1) + (xcd - r) * q) + off; }
        const int per = nMg * nN, g = wgid / per, rem = wgid % per;
        const int nig = WGM * nN, gid = rem / nig, fm = gid * WGM, gsz = (nMg - fm) < WGM ? (nMg - fm) : WGM;
        const int pm_l = fm + ((rem % nig) % gsz), pn_l = (rem % nig) / gsz;
        u.pm = g * nMs + pm_l; u.pn = g * nN + pn_l; return true;
    }
    __device__ __forceinline__ void a_ready(const Unit&) const {}
    __device__ __forceinline__ void done(const Unit&) const {}
};
typedef __bf16 bf16x2_n __attribute__((ext_vector_type(2)));
typedef float f32x2_n __attribute__((ext_vector_type(2)));
__device__ __forceinline__ unsigned cvt_pk_bf16(float lo, float hi) { const f32x2_n v = {lo, hi}; const bf16x2_n r = __builtin_convertvector(v, bf16x2_n); return __builtin_bit_cast(unsigned, r); }

typedef int i32x4 __attribute__((ext_vector_type(4)));
typedef int i32x8 __attribute__((ext_vector_type(8)));
__device__ __forceinline__ i32x8 frag_cat(bf16x8 lo, bf16x8 hi) { return __builtin_shufflevector(__builtin_bit_cast(i32x4, lo), __builtin_bit_cast(i32x4, hi), 0, 1, 2, 3, 4, 5, 6, 7); }
template <bool FP8> struct Frags { bf16x8 At[4][2], B0[2][2], B1[2][2]; };
template <> struct Frags<true> { i32x8 At[4], B0[2], B1[2]; };
template <bool GATHER, bool FP8, class Epi, class Sched>
__device__ __forceinline__ void gemm_phase(PG8_LAS unsigned char* lds, const Gemm g, const Sched& S, const Epi& E, const int tid, const PG8_LAS int* gix = nullptr) {
    const int wid = __builtin_amdgcn_readfirstlane(tid >> 6), lane = tid & 63, wr = wid >> 2, wc = wid & 3, fr = lane & 15, fq = lane >> 4;
    const int K = g.K, rowb = FP8 ? K : 2 * K, nt = rowb / (BK * 2);
    unsigned voffA[2], voffB[2];
#pragma unroll
    for (int i = 0; i < 2; ++i) { int R_, C_; stage_rc(tid * 16 + i * 8192, R_, C_); const int Rb = Epi::PERM ? ((R_ & ~31) + perm32(R_ & 31)) : R_;
        voffA[i] = (unsigned)(R_ * rowb + C_ * 2); voffB[i] = (unsigned)(Rb * rowb + C_ * 2); }
    unsigned gv[2][2];
#define PG8_GV(kk) do { _Pragma("unroll") for (int _i = 0; _i < 2; ++_i) { int _R, _C; stage_rc(tid * 16 + _i * 8192, _R, _C); _Pragma("unroll") for (int _h = 0; _h < 2; ++_h) \
        gv[_h][_i] = (unsigned)gix[(kk) * 256 + _h * 128 + _R] * (unsigned)rowb + (unsigned)_C * 2u; } } while (0)
#define PG8_UBASE(p) ({ const char* _ub = (const char*)(p); asm volatile("" : "+s"(_ub)); _ub; })
#define PG8_STAGE_A(bufoff, hf, kb, nx) do { if constexpr (GATHER) { const char* _gb = PG8_UBASE((const char*)g.A + (kb)); _Pragma("unroll") for (int _i = 0; _i < 2; ++_i) \
        __builtin_amdgcn_global_load_lds((const unsigned*)(_gb + gv[hf][_i]), (PG8_LAS unsigned*)(lds + (bufoff) + ldsw + _i * 8192), 16, 0, 0); } \
      else { const char* _gb = PG8_UBASE(((nx) ? nA : cA) + (kb) + (hf) * hstep); _Pragma("unroll") for (int _i = 0; _i < 2; ++_i) \
        __builtin_amdgcn_global_load_lds((const unsigned*)(_gb + voffA[_i]), (PG8_LAS unsigned*)(lds + (bufoff) + ldsw + _i * 8192), 16, 0, 0); } } while (0)
    const size_t kstep = (size_t)(BK * 2);
    const size_t hstep = (size_t)HALF * rowb;
    const size_t tstep = 2 * hstep;
    const unsigned ldsw = (unsigned)wid * 1024u;
    const int aoffk0 = FP8 ? lds_byte(wr * 64 + fr, fq * 16) : lds_byte(wr * 64 + fr, fq * 8), aoffk1 = FP8 ? lds_byte(wr * 64 + fr, fq * 16 + 8) : aoffk0 + 1024;
    const int boffk0 = FP8 ? lds_byte(wc * 32 + fr, fq * 16) : lds_byte(wc * 32 + fr, fq * 8), boffk1 = FP8 ? lds_byte(wc * 32 + fr, fq * 16 + 8) : boffk0 + 1024;
#define PG8_SA(b, h) (((b) * 2 + (h)) * HTB)
#define PG8_SB(b, h) ((4 + (b) * 2 + (h)) * HTB)
#define PG8_STAGE(bufoff, gbase, voff) do { const char* _gb = PG8_UBASE(gbase); _Pragma("unroll") for (int _i = 0; _i < 2; ++_i) \
        __builtin_amdgcn_global_load_lds((const unsigned*)(_gb + (voff)[_i]), (PG8_LAS unsigned*)(lds + (bufoff) + ldsw + _i * 8192), 16, 0, 0); } while (0)
#define PG8_LD16(off) (*(const PG8_LAS bf16x8*)(lds + (off)))
#define PG8_LDA(dst, b, h) do { _Pragma("unroll") for (int m = 0; m < 4; ++m) { \
        if constexpr (FP8) F.dst[m] = frag_cat(PG8_LD16(PG8_SA(b, h) + aoffk0 + m * 2048), PG8_LD16(PG8_SA(b, h) + aoffk1 + m * 2048));     \
        else { F.dst[m][0] = PG8_LD16(PG8_SA(b, h) + aoffk0 + m * 2048); F.dst[m][1] = PG8_LD16(PG8_SA(b, h) + aoffk1 + m * 2048); } } } while (0)
#define PG8_LDB(dst, b, h) do { _Pragma("unroll") for (int n = 0; n < 2; ++n) { \
        if constexpr (FP8) F.dst[n] = frag_cat(PG8_LD16(PG8_SB(b, h) + boffk0 + n * 2048), PG8_LD16(PG8_SB(b, h) + boffk1 + n * 2048)); \
        else { F.dst[n][0] = PG8_LD16(PG8_SB(b, h) + boffk0 + n * 2048); F.dst[n][1] = PG8_LD16(PG8_SB(b, h) + boffk1 + n * 2048); } } } while (0)
#define PG8_MMA(ai, bj, At, Bt) do { __builtin_amdgcn_s_setprio(1); _Pragma("unroll") for (int m = 0; m < 4; ++m) _Pragma("unroll") for (int n = 0; n < 2; ++n) { \
        if constexpr (FP8) asm volatile("v_mfma_scale_f32_16x16x128_f8f6f4 %0, %1, %2, %0, %3, %3 op_sel_hi:[0,0,0]" : "+v"(acc[ai][bj][m][n]) : "v"(F.Bt[n]), "v"(F.At[m]), "v"(scale1)); \
        else { _Pragma("unroll") for (int k = 0; k < 2; ++k) acc[ai][bj][m][n] = __builtin_amdgcn_mfma_f32_16x16x32_bf16(F.Bt[n][k], F.At[m][k], acc[ai][bj][m][n], 0, 0, 0); } } \
        __builtin_amdgcn_s_setprio(0); } while (0)
#define PG8_WAIT_V(n) asm volatile("s_waitcnt vmcnt(" #n ")" ::: "memory")
#define PG8_WAIT_L(n) asm volatile("s_waitcnt lgkmcnt(" #n ")" ::: "memory")
#define PG8_BAR __builtin_amdgcn_s_barrier()
#define PG8_SCHED __builtin_amdgcn_sched_barrier(0)
    Unit cur, nxt; int ui = 0;
    if (!S.next(0, cur)) return;
    f32x4 acc[2][2][4][2];
#pragma unroll
    for (int a = 0; a < 2; ++a)
#pragma unroll
        for (int b = 0; b < 2; ++b)
#pragma unroll
            for (int m = 0; m < 4; ++m)
#pragma unroll
                for (int n = 0; n < 2; ++n) acc[a][b][m][n] = (f32x4){0.f, 0.f, 0.f, 0.f};
    Frags<FP8> F;
    int scale1 = 127; asm volatile("" : "+v"(scale1));
    const char* cA = (const char*)g.A + (size_t)cur.pm * tstep; const char* cB = (const char*)g.Bt + (size_t)cur.pn * tstep;
    const char* nA = cA;
    if constexpr (GATHER) { PG8_GV(0); }
    S.a_ready(cur);
    PG8_STAGE(PG8_SB(0, 0), cB, voffB); PG8_STAGE_A(PG8_SA(0, 0), 0, (size_t)0, false); PG8_STAGE(PG8_SB(0, 1), cB + hstep, voffB); PG8_STAGE_A(PG8_SA(0, 1), 1, (size_t)0, false);
    if (wr == 1) PG8_BAR;
    PG8_WAIT_V(4); PG8_BAR;
    PG8_STAGE(PG8_SB(1, 0), cB + kstep, voffB); PG8_STAGE_A(PG8_SA(1, 0), 0, kstep, false); PG8_STAGE(PG8_SB(1, 1), cB + hstep + kstep, voffB);
    PG8_WAIT_V(6); PG8_BAR;
    for (;;) {
        const bool has_next = S.next(ui + 1, nxt);
        nA = has_next ? (const char*)g.A + (size_t)nxt.pm * tstep : cA; const char* nB = has_next ? (const char*)g.Bt + (size_t)nxt.pn * tstep : cB;
        constexpr int KREP = PROBE_SET == 30 ? 2 : 1;
#pragma nounroll
        for (int t = 0; t < nt * KREP; t += 2) {
            const bool last = (t == nt * KREP - 2);
            const size_t ka1 = (size_t)((t + 1) % nt) * kstep, ka2 = last ? (size_t)0 : (size_t)((t + 2) % nt) * kstep, ka3 = ka2 + kstep;
            const char* b2 = last ? nB : cB + (size_t)((t + 2) % nt) * kstep;
            const char* b3 = b2 + kstep;
            if (last && has_next) S.a_ready(nxt);
            PG8_LDB(B0, 0, 0); PG8_SCHED; PG8_LDA(At, 0, 0); PG8_STAGE_A(PG8_SA(1, 1), 1, ka1, false);
            PG8_WAIT_L(8); PG8_BAR; PG8_WAIT_L(0); PG8_MMA(0, 0, At, B0); PG8_BAR; PG8_SCHED;
            if constexpr (GATHER) { if (last && has_next) { PG8_GV(ui + 1); } }
            PG8_LDB(B1, 0, 1); PG8_STAGE(PG8_SB(0, 0), b2, voffB);
            PG8_BAR; PG8_WAIT_L(0); PG8_MMA(0, 1, At, B1); PG8_BAR;
            PG8_LDA(At, 0, 1); PG8_STAGE_A(PG8_SA(0, 0), 0, ka2, last);
            PG8_BAR; PG8_WAIT_L(0); PG8_MMA(1, 0, At, B0); PG8_BAR; PG8_SCHED;
            PG8_STAGE(PG8_SB(0, 1), b2 + hstep, voffB);
            PG8_WAIT_V(6); PG8_BAR; PG8_MMA(1, 1, At, B1); PG8_BAR;
            PG8_LDB(B0, 1, 0); PG8_SCHED; PG8_LDA(At, 1, 0); PG8_STAGE_A(PG8_SA(0, 1), 1, ka2, last);
            PG8_WAIT_L(8); PG8_BAR; PG8_WAIT_L(0); PG8_MMA(0, 0, At, B0); PG8_BAR; PG8_SCHED;
            PG8_LDB(B1, 1, 1); PG8_STAGE(PG8_SB(1, 0), b3, voffB);
            PG8_BAR; PG8_WAIT_L(0); PG8_MMA(0, 1, At, B1); PG8_BAR;
            PG8_LDA(At, 1, 1); PG8_STAGE_A(PG8_SA(1, 0), 0, ka3, last);
            PG8_BAR; PG8_WAIT_L(0); PG8_MMA(1, 0, At, B0); PG8_BAR; PG8_SCHED;
            PG8_STAGE(PG8_SB(1, 1), b3 + hstep, voffB);
            PG8_WAIT_V(6); PG8_BAR; PG8_MMA(1, 1, At, B1); PG8_BAR;
        }
        if constexpr (KREP > 1) {
#pragma unroll
            for (int a = 0; a < 2; ++a)
#pragma unroll
                for (int b = 0; b < 2; ++b)
#pragma unroll
                    for (int m = 0; m < 4; ++m)
#pragma unroll
                        for (int n = 0; n < 2; ++n) acc[a][b][m][n] *= (1.0f / KREP); }
        if constexpr (FP8) asm volatile("s_nop 15\n\ts_nop 15" ::: "memory");
        { int tz = tid; asm volatile("" : "+v"(tz));
          const int wz = tz >> 6, lz = tz & 63; E(acc, cur, wz >> 2, wz & 3, lz & 15, lz >> 4); }
        S.done(cur);
        if (!has_next) break;
#pragma unroll
        for (int a = 0; a < 2; ++a)
#pragma unroll
            for (int b = 0; b < 2; ++b)
#pragma unroll
                for (int m = 0; m < 4; ++m)
#pragma unroll
                    for (int n = 0; n < 2; ++n) acc[a][b][m][n] = (f32x4){0.f, 0.f, 0.f, 0.f};
        cur = nxt; cA = nA; cB = nB; ++ui;

    }
    PG8_WAIT_V(0);
    if (wr == 0) PG8_BAR;
    PG8_BAR;
#undef PG8_SA
#undef PG8_SB
#undef PG8_STAGE
#undef PG8_STAGE_A
#undef PG8_UBASE
#undef PG8_GV
#undef PG8_LDA
#undef PG8_LDB
#undef PG8_MMA
#undef PG8_WAIT_V
#undef PG8_WAIT_L
#undef PG8_BAR
#undef PG8_SCHED
}

struct EpiZ8 {
    static constexpr bool PERM = true;
    bf16_t* O; int ldc;
    __device__ __forceinline__ void operator()(const f32x4 (&acc)[2][2][4][2], const Unit& u, int wr, int wc, int fr, int fq) const {
        const int row0 = u.pm * BM + wr * 64 + fr, col0 = u.pn * BM + wc * 32 + 8 * fq;
#pragma unroll
        for (int ai = 0; ai < 2; ++ai)
#pragma unroll
            for (int m = 0; m < 4; ++m) { bf16_t* rowp = O + (size_t)(row0 + ai * HALF + m * 16) * ldc + col0;
#pragma unroll
                for (int bj = 0; bj < 2; ++bj) { const f32x4 v0 = acc[ai][bj][m][0], v1 = acc[ai][bj][m][1];
                    u32x4 w; w.x = cvt_pk_bf16(v0[0], v0[1]); w.y = cvt_pk_bf16(v0[2], v0[3]); w.z = cvt_pk_bf16(v1[0], v1[1]); w.w = cvt_pk_bf16(v1[2], v1[3]);
                    *(u32x4*)(rowp + bj * HALF) = w; } }
    }
};
template <bool SRC32>
struct EpiWoutB {
    static constexpr bool PERM = true;
    const float* src_lat; const float* src_ctx; bf16_t* xb; const float* modl;
    float* ssqp;
    __device__ __forceinline__ void operator()(const f32x4 (&acc)[2][2][4][2], const Unit& u, int wr, int wc, int fr, int fq) const {
        const int rowt = u.pm * BM; const bool lat = rowt < RL; const int bb = lat ? rowt / T : NB;
        const float* sp = lat ? src_lat + (size_t)rowt * D : src_ctx + (size_t)(rowt - RL) * D;
        bf16_t* dp = xb + (size_t)rowt * D;
        const float* mr = modl + (size_t)bb * MODW + 2 * D;
        const int r0 = wr * 64 + fr, col0 = u.pn * BM + wc * 32 + 8 * fq;
        f32x4 mv[2][2];
#pragma unroll
        for (int bj = 0; bj < 2; ++bj)
#pragma unroll
            for (int n = 0; n < 2; ++n) mv[bj][n] = *(const f32x4*)(mr + col0 + bj * HALF + 4 * n);
#pragma unroll
        for (int ai = 0; ai < 2; ++ai)
#pragma unroll
            for (int m = 0; m < 4; ++m) { const size_t ro = (size_t)(r0 + ai * HALF + m * 16) * D + col0; float sq = 0.f;
#pragma unroll
                for (int bj = 0; bj < 2; ++bj) { f32x4 x0, x1;
                    if (SRC32) { x0 = *(const f32x4*)(sp + ro + bj * HALF); x1 = *(const f32x4*)(sp + ro + bj * HALF + 4); }
                    else { const u32x4 w = *(const u32x4*)(dp + ro + bj * HALF);
                        x0 = (f32x4){__uint_as_float(w.x << 16), __uint_as_float(w.x & 0xffff0000u), __uint_as_float(w.y << 16), __uint_as_float(w.y & 0xffff0000u)};
                        x1 = (f32x4){__uint_as_float(w.z << 16), __uint_as_float(w.z & 0xffff0000u), __uint_as_float(w.w << 16), __uint_as_float(w.w & 0xffff0000u)}; }
                    const f32x4 v0 = x0 + mv[bj][0] * acc[ai][bj][m][0], v1 = x1 + mv[bj][1] * acc[ai][bj][m][1];
                    u32x4 o; o.x = cvt_pk_bf16(v0[0], v0[1]); o.y = cvt_pk_bf16(v0[2], v0[3]); o.z = cvt_pk_bf16(v1[0], v1[1]); o.w = cvt_pk_bf16(v1[2], v1[3]);
                    *(u32x4*)(dp + ro + bj * HALF) = o;
                    const unsigned ow[4] = {o.x, o.y, o.z, o.w};
#pragma unroll
                    for (int j = 0; j < 4; ++j) { const float a = __uint_as_float(ow[j] << 16), b = __uint_as_float(ow[j] & 0xffff0000u); sq += a * a + b * b; } }
                sq += __builtin_bit_cast(float, __builtin_amdgcn_ds_bpermute(((16 * fq + fr) ^ 16) << 2, __builtin_bit_cast(int, sq)));
                sq += __builtin_bit_cast(float, __builtin_amdgcn_ds_bpermute(((16 * fq + fr) ^ 32) << 2, __builtin_bit_cast(int, sq)));
                if (fq == 0) ssqp[(size_t)(rowt + r0 + ai * HALF + m * 16) * 16 + (u.pn & 3) * 4 + wc] = sq; }
    }
};
__device__ __forceinline__ float silu_fast(float x) { return x * __builtin_amdgcn_rcpf(1.0f + __expf(-x)); }
struct EpiGU8 {
    static constexpr bool PERM = true;
    bf16_t* hid; int nN;
    __device__ __forceinline__ void operator()(const f32x4 (&acc)[2][2][4][2], const Unit& u, int wr, int wc, int fr, int fq) const {
        const int row0 = u.pm * BM + wr * 64 + fr, col0 = (u.pn % nN) * HALF + wc * 32 + 8 * fq;
#pragma unroll
        for (int ai = 0; ai < 2; ++ai)
#pragma unroll
            for (int m = 0; m < 4; ++m) { bf16_t* rowp = hid + (size_t)(row0 + ai * HALF + m * 16) * D + col0;
                float v[8];
#pragma unroll
                for (int n = 0; n < 2; ++n)
#pragma unroll
                    for (int i = 0; i < 4; ++i) v[n * 4 + i] = silu_fast(acc[ai][0][m][n][i]) * acc[ai][1][m][n][i];
                u32x4 w; w.x = cvt_pk_bf16(v[0], v[1]); w.y = cvt_pk_bf16(v[2], v[3]); w.z = cvt_pk_bf16(v[4], v[5]); w.w = cvt_pk_bf16(v[6], v[7]);
                *(u32x4*)rowp = w; }
    }
};
constexpr float W8_SCALE = 32.0f;
__device__ __forceinline__ unsigned pack4_fp8(float a, float b, float c, float d) { int w = __builtin_amdgcn_cvt_pk_fp8_f32(a, b, 0, false); w = __builtin_amdgcn_cvt_pk_fp8_f32(c, d, w, true); return (unsigned)w; }
struct EpiGU_F8 {
    static constexpr bool PERM = true;
    unsigned char* hid; int nN;
    __device__ __forceinline__ void operator()(const f32x4 (&acc)[2][2][4][2], const Unit& u, int wr, int wc, int fr, int fq) const {
        const int row0 = u.pm * BM + wr * 64 + fr, col0 = (u.pn % nN) * HALF + wc * 32 + 8 * fq;
        constexpr float inv = 1.0f / W8_SCALE;
#pragma unroll
        for (int ai = 0; ai < 2; ++ai)
#pragma unroll
            for (int m = 0; m < 4; ++m) { unsigned char* rowp = hid + (size_t)(row0 + ai * HALF + m * 16) * D + col0;
                float v[8];
#pragma unroll
                for (int n = 0; n < 2; ++n)
#pragma unroll
                    for (int i = 0; i < 4; ++i) v[n * 4 + i] = silu_fast(acc[ai][0][m][n][i] * inv) * (acc[ai][1][m][n][i] * inv);
                typedef unsigned u32x2v __attribute__((ext_vector_type(2)));
                *(u32x2v*)rowp = (u32x2v){pack4_fp8(v[0], v[1], v[2], v[3]), pack4_fp8(v[4], v[5], v[6], v[7])}; }
    }
};
constexpr float OUTSLOT_SCALE = 32.0f;
struct EpiDown8 {
    static constexpr bool PERM = true;
    unsigned char* O; const float* selg; int nN; float wscale;
    __device__ __forceinline__ void operator()(const f32x4 (&acc)[2][2][4][2], const Unit& u, int wr, int wc, int fr, int fq) const {
        const int row0 = u.pm * BM + wr * 64 + fr, col0 = (u.pn % nN) * BM + wc * 32 + 8 * fq;
#pragma unroll
        for (int ai = 0; ai < 2; ++ai)
#pragma unroll
            for (int m = 0; m < 4; ++m) { const int row = row0 + ai * HALF + m * 16; const float gs = selg[row] * wscale * OUTSLOT_SCALE; unsigned char* rowp = O + (size_t)row * D + col0;
#pragma unroll
                for (int bj = 0; bj < 2; ++bj) { f32x4 v0 = acc[ai][bj][m][0] * gs, v1 = acc[ai][bj][m][1] * gs;
#pragma unroll
                    for (int i = 0; i < 4; ++i) { v0[i] = __builtin_amdgcn_fmed3f(v0[i], -448.0f, 448.0f); v1[i] = __builtin_amdgcn_fmed3f(v1[i], -448.0f, 448.0f); }
                    typedef unsigned u32x2v __attribute__((ext_vector_type(2)));
                    *(u32x2v*)(rowp + bj * HALF) = (u32x2v){pack4_fp8(v0[0], v0[1], v0[2], v0[3]), pack4_fp8(v1[0], v1[1], v1[2], v1[3])}; } }
    }
};
}
constexpr int GEMM_LDS_BYTES = pg8::STAGE_BYTES;
constexpr int WQ_QUOTA_IN_EVEN = 700, WQ_QUOTA_IN_ODD = 5600, WQ_QUOTA_OUT = 8600;
constexpr int GIX_UNITS = 10;
constexpr int DYN_LDS_BYTES = GEMM_LDS_BYTES + 16 + GIX_UNITS * 256 * 4;
#endif

struct EpiZ_ : EpiZ { DEV void pair_(int, int, float, float) const {} };
struct EpiWout_ : EpiWout { DEV void pair_(int, int, float, float) const {} };
struct EpiDown_ : EpiDown { DEV void pair_(int, int, float, float) const {} };
struct EpiGU_ : EpiGU { DEV void elem(int, int, float) const {} DEV void pair_(int r, int j, float g, float u) const { pair(r, j, g, u); } };

#ifndef CPU_EMU
typedef float f32x4_t __attribute__((ext_vector_type(4)));
typedef unsigned u32x4_t __attribute__((ext_vector_type(4)));
typedef unsigned u32x2_t __attribute__((ext_vector_type(2)));
typedef float f32x2_t __attribute__((ext_vector_type(2)));
typedef short bf16x8_t __attribute__((ext_vector_type(8)));
__device__ __forceinline__ unsigned pk_bf16(float lo, float hi) { return pg8::cvt_pk_bf16(lo, hi); }
__device__ __forceinline__ int bperm_i(int v, int src_lane) { return __builtin_amdgcn_ds_bpermute(src_lane << 2, v); }
__device__ __forceinline__ float bperm_f(float v, int src_lane) { return __builtin_bit_cast(float, __builtin_amdgcn_ds_bpermute(src_lane << 2, __builtin_bit_cast(int, v))); }
__device__ __forceinline__ int lane_bcast_i(int v, int uniform_lane) { return __builtin_amdgcn_readlane(v, __builtin_amdgcn_readfirstlane(uniform_lane)); }
__device__ __forceinline__ float wave_sum_fast(float v);
__device__ __forceinline__ float wave_sum(float v) { return wave_sum_fast(v); }
__device__ __forceinline__ float fsigmoid(float x) { return __builtin_amdgcn_rcpf(1.0f + __expf(-x)); }
__device__ __forceinline__ float fsilu(float x) { return x * fsigmoid(x); }
__device__ __forceinline__ float fgelu(float x) { const float u = 0.7978845608028654f * (x + 0.044715f * x * x * x); return x * fsigmoid(2.0f * u); }

__device__ __forceinline__ void tconv_tile(const float* __restrict__ src, int src_ld, int scol0, int nvalid, bf16_t* __restrict__ dst, int dst_ld, int drow0, int k0, PG8_LAS float* tile  , int t) {
#pragma unroll
    for (int i = 0; i < 8; ++i) { const int e = t + 512 * i, kk = e >> 6, nn = e & 63;
        tile[kk * 65 + nn] = nn < nvalid ? src[(size_t)(k0 + kk) * src_ld + scol0 + nn] : 0.f; }
    __syncthreads();
    { const int nn = t >> 3, ks = t & 7; float v[8];
#pragma unroll
        for (int j = 0; j < 8; ++j) v[j] = tile[(ks * 8 + j) * 65 + nn];
        u32x4_t w; w.x = pk_bf16(v[0], v[1]); w.y = pk_bf16(v[2], v[3]); w.z = pk_bf16(v[4], v[5]); w.w = pk_bf16(v[6], v[7]);
        *(u32x4_t*)(dst + (size_t)(drow0 + nn) * dst_ld + k0 + ks * 8) = w; }
    __syncthreads();
}
__device__ __forceinline__ void fs_wconv(const Params& P, PG8_LAS unsigned char* lds, int t) {
    PG8_LAS float* tile = (PG8_LAS float*)lds;
    constexpr int KT = D / 64, T_EIN = (NZE / 64) * KT, T_OIN = (NZO / 64) * KT, T_OUT = (D / 64) * KT, PER_Q = T_EIN + T_OIN + 2 * T_OUT;
    for (int u = blockIdx.x; u < 2 * PER_Q; u += gridDim.x) {
        const int q = u / PER_Q; int r = u % PER_Q;
        if (r < T_EIN) { const int nt = r / KT, kt = r % KT; tconv_tile(P.ev_w_in + (size_t)q * D * EV_IN, EV_IN, nt * 64, EV_IN - nt * 64, P.wt_ev_in + (size_t)q * NZE * D, D, nt * 64, kt * 64, tile, t); continue; }
        r -= T_EIN;
        if (r < T_OIN) { const int nt = r / KT, kt = r % KT; tconv_tile(P.od_w_in + (size_t)q * D * NZO, NZO, nt * 64, 64, P.wt_od_in + (size_t)q * NZO * D, D, nt * 64, kt * 64, tile, t); continue; }
        r -= T_OIN;
        if (r < T_OUT) { const int nt = r / KT, kt = r % KT; tconv_tile(P.ev_w_out + (size_t)q * D * D, D, nt * 64, 64, P.wt_ev_out + (size_t)q * D * D, D, nt * 64, kt * 64, tile, t); continue; }
        r -= T_OUT;
        { const int nt = r / KT, kt = r % KT; tconv_tile(P.od_w_out + (size_t)q * D * D, D, nt * 64, 64, P.wt_od_out + (size_t)q * D * D, D, nt * 64, kt * 64, tile, t); }
    }
    for (int u = blockIdx.x; u < 32 * 4; u += gridDim.x) {
        const int mi = u >> 2, tt = u & 3, li = mi >> 4, dir = (mi >> 3) & 1, gate = (mi >> 2) & 1, hh = mi & 3;
        const float* src = (gate == 0 ? P.od_gate_a_w : P.od_gate_x_w) + (size_t)(((li * 2 + dir) * 4 + hh) * HD) * HD;
        tconv_tile(src, HD, (tt >> 1) * 64, 64, P.gwT + (size_t)mi * HD * HD, HD, (tt >> 1) * 64, (tt & 1) * 64, tile, t);
    }
    for (int i = blockIdx.x * 512 + t; i < 2 * 4 * SGC * SGC; i += gridDim.x * 512) P.sgw[i] = f2bf(P.od_sg_w[i]);
}
struct MoeTile { const float* src; unsigned char* dst; };
__device__ __forceinline__ MoeTile moe_tile(const Params& P, int l, int u) {
    constexpr int KT = D / 64, T_GU = (2 * D / 64) * KT, T_DN = (D / 64) * KT, PER_E = T_GU + T_DN;
    const int e = u / PER_E; int r = u % PER_E; MoeTile mt;
    if (r < T_GU) { const int nt = r / KT, kt = r % KT, cv0 = nt * 64, w = cv0 % 256, j0 = (cv0 / 256) * 128 + (w % 128);
        mt.src = (w >= 128 ? P.moe_w_up : P.moe_w_gate) + ((size_t)l * NE + e) * D * D + (size_t)(kt * 64) * D + j0; mt.dst = (unsigned char*)P.wt_gu + (size_t)e * 2 * D * D + (size_t)cv0 * D + kt * 64; }
    else { r -= T_GU; const int nt = r / KT, kt = r % KT;
        mt.src = P.moe_w_down + ((size_t)l * NE + e) * D * D + (size_t)(kt * 64) * D + nt * 64; mt.dst = (unsigned char*)P.wt_dn + (size_t)e * D * D + (size_t)(nt * 64) * D + kt * 64; }
    return mt;
}
__device__ __forceinline__ void fs_moe_wconv(const Params& P, int l, PG8_LAS unsigned char* lds, int t, int limit) {
    PG8_LAS float* tile = (PG8_LAS float*)lds;
    PG8_LAS int* slot = (PG8_LAS int*)(lds + 2 * 64 * 65 * 4);
    constexpr int NT = NE * ((2 * D / 64) + (D / 64)) * (D / 64);
    if (limit > NT) limit = NT;
    const int kk0 = t >> 6, nn = t & 63;
    unsigned* ctr = P.wq + l;
    if (t == 0) { const unsigned c0 = __hip_atomic_load(ctr, __ATOMIC_RELAXED, __HIP_MEMORY_SCOPE_AGENT);
        slot[0] = (int)c0 >= limit ? NT : (int)__hip_atomic_fetch_add(ctr, 2u, __ATOMIC_RELAXED, __HIP_MEMORY_SCOPE_AGENT); }
    __syncthreads();
    for (int it = 0;; ++it) {
        const int u0 = slot[it & 1];
        if (u0 >= NT) break;
        int unext = NT;
        if (t == 0 && u0 + 2 < limit) unext = (int)__hip_atomic_fetch_add(ctr, 2u, __ATOMIC_RELAXED, __HIP_MEMORY_SCOPE_AGENT);
        const MoeTile m0 = moe_tile(P, l, u0), m1 = moe_tile(P, l, u0 + 1 < NT ? u0 + 1 : u0);
        float v0[8], v1[8];
#pragma unroll
        for (int i = 0; i < 8; ++i) { v0[i] = m0.src[(size_t)(kk0 + 8 * i) * D + nn]; v1[i] = m1.src[(size_t)(kk0 + 8 * i) * D + nn]; }
#pragma unroll
        for (int i = 0; i < 8; ++i) { tile[(kk0 + 8 * i) * 65 + nn] = v0[i]; tile[64 * 65 + (kk0 + 8 * i) * 65 + nn] = v1[i]; }
        if (t == 0) slot[(it + 1) & 1] = unext;
        __syncthreads();
        { const int n2 = t >> 3, ks = t & 7; float o[8], p[8];
#pragma unroll
            for (int j = 0; j < 8; ++j) { o[j] = tile[(ks * 8 + j) * 65 + n2]; p[j] = tile[64 * 65 + (ks * 8 + j) * 65 + n2]; }
            constexpr float ws = pg8::W8_SCALE;
            u32x2_t w; w.x = pg8::pack4_fp8(o[0] * ws, o[1] * ws, o[2] * ws, o[3] * ws); w.y = pg8::pack4_fp8(o[4] * ws, o[5] * ws, o[6] * ws, o[7] * ws);
            *(u32x2_t*)(m0.dst + (size_t)n2 * D + ks * 8) = w;
            if (u0 + 1 < NT) { w.x = pg8::pack4_fp8(p[0] * ws, p[1] * ws, p[2] * ws, p[3] * ws); w.y = pg8::pack4_fp8(p[4] * ws, p[5] * ws, p[6] * ws, p[7] * ws); *(u32x2_t*)(m1.dst + (size_t)n2 * D + ks * 8) = w; } }
        __syncthreads();
    }
    __syncthreads();
}
__device__ __forceinline__ void fs_mod(const Params& P, PG8_LAS unsigned char* lds, int t) {
    PG8_LAS float* sb = (PG8_LAS float*)lds;
    PG8_LAS float* red = sb + (NB + 1) * D;
    for (int i = t; i < (NB + 1) * D; i += 512) { const int bb = i / D, kk = i % D; const float v = bb < NB ? P.c[(size_t)bb * D + kk] : P.c_ctx[kk]; sb[i] = v / (1.0f + expf(-v)); }
    __syncthreads();
    constexpr int CB = MODW / 128;
    const int c4 = t & 31, ks = t >> 5;
    for (int u = blockIdx.x; u < DEPTH * CB; u += gridDim.x) {
        const int ll = u / CB, j0 = (u % CB) * 128 + c4 * 4;
        const float* w = P.ada_w + (size_t)ll * D * MODW + j0;
        f32x4_t acc[NB + 1];
#pragma unroll
        for (int bb = 0; bb <= NB; ++bb) acc[bb] = (f32x4_t){0.f, 0.f, 0.f, 0.f};
#pragma unroll 8
        for (int kk = ks * 64; kk < ks * 64 + 64; ++kk) { const f32x4_t wv = *(const f32x4_t*)(w + (size_t)kk * MODW);
#pragma unroll
            for (int bb = 0; bb <= NB; ++bb) acc[bb] += wv * sb[bb * D + kk]; }
#pragma unroll
        for (int bb = 0; bb <= NB; ++bb)
#pragma unroll
            for (int i = 0; i < 4; ++i) red[(ks * 32 + c4) * 36 + bb * 4 + i] = acc[bb][i];
        __syncthreads();
        for (int o = t; o < (NB + 1) * 128; o += 512) { const int bb = o / 128, col = o % 128, cc4 = col >> 2, ci = col & 3;
            float s = P.ada_b[(size_t)ll * MODW + (u % CB) * 128 + col];
#pragma unroll
            for (int k2 = 0; k2 < 16; ++k2) s += red[(k2 * 32 + cc4) * 36 + bb * 4 + ci];
            P.mod[((size_t)ll * (NB + 1) + bb) * MODW + (u % CB) * 128 + col] = s; }
        __syncthreads();
    }
}
#define DPP_ADD(v, ctrl) ((v) + __builtin_bit_cast(float, __builtin_amdgcn_update_dpp(0, __builtin_bit_cast(int, (v)), (ctrl), 0xF, 0xF, true)))
__device__ __forceinline__ float row16_sum(float v) {
    v = DPP_ADD(v, 0xB1);
    v = DPP_ADD(v, 0x4E);
    v = DPP_ADD(v, 0x141);
    v = DPP_ADD(v, 0x140);
    return v;
}
__device__ __forceinline__ float wave_sum_fast(float v) {
    v = row16_sum(v);
    const int iv = __builtin_bit_cast(int, v);
    return __builtin_bit_cast(float, __builtin_amdgcn_readlane(iv, 0)) + __builtin_bit_cast(float, __builtin_amdgcn_readlane(iv, 16)) +
           __builtin_bit_cast(float, __builtin_amdgcn_readlane(iv, 32)) + __builtin_bit_cast(float, __builtin_amdgcn_readlane(iv, 48));
}
template <int MODE>
__device__ __forceinline__ void fs_row(const Params& P, int l, PG8_LAS unsigned char* lds, int t) {
    const int lane = t & 63, wid = t >> 6;
    PG8_LAS float* wrT = (PG8_LAS float*)lds;
    if (MODE == 1) {
        const float* wr = P.moe_router + (size_t)l * D * NE;
        for (int i = t; i < D * NE; i += 512) { const int c = i / NE, e = i % NE; wrT[e * D + c] = wr[i]; }
        __syncthreads();
    }
    const bool combine = (MODE == 0 && l > 0) || MODE == 2;
    const int lc = MODE == 2 ? DEPTH - 1 : l - 1;
    const float* gvec = MODE == 0 ? P.norm_mix_g + (size_t)l * D : MODE == 1 ? P.norm_ffn_g + (size_t)l * D : P.norm_final_g;
    const int nrows = (MODE == 2 || (MODE == 1 && l == DEPTH - 1)) ? RL : R;
    const int nwaves = gridDim.x * 8, rpw = (nrows + nwaves - 1) / nwaves, rbeg = (blockIdx.x * 8 + wid) * rpw, rend = (rbeg + rpw < nrows) ? rbeg + rpw : nrows;
    const bool in32 = (MODE == 0 && l == 0);
    auto xload = [&](int r, u32x4_t (&raw)[4]) {
        if (in32) { const float* xs = r < RL ? P.x + (size_t)r * D : P.ctx + (size_t)(r - RL) * D;
#pragma unroll
            for (int i = 0; i < 4; ++i) raw[i] = *(const u32x4_t*)(xs + lane * 4 + i * 256); }
        else { const bf16_t* xs = P.xb + (size_t)r * D;
#pragma unroll
            for (int i = 0; i < 4; ++i) { const u32x2_t w = *(const u32x2_t*)(xs + lane * 4 + i * 256); raw[i].x = w.x; raw[i].y = w.y; } } };
    f32x4_t gv[4];
#pragma unroll
    for (int i = 0; i < 4; ++i) gv[i] = *(const f32x4_t*)(gvec + lane * 4 + i * 256);
    f32x4_t scv[4], shv[4], m5v[4]; int bbc = -1;
    u32x4_t xn[4]; int inv0 = -1, inv1 = -1, inv2 = -1;
    int pw0[4] = {0, 0, 0, 0}, pw1[4] = {0, 0, 0, 0};
    auto slot_prefetch = [&](int invv) {
        const unsigned long long mk = __ballot(invv >= 0) & 0xffffull;
        if (mk) { const int e0 = __builtin_ctzll(mk); const unsigned long long m2 = mk & (mk - 1); const int s0 = lane_bcast_i(invv, e0);
            const unsigned char* o0 = (const unsigned char*)P.outslot + (size_t)s0 * D + lane * 4;
#pragma unroll
            for (int i = 0; i < 4; ++i) pw0[i] = *(const int*)(o0 + i * 256);
            if (m2) { const int e1 = __builtin_ctzll(m2); const int s1 = lane_bcast_i(invv, e1); const unsigned char* o1 = (const unsigned char*)P.outslot + (size_t)s1 * D + lane * 4;
#pragma unroll
                for (int i = 0; i < 4; ++i) pw1[i] = *(const int*)(o1 + i * 256); } } };
    if (rbeg < rend) { xload(rbeg, xn);
        if (combine) { inv0 = P.inv[(size_t)rbeg * NE + (lane & 15)]; if (rbeg + 1 < rend) inv1 = P.inv[(size_t)(rbeg + 1) * NE + (lane & 15)]; if (rbeg + 2 < rend) inv2 = P.inv[(size_t)(rbeg + 2) * NE + (lane & 15)];
            slot_prefetch(inv0); } }
    for (int r = rbeg; r < rend; ++r) {
        const bool lat = r < RL; const int bb = lat ? r / T : NB;
        f32x4_t xv[4];
#pragma unroll
        for (int i = 0; i < 4; ++i) { if (in32) xv[i] = __builtin_bit_cast(f32x4_t, xn[i]);
            else xv[i] = (f32x4_t){__uint_as_float(xn[i].x << 16), __uint_as_float(xn[i].x & 0xffff0000u), __uint_as_float(xn[i].y << 16), __uint_as_float(xn[i].y & 0xffff0000u)}; }
        const int myinv = inv0;
        int cw0[4], cw1[4];
#pragma unroll
        for (int i = 0; i < 4; ++i) { cw0[i] = pw0[i]; cw1[i] = pw1[i]; }
        if (r + 1 < rend) { xload(r + 1, xn);
            if (combine) { slot_prefetch(inv1); inv0 = inv1; inv1 = inv2; if (r + 3 < rend) inv2 = P.inv[(size_t)(r + 3) * NE + (lane & 15)]; } }
        if (bb != bbc) { bbc = bb;
            if (MODE != 2) { const float* mr = modrow(P, l, bb) + lane * 4;
#pragma unroll
                for (int i = 0; i < 4; ++i) { scv[i] = *(const f32x4_t*)(mr + (MODE == 0 ? 1 : 4) * D + i * 256) + 1.0f; shv[i] = *(const f32x4_t*)(mr + (MODE == 0 ? 0 : 3) * D + i * 256); } }
            if (combine) { const float* m5 = modrow(P, lc, bb) + 5 * D + lane * 4;
#pragma unroll
                for (int i = 0; i < 4; ++i) m5v[i] = *(const f32x4_t*)(m5 + i * 256); } }
        if (combine) {
            f32x4_t sum[4];
#pragma unroll
            for (int i = 0; i < 4; ++i) sum[i] = (f32x4_t){0.f, 0.f, 0.f, 0.f};
            unsigned long long msk = __ballot(myinv >= 0) & 0xffffull;
            constexpr float fs = 1.0f / pg8::OUTSLOT_SCALE;
            if (msk) {
                msk &= msk - 1; const bool two = msk != 0; msk &= msk - 1; const float f1 = two ? fs : 0.0f;
#pragma unroll
                for (int i = 0; i < 4; ++i) {
                    sum[i][0] += fs * __builtin_amdgcn_cvt_f32_fp8(cw0[i], 0) + f1 * __builtin_amdgcn_cvt_f32_fp8(cw1[i], 0); sum[i][1] += fs * __builtin_amdgcn_cvt_f32_fp8(cw0[i], 1) + f1 * __builtin_amdgcn_cvt_f32_fp8(cw1[i], 1);
                    sum[i][2] += fs * __builtin_amdgcn_cvt_f32_fp8(cw0[i], 2) + f1 * __builtin_amdgcn_cvt_f32_fp8(cw1[i], 2); sum[i][3] += fs * __builtin_amdgcn_cvt_f32_fp8(cw0[i], 3) + f1 * __builtin_amdgcn_cvt_f32_fp8(cw1[i], 3); }
            }
            while (msk) {
                const int e0 = __builtin_ctzll(msk); msk &= msk - 1; const bool two = msk != 0; const int e1 = two ? __builtin_ctzll(msk) : e0; msk &= msk - 1;
                const int s0 = lane_bcast_i(myinv, e0), s1 = lane_bcast_i(myinv, e1);
                const unsigned char* o0 = (const unsigned char*)P.outslot + (size_t)s0 * D + lane * 4; const unsigned char* o1 = (const unsigned char*)P.outslot + (size_t)s1 * D + lane * 4;
                int w0[4], w1[4];
#pragma unroll
                for (int i = 0; i < 4; ++i) { w0[i] = *(const int*)(o0 + i * 256); w1[i] = *(const int*)(o1 + i * 256); }
                const float f1 = two ? fs : 0.0f;
#pragma unroll
                for (int i = 0; i < 4; ++i) {
                    sum[i][0] += fs * __builtin_amdgcn_cvt_f32_fp8(w0[i], 0) + f1 * __builtin_amdgcn_cvt_f32_fp8(w1[i], 0); sum[i][1] += fs * __builtin_amdgcn_cvt_f32_fp8(w0[i], 1) + f1 * __builtin_amdgcn_cvt_f32_fp8(w1[i], 1);
                    sum[i][2] += fs * __builtin_amdgcn_cvt_f32_fp8(w0[i], 2) + f1 * __builtin_amdgcn_cvt_f32_fp8(w1[i], 2); sum[i][3] += fs * __builtin_amdgcn_cvt_f32_fp8(w0[i], 3) + f1 * __builtin_amdgcn_cvt_f32_fp8(w1[i], 3); }
            }
            bf16_t* xd = P.xb + (size_t)r * D;
#pragma unroll
            for (int i = 0; i < 4; ++i) { xv[i] += m5v[i] * sum[i];
                if (MODE != 2) { u32x2_t w; w.x = pk_bf16(xv[i][0], xv[i][1]); w.y = pk_bf16(xv[i][2], xv[i][3]); *(u32x2_t*)(xd + lane * 4 + i * 256) = w;
                    xv[i] = (f32x4_t){__uint_as_float(w.x << 16), __uint_as_float(w.x & 0xffff0000u), __uint_as_float(w.y << 16), __uint_as_float(w.y & 0xffff0000u)}; } }
        }
        float ss = 0.f;
#pragma unroll
        for (int i = 0; i < 4; ++i) ss += xv[i][0] * xv[i][0] + xv[i][1] * xv[i][1] + xv[i][2] * xv[i][2] + xv[i][3] * xv[i][3];
        ss = wave_sum_fast(ss);
        const float rinv = 1.0f / sqrtf(ss * (1.0f / D) + EPS);
        if (MODE == 2) {
#pragma unroll
            for (int i = 0; i < 4; ++i) *(f32x4_t*)(P.xlat + (size_t)r * D + lane * 4 + i * 256) = xv[i] * rinv * gv[i];
            continue;
        }
        f32x4_t hv[4];
#pragma unroll
        for (int i = 0; i < 4; ++i) { hv[i] = (xv[i] * rinv * gv[i]) * scv[i] + shv[i];
            if (MODE == 1) *(unsigned*)((unsigned char*)P.h + (size_t)r * D + lane * 4 + i * 256) = pg8::pack4_fp8(hv[i][0], hv[i][1], hv[i][2], hv[i][3]);
            else { u32x2_t w; w.x = pk_bf16(hv[i][0], hv[i][1]); w.y = pk_bf16(hv[i][2], hv[i][3]); *(u32x2_t*)(P.h + (size_t)r * D + lane * 4 + i * 256) = w; } }
        if (MODE == 1) {
            float lg[NE];
#pragma unroll
            for (int e = 0; e < NE; ++e) { f32x4_t a4 = hv[0] * *(const PG8_LAS f32x4_t*)(wrT + e * D + lane * 4);
#pragma unroll
                for (int i = 1; i < 4; ++i) a4 += hv[i] * *(const PG8_LAS f32x4_t*)(wrT + e * D + lane * 4 + i * 256);
                lg[e] = wave_sum_fast((a4[0] + a4[1]) + (a4[2] + a4[3]));
                asm volatile("" ::: "memory"); }
            float mx = lg[0];
#pragma unroll
            for (int e = 1; e < NE; ++e) mx = fmaxf(mx, lg[e]);
            float s = 0.f, mine = 0.f;
#pragma unroll
            for (int e = 0; e < NE; ++e) { const float ex = __expf(lg[e] - mx); s += ex; mine = (lane == e) ? ex : mine; }
            if (lane < NE) P.aff[(size_t)lane * R + r] = mine / s;
        }
    }
}
__device__ __forceinline__ float row16_max(float v) {
#define DPP_MAX(v, ctrl) fmaxf((v), __builtin_bit_cast(float, __builtin_amdgcn_update_dpp(__builtin_bit_cast(int, (v)), __builtin_bit_cast(int, (v)), (ctrl), 0xF, 0xF, false)))
    v = DPP_MAX(v, 0xB1); v = DPP_MAX(v, 0x4E); v = DPP_MAX(v, 0x141); v = DPP_MAX(v, 0x140);
#undef DPP_MAX
    return v;
}
__device__ __forceinline__ void fs_row_ffn(const Params& P, int l, PG8_LAS unsigned char* lds, int t) {
    const int lane = t & 63, wid = t >> 6, rl = lane & 15, kg = lane >> 4;
    constexpr int WROW = D + 8;
    PG8_LAS bf16_t* wThi = (PG8_LAS bf16_t*)lds;
    PG8_LAS bf16_t* wTlo = wThi + NE * WROW;
    PG8_LAS float* gsv = (PG8_LAS float*)(lds + 2 * NE * WROW * 2);
    PG8_LAS float* shv = gsv + D;
    PG8_LAS float* red = shv + D;
    PG8_LAS float* cbv = red + 32 * NE;
    const float* wr = P.moe_router + (size_t)l * D * NE; const float* gvec = P.norm_ffn_g + (size_t)l * D;
    for (int i = t; i < D * NE; i += 512) { const int c = i / NE, e = i % NE; const float w = wr[i];
        const unsigned ph = pk_bf16(w, 0.f) & 0xffffu; const float wl = w - __uint_as_float(ph << 16);
        wThi[e * WROW + c] = (bf16_t)ph; wTlo[e * WROW + c] = (bf16_t)(pk_bf16(wl, 0.f) & 0xffffu); }
    const int nrows = (l == DEPTH - 1) ? RL : R, ntiles = nrows / 16, nwaves = gridDim.x * 8;
    const int nextra = ntiles - nwaves;
    for (int k0 = 0; k0 < 2; ++k0) {
        if (k0 == 1 && (int)blockIdx.x >= nextra) break;
        const int tl = k0 == 0 ? (int)blockIdx.x * 8 + wid : (wid == 0 ? nwaves + (int)blockIdx.x : ntiles), r0 = tl * 16;
        const int rb = k0 == 0 ? (int)blockIdx.x * 128 : (nwaves + (int)blockIdx.x) * 16, bb = rb < RL ? rb / T : NB;
        __syncthreads();
        { const float* mr = modrow(P, l, bb);
            for (int c = t; c < D; c += 512) { gsv[c] = gvec[c] * (1.0f + mr[4 * D + c]); shv[c] = mr[3 * D + c]; } }
        __syncthreads();
        { const int e = t & 15, part = t >> 4; float s = 0.f;
#pragma unroll 8
            for (int c = part * 32; c < part * 32 + 32; ++c) s += shv[c] * wr[(size_t)c * NE + e];
            red[part * NE + e] = s; }
        __syncthreads();
        if (t < NE) { float s = 0.f;
#pragma unroll
            for (int p2 = 0; p2 < 32; ++p2) s += red[p2 * NE + t];
            cbv[t] = s; }
        __syncthreads();
        if (tl >= ntiles) continue;
        const bf16_t* xrow = P.xb + (size_t)(r0 + rl) * D + kg * 16;
        unsigned char* hrow = (unsigned char*)P.h + (size_t)(r0 + rl) * D + kg * 16;
        float rinv;
        { const f32x4_t* sp = (const f32x4_t*)(P.ssqp + (size_t)(r0 + rl) * 16); const f32x4_t s0 = sp[0], s1 = sp[1], s2 = sp[2], s3 = sp[3];
            const float ss = ((s0[0] + s0[1]) + (s0[2] + s0[3])) + ((s1[0] + s1[1]) + (s1[2] + s1[3])) + ((s2[0] + s2[1]) + (s2[2] + s2[3])) + ((s3[0] + s3[1]) + (s3[2] + s3[3]));
            rinv = 1.0f / sqrtf(ss * (1.0f / D) + EPS); }
        pg8::f32x4 acc = (pg8::f32x4){0.f, 0.f, 0.f, 0.f};
        auto load8 = [&](int kb, u32x4_t (&xg)[8]) {
#pragma unroll
            for (int j = 0; j < 8; ++j) xg[j] = *(const u32x4_t*)(xrow + ((kb * 8 + j) >> 1) * 64 + ((kb * 8 + j) & 1) * 8); };
        u32x2_t hpair;
        auto step = [&](int ks, const u32x4_t& xv) {
            const int c0 = (ks >> 1) * 64 + kg * 16 + (ks & 1) * 8;
            const f32x4_t g0 = *(const PG8_LAS f32x4_t*)(gsv + c0), g1 = *(const PG8_LAS f32x4_t*)(gsv + c0 + 4), s0 = *(const PG8_LAS f32x4_t*)(shv + c0), s1 = *(const PG8_LAS f32x4_t*)(shv + c0 + 4);
            const bf16x8_t bh = *(const PG8_LAS bf16x8_t*)(wThi + rl * WROW + c0), bl = *(const PG8_LAS bf16x8_t*)(wTlo + rl * WROW + c0);
            const unsigned xw[4] = {xv.x, xv.y, xv.z, xv.w};
            float a[8], hv[8];
#pragma unroll
            for (int j = 0; j < 4; ++j) { const float x0 = __uint_as_float(xw[j] << 16), x1 = __uint_as_float(xw[j] & 0xffff0000u);
                a[2 * j] = x0 * (j < 2 ? g0[2 * j] : g1[2 * j - 4]); a[2 * j + 1] = x1 * (j < 2 ? g0[2 * j + 1] : g1[2 * j - 3]);
                hv[2 * j] = a[2 * j] * rinv + (j < 2 ? s0[2 * j] : s1[2 * j - 4]); hv[2 * j + 1] = a[2 * j + 1] * rinv + (j < 2 ? s0[2 * j + 1] : s1[2 * j - 3]); }
            u32x2_t w8; w8.x = pg8::pack4_fp8(hv[0], hv[1], hv[2], hv[3]); w8.y = pg8::pack4_fp8(hv[4], hv[5], hv[6], hv[7]);
            if (ks & 1) *(u32x4_t*)(hrow + (ks >> 1) * 64) = (u32x4_t){hpair.x, hpair.y, w8.x, w8.y}; else hpair = w8;
            unsigned hw[4], lw[4];
#pragma unroll
            for (int j = 0; j < 4; ++j) { hw[j] = pk_bf16(a[2 * j], a[2 * j + 1]);
                lw[j] = pk_bf16(a[2 * j] - __uint_as_float(hw[j] << 16), a[2 * j + 1] - __uint_as_float(hw[j] & 0xffff0000u)); }
            const bf16x8_t fah = __builtin_bit_cast(bf16x8_t, (u32x4_t){hw[0], hw[1], hw[2], hw[3]}), fal = __builtin_bit_cast(bf16x8_t, (u32x4_t){lw[0], lw[1], lw[2], lw[3]});
            acc = __builtin_amdgcn_mfma_f32_16x16x32_bf16(fah, bh, acc, 0, 0, 0);
            acc = __builtin_amdgcn_mfma_f32_16x16x32_bf16(fah, bl, acc, 0, 0, 0);
            acc = __builtin_amdgcn_mfma_f32_16x16x32_bf16(fal, bh, acc, 0, 0, 0);
            asm volatile("" ::: "memory"); };
        u32x4_t xa[8], xc[8];
        load8(0, xa);
#pragma nounroll
        for (int kb = 0; kb < 4; kb += 2) {
            load8(kb + 1, xc);
#pragma unroll
            for (int j = 0; j < 8; ++j) step(kb * 8 + j, xa[j]);
            if (kb + 2 < 4) load8(kb + 2, xa);
#pragma unroll
            for (int j = 0; j < 8; ++j) step((kb + 1) * 8 + j, xc[j]);
        }
        {
            const float cb = cbv[rl]; float aff[4];
#pragma unroll
            for (int i = 0; i < 4; ++i) { const float lg = bperm_f(rinv, 4 * kg + i) * acc[i] + cb;
                const float mx = row16_max(lg), ex = __expf(lg - mx), sm = row16_sum(ex); aff[i] = ex / sm; }
            *(f32x4_t*)(P.aff + (size_t)rl * R + r0 + 4 * kg) = (f32x4_t){aff[0], aff[1], aff[2], aff[3]};
        }
    }
    __syncthreads();
}
template <int KPT>
__device__ __forceinline__ void select_list(const Params& P, const float* a, int n, int cap, int base, int slot0, int e, PG8_LAS unsigned* sm, int t) {
    PG8_LAS unsigned* hist = sm;
    PG8_LAS unsigned* ctl = sm + 256;
    const int lane = t & 63, wid = t >> 6;
    unsigned key[KPT]; bool have[KPT];
#pragma unroll
    for (int j = 0; j < KPT; ++j) { const int i = t * KPT + j; have[j] = i < n; key[j] = have[j] ? __float_as_uint(a[i]) : 0u; }
    unsigned prefix = 0u, rem = (unsigned)cap;
#pragma unroll 1
    for (int pass = 0; pass < 4; ++pass) {
        const int shift = 24 - 8 * pass;
        if (t < 256) hist[t] = 0u;
        __syncthreads();
#pragma unroll
        for (int j = 0; j < KPT; ++j) if (have[j] && (pass == 0 || (key[j] >> (shift + 8)) == prefix)) (void)__hip_atomic_fetch_add(&hist[(key[j] >> shift) & 255u], 1u, __ATOMIC_RELAXED, __HIP_MEMORY_SCOPE_WORKGROUP);
        __syncthreads();
        if (wid == 0) {
            unsigned c[4]; unsigned s = 0u;
#pragma unroll
            for (int q = 0; q < 4; ++q) { c[q] = hist[255 - 4 * lane - q]; s += c[q]; }
            unsigned inc = s;
#pragma unroll
            for (int o = 1; o < 64; o <<= 1) { const unsigned v = (unsigned)bperm_i((int)inc, (lane - o) & 63); if (lane >= o) inc += v; }
            unsigned cum = inc - s;
#pragma unroll
            for (int q = 0; q < 4; ++q) { if (cum < rem && rem <= cum + c[q]) { ctl[0] = (prefix << 8) | (unsigned)(255 - 4 * lane - q); ctl[1] = rem - cum; ctl[2] = c[q]; } cum += c[q]; }
        }
        __syncthreads();
        prefix = ctl[0]; rem = ctl[1];
    }
    const unsigned T_ = prefix, need_eq = rem, cnt_eq = ctl[2];
    int nsel = 0, ntie = 0;
#pragma unroll
    for (int j = 0; j < KPT; ++j) { nsel += (have[j] && key[j] > T_) ? 1 : 0; ntie += (have[j] && key[j] == T_) ? 1 : 0; }
    int incs = nsel, inct = ntie;
#pragma unroll
    for (int o = 1; o < 64; o <<= 1) { const int v1 = bperm_i(incs, (lane - o) & 63), v2 = bperm_i(inct, (lane - o) & 63); if (lane >= o) { incs += v1; inct += v2; } }
    if (lane == 63) { ctl[4 + wid] = (unsigned)incs; ctl[16 + wid] = (unsigned)inct; }
    __syncthreads();
    int bs = 0, bt = 0;
#pragma unroll
    for (int w2 = 0; w2 < 8; ++w2) { if (w2 < wid) { bs += (int)ctl[4 + w2]; bt += (int)ctl[16 + w2]; } }
    int gpos = bs + incs - nsel, tpos = bt + inct - ntie;
    (void)cnt_eq;
#pragma unroll
    for (int j = 0; j < KPT; ++j) if (have[j]) { const int row = base + t * KPT + j;
        const bool gt = key[j] > T_, tie = key[j] == T_, take = gt || (tie && tpos < (int)need_eq);
        const int pos = gpos + (tpos < (int)need_eq ? tpos : (int)need_eq);
        if (take) { P.sel_row[slot0 + pos] = row; P.sel_g[slot0 + pos] = __uint_as_float(key[j]); P.inv[(size_t)row * NE + e] = slot0 + pos; }
        else P.inv[(size_t)row * NE + e] = -1;
        gpos += gt ? 1 : 0; tpos += tie ? 1 : 0; }
    __syncthreads();
}
__device__ __forceinline__ void fs_select(const Params& P, int l, PG8_LAS unsigned char* lds, int t) {
    PG8_LAS unsigned* sm = (PG8_LAS unsigned*)lds;
    for (int li = blockIdx.x; li < (l == DEPTH - 1 ? 1 : 2) * NB * NE; li += gridDim.x) {
        const bool lat = li < NB * NE; const int q = lat ? li : li - NB * NE, b = q / NE, e = q % NE;
        const int base = lat ? b * T : RL + b * TC, slot0 = e * SLOTS_E + (lat ? b * CAPL : NB * CAPL + b * CAPC);
        const float* a = P.aff + (size_t)e * R + base;
        if (lat) select_list<T / 512>(P, a, T, CAPL, base, slot0, e, sm, t);
        else select_list<1>(P, a, TC, CAPC, base, slot0, e, sm, t);
    }
}
__device__ __forceinline__ void fs_gather(const Params& P, int t) {
    const int lane = t & 63, wid = t >> 6;
    for (int s = blockIdx.x * 8 + wid; s < SLOTS; s += gridDim.x * 8) {
        const bf16_t* src = P.h + (size_t)P.sel_row[s] * D + lane * 8; bf16_t* dst = P.xg + (size_t)s * D + lane * 8;
        const u32x4_t v0 = *(const u32x4_t*)src, v1 = *(const u32x4_t*)(src + 512);
        *(u32x4_t*)dst = v0; *(u32x4_t*)(dst + 512) = v1;
    }
}
__device__ __forceinline__ float neg_expm1_fast(float x) {
    const float p = x * (1.0f + x * (0.5f + x * (1.0f / 6.0f + x * (1.0f / 24.0f + x * (1.0f / 120.0f + x * (1.0f / 720.0f))))));
    return x > -0.25f ? -p : 1.0f - __expf(x);
}
struct LruRegs { unsigned x[11], g[8]; float hin; };
template <bool FINAL>
__device__ __forceinline__ void lru_load(const Params& P, int u, int hh, int t, LruRegs& r) {
    const int rest = u >> 2, c = rest % NCH, b = rest / NCH;
    const int row0 = seqrow(b, c * CH), seglo = c < NCHC ? RL + b * TC : b * T, seghi = seglo + (c < NCHC ? TC : T);
    const int cp = t & 63, tg = t >> 6, r0 = row0 + tg * 8 - 2;
    const bf16_t* zc = P.z + O_XB + hh * HD + 2 * cp;
#pragma unroll
    for (int i = 0; i < 11; ++i) { int rr = r0 + i; rr = rr < seglo ? seglo : rr; rr = rr >= seghi ? seghi - 1 : rr; r.x[i] = *(const unsigned*)(zc + (size_t)rr * NZO); }
    if (FINAL) {
        const bf16_t* zg = P.z + O_GB + hh * HD + 2 * cp;
#pragma unroll
        for (int i = 0; i < 8; ++i) r.g[i] = *(const unsigned*)(zg + (size_t)(row0 + tg * 8 + i) * NZO);
        r.hin = t < 256 ? P.hinb[((size_t)((t >> 7) * NB + b) * NCH + c) * W2 + hh * HD + (t & 127)] : 0.f;
    }
}
template <bool FINAL>
__device__ __forceinline__ void fs_odd_lru(const Params& P, int l, PG8_LAS unsigned char* lds, int t) {
    const int lane = t & 63, w = t >> 6, q = lane >> 4, fr = lane & 15;
    const int li = l >> 1, hh = blockIdx.x & 3, jch = 16 * w + fr, chg = hh * HD + jch;
    PG8_LAS bf16_t* xcb = (PG8_LAS bf16_t*)lds;
    PG8_LAS float* xcf = (PG8_LAS float*)(lds + 17408);
    PG8_LAS float* hs = (PG8_LAS float*)(lds + 17408 + 32768);
    PG8_LAS float* hin = (PG8_LAS float*)(lds + 17408 + 65536);
    PG8_LAS bf16_t* gbs = (PG8_LAS bf16_t*)(lds + 17408 + 65536 + 1024);
    bf16x8_t bw[2][2][4];
#pragma unroll
    for (int dir = 0; dir < 2; ++dir)
#pragma unroll
        for (int gate = 0; gate < 2; ++gate)
#pragma unroll
            for (int ks = 0; ks < 4; ++ks) bw[dir][gate][ks] = *(const bf16x8_t*)(P.gwT + ((size_t)((((li * 2 + dir) * 2 + gate) * 4 + hh) * HD + jch)) * HD + ks * 32 + 8 * q);
    float ba[2], bx[2], sp[2];
#pragma unroll
    for (int dir = 0; dir < 2; ++dir) { ba[dir] = P.od_gate_a_b[(size_t)(li * 2 + dir) * W2 + chg]; bx[dir] = P.od_gate_x_b[(size_t)(li * 2 + dir) * W2 + chg];
        sp[dir] = -8.0f * softplusf_(-P.od_lambda[(size_t)(li * 2 + dir) * W2 + chg]); }
    const int cp = t & 63, tg = t >> 6;
    float cw[4][2], cbv[2];
#pragma unroll
    for (int h2 = 0; h2 < 2; ++h2) { cbv[h2] = P.od_conv_b[(size_t)li * W2 + hh * HD + 2 * cp + h2];
#pragma unroll
        for (int j = 0; j < 4; ++j) cw[j][h2] = P.od_conv_w[(size_t)(li * 4 + j) * W2 + hh * HD + 2 * cp + h2]; }
    constexpr int NU = NB * NCH * 4;
    LruRegs rg; if ((int)blockIdx.x < NU) lru_load<FINAL>(P, blockIdx.x, hh, t, rg);
    for (int u = blockIdx.x; u < NU; u += gridDim.x) {
        const int rest = u >> 2, c = rest % NCH, b = rest / NCH;
        const int row0 = seqrow(b, c * CH), seglo = c < NCHC ? RL + b * TC : b * T, seghi = seglo + (c < NCHC ? TC : T);
        {
            const int r0 = row0 + tg * 8 - 2;
            float xv[11][2];
#pragma unroll
            for (int i = 0; i < 11; ++i) { const bool ok = (r0 + i >= seglo && r0 + i < seghi); xv[i][0] = ok ? __uint_as_float(rg.x[i] << 16) : 0.f; xv[i][1] = ok ? __uint_as_float(rg.x[i] & 0xffff0000u) : 0.f; }
#pragma unroll
            for (int i = 0; i < 8; ++i) { const int tok = tg * 8 + i; float xc[2];
#pragma unroll
                for (int h2 = 0; h2 < 2; ++h2) xc[h2] = cbv[h2] + cw[0][h2] * xv[i][h2] + cw[1][h2] * xv[i + 1][h2] + cw[2][h2] * xv[i + 2][h2] + cw[3][h2] * xv[i + 3][h2];
                *(PG8_LAS f32x2_t*)(xcf + tok * 128 + 2 * cp) = (f32x2_t){xc[0], xc[1]}; *(PG8_LAS unsigned*)(xcb + tok * 136 + 2 * cp) = pk_bf16(xc[0], xc[1]); }
            if (FINAL) {
#pragma unroll
                for (int i = 0; i < 8; ++i) *(PG8_LAS unsigned*)(gbs + (tg * 8 + i) * 128 + 2 * cp) = rg.g[i];
                if (t < 256) hin[t] = rg.hin; }
        }
        __syncthreads();
        if (u + (int)gridDim.x < NU) lru_load<FINAL>(P, u + gridDim.x, hh, t, rg);
#pragma unroll
        for (int dir = 0; dir < 2; ++dir) {
            pg8::f32x4 aa[4], ax[4];
#pragma unroll
            for (int mt = 0; mt < 4; ++mt) { aa[mt] = (pg8::f32x4){0.f, 0.f, 0.f, 0.f}; ax[mt] = (pg8::f32x4){0.f, 0.f, 0.f, 0.f}; }
#pragma unroll
            for (int ks = 0; ks < 4; ++ks)
#pragma unroll
                for (int mt = 0; mt < 4; ++mt) { const bf16x8_t af = *(const PG8_LAS bf16x8_t*)(xcb + (mt * 16 + fr) * 136 + ks * 32 + 8 * q);
                    aa[mt] = __builtin_amdgcn_mfma_f32_16x16x32_bf16(af, bw[dir][0][ks], aa[mt], 0, 0, 0);
                    ax[mt] = __builtin_amdgcn_mfma_f32_16x16x32_bf16(af, bw[dir][1][ks], ax[mt], 0, 0, 0); }
            float Ac = 1.f, Bc = FINAL ? hin[dir * 128 + jch] : 0.f;
#pragma unroll
            for (int mm = 0; mm < 4; ++mm) { const int mt = dir == 0 ? mm : 3 - mm;
                float ca[4], cb2[4];
#pragma unroll
                for (int i = 0; i < 4; ++i) { const float xv = xcf[(mt * 16 + 4 * q + i) * 128 + jch];
                    const float rg_ = fsigmoid(aa[mt][i] + ba[dir]), ig = fsigmoid(ax[mt][i] + bx[dir]), la = rg_ * sp[dir];
                    ca[i] = __expf(la); cb2[i] = __builtin_amdgcn_sqrtf(fmaxf(fmaf(-ca[i], ca[i], 1.0f), 0.f)) * (ig * xv); }
                float Al = 1.f, Bl = 0.f;
#pragma unroll
                for (int ii = 0; ii < 4; ++ii) { const int i = dir == 0 ? ii : 3 - ii; Al = ca[i] * Al; Bl = ca[i] * Bl + cb2[i]; }
                float hq = Bc;
#pragma unroll
                for (int qq = 0; qq < 4; ++qq) { const int qs = dir == 0 ? qq : 3 - qq;
                    const float Aq = bperm_f(Al, fr + 16 * qs), Bq = bperm_f(Bl, fr + 16 * qs);
                    const bool before = dir == 0 ? (qs < q) : (qs > q);
                    if (FINAL) hq = before ? Aq * hq + Bq : hq;
                    Ac = Aq * Ac; Bc = Aq * Bc + Bq; }
                if (FINAL) {
                    float h = hq;
#pragma unroll
                    for (int ii = 0; ii < 4; ++ii) { const int i = dir == 0 ? ii : 3 - ii; h = ca[i] * h + cb2[i];
                        PG8_LAS float* hp = hs + (mt * 16 + 4 * q + i) * 128 + jch; if (dir == 0) *hp = h; else *hp += h; }
                }
            }
            if (!FINAL && q == 0) { const size_t si = ((size_t)(dir * NB + b) * NCH + c) * W2 + chg; P.sumA[si] = Ac; P.sumB[si] = Bc; }
        }
        __syncthreads();
        if (FINAL) {
            const int r = row0 + tg * 8;
#pragma unroll
            for (int i = 0; i < 8; ++i) { const f32x2_t hv = *(const PG8_LAS f32x2_t*)(hs + (tg * 8 + i) * 128 + 2 * cp); const unsigned gw = *(const PG8_LAS unsigned*)(gbs + (tg * 8 + i) * 128 + 2 * cp);
                *(unsigned*)(P.m + (size_t)(r + i) * D + hh * HD + 2 * cp) = pk_bf16(hv.x * fgelu(__uint_as_float(gw << 16)), hv.y * fgelu(__uint_as_float(gw & 0xffff0000u))); }
            __syncthreads();
        }
    }
}
__device__ __forceinline__ void fs_odd2(const Params& P, int t) {
    if (t >= 32) return;
    for (int it = blockIdx.x * 32 + t; it < 2 * NB * W2; it += gridDim.x * 32) {
        const int ch = it % W2, b = (it / W2) % NB, dir = it / (W2 * NB);
        const size_t base = ((size_t)(dir * NB + b) * NCH) * W2 + ch;
        float h = 0.f;
#pragma unroll 8
        for (int step = 0; step < NCH; ++step) {
            const int c = dir == 0 ? step : (step < NCHC ? NCHC - 1 - step : NCH - 1 - (step - NCHC));
            const float A = P.sumA[base + (size_t)c * W2], B = P.sumB[base + (size_t)c * W2];
            P.hinb[base + (size_t)c * W2] = h; h = A * h + B;
        }
    }
}
__device__ __forceinline__ void fs_sgstat(const Params& P, int t) {
    const int lane = t & 63, wid = t >> 6;
    for (int r = blockIdx.x * 8 + wid; r < R; r += gridDim.x * 8) {
        const u32x4_t w = *(const u32x4_t*)(P.z + (size_t)r * NZO + O_V + lane * 8);
        float g[8];
        g[0] = fgelu(__uint_as_float(w.x << 16)); g[1] = fgelu(__uint_as_float(w.x & 0xffff0000u)); g[2] = fgelu(__uint_as_float(w.y << 16)); g[3] = fgelu(__uint_as_float(w.y & 0xffff0000u));
        g[4] = fgelu(__uint_as_float(w.z << 16)); g[5] = fgelu(__uint_as_float(w.z & 0xffff0000u)); g[6] = fgelu(__uint_as_float(w.w << 16)); g[7] = fgelu(__uint_as_float(w.w & 0xffff0000u));
        float s = 0.f;
#pragma unroll
        for (int i = 0; i < 8; ++i) s += g[i];
        const float mean = wave_sum(s) * (1.0f / W2);
        float vs = 0.f;
#pragma unroll
        for (int i = 0; i < 8; ++i) { const float d = g[i] - mean; vs += d * d; }
        vs = wave_sum(vs);
        if (lane == 0) { P.sgstat[2 * r] = mean; P.sgstat[2 * r + 1] = 1.0f / sqrtf(vs * (1.0f / W2) + EPS); }
    }
}
__device__ __forceinline__ void fs_odd_sg(const Params& P, int l, PG8_LAS unsigned char* lds, int t) {
    const int lane = t & 63, w = t >> 6, q = lane >> 4, fr = lane & 15, li = l >> 1, g = blockIdx.x & 3;
    PG8_LAS bf16_t* vbT = (PG8_LAS bf16_t*)lds;
    bf16x8_t aw[4];
#pragma unroll
    for (int ks = 0; ks < 4; ++ks) aw[ks] = *(const bf16x8_t*)(P.sgw + ((size_t)((li * 4 + g) * SGC + 16 * w + fr)) * SGC + ks * 32 + 8 * q);
    float sgb[4];
#pragma unroll
    for (int ii = 0; ii < 4; ++ii) sgb[ii] = P.od_sg_b[(size_t)(li * 4 + g) * SGC + 16 * w + 4 * q + ii];
    const int cc = t & 127, jp = t >> 7; const float gn = P.od_sg_norm_g[(size_t)li * W2 + g * HD + cc];
    for (int u = (blockIdx.x + gridDim.x / 2) % gridDim.x; u < (R / SGC) * 4; u += gridDim.x) {
        const int base = (u >> 2) * SGC;
        { const bf16_t* zv = P.z + O_V + g * HD + cc;
#pragma unroll 4
            for (int jj = 0; jj < 16; ++jj) { const int j = (jp * 16 + jj) * 2, r0 = base + j;
                const float v0 = (fgelu(bf2f(zv[(size_t)r0 * NZO])) - P.sgstat[2 * r0]) * P.sgstat[2 * r0 + 1] * gn;
                const float v1 = (fgelu(bf2f(zv[(size_t)(r0 + 1) * NZO])) - P.sgstat[2 * r0 + 2]) * P.sgstat[2 * r0 + 3] * gn;
                *(PG8_LAS unsigned*)(vbT + cc * 136 + j) = pk_bf16(v0, v1); } }
        __syncthreads();
        pg8::f32x4 acc[8];
#pragma unroll
        for (int ct = 0; ct < 8; ++ct) acc[ct] = (pg8::f32x4){0.f, 0.f, 0.f, 0.f};
#pragma unroll
        for (int ks = 0; ks < 4; ++ks)
#pragma unroll
            for (int ct = 0; ct < 8; ++ct) { const bf16x8_t bf = *(const PG8_LAS bf16x8_t*)(vbT + (ct * 16 + fr) * 136 + ks * 32 + 8 * q);
                acc[ct] = __builtin_amdgcn_mfma_f32_16x16x32_bf16(aw[ks], bf, acc[ct], 0, 0, 0); }
#pragma unroll
        for (int ct = 0; ct < 8; ++ct)
#pragma unroll
            for (int ii = 0; ii < 4; ++ii) { const int row = base + 16 * w + 4 * q + ii, c = g * HD + ct * 16 + fr;
                const float uu = bf2f(P.z[(size_t)row * NZO + O_U + c]);
                P.m[(size_t)row * D + W2 + c] = f2bf(fgelu(uu) * (acc[ct][ii] + sgb[ii])); }
        __syncthreads();
    }
}
constexpr int LRS_ROW = 40;
constexpr int LAT_ROW = 68;
struct GlaUp { bf16x8_t b[4]; float bias[4]; };
__device__ __forceinline__ void gla_load_up(const Params& P, int li, int hh, int t, GlaUp& g) {
    const int lane = t & 63, w = t >> 6, q = lane >> 4, fr = lane & 15, dir = w >> 2;
    unsigned keep = (q >> 1) == dir ? 0xffffffffu : 0u; asm volatile("" : "+v"(keep));
#pragma unroll
    for (int j = 0; j < 4; ++j) { const int dcol = hh * DK + j * 16 + fr; unsigned pk[4];
#pragma unroll
        for (int i2 = 0; i2 < 4; ++i2) { const int r0 = 8 * (q & 1) + 2 * i2;
            const float a = P.ev_decay_up[((size_t)(li * 2 + dir) * RANK + r0) * KEY + dcol], b2 = P.ev_decay_up[((size_t)(li * 2 + dir) * RANK + r0 + 1) * KEY + dcol];
            pk[i2] = pk_bf16(a, b2) & keep; }
        g.b[j] = __builtin_bit_cast(bf16x8_t, (u32x4_t){pk[0], pk[1], pk[2], pk[3]});
        g.bias[j] = P.ev_decay_b[(size_t)(li * 2 + dir) * KEY + dcol]; }
}
__device__ __forceinline__ void gla_preact(const PG8_LAS bf16_t* lrs, const GlaUp& g, PG8_LAS float* laT, int t) {
    const int lane = t & 63, w = t >> 6, q = lane >> 4, fr = lane & 15, mt = w & 3, dir = w >> 2;
    const bf16x8_t af = *(const PG8_LAS bf16x8_t*)(lrs + (mt * 16 + fr) * LRS_ROW + 8 * q);
#pragma unroll
    for (int j = 0; j < 4; ++j) { const pg8::f32x4 acc = __builtin_amdgcn_mfma_f32_16x16x32_bf16(af, g.b[j], (pg8::f32x4){0.f, 0.f, 0.f, 0.f}, 0, 0, 0);
        f32x4_t la;
#pragma unroll
        for (int ii = 0; ii < 4; ++ii) { const float x = acc[ii] + g.bias[j]; la[ii] = (fminf(x, 0.f) - __logf(1.0f + __expf(-fabsf(x)))) * (1.0f / 16.0f); }
        *(PG8_LAS f32x4_t*)(laT + ((dir * 4 + j) * 16 + fr) * LAT_ROW + mt * 16 + 4 * q) = la; }
}
__device__ __forceinline__ void gla_local_cumsum(const PG8_LAS float* laT, int d, int tok_first, float (&csf)[8], float (&csb)[8]) {
    const f32x4_t a0 = *(const PG8_LAS f32x4_t*)(laT + d * LAT_ROW + tok_first), a1 = *(const PG8_LAS f32x4_t*)(laT + d * LAT_ROW + tok_first + 4);
    const f32x4_t b0 = *(const PG8_LAS f32x4_t*)(laT + (64 + d) * LAT_ROW + tok_first), b1 = *(const PG8_LAS f32x4_t*)(laT + (64 + d) * LAT_ROW + tok_first + 4);
#pragma unroll
    for (int i = 0; i < 4; ++i) { csf[i] = a0[i]; csf[4 + i] = a1[i]; csb[i] = b0[i]; csb[4 + i] = b1[i]; }
#pragma unroll
    for (int i = 1; i < 8; ++i) csf[i] += csf[i - 1];
#pragma unroll
    for (int i = 6; i >= 0; --i) csb[i] += csb[i + 1];
}
struct GlaRegs { u32x2_t lr; bf16_t k[8], q[8], v[16], g[16]; u32x4_t s[2][2]; };
template <bool E3>
__device__ __forceinline__ void gla_load(const Params& P, int u, int hh, int t, GlaRegs& r) {
    const int rest = u >> 2, c = rest % NCH, b = rest / NCH, row0 = seqrow(b, c * CH);
    const int d = t & 63, sg = t >> 6, e = t & 127, jp = t >> 7;
    r.lr = *(const u32x2_t*)(P.z + (size_t)(row0 + (t >> 3)) * NZE + E_LRF + (t & 7) * 4);
#pragma unroll
    for (int i = 0; i < 8; ++i) { const bf16_t* zr = P.z + (size_t)(row0 + sg * 8 + i) * NZE + hh * DK + d; r.k[i] = zr[E_K]; if (E3) r.q[i] = zr[E_Q]; }
#pragma unroll
    for (int jj = 0; jj < 16; ++jj) r.v[jj] = P.z[(size_t)(row0 + jp * 16 + jj) * NZE + E_V + hh * DV + e];
    if (E3) {
        const int lane = t & 63, w = t >> 6, q = lane >> 4, fr = lane & 15, it = w & 3, wh = w >> 2;
#pragma unroll
        for (int ii = 0; ii < 4; ++ii)
#pragma unroll
            for (int el = 0; el < 4; ++el) r.g[ii * 4 + el] = P.z[(size_t)(row0 + it * 16 + 4 * q + ii) * NZE + E_G + hh * DV + (wh * 4 + el) * 16 + fr];
#pragma unroll
        for (int dir = 0; dir < 2; ++dir) { const bf16_t* Sb = P.SinB + ((size_t)((dir * NB + b) * GH + hh) * NCH + c) * DV * DK;
#pragma unroll
            for (int i = 0; i < 2; ++i) r.s[dir][i] = *(const u32x4_t*)(Sb + (size_t)(t + 512 * i) * 8); }
    }
}
__device__ __forceinline__ void gla_store_common(const GlaRegs& r, PG8_LAS bf16_t* lrs, PG8_LAS bf16_t* vT, int t) {
    *(PG8_LAS u32x2_t*)(lrs + (t >> 3) * LRS_ROW + (t & 7) * 4) = r.lr;
    const int e = t & 127, jp = t >> 7;
#pragma unroll
    for (int jj = 0; jj < 16; jj += 2) *(PG8_LAS unsigned*)(vT + e * 72 + jp * 16 + jj) = (unsigned)r.v[jj] | ((unsigned)r.v[jj + 1] << 16);
}
__device__ __forceinline__ void fs_even1(const Params& P, int l, PG8_LAS unsigned char* lds, int t) {
    const int lane = t & 63, w = t >> 6, q = lane >> 4, fr = lane & 15, li = l >> 1, hh = blockIdx.x & 3, d = t & 63, sg = t >> 6;
    PG8_LAS bf16_t* vT = (PG8_LAS bf16_t*)lds;
    PG8_LAS bf16_t* kdT = (PG8_LAS bf16_t*)(lds + 18432);
    PG8_LAS float* tot = (PG8_LAS float*)(lds + 18432 + 18432);
    PG8_LAS bf16_t* lrs = (PG8_LAS bf16_t*)(lds + 18432 + 18432 + 4096);
    PG8_LAS bf16_t* sst = (PG8_LAS bf16_t*)(lds + 18432 + 18432 + 4096 + 5120);
    PG8_LAS float* laT = (PG8_LAS float*)sst;
    GlaUp gu; gla_load_up(P, li, hh, t, gu);
    constexpr int NU = NB * NCH * 4;
    GlaRegs rg; if ((int)blockIdx.x < NU) gla_load<false>(P, blockIdx.x, hh, t, rg);
    for (int u = blockIdx.x; u < NU; u += gridDim.x) {
        const int rest = u >> 2, c = rest % NCH, b = rest / NCH;
        gla_store_common(rg, lrs, vT, t);
        bf16_t kraw[8];
#pragma unroll
        for (int i = 0; i < 8; ++i) kraw[i] = rg.k[i];
        __syncthreads();
        if (u + (int)gridDim.x < NU) gla_load<false>(P, u + gridDim.x, hh, t, rg);
        gla_preact(lrs, gu, laT, t);
        __syncthreads();
        float csf[8], csb[8];
        gla_local_cumsum(laT, d, sg * 8, csf, csb);
        tot[sg * 64 + d] = csf[7]; tot[512 + sg * 64 + d] = csb[0];
        __syncthreads();
        float offf = 0.f, offb = 0.f, endf = 0.f, endb = 0.f;
#pragma unroll
        for (int s2 = 0; s2 < 8; ++s2) { const float tf = tot[s2 * 64 + d], tb = tot[512 + s2 * 64 + d]; endf += tf; endb += tb; offf += s2 < sg ? tf : 0.f; offb += s2 > sg ? tb : 0.f; }
        {
            float kf[8], kb[8];
#pragma unroll
            for (int i = 0; i < 8; ++i) { const float kk = bf2f(kraw[i]); kf[i] = kk * __expf(endf - (csf[i] + offf)); kb[i] = kk * __expf(endb - (csb[i] + offb)); }
            u32x4_t wf, wb; wf.x = pk_bf16(kf[0], kf[1]); wf.y = pk_bf16(kf[2], kf[3]); wf.z = pk_bf16(kf[4], kf[5]); wf.w = pk_bf16(kf[6], kf[7]);
            wb.x = pk_bf16(kb[0], kb[1]); wb.y = pk_bf16(kb[2], kb[3]); wb.z = pk_bf16(kb[4], kb[5]); wb.w = pk_bf16(kb[6], kb[7]);
            *(PG8_LAS u32x4_t*)(kdT + d * 72 + sg * 8) = wf; *(PG8_LAS u32x4_t*)(kdT + 64 * 72 + d * 72 + sg * 8) = wb;
        }
        if (sg == 0) { const size_t di = ((size_t)((0 * NB + b) * GH + hh) * NCH + c) * DK + d; P.decv[di] = __expf(endf); P.decv[di + (size_t)NB * GH * NCH * DK] = __expf(endb); }
        __syncthreads();
#pragma unroll
        for (int dir = 0; dir < 2; ++dir) {
            pg8::f32x4 acc[4];
#pragma unroll
            for (int dt = 0; dt < 4; ++dt) acc[dt] = (pg8::f32x4){0.f, 0.f, 0.f, 0.f};
#pragma unroll
            for (int ks = 0; ks < 2; ++ks) { const bf16x8_t af = *(const PG8_LAS bf16x8_t*)(vT + (16 * w + fr) * 72 + ks * 32 + 8 * q);
#pragma unroll
                for (int dt = 0; dt < 4; ++dt) { const bf16x8_t bfr = *(const PG8_LAS bf16x8_t*)(kdT + dir * 64 * 72 + (dt * 16 + fr) * 72 + ks * 32 + 8 * q);
                    acc[dt] = __builtin_amdgcn_mfma_f32_16x16x32_bf16(af, bfr, acc[dt], 0, 0, 0); } }
#pragma unroll
            for (int dt = 0; dt < 4; ++dt)
#pragma unroll
                for (int ii = 0; ii < 4; ++ii) sst[dir * 128 * 72 + (16 * w + 4 * q + ii) * 72 + dt * 16 + fr] = (bf16_t)pk_bf16(acc[dt][ii], 0.f);
        }
        __syncthreads();
#pragma unroll
        for (int dir = 0; dir < 2; ++dir) { bf16_t* Sb = P.Sd + ((size_t)((dir * NB + b) * GH + hh) * NCH + c) * DV * DK;
#pragma unroll
            for (int i = 0; i < 2; ++i) { const int f = t + 512 * i, e = f >> 3, d8 = (f & 7) * 8; *(u32x4_t*)(Sb + (size_t)f * 8) = *(const PG8_LAS u32x4_t*)(sst + dir * 128 * 72 + e * 72 + d8); } }
        __syncthreads();
    }
}
__device__ __forceinline__ void fs_even2(const Params& P, int t) {
    for (int it = blockIdx.x * 512 + t; it < 2 * NB * GH * DV * (DK / 4); it += gridDim.x * 512) {
        const int d4 = it % (DK / 4), e = (it / (DK / 4)) % DV, hh = (it / (DK / 4 * DV)) % GH, b = (it / (DK / 4 * DV * GH)) % NB, dir = it / (DK / 4 * DV * GH * NB);
        const size_t cb0 = ((size_t)((dir * NB + b) * GH + hh) * NCH) * DV * DK + (size_t)e * DK + d4 * 4;
        const bf16_t* Sb = P.Sd + cb0; bf16_t* So = P.SinB + cb0;
        const float* dv = P.decv + ((size_t)((dir * NB + b) * GH + hh) * NCH) * DK + d4 * 4;
        f32x4_t s = (f32x4_t){0.f, 0.f, 0.f, 0.f};
#pragma unroll 4
        for (int step = 0; step < NCH; ++step) {
            const int c = dir == 0 ? step : (step < NCHC ? NCHC - 1 - step : NCH - 1 - (step - NCHC));
            const u32x2_t tw = *(const u32x2_t*)(Sb + (size_t)c * DV * DK); const f32x4_t dec = *(const f32x4_t*)(dv + (size_t)c * DK);
            const f32x4_t tmp = (f32x4_t){__uint_as_float(tw.x << 16), __uint_as_float(tw.x & 0xffff0000u), __uint_as_float(tw.y << 16), __uint_as_float(tw.y & 0xffff0000u)};
            u32x2_t pw; pw.x = pk_bf16(s[0], s[1]); pw.y = pk_bf16(s[2], s[3]);
            *(u32x2_t*)(So + (size_t)c * DV * DK) = pw; s = dec * s + tmp;
        }
    }
}
__device__ __forceinline__ void fs_even3(const Params& P, int l, PG8_LAS unsigned char* lds, int t) {
    const int lane = t & 63, w = t >> 6, q = lane >> 4, fr = lane & 15, li = l >> 1, hh = blockIdx.x & 3, d = t & 63, sg = t >> 6;
    PG8_LAS bf16_t* vT = (PG8_LAS bf16_t*)lds;
    PG8_LAS bf16_t* qd = (PG8_LAS bf16_t*)(lds + 18432);
    PG8_LAS bf16_t* kd = (PG8_LAS bf16_t*)(lds + 18432 + 18432);
    PG8_LAS bf16_t* sT = (PG8_LAS bf16_t*)(lds + 18432 * 3);
    PG8_LAS bf16_t* att = (PG8_LAS bf16_t*)(lds + 18432 * 5);
    PG8_LAS float* tot = (PG8_LAS float*)(lds + 18432 * 6);
    PG8_LAS float* ssq = tot + 1024;
    PG8_LAS bf16_t* lrs = (PG8_LAS bf16_t*)(lds + 18432 * 6 + 4096 + 512);
    PG8_LAS float* laT = (PG8_LAS float*)qd;
    GlaUp gu; gla_load_up(P, li, hh, t, gu);
    const int it = w & 3, wh = w >> 2;
    float ng[4];
#pragma unroll
    for (int el = 0; el < 4; ++el) ng[el] = P.ev_norm_g[(size_t)li * W2 + hh * DV + (wh * 4 + el) * 16 + fr];
    constexpr int NU = NB * NCH * 4;
    GlaRegs rg; if ((int)blockIdx.x < NU) gla_load<true>(P, blockIdx.x, hh, t, rg);
    for (int u = blockIdx.x; u < NU; u += gridDim.x) {
        const int rest = u >> 2, c = rest % NCH, b = rest / NCH, row0 = seqrow(b, c * CH);
        gla_store_common(rg, lrs, vT, t);
#pragma unroll
        for (int dir = 0; dir < 2; ++dir)
#pragma unroll
            for (int i = 0; i < 2; ++i) { const int f = t + 512 * i, e = f >> 3, d8 = (f & 7) * 8; *(PG8_LAS u32x4_t*)(sT + dir * 128 * 72 + e * 72 + d8) = rg.s[dir][i]; }
        bf16_t kraw[8], qraw[8], graw[16];
#pragma unroll
        for (int i = 0; i < 8; ++i) { kraw[i] = rg.k[i]; qraw[i] = rg.q[i]; }
#pragma unroll
        for (int i = 0; i < 16; ++i) graw[i] = rg.g[i];
        __syncthreads();
        if (u + (int)gridDim.x < NU) gla_load<true>(P, u + gridDim.x, hh, t, rg);
        gla_preact(lrs, gu, laT, t);
        __syncthreads();
        float csf[8], csb[8];
        gla_local_cumsum(laT, d, sg * 8, csf, csb);
        tot[sg * 64 + d] = csf[7]; tot[512 + sg * 64 + d] = csb[0];
        __syncthreads();
        {
            float offf = 0.f, offb = 0.f;
#pragma unroll
            for (int s2 = 0; s2 < 8; ++s2) { const float tf = tot[s2 * 64 + d], tb = tot[512 + s2 * 64 + d]; offf += s2 < sg ? tf : 0.f; offb += s2 > sg ? tb : 0.f; }
#pragma unroll
            for (int i = 0; i < 8; ++i) { const int tok = sg * 8 + i;
                const float qq = bf2f(qraw[i]) * 0.125f, kk = bf2f(kraw[i]), bfv = csf[i] + offf, bbv = csb[i] + offb;
                const float ef = __expf(bfv), eb = __expf(bbv);
                const unsigned pf = pk_bf16(qq * ef, kk * __builtin_amdgcn_rcpf(ef)), pb = pk_bf16(qq * eb, kk * __builtin_amdgcn_rcpf(eb));
                qd[tok * 72 + d] = (bf16_t)pf; kd[tok * 72 + d] = (bf16_t)(pf >> 16);
                qd[64 * 72 + tok * 72 + d] = (bf16_t)pb; kd[64 * 72 + tok * 72 + d] = (bf16_t)(pb >> 16); }
        }
        __syncthreads();
#pragma unroll
        for (int dir = 0; dir < 2; ++dir)
#pragma unroll
            for (int jl = 0; jl < 2; ++jl) { const int jt = wh * 2 + jl;
                pg8::f32x4 a4 = (pg8::f32x4){0.f, 0.f, 0.f, 0.f};
                if (dir == 0 ? (jt <= it) : (jt >= it)) {
#pragma unroll
                    for (int ks = 0; ks < 2; ++ks) { const bf16x8_t af = *(const PG8_LAS bf16x8_t*)(qd + dir * 64 * 72 + (it * 16 + fr) * 72 + ks * 32 + 8 * q);
                        const bf16x8_t bfr = *(const PG8_LAS bf16x8_t*)(kd + dir * 64 * 72 + (jt * 16 + fr) * 72 + ks * 32 + 8 * q);
                        a4 = __builtin_amdgcn_mfma_f32_16x16x32_bf16(af, bfr, a4, 0, 0, 0); } }
#pragma unroll
                for (int ii = 0; ii < 4; ++ii) { const int i = it * 16 + 4 * q + ii, j = jt * 16 + fr; const bool keep = dir == 0 ? (j <= i) : (j >= i);
                    att[dir * 64 * 72 + i * 72 + j] = (bf16_t)pk_bf16(keep ? a4[ii] : 0.f, 0.f); } }
        __syncthreads();
        pg8::f32x4 o[4];
#pragma unroll
        for (int el = 0; el < 4; ++el) o[el] = (pg8::f32x4){0.f, 0.f, 0.f, 0.f};
#pragma unroll
        for (int dir = 0; dir < 2; ++dir)
#pragma unroll
            for (int ks = 0; ks < 2; ++ks) { const bf16x8_t aa = *(const PG8_LAS bf16x8_t*)(att + dir * 64 * 72 + (it * 16 + fr) * 72 + ks * 32 + 8 * q);
                const bf16x8_t aq = *(const PG8_LAS bf16x8_t*)(qd + dir * 64 * 72 + (it * 16 + fr) * 72 + ks * 32 + 8 * q);
#pragma unroll
                for (int el = 0; el < 4; ++el) { const int et = wh * 4 + el;
                    const bf16x8_t bv = *(const PG8_LAS bf16x8_t*)(vT + (et * 16 + fr) * 72 + ks * 32 + 8 * q);
                    const bf16x8_t bs = *(const PG8_LAS bf16x8_t*)(sT + dir * 128 * 72 + (et * 16 + fr) * 72 + ks * 32 + 8 * q);
                    o[el] = __builtin_amdgcn_mfma_f32_16x16x32_bf16(aa, bv, o[el], 0, 0, 0);
                    o[el] = __builtin_amdgcn_mfma_f32_16x16x32_bf16(aq, bs, o[el], 0, 0, 0); } }
#pragma unroll
        for (int ii = 0; ii < 4; ++ii) { float s = 0.f;
#pragma unroll
            for (int el = 0; el < 4; ++el) s += o[el][ii] * o[el][ii];
            s = row16_sum(s);
            if (fr == 0) ssq[wh * 64 + it * 16 + 4 * q + ii] = s; }
        __syncthreads();
#pragma unroll
        for (int ii = 0; ii < 4; ++ii) { const int i = it * 16 + 4 * q + ii; const float rinv = 1.0f / sqrtf((ssq[i] + ssq[64 + i]) * (1.0f / DV) + EPS);
            const size_t row = (size_t)(row0 + i);
#pragma unroll
            for (int el = 0; el < 4; ++el) { const int e = hh * DV + (wh * 4 + el) * 16 + fr; const float gg = bf2f(graw[ii * 4 + el]);
                P.m[row * D + W2 + e] = (bf16_t)pk_bf16(o[el][ii] * rinv * ng[el] * fsilu(gg), 0.f); } }
    }
}
__device__ __forceinline__ void fs_even_conv(const Params& P, int l, int t) {
    const int li = l >> 1;
    for (int it = blockIdx.x * 512 + t; it < (R / 4) * (W2 / 8); it += gridDim.x * 512) {
        const int rowb = (it / (W2 / 8)) * 4, c8 = (it % (W2 / 8)) * 8;
        bool lv, rv;
        if (rowb < RL) { const int pos = (rowb % T) % GRIDW; lv = pos > 0; rv = pos + 3 < GRIDW - 1; } else { const int tt = (rowb - RL) % TC; lv = tt > 0; rv = tt + 3 < TC - 1; }
        const bf16_t* zr = P.z + (size_t)rowb * NZE + c8;
        u32x4_t cg[6], xa[6], bg[4];
#pragma unroll
        for (int i = 0; i < 6; ++i) { const int dr = (i == 0 && !lv) ? 0 : (i == 5 && !rv) ? 3 : i - 1;
            cg[i] = *(const u32x4_t*)(zr + (ptrdiff_t)dr * NZE + E_CG); xa[i] = *(const u32x4_t*)(zr + (ptrdiff_t)dr * NZE + E_XA); }
#pragma unroll
        for (int i = 0; i < 4; ++i) bg[i] = *(const u32x4_t*)(zr + (size_t)i * NZE + E_BG);
        const float* cw = P.ev_conv_w + (size_t)li * 3 * W2 + c8; const float* cb = P.ev_conv_b + (size_t)li * W2 + c8;
        float w0[8], w1[8], w2[8], bb[8];
#pragma unroll
        for (int cc = 0; cc < 8; ++cc) { w0[cc] = cw[cc]; w1[cc] = cw[W2 + cc]; w2[cc] = cw[2 * W2 + cc]; bb[cc] = cb[cc]; }
        float p[6][8];
#pragma unroll
        for (int i = 0; i < 6; ++i) { const bool ok = (i == 0) ? lv : (i == 5) ? rv : true;
            const unsigned cv_[4] = {cg[i].x, cg[i].y, cg[i].z, cg[i].w}, xv_[4] = {xa[i].x, xa[i].y, xa[i].z, xa[i].w};
#pragma unroll
            for (int pp = 0; pp < 4; ++pp) { p[i][2 * pp] = ok ? __uint_as_float(cv_[pp] << 16) * __uint_as_float(xv_[pp] << 16) : 0.f;
                p[i][2 * pp + 1] = ok ? __uint_as_float(cv_[pp] & 0xffff0000u) * __uint_as_float(xv_[pp] & 0xffff0000u) : 0.f; } }
#pragma unroll
        for (int i = 0; i < 4; ++i) { const unsigned bv_[4] = {bg[i].x, bg[i].y, bg[i].z, bg[i].w}; float o[8];
#pragma unroll
            for (int cc = 0; cc < 8; ++cc) { const float bgf = (cc & 1) ? __uint_as_float(bv_[cc >> 1] & 0xffff0000u) : __uint_as_float(bv_[cc >> 1] << 16);
                o[cc] = bgf * (bb[cc] + w0[cc] * p[i][cc] + w1[cc] * p[i + 1][cc] + w2[cc] * p[i + 2][cc]); }
            u32x4_t ow; ow.x = pk_bf16(o[0], o[1]); ow.y = pk_bf16(o[2], o[3]); ow.z = pk_bf16(o[4], o[5]); ow.w = pk_bf16(o[6], o[7]);
            *(u32x4_t*)(P.m + (size_t)(rowb + i) * D + c8) = ow; }
    }
}
#endif

#ifdef CPU_EMU
#define GEMM_CALL(PAIR, A, Bt, G, Mg, N, K, epi) gemm_stage<PAIR>(A, Bt, G, Mg, N, K, epi)
DEV void do_stage(const Params& P, int l, int st) {
    const int tid_ = threadIdx.x;
#else
__device__ __forceinline__ void do_stage(const Params& P, int l, int st, PG8_LAS unsigned char* lds, int tid_in) {
#endif
#ifndef CPU_EMU
    int tid_ = tid_in; asm volatile("" : "+v"(tid_));
    if (st == ST_SILU) return;
    if (st == ST_MOD) { fs_wconv(P, lds, tid_); __syncthreads(); fs_mod(P, lds, tid_); return; }
    if (st == ST_ROW_MIX) { fs_row<0>(P, l, lds, tid_); return; }
    if (st == ST_ROW_FFN) { fs_row_ffn(P, l, lds, tid_); return; }
    if (st == ST_ROW_FINAL) { fs_row<2>(P, l, lds, tid_); return; }
    if (st == ST_SELECT_WCONV) { fs_select(P, l, lds, tid_); if (PROBE_SET == 14) { __syncthreads(); fs_select(P, l, lds, tid_); } fs_moe_wconv(P, l, lds, tid_, 1 << 30); return; }
    if (st == ST_GATHER2) { fs_gather(P, tid_); return; }
#define REP(kk, call) do { call; if (PROBE_SET == (kk)) { __syncthreads(); call; } } while (0)
    if (st == ST_EVEN1) { REP(6, fs_even1(P, l, lds, tid_)); return; }
    if (st == ST_EVEN2) { fs_even2(P, tid_); return; }
    if (st == ST_EVEN3) { fs_even3(P, l, lds, tid_); REP(8, fs_even_conv(P, l, tid_)); return; }
    if (st == ST_ODD1) { fs_odd_lru<false>(P, l, lds, tid_); REP(10, fs_sgstat(P, tid_)); return; }
    if (st == ST_ODD2) { fs_odd2(P, tid_); return; }
    if (st == ST_ODD3) { fs_odd_lru<true>(P, l, lds, tid_); REP(12, fs_odd_sg(P, l, lds, tid_)); return; }
#endif
    const int li = l >> 1;
    const bool even = (l & 1) == 0;
    const int ldz = even ? NZE : NZO;
    switch (st) {
    case ST_SILU: {
        GSL(i, (NB + 1) * D) { const int bb = (int)(i / D), k = (int)(i % D); const float v = bb < NB ? P.c[(size_t)bb * D + k] : P.c_ctx[k]; P.sbuf[i] = siluf_(v); }
    } break;
    case ST_MOD: {
        GSL(i, (long)DEPTH * (NB + 1) * MODW) {
            const int j = (int)(i % MODW), bb = (int)((i / MODW) % (NB + 1)), ll = (int)(i / ((long)MODW * (NB + 1)));
            float acc = P.ada_b[(size_t)ll * MODW + j];
            const float* w = P.ada_w + (size_t)ll * D * MODW + j; const float* s = P.sbuf + (size_t)bb * D;
            for (int k = 0; k < D; ++k) acc += s[k] * w[(size_t)k * MODW];
            P.mod[i] = acc;
        }
    } break;
    case ST_WCONV: {
        GSL(i, 2L * NZE * D) { const int q = (int)(i / ((long)NZE * D)), n = (int)((i / D) % NZE), k = (int)(i % D);
            P.wt_ev_in[i] = n < EV_IN ? f2bf(P.ev_w_in[((size_t)q * D + k) * EV_IN + n]) : (bf16_t)0; }
        GSL(i, 2L * NZO * D) { const int q = (int)(i / ((long)NZO * D)), n = (int)((i / D) % NZO), k = (int)(i % D);
            P.wt_od_in[i] = f2bf(P.od_w_in[((size_t)q * D + k) * NZO + n]); }
        GSL(i, 2L * D * D) { const int q = (int)(i / ((long)D * D)), n = (int)((i / D) % D), k = (int)(i % D);
            P.wt_ev_out[i] = f2bf(P.ev_w_out[((size_t)q * D + k) * D + n]);
            P.wt_od_out[i] = f2bf(P.od_w_out[((size_t)q * D + k) * D + n]); }
    } break;
    case ST_NORM_STATS_MIX: case ST_NORM_STATS_FFN: case ST_FINAL_STATS: {
        const int nrows = st == ST_FINAL_STATS ? RL : R;
        GSL(r, nrows) { const float* xr = st == ST_NORM_STATS_MIX ? xsrc_row(P, l, (int)r) : x_row(P, (int)r);
            float ss = 0.f; for (int j = 0; j < D; ++j) ss += xr[j] * xr[j];
            P.rinv[r] = rsq_(ss / D + EPS); }
    } break;
    case ST_NORM_APPLY_MIX: case ST_NORM_APPLY_FFN: {
        const bool mix = st == ST_NORM_APPLY_MIX;
        const float* g = (mix ? P.norm_mix_g : P.norm_ffn_g) + (size_t)l * D;
        GSL(i, (long)R * D) { const int r = (int)(i / D), j = (int)(i % D);
            const float* mr = modrow(P, l, row_bb(r));
            const float xv = mix ? xsrc_row(P, l, r)[j] : x_row(P, r)[j];
            const float hv = (xv * P.rinv[r] * g[j]) * (1.0f + mr[(mix ? 1 : 4) * D + j]) + mr[(mix ? 0 : 3) * D + j];
            P.h[i] = f2bf(hv); }
    } break;
    case ST_GEMM_IN: {
        const bf16_t* wt = even ? P.wt_ev_in + (size_t)li * NZE * D : P.wt_od_in + (size_t)li * NZO * D;
#ifdef CPU_EMU
        EpiZ_ e; e.z = P.z; e.ldz = ldz;
        GEMM_CALL(false, P.h, wt, 1, R, ldz, D, e);
#else
        pg8::Gemm g{P.h, wt, D}; pg8::StaticOrder S; S.init(R, ldz, (int)gridDim.x, (int)blockIdx.x);
        pg8::EpiZ8 e{P.z, ldz}; pg8::gemm_phase<false, false>(lds, g, S, e, tid_);
        fs_moe_wconv(P, l, lds, tid_, even ? WQ_QUOTA_IN_EVEN : WQ_QUOTA_IN_ODD);
#endif
    } break;
    case ST_E_LA: {
        GSL(i, 2L * NB * NCH * KEY) {
            const int col = (int)(i % KEY), c = (int)((i / KEY) % NCH), b = (int)((i / ((long)KEY * NCH)) % NB), dir = (int)(i / ((long)KEY * NCH * NB));
            const float* up = P.ev_decay_up + ((size_t)li * 2 + dir) * RANK * KEY;
            const float bias = P.ev_decay_b[((size_t)li * 2 + dir) * KEY + col];
            float acc = 0.f;
            for (int s = 0; s < CH; ++s) {
                const int sp = dir == 0 ? s : CH - 1 - s;
                const int row = seqrow(b, c * CH + sp);
                const bf16_t* lr = P.z + (size_t)row * ldz + (dir == 0 ? E_LRF : E_LRB);
                float xx = bias;
                for (int rr = 0; rr < RANK; ++rr) xx += bf2f(lr[rr]) * up[(size_t)rr * KEY + col];
                acc += logsigmoidf_(xx) * (1.0f / 16.0f);
                P.bcum[((size_t)dir * R + row) * KEY + col] = acc;
            }
        }
    } break;
    case ST_E_DS: {
        GSL(i, 2L * NB * GH * NCH * DK * DV) {
            const int e = (int)(i % DV), d = (int)((i / DV) % DK), c = (int)((i / ((long)DV * DK)) % NCH), hh = (int)((i / ((long)DV * DK * NCH)) % GH),
                      b = (int)((i / ((long)DV * DK * NCH * GH)) % NB), dir = (int)(i / ((long)DV * DK * NCH * GH * NB));
            const int rend = seqrow(b, c * CH + (dir == 0 ? CH - 1 : 0));
            const float bend = P.bcum[((size_t)dir * R + rend) * KEY + hh * DK + d];
            float acc = 0.f;
            for (int j = 0; j < CH; ++j) { const int row = seqrow(b, c * CH + j);
                const float kk = bf2f(P.z[(size_t)row * ldz + E_K + hh * DK + d]), vv = bf2f(P.z[(size_t)row * ldz + E_V + hh * DV + e]);
                acc += kk * expf(bend - P.bcum[((size_t)dir * R + row) * KEY + hh * DK + d]) * vv; }
            P.S[i] = acc;
        }
    } break;
    case ST_E_SCAN: {
        GSL(i, 2L * NB * GH * DK * DV) {
            const int e = (int)(i % DV), d = (int)((i / DV) % DK), hh = (int)((i / ((long)DV * DK)) % GH), b = (int)((i / ((long)DV * DK * GH)) % NB), dir = (int)(i / ((long)DV * DK * GH * NB));
            float s = 0.f;
            for (int step = 0; step < NCH; ++step) {
                const int c = dir == 0 ? step : (step < NCHC ? NCHC - 1 - step : NCH - 1 - (step - NCHC));
                const size_t idx = (((((size_t)dir * NB + b) * GH + hh) * NCH + c) * DK + d) * DV + e;
                const int rend = seqrow(b, c * CH + (dir == 0 ? CH - 1 : 0));
                const float dec = expf(P.bcum[((size_t)dir * R + rend) * KEY + hh * DK + d]);
                const float tmp = P.S[idx]; P.S[idx] = s; s = dec * s + tmp;
            }
        }
    } break;
    case ST_E_ATT: {
        const float scale = 1.0f / sqrtf((float)DK);
        GSL(i, 2L * NB * GH * NCH * CH * CH) {
            const int j = (int)(i % CH), ii = (int)((i / CH) % CH), c = (int)((i / ((long)CH * CH)) % NCH), hh = (int)((i / ((long)CH * CH * NCH)) % GH),
                      b = (int)((i / ((long)CH * CH * NCH * GH)) % NB), dir = (int)(i / ((long)CH * CH * NCH * GH * NB));
            float acc = 0.f;
            if (dir == 0 ? (j <= ii) : (j >= ii)) {
                const int ri = seqrow(b, c * CH + ii), rj = seqrow(b, c * CH + j);
                for (int d = 0; d < DK; ++d) {
                    const float qq = bf2f(P.z[(size_t)ri * ldz + E_Q + hh * DK + d]) * scale, kk = bf2f(P.z[(size_t)rj * ldz + E_K + hh * DK + d]);
                    acc += qq * kk * expf(P.bcum[((size_t)dir * R + ri) * KEY + hh * DK + d] - P.bcum[((size_t)dir * R + rj) * KEY + hh * DK + d]); }
            }
            P.att[i] = acc;
        }
    } break;
    case ST_E_O: {
        const float scale = 1.0f / sqrtf((float)DK);
        GSL(i, (long)NB * GH * NCH * CH * DV) {
            const int e = (int)(i % DV), ii = (int)((i / DV) % CH), c = (int)((i / ((long)DV * CH)) % NCH), hh = (int)((i / ((long)DV * CH * NCH)) % GH), b = (int)(i / ((long)DV * CH * NCH * GH));
            const int ri = seqrow(b, c * CH + ii);
            float acc = 0.f;
            for (int dir = 0; dir < 2; ++dir) {
                const size_t cb = ((((size_t)dir * NB + b) * GH + hh) * NCH + c);
                const float* at = P.att + (cb * CH + ii) * CH;
                for (int j = 0; j < CH; ++j) { const int rj = seqrow(b, c * CH + j); acc += at[j] * bf2f(P.z[(size_t)rj * ldz + E_V + hh * DV + e]); }
                const float* Sin = P.S + cb * DK * DV;
                for (int d = 0; d < DK; ++d) {
                    const float qq = bf2f(P.z[(size_t)ri * ldz + E_Q + hh * DK + d]) * scale;
                    acc += qq * expf(P.bcum[((size_t)dir * R + ri) * KEY + hh * DK + d]) * Sin[(size_t)d * DV + e]; }
            }
            P.o[(size_t)ri * W2 + hh * DV + e] = acc;
        }
    } break;
    case ST_E_READOUT: {
        const float* ng = P.ev_norm_g + (size_t)li * W2;
        GSL(i, (long)R * GH) { const int row = (int)(i / GH), hh = (int)(i % GH);
            const float* orow = P.o + (size_t)row * W2 + hh * DV;
            float ss = 0.f; for (int e = 0; e < DV; ++e) ss += orow[e] * orow[e];
            const float rinv = rsq_(ss / DV + EPS);
            for (int e = 0; e < DV; ++e) { const float g = bf2f(P.z[(size_t)row * ldz + E_G + hh * DV + e]);
                P.m[(size_t)row * D + W2 + hh * DV + e] = f2bf(orow[e] * rinv * ng[hh * DV + e] * siluf_(g)); }
        }
    } break;
    case ST_E_CONV: {
        const float* cw = P.ev_conv_w + (size_t)li * 3 * W2; const float* cb = P.ev_conv_b + (size_t)li * W2;
        GSL(i, (long)R * W2) { const int row = (int)(i / W2), col = (int)(i % W2);
            bool lv, rv;
            if (row < RL) { const int pos = (row % T) % GRIDW; lv = pos > 0; rv = pos < GRIDW - 1; }
            else { const int t = (row - RL) % TC; lv = t > 0; rv = t < TC - 1; }
            const bf16_t* zr = P.z + (size_t)row * ldz;
            float acc = cb[col] + cw[W2 + col] * (bf2f(zr[E_CG + col]) * bf2f(zr[E_XA + col]));
            if (lv) acc += cw[col] * (bf2f(zr[E_CG + col - ldz]) * bf2f(zr[E_XA + col - ldz]));
            if (rv) acc += cw[2 * W2 + col] * (bf2f(zr[E_CG + col + ldz]) * bf2f(zr[E_XA + col + ldz]));
            P.m[(size_t)row * D + col] = f2bf(bf2f(zr[E_BG + col]) * acc); }
    } break;
    case ST_O_XC: {
        const float* cw = P.od_conv_w + (size_t)li * 4 * W2; const float* cb = P.od_conv_b + (size_t)li * W2;
        GSL(i, (long)R * W2) { const int row = (int)(i / W2), col = (int)(i % W2);
            int t, len; if (row < RL) { t = row % T; len = T; } else { t = (row - RL) % TC; len = TC; }
            float acc = cb[col];
            for (int j = 0; j < 4; ++j) { const int tt = t - 2 + j; if (tt >= 0 && tt < len) acc += cw[j * W2 + col] * bf2f(P.z[(size_t)(row - 2 + j) * ldz + O_XB + col]); }
            P.xc[i] = acc; }
    } break;
    case ST_O_COEF: {
        GSL(i, 2L * R * W2) { const int col = (int)(i % W2), row = (int)((i / W2) % R), dir = (int)(i / ((long)W2 * R));
            const int hh = col / HD, jj = col % HD;
            const float* wa = P.od_gate_a_w + ((((size_t)li * 2 + dir) * 4 + hh) * HD) * HD + jj;
            const float* wx = P.od_gate_x_w + ((((size_t)li * 2 + dir) * 4 + hh) * HD) * HD + jj;
            const float* xr = P.xc + (size_t)row * W2 + hh * HD;
            float ra = P.od_gate_a_b[((size_t)li * 2 + dir) * W2 + col], rx = P.od_gate_x_b[((size_t)li * 2 + dir) * W2 + col];
            for (int k = 0; k < HD; ++k) { ra += xr[k] * wa[(size_t)k * HD]; rx += xr[k] * wx[(size_t)k * HD]; }
            const float rg = sigmoidf_(ra), ig = sigmoidf_(rx);
            const float log_a = -8.0f * rg * softplusf_(-P.od_lambda[((size_t)li * 2 + dir) * W2 + col]);
            P.A[i] = expf(log_a);
            P.Bc[i] = sqrtf(-expm1f(2.0f * log_a)) * (ig * P.xc[(size_t)row * W2 + col]); }
    } break;
    case ST_O_SCAN: {
        GSL(i, 2L * NB * W2) { const int col = (int)(i % W2), b = (int)((i / W2) % NB), dir = (int)(i / ((long)W2 * NB));
            float hc = 0.f;
            for (int step = 0; step < SEQ_ALL; ++step) {
                const int s = dir == 0 ? step : (step < TC ? TC - 1 - step : TC + (T - 1 - (step - TC)));
                const size_t idx = ((size_t)dir * R + seqrow(b, s)) * W2 + col;
                hc = P.A[idx] * hc + P.Bc[idx]; P.Bc[idx] = hc; }
        }
    } break;
    case ST_O_YREC: {
        GSL(i, (long)R * W2) { const int row = (int)(i / W2), col = (int)(i % W2);
            const float gb = bf2f(P.z[(size_t)row * ldz + O_GB + col]);
            P.m[(size_t)row * D + col] = f2bf((P.Bc[i] + P.Bc[(size_t)R * W2 + i]) * geluf_(gb)); }
    } break;
    case ST_O_SGSTAT: {
        GSL(r, R) { const bf16_t* vr = P.z + (size_t)r * ldz + O_V;
            float s = 0.f; for (int j = 0; j < W2; ++j) s += geluf_(bf2f(vr[j]));
            const float mean = s / W2; float vs = 0.f;
            for (int j = 0; j < W2; ++j) { const float dlt = geluf_(bf2f(vr[j])) - mean; vs += dlt * dlt; }
            P.sgstat[2 * r] = mean; P.sgstat[2 * r + 1] = rsq_(vs / W2 + EPS); }
    } break;
    case ST_O_VB: {
        const float* gn = P.od_sg_norm_g + (size_t)li * W2;
        GSL(i, (long)R * W2) { const int row = (int)(i / W2), col = (int)(i % W2);
            P.vb[i] = (geluf_(bf2f(P.z[(size_t)row * ldz + O_V + col])) - P.sgstat[2 * row]) * P.sgstat[2 * row + 1] * gn[col]; }
    } break;
    case ST_O_SGMIX: {
        GSL(i, (long)R * W2) { const int row = (int)(i / W2), col = (int)(i % W2);
            const int t = row < RL ? row % T : (row - RL) % TC;
            const int ii = t % SGC, base = row - ii, g = col / HD;
            const float* w = P.od_sg_w + (((size_t)li * 4 + g) * SGC + ii) * SGC;
            float acc = P.od_sg_b[((size_t)li * 4 + g) * SGC + ii];
            for (int j = 0; j < SGC; ++j) acc += w[j] * P.vb[(size_t)(base + j) * W2 + col];
            P.m[(size_t)row * D + W2 + col] = f2bf(geluf_(bf2f(P.z[(size_t)row * ldz + O_U + col])) * acc); }
    } break;
    case ST_GEMM_OUT: {
        const bf16_t* wt = (even ? P.wt_ev_out : P.wt_od_out) + (size_t)li * D * D;
#ifdef CPU_EMU
        EpiWout_ e; e.P = &P; e.l = l;
        GEMM_CALL(false, P.m, wt, 1, R, D, D, e);
#else
        pg8::Gemm g{P.m, wt, D}; pg8::StaticOrder S; S.init(l == DEPTH - 1 ? RL : R, D, (int)gridDim.x, (int)blockIdx.x);
        if (l == 0) { pg8::EpiWoutB<true> e{P.x, P.ctx, P.xb, P.mod + (size_t)l * (NB + 1) * MODW, P.ssqp}; pg8::gemm_phase<false, false>(lds, g, S, e, tid_); }
        else { pg8::EpiWoutB<false> e{nullptr, nullptr, P.xb, P.mod + (size_t)l * (NB + 1) * MODW, P.ssqp}; pg8::gemm_phase<false, false>(lds, g, S, e, tid_); }
        fs_moe_wconv(P, l, lds, tid_, (even ? WQ_QUOTA_IN_EVEN : WQ_QUOTA_IN_ODD) + WQ_QUOTA_OUT);
#endif
    } break;
    case ST_ROUTER_LOGIT: {
        const float* g = P.norm_ffn_g + (size_t)l * D; const float* wr = P.moe_router + (size_t)l * D * NE;
        GSL(i, (long)R * NE) { const int r = (int)(i / NE), e = (int)(i % NE);
            const float* mr = modrow(P, l, row_bb(r)); const float* xr = x_row(P, r); const float ri = P.rinv[r];
            float acc = 0.f;
            for (int j = 0; j < D; ++j) acc += ((xr[j] * ri * g[j]) * (1.0f + mr[4 * D + j]) + mr[3 * D + j]) * wr[(size_t)j * NE + e];
            P.logit[i] = acc; }
    } break;
    case ST_ROUTER_SOFTMAX: {
        GSL(r, R) { const float* lg = P.logit + (size_t)r * NE; float mx = lg[0]; for (int e = 1; e < NE; ++e) mx = fmaxf(mx, lg[e]);
            float s = 0.f;
            for (int e = 0; e < NE; ++e) s += expf(lg[e] - mx);
            for (int e = 0; e < NE; ++e) P.aff[(size_t)r * NE + e] = expf(lg[e] - mx) / s; }
    } break;
    case ST_MOE_WCONV: {
        const float* wg = P.moe_w_gate + (size_t)l * NE * D * D; const float* wu = P.moe_w_up + (size_t)l * NE * D * D; const float* wd = P.moe_w_down + (size_t)l * NE * D * D;
        GSL(i, (long)NE * 2 * D * D) { const int e = (int)(i / (2L * D * D)), cv = (int)((i / D) % (2 * D)), k = (int)(i % D);
            const int w = cv % 256, j = (cv / 256) * 128 + (w % 128);
            P.wt_gu[i] = f2bf((w >= 128 ? wu : wg)[((size_t)e * D + k) * D + j]); }
        GSL(i, (long)NE * D * D) { const int e = (int)(i / ((long)D * D)), n = (int)((i / D) % D), k = (int)(i % D);
            P.wt_dn[i] = f2bf(wd[((size_t)e * D + k) * D + n]); }
    } break;
    case ST_SELECT: {
        GSL(i, (long)R * NE) { const int e = (int)(i / R), r = (int)(i % R);
            int base, n, cap, slot0;
            if (r < RL) { const int b = r / T; base = b * T; n = T; cap = CAPL; slot0 = b * CAPL; }
            else { const int b = (r - RL) / TC; base = RL + b * TC; n = TC; cap = CAPC; slot0 = NB * CAPL + b * CAPC; }
            const float a = P.aff[(size_t)r * NE + e];
            int rank = 0;
            for (int t = 0; t < n; ++t) { const float o = P.aff[(size_t)(base + t) * NE + e]; rank += (o > a || (o == a && base + t < r)) ? 1 : 0; }
            if (rank < cap) { const int slot = e * SLOTS_E + slot0 + rank; P.sel_row[slot] = r; P.sel_g[slot] = a; P.inv[(size_t)r * NE + e] = slot; }
            else P.inv[(size_t)r * NE + e] = -1; }
    } break;
    case ST_GATHER: {
        GSL(i, (long)SLOTS * D) { const int slot = (int)(i / D), j = (int)(i % D); P.xg[i] = P.h[(size_t)P.sel_row[slot] * D + j]; }
    } break;
    case ST_GEMM_GU: {
#ifdef CPU_EMU
        EpiGU_ e; e.hid = P.hid;
        GEMM_CALL(true, P.xg, P.wt_gu, NE, SLOTS_E, 2 * D, D, e);
#else
        pg8::Gemm g{P.h, P.wt_gu, D}; pg8::GroupedOrder S; S.init(l == DEPTH - 1 ? NB * CAPL : SLOTS_E, SLOTS_E, 2 * D, NE, (int)gridDim.x, (int)blockIdx.x);
        PG8_LAS int* gix = (PG8_LAS int*)(lds + GEMM_LDS_BYTES + 16);
        for (int kk = tid_ >> 8; kk < GIX_UNITS; kk += 2) { pg8::Unit uu; if (S.next(kk, uu)) gix[kk * 256 + (tid_ & 255)] = P.sel_row[uu.pm * 256 + (tid_ & 255)]; }
        __syncthreads();
        pg8::EpiGU_F8 e{(unsigned char*)P.hid, 2 * D / 256}; pg8::gemm_phase<true, true>(lds, g, S, e, tid_, gix);
#endif
    } break;
    case ST_GEMM_DOWN: {
#ifdef CPU_EMU
        EpiDown_ e; e.out = P.outslot; e.selg = P.sel_g;
        GEMM_CALL(false, P.hid, P.wt_dn, NE, SLOTS_E, D, D, e);
#else
        pg8::Gemm g{P.hid, P.wt_dn, D}; pg8::GroupedOrder S; S.init(l == DEPTH - 1 ? NB * CAPL : SLOTS_E, SLOTS_E, D, NE, (int)gridDim.x, (int)blockIdx.x);
        pg8::EpiDown8 e{(unsigned char*)P.outslot, P.sel_g, D / 256, 1.0f / pg8::W8_SCALE}; pg8::gemm_phase<false, true>(lds, g, S, e, tid_);
#endif
    } break;
    case ST_COMBINE: {
        GSL(i, (long)R * D) { const int r = (int)(i / D), j = (int)(i % D);
            float s = 0.f;
            for (int e = 0; e < NE; ++e) { const int sl = P.inv[(size_t)r * NE + e]; if (sl >= 0) s += bf2f(P.outslot[(size_t)sl * D + j]); }
            float* xr = x_row(P, r); xr[j] += modrow(P, l, row_bb(r))[5 * D + j] * s; }
    } break;
    case ST_FINAL_APPLY: {
        GSL(i, (long)RL * D) { const int r = (int)(i / D), j = (int)(i % D); P.xlat[i] = P.xlat[i] * P.rinv[r] * P.norm_final_g[j]; }
    } break;
    default: break;
    }
}

template <class F> inline void stage_program(F&& run) {
    run(0, ST_SILU); run(0, ST_MOD); run(0, ST_WCONV);
    for (int l = 0; l < DEPTH; ++l) {
        run(l, ST_NORM_STATS_MIX); run(l, ST_NORM_APPLY_MIX); run(l, ST_GEMM_IN);
        if ((l & 1) == 0) { run(l, ST_E_LA); run(l, ST_E_DS); run(l, ST_E_SCAN); run(l, ST_E_ATT); run(l, ST_E_O); run(l, ST_E_READOUT); run(l, ST_E_CONV); }
        else { run(l, ST_O_XC); run(l, ST_O_COEF); run(l, ST_O_SCAN); run(l, ST_O_YREC); run(l, ST_O_SGSTAT); run(l, ST_O_VB); run(l, ST_O_SGMIX); }
        run(l, ST_GEMM_OUT);
        run(l, ST_NORM_STATS_FFN); run(l, ST_NORM_APPLY_FFN); run(l, ST_ROUTER_LOGIT); run(l, ST_ROUTER_SOFTMAX); run(l, ST_MOE_WCONV);
        run(l, ST_SELECT); run(l, ST_GATHER); run(l, ST_GEMM_GU); run(l, ST_GEMM_DOWN); run(l, ST_COMBINE);
    }
    run(0, ST_FINAL_STATS); run(0, ST_FINAL_APPLY);
}

struct KArgs { const float* in[32]; float* out; char* ws; };
#ifdef CPU_EMU
#define HD_ inline
#else
#define HD_ __host__ __device__ __forceinline__
#endif
struct Carver { char* base; size_t off; template <class Tp> HD_ Tp* take(size_t n) { off = (off + 255) & ~(size_t)255; Tp* p = (Tp*)(base + off); off += n * sizeof(Tp); return p; } };
HD_ size_t carve(Params& p, void* d_ws) {
    Carver cv{(char*)d_ws, 0};
    p.bar = cv.take<unsigned>(4096); p.wq = p.bar + 3584;
    p.mod = cv.take<float>((size_t)DEPTH * (NB + 1) * MODW); p.sbuf = cv.take<float>((size_t)(NB + 1) * D); p.xctx = cv.take<float>((size_t)RC * D);
    p.rinv = cv.take<float>(R); p.aff = cv.take<float>((size_t)R * NE); p.logit = cv.take<float>((size_t)R * NE); p.sel_g = cv.take<float>(SLOTS);
    p.sel_row = cv.take<int>(SLOTS); p.inv = cv.take<int>((size_t)R * NE);
    p.wt_ev_in = cv.take<bf16_t>(2ull * NZE * D); p.wt_od_in = cv.take<bf16_t>(2ull * NZO * D); p.wt_ev_out = cv.take<bf16_t>(2ull * D * D); p.wt_od_out = cv.take<bf16_t>(2ull * D * D);
    p.gwT = cv.take<bf16_t>(2ull * 2 * 2 * 4 * HD * HD); p.sgw = cv.take<bf16_t>(2ull * 4 * SGC * SGC); p.sumA = cv.take<float>(2ull * NB * NCH * W2); p.sumB = cv.take<float>(2ull * NB * NCH * W2); p.decv = cv.take<float>(2ull * NB * GH * NCH * DK); p.hinb = cv.take<float>(2ull * NB * NCH * W2); p.ssqp = cv.take<float>((size_t)R * 16);
    p.xb = cv.take<bf16_t>((size_t)R * D);
    p.wt_gu = cv.take<bf16_t>((size_t)NE * 2 * D * D); p.wt_dn = cv.take<bf16_t>((size_t)NE * D * D); p.h = cv.take<bf16_t>((size_t)R * D);
    const size_t u0 = (cv.off + 255) & ~(size_t)255;
    p.z = cv.take<bf16_t>((size_t)R * NZE); p.m = cv.take<bf16_t>((size_t)R * D);
    const size_t u1 = cv.off;
#ifdef CPU_EMU
    p.bcum = cv.take<float>(2ull * R * KEY); p.att = cv.take<float>(2ull * NB * GH * NCH * CH * CH); p.o = cv.take<float>((size_t)R * W2);
#endif
#ifdef CPU_EMU
    p.S = cv.take<float>(2ull * NB * GH * NCH * DK * DV);
#endif
    p.Sd = cv.take<bf16_t>(2ull * NB * GH * NCH * DK * DV); p.SinB = cv.take<bf16_t>(2ull * NB * GH * NCH * DK * DV);
    size_t end = cv.off;
    cv.off = u1;
    p.sgstat = cv.take<float>(2ull * R);
#ifdef CPU_EMU
    p.xc = cv.take<float>((size_t)R * W2); p.A = cv.take<float>(2ull * R * W2); p.Bc = cv.take<float>(2ull * R * W2); p.vb = cv.take<float>((size_t)R * W2);
#endif
    if (cv.off > end) end = cv.off;
    cv.off = u0;
    p.xg = cv.take<bf16_t>((size_t)SLOTS * D); p.hid = cv.take<bf16_t>((size_t)SLOTS * D); p.outslot = cv.take<bf16_t>((size_t)SLOTS * D);
    if (cv.off > end) end = cv.off;
    return end;
}
HD_ void fill_inputs(Params& p, const float* const* in, void* d_out) {
    p.x = in[0]; p.c = in[1]; p.ctx = in[2]; p.c_ctx = in[3]; p.ada_w = in[4]; p.ada_b = in[5]; p.norm_mix_g = in[6]; p.norm_ffn_g = in[7]; p.norm_final_g = in[8];
    p.ev_w_in = in[9]; p.ev_conv_w = in[10]; p.ev_conv_b = in[11]; p.ev_decay_up = in[12]; p.ev_decay_b = in[13]; p.ev_norm_g = in[14]; p.ev_w_out = in[15];
    p.od_w_in = in[16]; p.od_conv_w = in[17]; p.od_conv_b = in[18]; p.od_gate_a_w = in[19]; p.od_gate_a_b = in[20]; p.od_gate_x_w = in[21]; p.od_gate_x_b = in[22];
    p.od_lambda = in[23]; p.od_sg_norm_g = in[24]; p.od_sg_w = in[25]; p.od_sg_b = in[26]; p.od_w_out = in[27];
    p.moe_router = in[28]; p.moe_w_gate = in[29]; p.moe_w_up = in[30]; p.moe_w_down = in[31];
    p.xlat = (float*)d_out;
}

#ifndef CPU_EMU
#define XB_TMO      128
#define XB_XCNT(j)  (256  + 64 * (j))
#define XB_XSUB(j)  (1280 + 64 * (j))
#define XB_XGEN(j)  (2304 + 64 * (j))
#define XB_TOP      3328
#define XB_TOPGEN   3392
#define XCD_BAR_WORDS 3456
#define XB_SPIN_CAP (1u << 18)
#define LAS __attribute__((address_space(3)))

__device__ __forceinline__ unsigned xb_ld(unsigned* p)              { return __hip_atomic_load(p, __ATOMIC_RELAXED, __HIP_MEMORY_SCOPE_AGENT); }
__device__ __forceinline__ unsigned xb_add(unsigned* p, unsigned v) { return __hip_atomic_fetch_add(p, v, __ATOMIC_RELAXED, __HIP_MEMORY_SCOPE_AGENT); }
__device__ __forceinline__ unsigned xb_xcc_id() { return (unsigned)__builtin_amdgcn_s_getreg((3 << 11) | 20) & 0xFu; }
#define XB_SPIN(cond, bar) do { unsigned _sp = 0; while (cond) { __builtin_amdgcn_s_sleep(1); \
    if ((++_sp & 255u) == 0u) { if (xb_ld(&(bar)[XB_TMO])) break; if (_sp > XB_SPIN_CAP) { atomicAdd(&(bar)[XB_TMO], 1u); break; } } } } while (0)

struct XcdBarrier {
    unsigned* bar; unsigned x;
    volatile LAS unsigned* st;
};

__device__ __forceinline__ XcdBarrier xcd_barrier_post(unsigned* bar, volatile LAS unsigned* st, bool lead  ) {
    XcdBarrier b; b.bar = bar; b.x = xb_xcc_id(); b.st = st;
    if (lead) (void)xb_add(&bar[XB_XCNT(b.x)], 1u);
    return b;
}
__device__ __forceinline__ void xcd_barrier_complete(unsigned* bar, unsigned x, unsigned& nloc, unsigned& nx) {
    const unsigned G = gridDim.x * gridDim.y * gridDim.z;
    unsigned sum, cnt, mine, sp = 0u;
    for (;;) {
        sum = 0u; cnt = 0u; mine = 0u;
#pragma unroll
        for (unsigned j = 0; j < 16; ++j) { const unsigned c = xb_ld(&bar[XB_XCNT(j)]); sum += c; cnt += (c > 0u) ? 1u : 0u; mine = (j == x) ? c : mine; }
        if (sum == G) break;
        __builtin_amdgcn_s_sleep(1);
        if ((++sp & 255u) == 0u) { if (xb_ld(&bar[XB_TMO])) break; if (sp > XB_SPIN_CAP) { atomicAdd(&bar[XB_TMO], 1u); break; } }
    }
    nloc = mine > 0u ? mine : 1u; nx = cnt > 0u ? cnt : 1u;
}

__device__ __forceinline__ void xcd_barrier(const XcdBarrier& b, bool lead  ) {
    asm volatile("s_waitcnt vmcnt(0)" ::: "memory");
    __syncthreads();
    if (lead) {
        unsigned* bar = b.bar;
        __builtin_amdgcn_s_waitcnt(0);
        unsigned nloc = b.st[0], nx = b.st[1];
        if (nloc == 0u) { xcd_barrier_complete(bar, b.x, nloc, nx); b.st[0] = nloc; b.st[1] = nx; }
        const unsigned old = xb_add(&bar[XB_XSUB(b.x)], 1u);
        const unsigned gen = old / nloc;
        if (old + 1u == (gen + 1u) * nloc) {
            __builtin_amdgcn_fence(__ATOMIC_RELEASE, "agent");
            asm volatile("s_waitcnt vmcnt(0)" ::: "memory");
            const unsigned og = xb_add(&bar[XB_TOP], 1u);
            const unsigned tg = og / nx;
            if (og + 1u == (tg + 1u) * nx) xb_add(&bar[XB_TOPGEN], 1u);
            else XB_SPIN(xb_ld(&bar[XB_TOPGEN]) == tg, bar);
            __builtin_amdgcn_fence(__ATOMIC_ACQUIRE, "agent");
            xb_add(&bar[XB_XGEN(b.x)], 1u);
            asm volatile("s_waitcnt vmcnt(0)" ::: "memory");
        } else {
            XB_SPIN(xb_ld(&bar[XB_XGEN(b.x)]) == gen, bar);
            __builtin_amdgcn_fence(__ATOMIC_ACQUIRE, "agent");
            asm volatile("s_waitcnt vmcnt(0)" ::: "memory");
        }
    }
    __syncthreads();
}


typedef const __attribute__((address_space(4))) char* kargp_t;
__device__ __forceinline__ void load_params(Params& p, kargp_t kp) {
    const float* in[32];
#pragma unroll
    for (int i = 0; i < 32; ++i) in[i] = *(const float* const __attribute__((address_space(4)))*)(kp + 8 * i);
    float* out = *(float* const __attribute__((address_space(4)))*)(kp + 256);
    char* ws = *(char* const __attribute__((address_space(4)))*)(kp + 264);
    fill_inputs(p, in, out); carve(p, ws);
}
__device__ __forceinline__ constexpr bool probe_double(int st) {
    return PROBE_SET == 1 ? (st == ST_GEMM_IN || st == ST_GEMM_GU || st == ST_GEMM_DOWN)
         : PROBE_SET == 2 ? (st == ST_EVEN1 || st == ST_EVEN3)
         : PROBE_SET == 3 ? (st == ST_ODD1 || st == ST_ODD3)
         : PROBE_SET == 31 ? (st == ST_ODD1)
         : PROBE_SET == 33 ? (st == ST_EVEN1)
         : PROBE_SET == 4 ? (st == ST_ROW_FFN || st == ST_SELECT_WCONV)
         : PROBE_SET == 13 ? (st == ST_ROW_FFN)
         : PROBE_SET == 21 ? (st == ST_EVEN2 || st == ST_ODD2)
         : PROBE_SET == 5 ? (st == ST_MOD || st == ST_WCONV) : false;
}
#define PHASE(l, st) do { unsigned zo_; asm volatile("s_mov_b32 %0, 0" : "=s"(zo_)); \
    Params P; load_params(P, (kargp_t)__builtin_amdgcn_kernarg_segment_ptr() + zo_); \
    const int tid_ph = wv_ * 64 + (int)__builtin_amdgcn_mbcnt_hi(~0u, __builtin_amdgcn_mbcnt_lo(~0u, 0u)); \
    do_stage(P, (l), (st), lds, tid_ph); if (probe_double(st) || (PROBE_SET == 22 && (l) == 0 && ((st) == ST_GEMM_OUT)) || (PROBE_SET == 23 && (l) == 0 && ((st) == ST_ROW_MIX))) { __syncthreads(); do_stage(P, (l), (st), lds, tid_ph); } xcd_barrier(bar, tid_ph == 0); } while (0)
#define LAYER_HEAD(l) PHASE(l, ST_ROW_MIX); PHASE(l, ST_GEMM_IN);
#define LAYER_TAIL(l) PHASE(l, ST_GEMM_OUT); PHASE(l, ST_ROW_FFN); PHASE(l, ST_SELECT_WCONV); PHASE(l, ST_GEMM_GU); PHASE(l, ST_GEMM_DOWN);
#define LAYER_EVEN(l) LAYER_HEAD(l) PHASE(l, ST_EVEN1); PHASE(l, ST_EVEN2); PHASE(l, ST_EVEN3); LAYER_TAIL(l)
#define LAYER_ODD(l) LAYER_HEAD(l) PHASE(l, ST_ODD1); PHASE(l, ST_ODD2); PHASE(l, ST_ODD3); LAYER_TAIL(l)
__global__ void __launch_bounds__(512, 2) k_all(KArgs ka) {
    extern __shared__ __attribute__((aligned(16))) unsigned char shm[];
    PG8_LAS unsigned char* lds = (PG8_LAS unsigned char*)shm;
    volatile LAS unsigned* xbw = (volatile LAS unsigned*)(lds + GEMM_LDS_BYTES);
    if (threadIdx.x == 0) { xbw[0] = 0u; xbw[1] = 0u; xbw[2] = 0u; xbw[3] = 0u; }
    __syncthreads();
    const int wv_ = __builtin_amdgcn_readfirstlane((int)(threadIdx.x >> 6));
    XcdBarrier bar = xcd_barrier_post((unsigned*)ka.ws, xbw, threadIdx.x == 0);
    PHASE(0, ST_MOD);
    LAYER_EVEN(0) LAYER_ODD(1) LAYER_EVEN(2) LAYER_ODD(3)
    PHASE(0, ST_ROW_FINAL);
}

extern "C" void kernel_launch(void* const* d_in, const int* in_sizes, int n_in, void* d_out, int out_size, void* d_ws, size_t ws_size, hipStream_t stream) {
    KArgs ka; memset(&ka, 0, sizeof(ka));
    for (int i = 0; i < 32; ++i) ka.in[i] = (const float*)d_in[i];
    ka.out = (float*)d_out; ka.ws = (char*)d_ws;
    Params p{}; fill_inputs(p, ka.in, d_out);
    const size_t need = carve(p, d_ws);
    if (need > ws_size) { fprintf(stderr, "workspace too small: need %zu have %zu\n", need, ws_size); return; }
    constexpr size_t kDynLds = DYN_LDS_BYTES;
    static int grid = 0;
    if (!grid) {
        int dev = 0, cus = 0, per_cu = 0;
        (void)hipGetDevice(&dev);
        (void)hipDeviceGetAttribute(&cus, hipDeviceAttributeMultiprocessorCount, dev);
        (void)hipFuncSetAttribute((const void*)k_all, hipFuncAttributeMaxDynamicSharedMemorySize, (int)kDynLds);
        (void)hipOccupancyMaxActiveBlocksPerMultiprocessor(&per_cu, k_all, 512, kDynLds);
        grid = cus * (per_cu < 1 ? per_cu : 1);
    }
    (void)hipMemsetAsync(p.bar, 0, 4096 * sizeof(unsigned), stream);
    hipLaunchKernelGGL(k_all, dim3(grid), dim3(512), kDynLds, stream, ka);
}
#endif
```

```cpp
#ifndef CPU_EMU
#include <hip/hip_runtime.h>
#include <cstdio>
#include <cstring>
#define DEV __device__ __forceinline__
#else
#define DEV inline
#endif
#include <cstdint>
#include <cstddef>

#ifndef D_MODEL
#define D_MODEL 1024
#define BATCH 8
#define SEQ 4096
#define CTXL 256
#endif

#ifndef PROBE_SET
#define PROBE_SET 0
#endif
typedef unsigned short bf16_t;
constexpr int D = D_MODEL, NB = BATCH, T = SEQ, TC = CTXL, DEPTH = 4;
constexpr int RL = NB * T, RC = NB * TC, R = RL + RC;
constexpr int W2 = D / 2;
constexpr int GH = 4, DV = W2 / GH, DK = DV / 2, KEY = GH * DK, RANK = 16, CH = 64, GRIDW = 64;
constexpr int EV_IN = 3 * W2 + KEY + W2 + KEY + W2 + 2 * RANK;
constexpr int NZE = ((EV_IN + 255) / 256) * 256, NZO = 4 * W2;
constexpr int E_BG = 0, E_CG = W2, E_XA = 2 * W2, E_Q = 3 * W2, E_G = E_Q + KEY, E_K = E_G + W2, E_V = E_K + KEY, E_LRF = E_V + W2, E_LRB = E_LRF + RANK;
constexpr int O_XB = 0, O_GB = W2, O_U = 2 * W2, O_V = 3 * W2;
constexpr int NE = 16, CAPL = 2 * T / NE, CAPC = 2 * TC / NE, SLOTS_E = NB * (CAPL + CAPC), SLOTS = NE * SLOTS_E;
constexpr int SEQ_ALL = TC + T, NCH = SEQ_ALL / CH, NCHC = TC / CH;
constexpr int SGC = 128, HD = W2 / 4;
constexpr float EPS = 1e-6f;
constexpr int MODW = 6 * D;

struct Params {
    const float *x, *c, *ctx, *c_ctx, *ada_w, *ada_b, *norm_mix_g, *norm_ffn_g, *norm_final_g;
    const float *ev_w_in, *ev_conv_w, *ev_conv_b, *ev_decay_up, *ev_decay_b, *ev_norm_g, *ev_w_out;
    const float *od_w_in, *od_conv_w, *od_conv_b, *od_gate_a_w, *od_gate_a_b, *od_gate_x_w, *od_gate_x_b, *od_lambda, *od_sg_norm_g, *od_sg_w, *od_sg_b, *od_w_out;
    const float *moe_router, *moe_w_gate, *moe_w_up, *moe_w_down;
    float* xlat;
    float *xctx, *mod, *sbuf, *rinv, *aff, *logit, *sel_g;
    int *sel_row, *inv;
    bf16_t *wt_ev_in, *wt_od_in, *wt_ev_out, *wt_od_out, *wt_gu, *wt_dn, *h, *gwT, *sgw;
    float *sumA, *sumB, *decv, *hinb, *ssqp;
    bf16_t *z, *m;
    float *bcum, *S, *att, *o;
    float *xc, *A, *Bc, *sgstat, *vb;
    bf16_t *xg, *hid, *outslot;
    bf16_t *SinB, *Sd;
    bf16_t* xb;
    unsigned* bar; unsigned* wq;
};

DEV float bf2f(bf16_t v) { union { unsigned u; float f; } c; c.u = (unsigned)v << 16; return c.f; }
DEV bf16_t f2bf(float f) { union { unsigned u; float f; } c; c.f = f; unsigned u = c.u; u += 0x7fffu + ((u >> 16) & 1u); return (bf16_t)(u >> 16); }
DEV float sigmoidf_(float x) { return 1.0f / (1.0f + expf(-x)); }
DEV float siluf_(float x) { return x / (1.0f + expf(-x)); }
DEV float softplusf_(float x) { return fmaxf(x, 0.0f) + log1pf(expf(-fabsf(x))); }
DEV float logsigmoidf_(float x) { return fminf(x, 0.0f) - log1pf(expf(-fabsf(x))); }
DEV float geluf_(float x) { return 0.5f * x * (1.0f + tanhf(0.7978845608028654f * (x + 0.044715f * x * x * x))); }
DEV float rsq_(float x) { return 1.0f / sqrtf(x); }

DEV const float* xsrc_row(const Params& P, int l, int r) {
    if (l == 0) return r < RL ? P.x + (size_t)r * D : P.ctx + (size_t)(r - RL) * D;
    return r < RL ? P.xlat + (size_t)r * D : P.xctx + (size_t)(r - RL) * D;
}
DEV float* x_row(const Params& P, int r) { return r < RL ? P.xlat + (size_t)r * D : P.xctx + (size_t)(r - RL) * D; }
DEV int row_bb(int r) { return r < RL ? r / T : NB; }
DEV int seqrow(int b, int s) { return s < TC ? RL + b * TC + s : b * T + (s - TC); }
DEV const float* modrow(const Params& P, int l, int bb) { return P.mod + ((size_t)l * (NB + 1) + bb) * MODW; }

#define GSL(i, n) for (long i = (long)blockIdx.x * blockDim.x + tid_; i < (long)(n); i += (long)gridDim.x * blockDim.x)

enum {
    ST_SILU = 0, ST_MOD, ST_WCONV,
    ST_NORM_STATS_MIX, ST_NORM_APPLY_MIX, ST_GEMM_IN,
    ST_E_LA, ST_E_DS, ST_E_SCAN, ST_E_ATT, ST_E_O, ST_E_READOUT, ST_E_CONV,
    ST_O_XC, ST_O_COEF, ST_O_SCAN, ST_O_YREC, ST_O_SGSTAT, ST_O_VB, ST_O_SGMIX,
    ST_GEMM_OUT,
    ST_NORM_STATS_FFN, ST_NORM_APPLY_FFN, ST_ROUTER_LOGIT, ST_ROUTER_SOFTMAX, ST_MOE_WCONV, ST_SELECT, ST_GATHER, ST_GEMM_GU, ST_GEMM_DOWN, ST_COMBINE,
    ST_FINAL_STATS, ST_FINAL_APPLY,
    ST_ROW_MIX, ST_ROW_FFN, ST_ROW_FINAL, ST_SELECT_WCONV, ST_GATHER2, ST_ODD1, ST_ODD3, ST_EVEN1, ST_EVEN2, ST_EVEN3, ST_ODD2, ST_COUNT
};

struct EpiZ {
    bf16_t* z; int ldz;
    DEV void elem(int row, int col, float v) const { z[(size_t)row * ldz + col] = f2bf(v); }
};
struct EpiWout {
    const Params* P; int l;
    DEV void elem(int row, int col, float v) const {
        const float* mr = modrow(*P, l, row_bb(row));
        x_row(*P, row)[col] = xsrc_row(*P, l, row)[col] + mr[2 * D + col] * v;
    }
};
struct EpiGU {
    bf16_t* hid;
    DEV void pair(int row, int j, float g, float u) const { hid[(size_t)row * D + j] = f2bf(siluf_(g) * u); }
};
struct EpiDown {
    bf16_t* out; const float* selg;
    DEV void elem(int row, int col, float v) const { out[(size_t)row * D + col] = f2bf(v * selg[row]); }
};

#ifdef CPU_EMU
template <bool PAIR, class Epi>
void gemm_stage(const bf16_t* A, const bf16_t* Bt, int G, int Mg, int N, int K, const Epi& epi) {
    const int tid_ = threadIdx.x;
    GSL(i, (long)G * Mg) {
        const int g = (int)(i / Mg); const int row = (int)i;
        const bf16_t* a = A + (size_t)row * K;
        if (!PAIR) {
            for (int n = 0; n < N; ++n) { const bf16_t* b = Bt + ((size_t)g * N + n) * K; float s = 0.f; for (int k = 0; k < K; ++k) s += bf2f(a[k]) * bf2f(b[k]); epi.elem(row, n, s); }
        } else {
            for (int j = 0; j < N / 2; ++j) {
                const int cg = (j / 128) * 256 + (j % 128), cu = cg + 128;
                const bf16_t* bg = Bt + ((size_t)g * N + cg) * K; const bf16_t* bu = Bt + ((size_t)g * N + cu) * K;
                float sg = 0.f, su = 0.f; for (int k = 0; k < K; ++k) { sg += bf2f(a[k]) * bf2f(bg[k]); su += bf2f(a[k]) * bf2f(bu[k]); }
                epi.pair_(row, j, sg, su);
            }
        }
    }
}
#else
namespace pg8 {
#define PG8_LAS __attribute__((address_space(3)))
typedef short bf16x8 __attribute__((ext_vector_type(8)));
typedef float f32x4 __attribute__((ext_vector_type(4)));
typedef unsigned u32x4 __attribute__((ext_vector_type(4)));
constexpr int BM = 256, BK = 64, HALF = 128, HTB = HALF * BK * 2, STAGE_BYTES = 8 * HTB, NXCD = 8, WGM = 8;
__host__ __device__ __forceinline__ int lds_byte(int r, int c) { const int st = (r >> 4) * 2 + (c >> 5), rr = r & 15, cc = c & 31, ob = rr * 64 + cc * 2; return st * 1024 + (ob ^ (((ob >> 9) & 1) << 5)); }
__host__ __device__ __forceinline__ void stage_rc(int b, int& R_, int& C_) { const int st = b / 1024, sb = b % 1024, swz = sb ^ (((sb >> 9) & 1) << 5); R_ = (st >> 1) * 16 + swz / 64; C_ = (st & 1) * 32 + (swz % 64) / 2; }
__host__ __device__ __forceinline__ int perm32(int rho) { const int n = rho >> 4, i = rho & 15; return 8 * (i >> 2) + 4 * n + (i & 3); }
struct Unit { int pm, pn; };
struct Gemm { const bf16_t* A; const bf16_t* Bt; int K; };
struct StaticOrder {
    int nM, nN, nwg, G, c;
    __device__ __forceinline__ void init(int M, int N, int G_, int c_) { nM = M / BM; nN = N / BM; nwg = nM * nN; G = G_; c = c_; }
    __device__ __forceinline__ bool next(int i, Unit& u) const {
        const long L = (long)i * G + c; if (L >= nwg) return false;
        int wgid = (int)L; { const int q = nwg / NXCD, r = nwg % NXCD, xcd = wgid % NXCD, off = wgid / NXCD; wgid = (xcd < r ? xcd * (q + 1) : r * (q + 1) + (xcd - r) * q) + off; }
        const int nig = WGM * nN, gid = wgid / nig, fm = gid * WGM, gsz = (nM - fm) < WGM ? (nM - fm) : WGM;
        u.pm = fm + ((wgid % nig) % gsz); u.pn = (wgid % nig) / gsz; return true;
    }
    __device__ __forceinline__ void a_ready(const Unit&) const {}
    __device__ __forceinline__ void done(const Unit&) const {}
};
struct GroupedOrder {
    int nMg, nMs, nN, total, G, c;
    __device__ __forceinline__ void init(int Mg_used, int Mg_stride, int N, int groups, int G_, int c_) { nMg = Mg_used / BM; nMs = Mg_stride / BM; nN = N / BM; total = groups * nMg * nN; G = G_; c = c_; }
    __device__ __forceinline__ bool next(int i, Unit& u) const {
        const long L = (long)i * G + c; if (L >= total) return false;
        int wgid = (int)L; { const int q = total / NXCD, r = total % NXCD, xcd = wgid % NXCD, off = wgid / NXCD; wgid = (xcd < r ? xcd * (q + 1) : r * (q + 1) + (xcd - r) * q) + off; }
        const int per = nMg * nN, g = wgid / per, rem = wgid % per;
        const int nig = WGM * nN, gid = rem / nig, fm = gid * WGM, gsz = (nMg - fm) < WGM ? (nMg - fm) : WGM;
        const int pm_l = fm + ((rem % nig) % gsz), pn_l = (rem % nig) / gsz;
        u.pm = g * nMs + pm_l; u.pn = g * nN + pn_l; return true;
    }
    __device__ __forceinline__ void a_ready(const Unit&) const {}
    __device__ __forceinline__ void done(const Unit&) const {}
};
typedef __bf16 bf16x2_n __attribute__((ext_vector_type(2)));
typedef float f32x2_n __attribute__((ext_vector_type(2)));
__device__ __forceinline__ unsigned cvt_pk_bf16(float lo, float hi) { const f32x2_n v = {lo, hi}; const bf16x2_n r = __builtin_convertvector(v, bf16x2_n); return __builtin_bit_cast(unsigned, r); }

typedef int i32x4 __attribute__((ext_vector_type(4)));
typedef int i32x8 __attribute__((ext_vector_type(8)));
__device__ __forceinline__ i32x8 frag_cat(bf16x8 lo, bf16x8 hi) { return __builtin_shufflevector(__builtin_bit_cast(i32x4, lo), __builtin_bit_cast(i32x4, hi), 0, 1, 2, 3, 4, 5, 6, 7); }
template <bool FP8> struct Frags { bf16x8 At[4][2], B0[2][2], B1[2][2]; };
template <> struct Frags<true> { i32x8 At[4], B0[2], B1[2]; };
template <bool GATHER, bool FP8, class Epi, class Sched>
__device__ __forceinline__ void gemm_phase(PG8_LAS unsigned char* lds, const Gemm g, const Sched& S, const Epi& E, const int tid, const PG8_LAS int* gix = nullptr) {
    const int wid = __builtin_amdgcn_readfirstlane(tid >> 6), lane = tid & 63, wr = wid >> 2, wc = wid & 3, fr = lane & 15, fq = lane >> 4;
    const int K = g.K, rowb = FP8 ? K : 2 * K, nt = rowb / (BK * 2);
    unsigned voffA[2], voffB[2];
#pragma unroll
    for (int i = 0; i < 2; ++i) { int R_, C_; stage_rc(tid * 16 + i * 8192, R_, C_); const int Rb = Epi::PERM ? ((R_ & ~31) + perm32(R_ & 31)) : R_;
        voffA[i] = (unsigned)(R_ * rowb + C_ * 2); voffB[i] = (unsigned)(Rb * rowb + C_ * 2); }
    unsigned gv[2][2];
#define PG8_GV(kk) do { _Pragma("unroll") for (int _i = 0; _i < 2; ++_i) { int _R, _C; stage_rc(tid * 16 + _i * 8192, _R, _C); _Pragma("unroll") for (int _h = 0; _h < 2; ++_h) \
        gv[_h][_i] = (unsigned)gix[(kk) * 256 + _h * 128 + _R] * (unsigned)rowb + (unsigned)_C * 2u; } } while (0)
#define PG8_UBASE(p) ({ const char* _ub = (const char*)(p); asm volatile("" : "+s"(_ub)); _ub; })
#define PG8_STAGE_A(bufoff, hf, kb, nx) do { if constexpr (GATHER) { const char* _gb = PG8_UBASE((const char*)g.A + (kb)); _Pragma("unroll") for (int _i = 0; _i < 2; ++_i) \
        __builtin_amdgcn_global_load_lds((const unsigned*)(_gb + gv[hf][_i]), (PG8_LAS unsigned*)(lds + (bufoff) + ldsw + _i * 8192), 16, 0, 0); } \
      else { const char* _gb = PG8_UBASE(((nx) ? nA : cA) + (kb) + (hf) * hstep); _Pragma("unroll") for (int _i = 0; _i < 2; ++_i) \
        __builtin_amdgcn_global_load_lds((const unsigned*)(_gb + voffA[_i]), (PG8_LAS unsigned*)(lds + (bufoff) + ldsw + _i * 8192), 16, 0, 0); } } while (0)
    const size_t kstep = (size_t)(BK * 2);
    const size_t hstep = (size_t)HALF * rowb;
    const size_t tstep = 2 * hstep;
    const unsigned ldsw = (unsigned)wid * 1024u;
    const int aoffk0 = FP8 ? lds_byte(wr * 64 + fr, fq * 16) : lds_byte(wr * 64 + fr, fq * 8), aoffk1 = FP8 ? lds_byte(wr * 64 + fr, fq * 16 + 8) : aoffk0 + 1024;
    const int boffk0 = FP8 ? lds_byte(wc * 32 + fr, fq * 16) : lds_byte(wc * 32 + fr, fq * 8), boffk1 = FP8 ? lds_byte(wc * 32 + fr, fq * 16 + 8) : boffk0 + 1024;
#define PG8_SA(b, h) (((b) * 2 + (h)) * HTB)
#define PG8_SB(b, h) ((4 + (b) * 2 + (h)) * HTB)
#define PG8_STAGE(bufoff, gbase, voff) do { const char* _gb = PG8_UBASE(gbase); _Pragma("unroll") for (int _i = 0; _i < 2; ++_i) \
        __builtin_amdgcn_global_load_lds((const unsigned*)(_gb + (voff)[_i]), (PG8_LAS unsigned*)(lds + (bufoff) + ldsw + _i * 8192), 16, 0, 0); } while (0)
#define PG8_LD16(off) (*(const PG8_LAS bf16x8*)(lds + (off)))
#define PG8_LDA(dst, b, h) do { _Pragma("unroll") for (int m = 0; m < 4; ++m) { \
        if constexpr (FP8) F.dst[m] = frag_cat(PG8_LD16(PG8_SA(b, h) + aoffk0 + m * 2048), PG8_LD16(PG8_SA(b, h) + aoffk1 + m * 2048));     \
        else { F.dst[m][0] = PG8_LD16(PG8_SA(b, h) + aoffk0 + m * 2048); F.dst[m][1] = PG8_LD16(PG8_SA(b, h) + aoffk1 + m * 2048); } } } while (0)
#define PG8_LDB(dst, b, h) do { _Pragma("unroll") for (int n = 0; n < 2; ++n) { \
        if constexpr (FP8) F.dst[n] = frag_cat(PG8_LD16(PG8_SB(b, h) + boffk0 + n * 2048), PG8_LD16(PG8_SB(b, h) + boffk1 + n * 2048)); \
        else { F.dst[n][0] = PG8_LD16(PG8_SB(b, h) + boffk0 + n * 2048); F.dst[n][1] = PG8_LD16(PG8_SB(b, h) + boffk1 + n * 2048); } } } while (0)
#define PG8_MMA(ai, bj, At, Bt) do { __builtin_amdgcn_s_setprio(1); _Pragma("unroll") for (int m = 0; m < 4; ++m) _Pragma("unroll") for (int n = 0; n < 2; ++n) { \
        if constexpr (FP8) asm volatile("v_mfma_scale_f32_16x16x128_f8f6f4 %0, %1, %2, %0, %3, %3 op_sel_hi:[0,0,0]" : "+v"(acc[ai][bj][m][n]) : "v"(F.Bt[n]), "v"(F.At[m]), "v"(scale1)); \
        else { _Pragma("unroll") for (int k = 0; k < 2; ++k) acc[ai][bj][m][n] = __builtin_amdgcn_mfma_f32_16x16x32_bf16(F.Bt[n][k], F.At[m][k], acc[ai][bj][m][n], 0, 0, 0); } } \
        __builtin_amdgcn_s_setprio(0); } while (0)
#define PG8_WAIT_V(n) asm volatile("s_waitcnt vmcnt(" #n ")" ::: "memory")
#define PG8_WAIT_L(n) asm volatile("s_waitcnt lgkmcnt(" #n ")" ::: "memory")
#define PG8_BAR __builtin_amdgcn_s_barrier()
#define PG8_SCHED __builtin_amdgcn_sched_barrier(0)
    Unit cur, nxt; int ui = 0;
    if (!S.next(0, cur)) return;
    f32x4 acc[2][2][4][2];
#pragma unroll
    for (int a = 0; a < 2; ++a)
#pragma unroll
        for (int b = 0; b < 2; ++b)
#pragma unroll
            for (int m = 0; m < 4; ++m)
#pragma unroll
                for (int n = 0; n < 2; ++n) acc[a][b][m][n] = (f32x4){0.f, 0.f, 0.f, 0.f};
    Frags<FP8> F;
    int scale1 = 127; asm volatile("" : "+v"(scale1));
    const char* cA = (const char*)g.A + (size_t)cur.pm * tstep; const char* cB = (const char*)g.Bt + (size_t)cur.pn * tstep;
    const char* nA = cA;
    if constexpr (GATHER) { PG8_GV(0); }
    S.a_ready(cur);
    PG8_STAGE(PG8_SB(0, 0), cB, voffB); PG8_STAGE_A(PG8_SA(0, 0), 0, (size_t)0, false); PG8_STAGE(PG8_SB(0, 1), cB + hstep, voffB); PG8_STAGE_A(PG8_SA(0, 1), 1, (size_t)0, false);
    if (wr == 1) PG8_BAR;
    PG8_WAIT_V(4); PG8_BAR;
    PG8_STAGE(PG8_SB(1, 0), cB + kstep, voffB); PG8_STAGE_A(PG8_SA(1, 0), 0, kstep, false); PG8_STAGE(PG8_SB(1, 1), cB + hstep + kstep, voffB);
    PG8_WAIT_V(6); PG8_BAR;
    for (;;) {
        const bool has_next = S.next(ui + 1, nxt);
        nA = has_next ? (const char*)g.A + (size_t)nxt.pm * tstep : cA; const char* nB = has_next ? (const char*)g.Bt + (size_t)nxt.pn * tstep : cB;
        constexpr int KREP = PROBE_SET == 30 ? 2 : 1;
#pragma nounroll
        for (int t = 0; t < nt * KREP; t += 2) {
            const bool last = (t == nt * KREP - 2);
            const size_t ka1 = (size_t)((t + 1) % nt) * kstep, ka2 = last ? (size_t)0 : (size_t)((t + 2) % nt) * kstep, ka3 = ka2 + kstep;
            const char* b2 = last ? nB : cB + (size_t)((t + 2) % nt) * kstep;
            const char* b3 = b2 + kstep;
            if (last && has_next) S.a_ready(nxt);
            PG8_LDB(B0, 0, 0); PG8_SCHED; PG8_LDA(At, 0, 0); PG8_STAGE_A(PG8_SA(1, 1), 1, ka1, false);
            PG8_WAIT_L(8); PG8_BAR; PG8_WAIT_L(0); PG8_MMA(0, 0, At, B0); PG8_BAR; PG8_SCHED;
            if constexpr (GATHER) { if (last && has_next) { PG8_GV(ui + 1); } }
            PG8_LDB(B1, 0, 1); PG8_STAGE(PG8_SB(0, 0), b2, voffB);
            PG8_BAR; PG8_WAIT_L(0); PG8_MMA(0, 1, At, B1); PG8_BAR;
            PG8_LDA(At, 0, 1); PG8_STAGE_A(PG8_SA(0, 0), 0, ka2, last);
            PG8_BAR; PG8_WAIT_L(0); PG8_MMA(1, 0, At, B0); PG8_BAR; PG8_SCHED;
            PG8_STAGE(PG8_SB(0, 1), b2 + hstep, voffB);
            PG8_WAIT_V(6); PG8_BAR; PG8_MMA(1, 1, At, B1); PG8_BAR;
            PG8_LDB(B0, 1, 0); PG8_SCHED; PG8_LDA(At, 1, 0); PG8_STAGE_A(PG8_SA(0, 1), 1, ka2, last);
            PG8_WAIT_L(8); PG8_BAR; PG8_WAIT_L(0); PG8_MMA(0, 0, At, B0); PG8_BAR; PG8_SCHED;
            PG8_LDB(B1, 1, 1); PG8_STAGE(PG8_SB(1, 0), b3, voffB);
            PG8_BAR; PG8_WAIT_L(0); PG8_MMA(0, 1, At, B1); PG8_BAR;
            PG8_LDA(At, 1, 1); PG8_STAGE_A(PG8_SA(1, 0), 0, ka3, last);
            PG8_BAR; PG8_WAIT_L(0); PG8_MMA(1, 0, At, B0); PG8_BAR; PG8_SCHED;
            PG8_STAGE(PG8_SB(1, 1), b3 + hstep, voffB);
            PG8_WAIT_V(6); PG8_BAR; PG8_MMA(1, 1, At, B1); PG8_BAR;
        }
        if constexpr (KREP > 1) {
#pragma unroll
            for (int a = 0; a < 2; ++a)
#pragma unroll
                for (int b = 0; b < 2; ++b)
#pragma unroll
                    for (int m = 0; m < 4; ++m)
#pragma unroll
                        for (int n = 0; n < 2; ++n) acc[a][b][m][n] *= (1.0f / KREP); }
        if constexpr (FP8) asm volatile("s_nop 15\n\ts_nop 15" ::: "memory");
        { int tz = tid; asm volatile("" : "+v"(tz));
          const int wz = tz >> 6, lz = tz & 63; E(acc, cur, wz >> 2, wz & 3, lz & 15, lz >> 4); }
        S.done(cur);
        if (!has_next) break;
#pragma unroll
        for (int a = 0; a < 2; ++a)
#pragma unroll
            for (int b = 0; b < 2; ++b)
#pragma unroll
                for (int m = 0; m < 4; ++m)
#pragma unroll
                    for (int n = 0; n < 2; ++n) acc[a][b][m][n] = (f32x4){0.f, 0.f, 0.f, 0.f};
        cur = nxt; cA = nA; cB = nB; ++ui;

    }
    PG8_WAIT_V(0);
    if (wr == 0) PG8_BAR;
    PG8_BAR;
#undef PG8_SA
#undef PG8_SB
#undef PG8_STAGE
#undef PG8_STAGE_A
#undef PG8_UBASE
#undef PG8_GV
#undef PG8_LDA
#undef PG8_LDB
#undef PG8_MMA
#undef PG8_WAIT_V
#undef PG8_WAIT_L
#undef PG8_BAR
#undef PG8_SCHED
}

struct EpiZ8 {
    static constexpr bool PERM = true;
    bf16_t* O; int ldc;
    __device__ __forceinline__ void operator()(const f32x4 (&acc)[2][2][4][2], const Unit& u, int wr, int wc, int fr, int fq) const {
        const int row0 = u.pm * BM + wr * 64 + fr, col0 = u.pn * BM + wc * 32 + 8 * fq;
#pragma unroll
        for (int ai = 0; ai < 2; ++ai)
#pragma unroll
            for (int m = 0; m < 4; ++m) { bf16_t* rowp = O + (size_t)(row0 + ai * HALF + m * 16) * ldc + col0;
#pragma unroll
                for (int bj = 0; bj < 2; ++bj) { const f32x4 v0 = acc[ai][bj][m][0], v1 = acc[ai][bj][m][1];
                    u32x4 w; w.x = cvt_pk_bf16(v0[0], v0[1]); w.y = cvt_pk_bf16(v0[2], v0[3]); w.z = cvt_pk_bf16(v1[0], v1[1]); w.w = cvt_pk_bf16(v1[2], v1[3]);
                    *(u32x4*)(rowp + bj * HALF) = w; } }
    }
};
template <bool SRC32>
struct EpiWoutB {
    static constexpr bool PERM = true;
    const float* src_lat; const float* src_ctx; bf16_t* xb; const float* modl;
    float* ssqp;
    __device__ __forceinline__ void operator()(const f32x4 (&acc)[2][2][4][2], const Unit& u, int wr, int wc, int fr, int fq) const {
        const int rowt = u.pm * BM; const bool lat = rowt < RL; const int bb = lat ? rowt / T : NB;
        const float* sp = lat ? src_lat + (size_t)rowt * D : src_ctx + (size_t)(rowt - RL) * D;
        bf16_t* dp = xb + (size_t)rowt * D;
        const float* mr = modl + (size_t)bb * MODW + 2 * D;
        const int r0 = wr * 64 + fr, col0 = u.pn * BM + wc * 32 + 8 * fq;
        f32x4 mv[2][2];
#pragma unroll
        for (int bj = 0; bj < 2; ++bj)
#pragma unroll
            for (int n = 0; n < 2; ++n) mv[bj][n] = *(const f32x4*)(mr + col0 + bj * HALF + 4 * n);
#pragma unroll
        for (int ai = 0; ai < 2; ++ai)
#pragma unroll
            for (int m = 0; m < 4; ++m) { const size_t ro = (size_t)(r0 + ai * HALF + m * 16) * D + col0; float sq = 0.f;
#pragma unroll
                for (int bj = 0; bj < 2; ++bj) { f32x4 x0, x1;
                    if (SRC32) { x0 = *(const f32x4*)(sp + ro + bj * HALF); x1 = *(const f32x4*)(sp + ro + bj * HALF + 4); }
                    else { const u32x4 w = *(const u32x4*)(dp + ro + bj * HALF);
                        x0 = (f32x4){__uint_as_float(w.x << 16), __uint_as_float(w.x & 0xffff0000u), __uint_as_float(w.y << 16), __uint_as_float(w.y & 0xffff0000u)};
                        x1 = (f32x4){__uint_as_float(w.z << 16), __uint_as_float(w.z & 0xffff0000u), __uint_as_float(w.w << 16), __uint_as_float(w.w & 0xffff0000u)}; }
                    const f32x4 v0 = x0 + mv[bj][0] * acc[ai][bj][m][0], v1 = x1 + mv[bj][1] * acc[ai][bj][m][1];
                    u32x4 o; o.x = cvt_pk_bf16(v0[0], v0[1]); o.y = cvt_pk_bf16(v0[2], v0[3]); o.z = cvt_pk_bf16(v1[0], v1[1]); o.w = cvt_pk_bf16(v1[2], v1[3]);
                    *(u32x4*)(dp + ro + bj * HALF) = o;
                    const unsigned ow[4] = {o.x, o.y, o.z, o.w};
#pragma unroll
                    for (int j = 0; j < 4; ++j) { const float a = __uint_as_float(ow[j] << 16), b = __uint_as_float(ow[j] & 0xffff0000u); sq += a * a + b * b; } }
                sq += __builtin_bit_cast(float, __builtin_amdgcn_ds_bpermute(((16 * fq + fr) ^ 16) << 2, __builtin_bit_cast(int, sq)));
                sq += __builtin_bit_cast(float, __builtin_amdgcn_ds_bpermute(((16 * fq + fr) ^ 32) << 2, __builtin_bit_cast(int, sq)));
                if (fq == 0) ssqp[(size_t)(rowt + r0 + ai * HALF + m * 16) * 16 + (u.pn & 3) * 4 + wc] = sq; }
    }
};
__device__ __forceinline__ float silu_fast(float x) { return x * __builtin_amdgcn_rcpf(1.0f + __expf(-x)); }
struct EpiGU8 {
    static constexpr bool PERM = true;
    bf16_t* hid; int nN;
    __device__ __forceinline__ void operator()(const f32x4 (&acc)[2][2][4][2], const Unit& u, int wr, int wc, int fr, int fq) const {
        const int row0 = u.pm * BM + wr * 64 + fr, col0 = (u.pn % nN) * HALF + wc * 32 + 8 * fq;
#pragma unroll
        for (int ai = 0; ai < 2; ++ai)
#pragma unroll
            for (int m = 0; m < 4; ++m) { bf16_t* rowp = hid + (size_t)(row0 + ai * HALF + m * 16) * D + col0;
                float v[8];
#pragma unroll
                for (int n = 0; n < 2; ++n)
#pragma unroll
                    for (int i = 0; i < 4; ++i) v[n * 4 + i] = silu_fast(acc[ai][0][m][n][i]) * acc[ai][1][m][n][i];
                u32x4 w; w.x = cvt_pk_bf16(v[0], v[1]); w.y = cvt_pk_bf16(v[2], v[3]); w.z = cvt_pk_bf16(v[4], v[5]); w.w = cvt_pk_bf16(v[6], v[7]);
                *(u32x4*)rowp = w; }
    }
};
constexpr float W8_SCALE = 32.0f;
__device__ __forceinline__ unsigned pack4_fp8(float a, float b, float c, float d) { int w = __builtin_amdgcn_cvt_pk_fp8_f32(a, b, 0, false); w = __builtin_amdgcn_cvt_pk_fp8_f32(c, d, w, true); return (unsigned)w; }
struct EpiGU_F8 {
    static constexpr bool PERM = true;
    unsigned char* hid; int nN;
    __device__ __forceinline__ void operator()(const f32x4 (&acc)[2][2][4][2], const Unit& u, int wr, int wc, int fr, int fq) const {
        const int row0 = u.pm * BM + wr * 64 + fr, col0 = (u.pn % nN) * HALF + wc * 32 + 8 * fq;
        constexpr float inv = 1.0f / W8_SCALE;
#pragma unroll
        for (int ai = 0; ai < 2; ++ai)
#pragma unroll
            for (int m = 0; m < 4; ++m) { unsigned char* rowp = hid + (size_t)(row0 + ai * HALF + m * 16) * D + col0;
                float v[8];
#pragma unroll
                for (int n = 0; n < 2; ++n)
#pragma unroll
                    for (int i = 0; i < 4; ++i) v[n * 4 + i] = silu_fast(acc[ai][0][m][n][i] * inv) * (acc[ai][1][m][n][i] * inv);
                typedef unsigned u32x2v __attribute__((ext_vector_type(2)));
                *(u32x2v*)rowp = (u32x2v){pack4_fp8(v[0], v[1], v[2], v[3]), pack4_fp8(v[4], v[5], v[6], v[7])}; }
    }
};
constexpr float OUTSLOT_SCALE = 32.0f;
struct EpiDown8 {
    static constexpr bool PERM = true;
    unsigned char* O; const float* selg; int nN; float wscale;
    __device__ __forceinline__ void operator()(const f32x4 (&acc)[2][2][4][2], const Unit& u, int wr, int wc, int fr, int fq) const {
        const int row0 = u.pm * BM + wr * 64 + fr, col0 = (u.pn % nN) * BM + wc * 32 + 8 * fq;
#pragma unroll
        for (int ai = 0; ai < 2; ++ai)
#pragma unroll
            for (int m = 0; m < 4; ++m) { const int row = row0 + ai * HALF + m * 16; const float gs = selg[row] * wscale * OUTSLOT_SCALE; unsigned char* rowp = O + (size_t)row * D + col0;
#pragma unroll
                for (int bj = 0; bj < 2; ++bj) { f32x4 v0 = acc[ai][bj][m][0] * gs, v1 = acc[ai][bj][m][1] * gs;
#pragma unroll
                    for (int i = 0; i < 4; ++i) { v0[i] = __builtin_amdgcn_fmed3f(v0[i], -448.0f, 448.0f); v1[i] = __builtin_amdgcn_fmed3f(v1[i], -448.0f, 448.0f); }
                    typedef unsigned u32x2v __attribute__((ext_vector_type(2)));
                    *(u32x2v*)(rowp + bj * HALF) = (u32x2v){pack4_fp8(v0[0], v0[1], v0[2], v0[3]), pack4_fp8(v1[0], v1[1], v1[2], v1[3])}; } }
    }
};
}
constexpr int GEMM_LDS_BYTES = pg8::STAGE_BYTES;
constexpr int WQ_QUOTA_IN_EVEN = 700, WQ_QUOTA_IN_ODD = 5600, WQ_QUOTA_OUT = 8600;
constexpr int GIX_UNITS = 10;
constexpr int DYN_LDS_BYTES = GEMM_LDS_BYTES + 16 + GIX_UNITS * 256 * 4;
#endif

struct EpiZ_ : EpiZ { DEV void pair_(int, int, float, float) const {} };
struct EpiWout_ : EpiWout { DEV void pair_(int, int, float, float) const {} };
struct EpiDown_ : EpiDown { DEV void pair_(int, int, float, float) const {} };
struct EpiGU_ : EpiGU { DEV void elem(int, int, float) const {} DEV void pair_(int r, int j, float g, float u) const { pair(r, j, g, u); } };

#ifndef CPU_EMU
typedef float f32x4_t __attribute__((ext_vector_type(4)));
typedef unsigned u32x4_t __attribute__((ext_vector_type(4)));
typedef unsigned u32x2_t __attribute__((ext_vector_type(2)));
typedef float f32x2_t __attribute__((ext_vector_type(2)));
typedef short bf16x8_t __attribute__((ext_vector_type(8)));
__device__ __forceinline__ unsigned pk_bf16(float lo, float hi) { return pg8::cvt_pk_bf16(lo, hi); }
__device__ __forceinline__ int bperm_i(int v, int src_lane) { return __builtin_amdgcn_ds_bpermute(src_lane << 2, v); }
__device__ __forceinline__ float bperm_f(float v, int src_lane) { return __builtin_bit_cast(float, __builtin_amdgcn_ds_bpermute(src_lane << 2, __builtin_bit_cast(int, v))); }
__device__ __forceinline__ int lane_bcast_i(int v, int uniform_lane) { return __builtin_amdgcn_readlane(v, __builtin_amdgcn_readfirstlane(uniform_lane)); }
__device__ __forceinline__ float wave_sum_fast(float v);
__device__ __forceinline__ float wave_sum(float v) { return wave_sum_fast(v); }
__device__ __forceinline__ float fsigmoid(float x) { return __builtin_amdgcn_rcpf(1.0f + __expf(-x)); }
__device__ __forceinline__ float fsilu(float x) { return x * fsigmoid(x); }
__device__ __forceinline__ float fgelu(float x) { const float u = 0.7978845608028654f * (x + 0.044715f * x * x * x); return x * fsigmoid(2.0f * u); }

__device__ __forceinline__ void tconv_tile(const float* __restrict__ src, int src_ld, int scol0, int nvalid, bf16_t* __restrict__ dst, int dst_ld, int drow0, int k0, PG8_LAS float* tile  , int t) {
#pragma unroll
    for (int i = 0; i < 8; ++i) { const int e = t + 512 * i, kk = e >> 6, nn = e & 63;
        tile[kk * 65 + nn] = nn < nvalid ? src[(size_t)(k0 + kk) * src_ld + scol0 + nn] : 0.f; }
    __syncthreads();
    { const int nn = t >> 3, ks = t & 7; float v[8];
#pragma unroll
        for (int j = 0; j < 8; ++j) v[j] = tile[(ks * 8 + j) * 65 + nn];
        u32x4_t w; w.x = pk_bf16(v[0], v[1]); w.y = pk_bf16(v[2], v[3]); w.z = pk_bf16(v[4], v[5]); w.w = pk_bf16(v[6], v[7]);
        *(u32x4_t*)(dst + (size_t)(drow0 + nn) * dst_ld + k0 + ks * 8) = w; }
    __syncthreads();
}
__device__ __forceinline__ void fs_wconv(const Params& P, PG8_LAS unsigned char* lds, int t) {
    PG8_LAS float* tile = (PG8_LAS float*)lds;
    constexpr int KT = D / 64, T_EIN = (NZE / 64) * KT, T_OIN = (NZO / 64) * KT, T_OUT = (D / 64) * KT, PER_Q = T_EIN + T_OIN + 2 * T_OUT;
    for (int u = blockIdx.x; u < 2 * PER_Q; u += gridDim.x) {
        const int q = u / PER_Q; int r = u % PER_Q;
        if (r < T_EIN) { const int nt = r / KT, kt = r % KT; tconv_tile(P.ev_w_in + (size_t)q * D * EV_IN, EV_IN, nt * 64, EV_IN - nt * 64, P.wt_ev_in + (size_t)q * NZE * D, D, nt * 64, kt * 64, tile, t); continue; }
        r -= T_EIN;
        if (r < T_OIN) { const int nt = r / KT, kt = r % KT; tconv_tile(P.od_w_in + (size_t)q * D * NZO, NZO, nt * 64, 64, P.wt_od_in + (size_t)q * NZO * D, D, nt * 64, kt * 64, tile, t); continue; }
        r -= T_OIN;
        if (r < T_OUT) { const int nt = r / KT, kt = r % KT; tconv_tile(P.ev_w_out + (size_t)q * D * D, D, nt * 64, 64, P.wt_ev_out + (size_t)q * D * D, D, nt * 64, kt * 64, tile, t); continue; }
        r -= T_OUT;
        { const int nt = r / KT, kt = r % KT; tconv_tile(P.od_w_out + (size_t)q * D * D, D, nt * 64, 64, P.wt_od_out + (size_t)q * D * D, D, nt * 64, kt * 64, tile, t); }
    }
    for (int u = blockIdx.x; u < 32 * 4; u += gridDim.x) {
        const int mi = u >> 2, tt = u & 3, li = mi >> 4, dir = (mi >> 3) & 1, gate = (mi >> 2) & 1, hh = mi & 3;
        const float* src = (gate == 0 ? P.od_gate_a_w : P.od_gate_x_w) + (size_t)(((li * 2 + dir) * 4 + hh) * HD) * HD;
        tconv_tile(src, HD, (tt >> 1) * 64, 64, P.gwT + (size_t)mi * HD * HD, HD, (tt >> 1) * 64, (tt & 1) * 64, tile, t);
    }
    for (int i = blockIdx.x * 512 + t; i < 2 * 4 * SGC * SGC; i += gridDim.x * 512) P.sgw[i] = f2bf(P.od_sg_w[i]);
}
struct MoeTile { const float* src; unsigned char* dst; };
__device__ __forceinline__ MoeTile moe_tile(const Params& P, int l, int u) {
    constexpr int KT = D / 64, T_GU = (2 * D / 64) * KT, T_DN = (D / 64) * KT, PER_E = T_GU + T_DN;
    const int e = u / PER_E; int r = u % PER_E; MoeTile mt;
    if (r < T_GU) { const int nt = r / KT, kt = r % KT, cv0 = nt * 64, w = cv0 % 256, j0 = (cv0 / 256) * 128 + (w % 128);
        mt.src = (w >= 128 ? P.moe_w_up : P.moe_w_gate) + ((size_t)l * NE + e) * D * D + (size_t)(kt * 64) * D + j0; mt.dst = (unsigned char*)P.wt_gu + (size_t)e * 2 * D * D + (size_t)cv0 * D + kt * 64; }
    else { r -= T_GU; const int nt = r / KT, kt = r % KT;
        mt.src = P.moe_w_down + ((size_t)l * NE + e) * D * D + (size_t)(kt * 64) * D + nt * 64; mt.dst = (unsigned char*)P.wt_dn + (size_t)e * D * D + (size_t)(nt * 64) * D + kt * 64; }
    return mt;
}
__device__ __forceinline__ void fs_moe_wconv(const Params& P, int l, PG8_LAS unsigned char* lds, int t, int limit) {
    PG8_LAS float* tile = (PG8_LAS float*)lds;
    PG8_LAS int* slot = (PG8_LAS int*)(lds + 2 * 64 * 65 * 4);
    constexpr int NT = NE * ((2 * D / 64) + (D / 64)) * (D / 64);
    if (limit > NT) limit = NT;
    const int kk0 = t >> 6, nn = t & 63;
    unsigned* ctr = P.wq + l;
    if (t == 0) { const unsigned c0 = __hip_atomic_load(ctr, __ATOMIC_RELAXED, __HIP_MEMORY_SCOPE_AGENT);
        slot[0] = (int)c0 >= limit ? NT : (int)__hip_atomic_fetch_add(ctr, 2u, __ATOMIC_RELAXED, __HIP_MEMORY_SCOPE_AGENT); }
    __syncthreads();
    for (int it = 0;; ++it) {
        const int u0 = slot[it & 1];
        if (u0 >= NT) break;
        int unext = NT;
        if (t == 0 && u0 + 2 < limit) unext = (int)__hip_atomic_fetch_add(ctr, 2u, __ATOMIC_RELAXED, __HIP_MEMORY_SCOPE_AGENT);
        const MoeTile m0 = moe_tile(P, l, u0), m1 = moe_tile(P, l, u0 + 1 < NT ? u0 + 1 : u0);
        float v0[8], v1[8];
#pragma unroll
        for (int i = 0; i < 8; ++i) { v0[i] = m0.src[(size_t)(kk0 + 8 * i) * D + nn]; v1[i] = m1.src[(size_t)(kk0 + 8 * i) * D + nn]; }
#pragma unroll
        for (int i = 0; i < 8; ++i) { tile[(kk0 + 8 * i) * 65 + nn] = v0[i]; tile[64 * 65 + (kk0 + 8 * i) * 65 + nn] = v1[i]; }
        if (t == 0) slot[(it + 1) & 1] = unext;
        __syncthreads();
        { const int n2 = t >> 3, ks = t & 7; float o[8], p[8];
#pragma unroll
            for (int j = 0; j < 8; ++j) { o[j] = tile[(ks * 8 + j) * 65 + n2]; p[j] = tile[64 * 65 + (ks * 8 + j) * 65 + n2]; }
            constexpr float ws = pg8::W8_SCALE;
            u32x2_t w; w.x = pg8::pack4_fp8(o[0] * ws, o[1] * ws, o[2] * ws, o[3] * ws); w.y = pg8::pack4_fp8(o[4] * ws, o[5] * ws, o[6] * ws, o[7] * ws);
            *(u32x2_t*)(m0.dst + (size_t)n2 * D + ks * 8) = w;
            if (u0 + 1 < NT) { w.x = pg8::pack4_fp8(p[0] * ws, p[1] * ws, p[2] * ws, p[3] * ws); w.y = pg8::pack4_fp8(p[4] * ws, p[5] * ws, p[6] * ws, p[7] * ws); *(u32x2_t*)(m1.dst + (size_t)n2 * D + ks * 8) = w; } }
        __syncthreads();
    }
    __syncthreads();
}
__device__ __forceinline__ void fs_mod(const Params& P, PG8_LAS unsigned char* lds, int t) {
    PG8_LAS float* sb = (PG8_LAS float*)lds;
    PG8_LAS float* red = sb + (NB + 1) * D;
    for (int i = t; i < (NB + 1) * D; i += 512) { const int bb = i / D, kk = i % D; const float v = bb < NB ? P.c[(size_t)bb * D + kk] : P.c_ctx[kk]; sb[i] = v / (1.0f + expf(-v)); }
    __syncthreads();
    constexpr int CB = MODW / 128;
    const int c4 = t & 31, ks = t >> 5;
    for (int u = blockIdx.x; u < DEPTH * CB; u += gridDim.x) {
        const int ll = u / CB, j0 = (u % CB) * 128 + c4 * 4;
        const float* w = P.ada_w + (size_t)ll * D * MODW + j0;
        f32x4_t acc[NB + 1];
#pragma unroll
        for (int bb = 0; bb <= NB; ++bb) acc[bb] = (f32x4_t){0.f, 0.f, 0.f, 0.f};
#pragma unroll 8
        for (int kk = ks * 64; kk < ks * 64 + 64; ++kk) { const f32x4_t wv = *(const f32x4_t*)(w + (size_t)kk * MODW);
#pragma unroll
            for (int bb = 0; bb <= NB; ++bb) acc[bb] += wv * sb[bb * D + kk]; }
#pragma unroll
        for (int bb = 0; bb <= NB; ++bb)
#pragma unroll
            for (int i = 0; i < 4; ++i) red[(ks * 32 + c4) * 36 + bb * 4 + i] = acc[bb][i];
        __syncthreads();
        for (int o = t; o < (NB + 1) * 128; o += 512) { const int bb = o / 128, col = o % 128, cc4 = col >> 2, ci = col & 3;
            float s = P.ada_b[(size_t)ll * MODW + (u % CB) * 128 + col];
#pragma unroll
            for (int k2 = 0; k2 < 16; ++k2) s += red[(k2 * 32 + cc4) * 36 + bb * 4 + ci];
            P.mod[((size_t)ll * (NB + 1) + bb) * MODW + (u % CB) * 128 + col] = s; }
        __syncthreads();
    }
}
#define DPP_ADD(v, ctrl) ((v) + __builtin_bit_cast(float, __builtin_amdgcn_update_dpp(0, __builtin_bit_cast(int, (v)), (ctrl), 0xF, 0xF, true)))
__device__ __forceinline__ float row16_sum(float v) {
    v = DPP_ADD(v, 0xB1);
    v = DPP_ADD(v, 0x4E);
    v = DPP_ADD(v, 0x141);
    v = DPP_ADD(v, 0x140);
    return v;
}
__device__ __forceinline__ float wave_sum_fast(float v) {
    v = row16_sum(v);
    const int iv = __builtin_bit_cast(int, v);
    return __builtin_bit_cast(float, __builtin_amdgcn_readlane(iv, 0)) + __builtin_bit_cast(float, __builtin_amdgcn_readlane(iv, 16)) +
           __builtin_bit_cast(float, __builtin_amdgcn_readlane(iv, 32)) + __builtin_bit_cast(float, __builtin_amdgcn_readlane(iv, 48));
}
template <int MODE>
__device__ __forceinline__ void fs_row(const Params& P, int l, PG8_LAS unsigned char* lds, int t) {
    const int lane = t & 63, wid = t >> 6;
    PG8_LAS float* wrT = (PG8_LAS float*)lds;
    if (MODE == 1) {
        const float* wr = P.moe_router + (size_t)l * D * NE;
        for (int i = t; i < D * NE; i += 512) { const int c = i / NE, e = i % NE; wrT[e * D + c] = wr[i]; }
        __syncthreads();
    }
    const bool combine = (MODE == 0 && l > 0) || MODE == 2;
    const int lc = MODE == 2 ? DEPTH - 1 : l - 1;
    const float* gvec = MODE == 0 ? P.norm_mix_g + (size_t)l * D : MODE == 1 ? P.norm_ffn_g + (size_t)l * D : P.norm_final_g;
    const int nrows = (MODE == 2 || (MODE == 1 && l == DEPTH - 1)) ? RL : R;
    const int nwaves = gridDim.x * 8, rpw = (nrows + nwaves - 1) / nwaves, rbeg = (blockIdx.x * 8 + wid) * rpw, rend = (rbeg + rpw < nrows) ? rbeg + rpw : nrows;
    const bool in32 = (MODE == 0 && l == 0);
    auto xload = [&](int r, u32x4_t (&raw)[4]) {
        if (in32) { const float* xs = r < RL ? P.x + (size_t)r * D : P.ctx + (size_t)(r - RL) * D;
#pragma unroll
            for (int i = 0; i < 4; ++i) raw[i] = *(const u32x4_t*)(xs + lane * 4 + i * 256); }
        else { const bf16_t* xs = P.xb + (size_t)r * D;
#pragma unroll
            for (int i = 0; i < 4; ++i) { const u32x2_t w = *(const u32x2_t*)(xs + lane * 4 + i * 256); raw[i].x = w.x; raw[i].y = w.y; } } };
    f32x4_t gv[4];
#pragma unroll
    for (int i = 0; i < 4; ++i) gv[i] = *(const f32x4_t*)(gvec + lane * 4 + i * 256);
    f32x4_t scv[4], shv[4], m5v[4]; int bbc = -1;
    u32x4_t xn[4]; int inv0 = -1, inv1 = -1, inv2 = -1;
    int pw0[4] = {0, 0, 0, 0}, pw1[4] = {0, 0, 0, 0};
    auto slot_prefetch = [&](int invv) {
        const unsigned long long mk = __ballot(invv >= 0) & 0xffffull;
        if (mk) { const int e0 = __builtin_ctzll(mk); const unsigned long long m2 = mk & (mk - 1); const int s0 = lane_bcast_i(invv, e0);
            const unsigned char* o0 = (const unsigned char*)P.outslot + (size_t)s0 * D + lane * 4;
#pragma unroll
            for (int i = 0; i < 4; ++i) pw0[i] = *(const int*)(o0 + i * 256);
            if (m2) { const int e1 = __builtin_ctzll(m2); const int s1 = lane_bcast_i(invv, e1); const unsigned char* o1 = (const unsigned char*)P.outslot + (size_t)s1 * D + lane * 4;
#pragma unroll
                for (int i = 0; i < 4; ++i) pw1[i] = *(const int*)(o1 + i * 256); } } };
    if (rbeg < rend) { xload(rbeg, xn);
        if (combine) { inv0 = P.inv[(size_t)rbeg * NE + (lane & 15)]; if (rbeg + 1 < rend) inv1 = P.inv[(size_t)(rbeg + 1) * NE + (lane & 15)]; if (rbeg + 2 < rend) inv2 = P.inv[(size_t)(rbeg + 2) * NE + (lane & 15)];
            slot_prefetch(inv0); } }
    for (int r = rbeg; r < rend; ++r) {
        const bool lat = r < RL; const int bb = lat ? r / T : NB;
        f32x4_t xv[4];
#pragma unroll
        for (int i = 0; i < 4; ++i) { if (in32) xv[i] = __builtin_bit_cast(f32x4_t, xn[i]);
            else xv[i] = (f32x4_t){__uint_as_float(xn[i].x << 16), __uint_as_float(xn[i].x & 0xffff0000u), __uint_as_float(xn[i].y << 16), __uint_as_float(xn[i].y & 0xffff0000u)}; }
        const int myinv = inv0;
        int cw0[4], cw1[4];
#pragma unroll
        for (int i = 0; i < 4; ++i) { cw0[i] = pw0[i]; cw1[i] = pw1[i]; }
        if (r + 1 < rend) { xload(r + 1, xn);
            if (combine) { slot_prefetch(inv1); inv0 = inv1; inv1 = inv2; if (r + 3 < rend) inv2 = P.inv[(size_t)(r + 3) * NE + (lane & 15)]; } }
        if (bb != bbc) { bbc = bb;
            if (MODE != 2) { const float* mr = modrow(P, l, bb) + lane * 4;
#pragma unroll
                for (int i = 0; i < 4; ++i) { scv[i] = *(const f32x4_t*)(mr + (MODE == 0 ? 1 : 4) * D + i * 256) + 1.0f; shv[i] = *(const f32x4_t*)(mr + (MODE == 0 ? 0 : 3) * D + i * 256); } }
            if (combine) { const float* m5 = modrow(P, lc, bb) + 5 * D + lane * 4;
#pragma unroll
                for (int i = 0; i < 4; ++i) m5v[i] = *(const f32x4_t*)(m5 + i * 256); } }
        if (combine) {
            f32x4_t sum[4];
#pragma unroll
            for (int i = 0; i < 4; ++i) sum[i] = (f32x4_t){0.f, 0.f, 0.f, 0.f};
            unsigned long long msk = __ballot(myinv >= 0) & 0xffffull;
            constexpr float fs = 1.0f / pg8::OUTSLOT_SCALE;
            if (msk) {
                msk &= msk - 1; const bool two = msk != 0; msk &= msk - 1; const float f1 = two ? fs : 0.0f;
#pragma unroll
                for (int i = 0; i < 4; ++i) {
                    sum[i][0] += fs * __builtin_amdgcn_cvt_f32_fp8(cw0[i], 0) + f1 * __builtin_amdgcn_cvt_f32_fp8(cw1[i], 0); sum[i][1] += fs * __builtin_amdgcn_cvt_f32_fp8(cw0[i], 1) + f1 * __builtin_amdgcn_cvt_f32_fp8(cw1[i], 1);
                    sum[i][2] += fs * __builtin_amdgcn_cvt_f32_fp8(cw0[i], 2) + f1 * __builtin_amdgcn_cvt_f32_fp8(cw1[i], 2); sum[i][3] += fs * __builtin_amdgcn_cvt_f32_fp8(cw0[i], 3) + f1 * __builtin_amdgcn_cvt_f32_fp8(cw1[i], 3); }
            }
            while (msk) {
                const int e0 = __builtin_ctzll(msk); msk &= msk - 1; const bool two = msk != 0; const int e1 = two ? __builtin_ctzll(msk) : e0; msk &= msk - 1;
                const int s0 = lane_bcast_i(myinv, e0), s1 = lane_bcast_i(myinv, e1);
                const unsigned char* o0 = (const unsigned char*)P.outslot + (size_t)s0 * D + lane * 4; const unsigned char* o1 = (const unsigned char*)P.outslot + (size_t)s1 * D + lane * 4;
                int w0[4], w1[4];
#pragma unroll
                for (int i = 0; i < 4; ++i) { w0[i] = *(const int*)(o0 + i * 256); w1[i] = *(const int*)(o1 + i * 256); }
                const float f1 = two ? fs : 0.0f;
#pragma unroll
                for (int i = 0; i < 4; ++i) {
                    sum[i][0] += fs * __builtin_amdgcn_cvt_f32_fp8(w0[i], 0) + f1 * __builtin_amdgcn_cvt_f32_fp8(w1[i], 0); sum[i][1] += fs * __builtin_amdgcn_cvt_f32_fp8(w0[i], 1) + f1 * __builtin_amdgcn_cvt_f32_fp8(w1[i], 1);
                    sum[i][2] += fs * __builtin_amdgcn_cvt_f32_fp8(w0[i], 2) + f1 * __builtin_amdgcn_cvt_f32_fp8(w1[i], 2); sum[i][3] += fs * __builtin_amdgcn_cvt_f32_fp8(w0[i], 3) + f1 * __builtin_amdgcn_cvt_f32_fp8(w1[i], 3); }
            }
            bf16_t* xd = P.xb + (size_t)r * D;
#pragma unroll
            for (int i = 0; i < 4; ++i) { xv[i] += m5v[i] * sum[i];
                if (MODE != 2) { u32x2_t w; w.x = pk_bf16(xv[i][0], xv[i][1]); w.y = pk_bf16(xv[i][2], xv[i][3]); *(u32x2_t*)(xd + lane * 4 + i * 256) = w;
                    xv[i] = (f32x4_t){__uint_as_float(w.x << 16), __uint_as_float(w.x & 0xffff0000u), __uint_as_float(w.y << 16), __uint_as_float(w.y & 0xffff0000u)}; } }
        }
        float ss = 0.f;
#pragma unroll
        for (int i = 0; i < 4; ++i) ss += xv[i][0] * xv[i][0] + xv[i][1] * xv[i][1] + xv[i][2] * xv[i][2] + xv[i][3] * xv[i][3];
        ss = wave_sum_fast(ss);
        const float rinv = 1.0f / sqrtf(ss * (1.0f / D) + EPS);
        if (MODE == 2) {
#pragma unroll
            for (int i = 0; i < 4; ++i) *(f32x4_t*)(P.xlat + (size_t)r * D + lane * 4 + i * 256) = xv[i] * rinv * gv[i];
            continue;
        }
        f32x4_t hv[4];
#pragma unroll
        for (int i = 0; i < 4; ++i) { hv[i] = (xv[i] * rinv * gv[i]) * scv[i] + shv[i];
            if (MODE == 1) *(unsigned*)((unsigned char*)P.h + (size_t)r * D + lane * 4 + i * 256) = pg8::pack4_fp8(hv[i][0], hv[i][1], hv[i][2], hv[i][3]);
            else { u32x2_t w; w.x = pk_bf16(hv[i][0], hv[i][1]); w.y = pk_bf16(hv[i][2], hv[i][3]); *(u32x2_t*)(P.h + (size_t)r * D + lane * 4 + i * 256) = w; } }
        if (MODE == 1) {
            float lg[NE];
#pragma unroll
            for (int e = 0; e < NE; ++e) { f32x4_t a4 = hv[0] * *(const PG8_LAS f32x4_t*)(wrT + e * D + lane * 4);
#pragma unroll
                for (int i = 1; i < 4; ++i) a4 += hv[i] * *(const PG8_LAS f32x4_t*)(wrT + e * D + lane * 4 + i * 256);
                lg[e] = wave_sum_fast((a4[0] + a4[1]) + (a4[2] + a4[3]));
                asm volatile("" ::: "memory"); }
            float mx = lg[0];
#pragma unroll
            for (int e = 1; e < NE; ++e) mx = fmaxf(mx, lg[e]);
            float s = 0.f, mine = 0.f;
#pragma unroll
            for (int e = 0; e < NE; ++e) { const float ex = __expf(lg[e] - mx); s += ex; mine = (lane == e) ? ex : mine; }
            if (lane < NE) P.aff[(size_t)lane * R + r] = mine / s;
        }
    }
}
__device__ __forceinline__ float row16_max(float v) {
#define DPP_MAX(v, ctrl) fmaxf((v), __builtin_bit_cast(float, __builtin_amdgcn_update_dpp(__builtin_bit_cast(int, (v)), __builtin_bit_cast(int, (v)), (ctrl), 0xF, 0xF, false)))
    v = DPP_MAX(v, 0xB1); v = DPP_MAX(v, 0x4E); v = DPP_MAX(v, 0x141); v = DPP_MAX(v, 0x140);
#undef DPP_MAX
    return v;
}
__device__ __forceinline__ void fs_row_ffn(const Params& P, int l, PG8_LAS unsigned char* lds, int t) {
    const int lane = t & 63, wid = t >> 6, rl = lane & 15, kg = lane >> 4;
    constexpr int WROW = D + 8;
    PG8_LAS bf16_t* wThi = (PG8_LAS bf16_t*)lds;
    PG8_LAS bf16_t* wTlo = wThi + NE * WROW;
    PG8_LAS float* gsv = (PG8_LAS float*)(lds + 2 * NE * WROW * 2);
    PG8_LAS float* shv = gsv + D;
    PG8_LAS float* red = shv + D;
    PG8_LAS float* cbv = red + 32 * NE;
    const float* wr = P.moe_router + (size_t)l * D * NE; const float* gvec = P.norm_ffn_g + (size_t)l * D;
    for (int i = t; i < D * NE; i += 512) { const int c = i / NE, e = i % NE; const float w = wr[i];
        const unsigned ph = pk_bf16(w, 0.f) & 0xffffu; const float wl = w - __uint_as_float(ph << 16);
        wThi[e * WROW + c] = (bf16_t)ph; wTlo[e * WROW + c] = (bf16_t)(pk_bf16(wl, 0.f) & 0xffffu); }
    const int nrows = (l == DEPTH - 1) ? RL : R, ntiles = nrows / 16, nwaves = gridDim.x * 8;
    const int nextra = ntiles - nwaves;
    for (int k0 = 0; k0 < 2; ++k0) {
        if (k0 == 1 && (int)blockIdx.x >= nextra) break;
        const int tl = k0 == 0 ? (int)blockIdx.x * 8 + wid : (wid == 0 ? nwaves + (int)blockIdx.x : ntiles), r0 = tl * 16;
        const int rb = k0 == 0 ? (int)blockIdx.x * 128 : (nwaves + (int)blockIdx.x) * 16, bb = rb < RL ? rb / T : NB;
        __syncthreads();
        { const float* mr = modrow(P, l, bb);
            for (int c = t; c < D; c += 512) { gsv[c] = gvec[c] * (1.0f + mr[4 * D + c]); shv[c] = mr[3 * D + c]; } }
        __syncthreads();
        { const int e = t & 15, part = t >> 4; float s = 0.f;
#pragma unroll 8
            for (int c = part * 32; c < part * 32 + 32; ++c) s += shv[c] * wr[(size_t)c * NE + e];
            red[part * NE + e] = s; }
        __syncthreads();
        if (t < NE) { float s = 0.f;
#pragma unroll
            for (int p2 = 0; p2 < 32; ++p2) s += red[p2 * NE + t];
            cbv[t] = s; }
        __syncthreads();
        if (tl >= ntiles) continue;
        const bf16_t* xrow = P.xb + (size_t)(r0 + rl) * D + kg * 16;
        unsigned char* hrow = (unsigned char*)P.h + (size_t)(r0 + rl) * D + kg * 16;
        float rinv;
        { const f32x4_t* sp = (const f32x4_t*)(P.ssqp + (size_t)(r0 + rl) * 16); const f32x4_t s0 = sp[0], s1 = sp[1], s2 = sp[2], s3 = sp[3];
            const float ss = ((s0[0] + s0[1]) + (s0[2] + s0[3])) + ((s1[0] + s1[1]) + (s1[2] + s1[3])) + ((s2[0] + s2[1]) + (s2[2] + s2[3])) + ((s3[0] + s3[1]) + (s3[2] + s3[3]));
            rinv = 1.0f / sqrtf(ss * (1.0f / D) + EPS); }
        pg8::f32x4 acc = (pg8::f32x4){0.f, 0.f, 0.f, 0.f};
        auto load8 = [&](int kb, u32x4_t (&xg)[8]) {
#pragma unroll
            for (int j = 0; j < 8; ++j) xg[j] = *(const u32x4_t*)(xrow + ((kb * 8 + j) >> 1) * 64 + ((kb * 8 + j) & 1) * 8); };
        u32x2_t hpair;
        auto step = [&](int ks, const u32x4_t& xv) {
            const int c0 = (ks >> 1) * 64 + kg * 16 + (ks & 1) * 8;
            const f32x4_t g0 = *(const PG8_LAS f32x4_t*)(gsv + c0), g1 = *(const PG8_LAS f32x4_t*)(gsv + c0 + 4), s0 = *(const PG8_LAS f32x4_t*)(shv + c0), s1 = *(const PG8_LAS f32x4_t*)(shv + c0 + 4);
            const bf16x8_t bh = *(const PG8_LAS bf16x8_t*)(wThi + rl * WROW + c0), bl = *(const PG8_LAS bf16x8_t*)(wTlo + rl * WROW + c0);
            const unsigned xw[4] = {xv.x, xv.y, xv.z, xv.w};
            float a[8], hv[8];
#pragma unroll
            for (int j = 0; j < 4; ++j) { const float x0 = __uint_as_float(xw[j] << 16), x1 = __uint_as_float(xw[j] & 0xffff0000u);
                a[2 * j] = x0 * (j < 2 ? g0[2 * j] : g1[2 * j - 4]); a[2 * j + 1] = x1 * (j < 2 ? g0[2 * j + 1] : g1[2 * j - 3]);
                hv[2 * j] = a[2 * j] * rinv + (j < 2 ? s0[2 * j] : s1[2 * j - 4]); hv[2 * j + 1] = a[2 * j + 1] * rinv + (j < 2 ? s0[2 * j + 1] : s1[2 * j - 3]); }
            u32x2_t w8; w8.x = pg8::pack4_fp8(hv[0], hv[1], hv[2], hv[3]); w8.y = pg8::pack4_fp8(hv[4], hv[5], hv[6], hv[7]);
            if (ks & 1) *(u32x4_t*)(hrow + (ks >> 1) * 64) = (u32x4_t){hpair.x, hpair.y, w8.x, w8.y}; else hpair = w8;
            unsigned hw[4], lw[4];
#pragma unroll
            for (int j = 0; j < 4; ++j) { hw[j] = pk_bf16(a[2 * j], a[2 * j + 1]);
                lw[j] = pk_bf16(a[2 * j] - __uint_as_float(hw[j] << 16), a[2 * j + 1] - __uint_as_float(hw[j] & 0xffff0000u)); }
            const bf16x8_t fah = __builtin_bit_cast(bf16x8_t, (u32x4_t){hw[0], hw[1], hw[2], hw[3]}), fal = __builtin_bit_cast(bf16x8_t, (u32x4_t){lw[0], lw[1], lw[2], lw[3]});
            acc = __builtin_amdgcn_mfma_f32_16x16x32_bf16(fah, bh, acc, 0, 0, 0);
            acc = __builtin_amdgcn_mfma_f32_16x16x32_bf16(fah, bl, acc, 0, 0, 0);
            acc = __builtin_amdgcn_mfma_f32_16x16x32_bf16(fal, bh, acc, 0, 0, 0);
            asm volatile("" ::: "memory"); };
        u32x4_t xa[8], xc[8];
        load8(0, xa);
#pragma nounroll
        for (int kb = 0; kb < 4; kb += 2) {
            load8(kb + 1, xc);
#pragma unroll
            for (int j = 0; j < 8; ++j) step(kb * 8 + j, xa[j]);
            if (kb + 2 < 4) load8(kb + 2, xa);
#pragma unroll
            for (int j = 0; j < 8; ++j) step((kb + 1) * 8 + j, xc[j]);
        }
        {
            const float cb = cbv[rl]; float aff[4];
#pragma unroll
            for (int i = 0; i < 4; ++i) { const float lg = bperm_f(rinv, 4 * kg + i) * acc[i] + cb;
                const float mx = row16_max(lg), ex = __expf(lg - mx), sm = row16_sum(ex); aff[i] = ex / sm; }
            *(f32x4_t*)(P.aff + (size_t)rl * R + r0 + 4 * kg) = (f32x4_t){aff[0], aff[1], aff[2], aff[3]};
        }
    }
    __syncthreads();
}
template <int KPT>
__device__ __forceinline__ void select_list(const Params& P, const float* a, int n, int cap, int base, int slot0, int e, PG8_LAS unsigned* sm, int t) {
    PG8_LAS unsigned* hist = sm;
    PG8_LAS unsigned* ctl = sm + 256;
    const int lane = t & 63, wid = t >> 6;
    unsigned key[KPT]; bool have[KPT];
#pragma unroll
    for (int j = 0; j < KPT; ++j) { const int i = t * KPT + j; have[j] = i < n; key[j] = have[j] ? __float_as_uint(a[i]) : 0u; }
    unsigned prefix = 0u, rem = (unsigned)cap;
#pragma unroll 1
    for (int pass = 0; pass < 4; ++pass) {
        const int shift = 24 - 8 * pass;
        if (t < 256) hist[t] = 0u;
        __syncthreads();
#pragma unroll
        for (int j = 0; j < KPT; ++j) if (have[j] && (pass == 0 || (key[j] >> (shift + 8)) == prefix)) (void)__hip_atomic_fetch_add(&hist[(key[j] >> shift) & 255u], 1u, __ATOMIC_RELAXED, __HIP_MEMORY_SCOPE_WORKGROUP);
        __syncthreads();
        if (wid == 0) {
            unsigned c[4]; unsigned s = 0u;
#pragma unroll
            for (int q = 0; q < 4; ++q) { c[q] = hist[255 - 4 * lane - q]; s += c[q]; }
            unsigned inc = s;
#pragma unroll
            for (int o = 1; o < 64; o <<= 1) { const unsigned v = (unsigned)bperm_i((int)inc, (lane - o) & 63); if (lane >= o) inc += v; }
            unsigned cum = inc - s;
#pragma unroll
            for (int q = 0; q < 4; ++q) { if (cum < rem && rem <= cum + c[q]) { ctl[0] = (prefix << 8) | (unsigned)(255 - 4 * lane - q); ctl[1] = rem - cum; ctl[2] = c[q]; } cum += c[q]; }
        }
        __syncthreads();
        prefix = ctl[0]; rem = ctl[1];
    }
    const unsigned T_ = prefix, need_eq = rem, cnt_eq = ctl[2];
    int nsel = 0, ntie = 0;
#pragma unroll
    for (int j = 0; j < KPT; ++j) { nsel += (have[j] && key[j] > T_) ? 1 : 0; ntie += (have[j] && key[j] == T_) ? 1 : 0; }
    int incs = nsel, inct = ntie;
#pragma unroll
    for (int o = 1; o < 64; o <<= 1) { const int v1 = bperm_i(incs, (lane - o) & 63), v2 = bperm_i(inct, (lane - o) & 63); if (lane >= o) { incs += v1; inct += v2; } }
    if (lane == 63) { ctl[4 + wid] = (unsigned)incs; ctl[16 + wid] = (unsigned)inct; }
    __syncthreads();
    int bs = 0, bt = 0;
#pragma unroll
    for (int w2 = 0; w2 < 8; ++w2) { if (w2 < wid) { bs += (int)ctl[4 + w2]; bt += (int)ctl[16 + w2]; } }
    int gpos = bs + incs - nsel, tpos = bt + inct - ntie;
    (void)cnt_eq;
#pragma unroll
    for (int j = 0; j < KPT; ++j) if (have[j]) { const int row = base + t * KPT + j;
        const bool gt = key[j] > T_, tie = key[j] == T_, take = gt || (tie && tpos < (int)need_eq);
        const int pos = gpos + (tpos < (int)need_eq ? tpos : (int)need_eq);
        if (take) { P.sel_row[slot0 + pos] = row; P.sel_g[slot0 + pos] = __uint_as_float(key[j]); P.inv[(size_t)row * NE + e] = slot0 + pos; }
        else P.inv[(size_t)row * NE + e] = -1;
        gpos += gt ? 1 : 0; tpos += tie ? 1 : 0; }
    __syncthreads();
}
__device__ __forceinline__ void fs_select(const Params& P, int l, PG8_LAS unsigned char* lds, int t) {
    PG8_LAS unsigned* sm = (PG8_LAS unsigned*)lds;
    for (int li = blockIdx.x; li < (l == DEPTH - 1 ? 1 : 2) * NB * NE; li += gridDim.x) {
        const bool lat = li < NB * NE; const int q = lat ? li : li - NB * NE, b = q / NE, e = q % NE;
        const int base = lat ? b * T : RL + b * TC, slot0 = e * SLOTS_E + (lat ? b * CAPL : NB * CAPL + b * CAPC);
        const float* a = P.aff + (size_t)e * R + base;
        if (lat) select_list<T / 512>(P, a, T, CAPL, base, slot0, e, sm, t);
        else select_list<1>(P, a, TC, CAPC, base, slot0, e, sm, t);
    }
}
__device__ __forceinline__ void fs_gather(const Params& P, int t) {
    const int lane = t & 63, wid = t >> 6;
    for (int s = blockIdx.x * 8 + wid; s < SLOTS; s += gridDim.x * 8) {
        const bf16_t* src = P.h + (size_t)P.sel_row[s] * D + lane * 8; bf16_t* dst = P.xg + (size_t)s * D + lane * 8;
        const u32x4_t v0 = *(const u32x4_t*)src, v1 = *(const u32x4_t*)(src + 512);
        *(u32x4_t*)dst = v0; *(u32x4_t*)(dst + 512) = v1;
    }
}
__device__ __forceinline__ float neg_expm1_fast(float x) {
    const float p = x * (1.0f + x * (0.5f + x * (1.0f / 6.0f + x * (1.0f / 24.0f + x * (1.0f / 120.0f + x * (1.0f / 720.0f))))));
    return x > -0.25f ? -p : 1.0f - __expf(x);
}
struct LruRegs { unsigned x[11], g[8]; float hin; };
template <bool FINAL>
__device__ __forceinline__ void lru_load(const Params& P, int u, int hh, int t, LruRegs& r) {
    const int rest = u >> 2, c = rest % NCH, b = rest / NCH;
    const int row0 = seqrow(b, c * CH), seglo = c < NCHC ? RL + b * TC : b * T, seghi = seglo + (c < NCHC ? TC : T);
    const int cp = t & 63, tg = t >> 6, r0 = row0 + tg * 8 - 2;
    const bf16_t* zc = P.z + O_XB + hh * HD + 2 * cp;
#pragma unroll
    for (int i = 0; i < 11; ++i) { int rr = r0 + i; rr = rr < seglo ? seglo : rr; rr = rr >= seghi ? seghi - 1 : rr; r.x[i] = *(const unsigned*)(zc + (size_t)rr * NZO); }
    if (FINAL) {
        const bf16_t* zg = P.z + O_GB + hh * HD + 2 * cp;
#pragma unroll
        for (int i = 0; i < 8; ++i) r.g[i] = *(const unsigned*)(zg + (size_t)(row0 + tg * 8 + i) * NZO);
        r.hin = t < 256 ? P.hinb[((size_t)((t >> 7) * NB + b) * NCH + c) * W2 + hh * HD + (t & 127)] : 0.f;
    }
}
template <bool FINAL>
__device__ __forceinline__ void fs_odd_lru(const Params& P, int l, PG8_LAS unsigned char* lds, int t) {
    const int lane = t & 63, w = t >> 6, q = lane >> 4, fr = lane & 15;
    const int li = l >> 1, hh = blockIdx.x & 3, jch = 16 * w + fr, chg = hh * HD + jch;
    PG8_LAS bf16_t* xcb = (PG8_LAS bf16_t*)lds;
    constexpr int XROW = 132;
    PG8_LAS float* xcf = (PG8_LAS float*)(lds + 17408);
    PG8_LAS float* hs = (PG8_LAS float*)(lds + 17408 + 33792);
    PG8_LAS float* hin = (PG8_LAS float*)(lds + 17408 + 67584);
    PG8_LAS bf16_t* gbs = (PG8_LAS bf16_t*)(lds + 17408 + 67584 + 1024);
    bf16x8_t bw[2][2][4];
#pragma unroll
    for (int dir = 0; dir < 2; ++dir)
#pragma unroll
        for (int gate = 0; gate < 2; ++gate)
#pragma unroll
            for (int ks = 0; ks < 4; ++ks) bw[dir][gate][ks] = *(const bf16x8_t*)(P.gwT + ((size_t)((((li * 2 + dir) * 2 + gate) * 4 + hh) * HD + jch)) * HD + ks * 32 + 8 * q);
    constexpr float L2E = 1.4426950408889634f;
    float ba[2], bx[2], sp[2];
#pragma unroll
    for (int dir = 0; dir < 2; ++dir) { ba[dir] = -L2E * P.od_gate_a_b[(size_t)(li * 2 + dir) * W2 + chg]; bx[dir] = -L2E * P.od_gate_x_b[(size_t)(li * 2 + dir) * W2 + chg];
        sp[dir] = L2E * -8.0f * softplusf_(-P.od_lambda[(size_t)(li * 2 + dir) * W2 + chg]); }
    const int cp = t & 63, tg = t >> 6;
    float cw[4][2], cbv[2];
#pragma unroll
    for (int h2 = 0; h2 < 2; ++h2) { cbv[h2] = P.od_conv_b[(size_t)li * W2 + hh * HD + 2 * cp + h2];
#pragma unroll
        for (int j = 0; j < 4; ++j) cw[j][h2] = P.od_conv_w[(size_t)(li * 4 + j) * W2 + hh * HD + 2 * cp + h2]; }
    constexpr int NU = NB * NCH * 4;
    LruRegs rg; if ((int)blockIdx.x < NU) lru_load<FINAL>(P, blockIdx.x, hh, t, rg);
    for (int u = blockIdx.x; u < NU; u += gridDim.x) {
        const int rest = u >> 2, c = rest % NCH, b = rest / NCH;
        const int row0 = seqrow(b, c * CH), seglo = c < NCHC ? RL + b * TC : b * T, seghi = seglo + (c < NCHC ? TC : T);
        {
            const int r0 = row0 + tg * 8 - 2;
            f32x2_t xv[11];
#pragma unroll
            for (int i = 0; i < 11; ++i) { const unsigned w = (r0 + i >= seglo && r0 + i < seghi) ? rg.x[i] : 0u; xv[i] = (f32x2_t){__uint_as_float(w << 16), __uint_as_float(w & 0xffff0000u)}; }
            const f32x2_t cb2v = (f32x2_t){cbv[0], cbv[1]}, cw0 = (f32x2_t){cw[0][0], cw[0][1]}, cw1 = (f32x2_t){cw[1][0], cw[1][1]}, cw2 = (f32x2_t){cw[2][0], cw[2][1]}, cw3 = (f32x2_t){cw[3][0], cw[3][1]};
#pragma unroll
            for (int i = 0; i < 8; ++i) { const int tok = tg * 8 + i;
                const f32x2_t xc = cb2v + cw0 * xv[i] + cw1 * xv[i + 1] + cw2 * xv[i + 2] + cw3 * xv[i + 3];
                *(PG8_LAS f32x2_t*)(xcf + tok * XROW + 2 * cp) = xc; *(PG8_LAS unsigned*)(xcb + tok * 136 + 2 * cp) = pk_bf16(xc.x, xc.y); }
            if (FINAL) {
#pragma unroll
                for (int i = 0; i < 8; ++i) *(PG8_LAS unsigned*)(gbs + (tg * 8 + i) * 128 + 2 * cp) = rg.g[i];
                if (t < 256) hin[t] = rg.hin; }
        }
        __syncthreads();
        if (u + (int)gridDim.x < NU) lru_load<FINAL>(P, u + gridDim.x, hh, t, rg);
#pragma unroll
        for (int dir = 0; dir < 2; ++dir) {
            pg8::f32x4 aa[4], ax[4];
#pragma unroll
            for (int mt = 0; mt < 4; ++mt) { aa[mt] = (pg8::f32x4){0.f, 0.f, 0.f, 0.f}; ax[mt] = (pg8::f32x4){0.f, 0.f, 0.f, 0.f}; }
#pragma unroll
            for (int ks = 0; ks < 4; ++ks)
#pragma unroll
                for (int mt = 0; mt < 4; ++mt) { const bf16x8_t af = *(const PG8_LAS bf16x8_t*)(xcb + (mt * 16 + fr) * 136 + ks * 32 + 8 * q);
                    aa[mt] = __builtin_amdgcn_mfma_f32_16x16x32_bf16(af, bw[dir][0][ks], aa[mt], 0, 0, 0);
                    ax[mt] = __builtin_amdgcn_mfma_f32_16x16x32_bf16(af, bw[dir][1][ks], ax[mt], 0, 0, 0); }
            float Ac = 1.f, Bc = FINAL ? hin[dir * 128 + jch] : 0.f;
#pragma unroll
            for (int mm = 0; mm < 4; ++mm) { const int mt = dir == 0 ? mm : 3 - mm;
                float ca[4], cb2[4];
#pragma unroll
                for (int ip = 0; ip < 2; ++ip) { const int i0 = 2 * ip;
                    const f32x2_t xv = (f32x2_t){xcf[(mt * 16 + 4 * q + i0) * XROW + jch], xcf[(mt * 16 + 4 * q + i0 + 1) * XROW + jch]};
                    const f32x2_t ta = (f32x2_t){aa[mt][i0], aa[mt][i0 + 1]} * (f32x2_t){-L2E, -L2E} + (f32x2_t){ba[dir], ba[dir]};
                    const f32x2_t tx = (f32x2_t){ax[mt][i0], ax[mt][i0 + 1]} * (f32x2_t){-L2E, -L2E} + (f32x2_t){bx[dir], bx[dir]};
                    const f32x2_t da = (f32x2_t){__builtin_amdgcn_exp2f(ta.x), __builtin_amdgcn_exp2f(ta.y)} + (f32x2_t){1.0f, 1.0f};
                    const f32x2_t dx = (f32x2_t){__builtin_amdgcn_exp2f(tx.x), __builtin_amdgcn_exp2f(tx.y)} + (f32x2_t){1.0f, 1.0f};
                    const f32x2_t rg2 = (f32x2_t){__builtin_amdgcn_rcpf(da.x), __builtin_amdgcn_rcpf(da.y)}, ig2 = (f32x2_t){__builtin_amdgcn_rcpf(dx.x), __builtin_amdgcn_rcpf(dx.y)};
                    const f32x2_t l2 = rg2 * (f32x2_t){sp[dir], sp[dir]};
                    const f32x2_t a2 = (f32x2_t){__builtin_amdgcn_exp2f(l2.x), __builtin_amdgcn_exp2f(l2.y)};
                    const f32x2_t om = (f32x2_t){1.0f, 1.0f} - a2 * a2;
                    const f32x2_t sq = (f32x2_t){__builtin_amdgcn_sqrtf(fmaxf(om.x, 0.f)), __builtin_amdgcn_sqrtf(fmaxf(om.y, 0.f))};
                    const f32x2_t cb = sq * (ig2 * xv);
                    ca[i0] = a2.x; ca[i0 + 1] = a2.y; cb2[i0] = cb.x; cb2[i0 + 1] = cb.y; }
                float Al = 1.f, Bl = 0.f;
#pragma unroll
                for (int ii = 0; ii < 4; ++ii) { const int i = dir == 0 ? ii : 3 - ii; Al = ca[i] * Al; Bl = ca[i] * Bl + cb2[i]; }
                float hq = Bc;
#pragma unroll
                for (int qq = 0; qq < 4; ++qq) { const int qs = dir == 0 ? qq : 3 - qq;
                    const float Aq = bperm_f(Al, fr + 16 * qs), Bq = bperm_f(Bl, fr + 16 * qs);
                    const bool before = dir == 0 ? (qs < q) : (qs > q);
                    if (FINAL) hq = before ? Aq * hq + Bq : hq;
                    Ac = Aq * Ac; Bc = Aq * Bc + Bq; }
                if (FINAL) {
                    float h = hq;
#pragma unroll
                    for (int ii = 0; ii < 4; ++ii) { const int i = dir == 0 ? ii : 3 - ii; h = ca[i] * h + cb2[i];
                        PG8_LAS float* hp = hs + (mt * 16 + 4 * q + i) * XROW + jch; if (dir == 0) *hp = h; else *hp += h; }
                }
            }
            if (!FINAL && q == 0) { const size_t si = ((size_t)(dir * NB + b) * NCH + c) * W2 + chg; P.sumA[si] = Ac; P.sumB[si] = Bc; }
        }
        __syncthreads();
        if (FINAL) {
            const int r = row0 + tg * 8;
#pragma unroll
            for (int i = 0; i < 8; ++i) { const f32x2_t hv = *(const PG8_LAS f32x2_t*)(hs + (tg * 8 + i) * XROW + 2 * cp); const unsigned gw = *(const PG8_LAS unsigned*)(gbs + (tg * 8 + i) * 128 + 2 * cp);
                const f32x2_t gx = (f32x2_t){__uint_as_float(gw << 16), __uint_as_float(gw & 0xffff0000u)};
                const f32x2_t ag = gx * (gx * gx * (f32x2_t){0.044715f, 0.044715f} + (f32x2_t){1.0f, 1.0f}) * (f32x2_t){-2.0f * 1.4426950408889634f * 0.7978845608028654f, -2.0f * 1.4426950408889634f * 0.7978845608028654f};
                const f32x2_t dg = (f32x2_t){__builtin_amdgcn_exp2f(ag.x), __builtin_amdgcn_exp2f(ag.y)} + (f32x2_t){1.0f, 1.0f};
                const f32x2_t yv = hv * gx * (f32x2_t){__builtin_amdgcn_rcpf(dg.x), __builtin_amdgcn_rcpf(dg.y)};
                *(unsigned*)(P.m + (size_t)(r + i) * D + hh * HD + 2 * cp) = pk_bf16(yv.x, yv.y); }
            __syncthreads();
        }
    }
}
__device__ __forceinline__ void fs_sgstat(const Params& P, int lane, int wid, int nw);
__device__ __forceinline__ void fs_odd2(const Params& P, int t) {
    if (t >= 64) { fs_sgstat(P, t & 63, (t >> 6) - 1, 7); return; }
    if (t >= 32) return;
    static_assert(NCH % 17 == 0, "chunk steps are taken 17 at a time");
    for (int it = blockIdx.x * 32 + t; it < 2 * NB * W2; it += gridDim.x * 32) {
        const int ch = it % W2, b = (it / W2) % NB, dir = it / (W2 * NB);
        const size_t base = ((size_t)(dir * NB + b) * NCH) * W2 + ch;
        const float* __restrict__ sA = P.sumA + base; const float* __restrict__ sB = P.sumB + base; float* __restrict__ hb = P.hinb + base;
        float h = 0.f;
#pragma unroll 1
        for (int s0 = 0; s0 < NCH; s0 += 17) {
            float A[17], B[17];
#pragma unroll
            for (int j = 0; j < 17; ++j) { const int step = s0 + j, c = dir == 0 ? step : (step < NCHC ? NCHC - 1 - step : NCH - 1 - (step - NCHC)); A[j] = sA[(size_t)c * W2]; B[j] = sB[(size_t)c * W2]; }
#pragma unroll
            for (int j = 0; j < 17; ++j) { const int step = s0 + j, c = dir == 0 ? step : (step < NCHC ? NCHC - 1 - step : NCH - 1 - (step - NCHC)); hb[(size_t)c * W2] = h; h = A[j] * h + B[j]; }
        }
    }
}
__device__ __forceinline__ void fs_sgstat(const Params& P, int lane, int wid, int nw  ) {
    const int stride = gridDim.x * nw;
    for (int r0 = blockIdx.x * nw + wid; r0 < R; r0 += 4 * stride) {
        u32x4_t w[4];
#pragma unroll
        for (int j = 0; j < 4; ++j) { const int r = r0 + j * stride < R ? r0 + j * stride : r0; w[j] = *(const u32x4_t*)(P.z + (size_t)r * NZO + O_V + lane * 8); }
#pragma unroll
        for (int j = 0; j < 4; ++j) { const int r = r0 + j * stride;
            const unsigned ww[4] = {w[j].x, w[j].y, w[j].z, w[j].w};
            float g[8];
#pragma unroll
            for (int i = 0; i < 4; ++i) { g[2 * i] = fgelu(__uint_as_float(ww[i] << 16)); g[2 * i + 1] = fgelu(__uint_as_float(ww[i] & 0xffff0000u)); }
            float s = 0.f;
#pragma unroll
            for (int i = 0; i < 8; ++i) s += g[i];
            const float mean = wave_sum(s) * (1.0f / W2);
            float vs = 0.f;
#pragma unroll
            for (int i = 0; i < 8; ++i) { const float d = g[i] - mean; vs += d * d; }
            vs = wave_sum(vs);
            if (lane == 0 && r < R) { P.sgstat[2 * r] = mean; P.sgstat[2 * r + 1] = 1.0f / sqrtf(vs * (1.0f / W2) + EPS); } }
    }
}
__device__ __forceinline__ void fs_odd_sg(const Params& P, int l, PG8_LAS unsigned char* lds, int t) {
    const int lane = t & 63, w = t >> 6, q = lane >> 4, fr = lane & 15, li = l >> 1, g = blockIdx.x & 3;
    PG8_LAS bf16_t* vbT = (PG8_LAS bf16_t*)lds;
    bf16x8_t aw[4];
#pragma unroll
    for (int ks = 0; ks < 4; ++ks) aw[ks] = *(const bf16x8_t*)(P.sgw + ((size_t)((li * 4 + g) * SGC + 16 * w + fr)) * SGC + ks * 32 + 8 * q);
    float sgb[4];
#pragma unroll
    for (int ii = 0; ii < 4; ++ii) sgb[ii] = P.od_sg_b[(size_t)(li * 4 + g) * SGC + 16 * w + 4 * q + ii];
    const int cc = t & 127, jp = t >> 7; const float gn = P.od_sg_norm_g[(size_t)li * W2 + g * HD + cc];
    for (int u = (blockIdx.x + gridDim.x / 2) % gridDim.x; u < (R / SGC) * 4; u += gridDim.x) {
        const int base = (u >> 2) * SGC;
        { const bf16_t* zv = P.z + O_V + g * HD + cc;
            bf16_t vr[32]; f32x4_t sv[16];
#pragma unroll
            for (int jj = 0; jj < 16; ++jj) { const int r0 = base + (jp * 16 + jj) * 2;
                vr[2 * jj] = zv[(size_t)r0 * NZO]; vr[2 * jj + 1] = zv[(size_t)(r0 + 1) * NZO]; sv[jj] = *(const f32x4_t*)(P.sgstat + 2 * r0); }
#pragma unroll
            for (int jj = 0; jj < 16; ++jj) { const int j = (jp * 16 + jj) * 2;
                const float v0 = (fgelu(bf2f(vr[2 * jj])) - sv[jj][0]) * sv[jj][1] * gn;
                const float v1 = (fgelu(bf2f(vr[2 * jj + 1])) - sv[jj][2]) * sv[jj][3] * gn;
                *(PG8_LAS unsigned*)(vbT + cc * 136 + j) = pk_bf16(v0, v1); } }
        __syncthreads();
        bf16_t ur[32];
#pragma unroll
        for (int ct = 0; ct < 8; ++ct)
#pragma unroll
            for (int ii = 0; ii < 4; ++ii) ur[ct * 4 + ii] = P.z[(size_t)(base + 16 * w + 4 * q + ii) * NZO + O_U + g * HD + ct * 16 + fr];
        pg8::f32x4 acc[8];
#pragma unroll
        for (int ct = 0; ct < 8; ++ct) acc[ct] = (pg8::f32x4){0.f, 0.f, 0.f, 0.f};
#pragma unroll
        for (int ks = 0; ks < 4; ++ks)
#pragma unroll
            for (int ct = 0; ct < 8; ++ct) { const bf16x8_t bf = *(const PG8_LAS bf16x8_t*)(vbT + (ct * 16 + fr) * 136 + ks * 32 + 8 * q);
                acc[ct] = __builtin_amdgcn_mfma_f32_16x16x32_bf16(aw[ks], bf, acc[ct], 0, 0, 0); }
#pragma unroll
        for (int ct = 0; ct < 8; ++ct)
#pragma unroll
            for (int ii = 0; ii < 4; ++ii) { const int row = base + 16 * w + 4 * q + ii, c = g * HD + ct * 16 + fr;
                const float uu = bf2f(ur[ct * 4 + ii]);
                P.m[(size_t)row * D + W2 + c] = f2bf(fgelu(uu) * (acc[ct][ii] + sgb[ii])); }
        __syncthreads();
    }
}
constexpr int LRS_ROW = 40;
constexpr int LAT_ROW = 68;
struct GlaUp { bf16x8_t b[4]; float bias[4]; };
__device__ __forceinline__ void gla_load_up(const Params& P, int li, int hh, int t, GlaUp& g) {
    const int lane = t & 63, w = t >> 6, q = lane >> 4, fr = lane & 15, dir = w >> 2;
    unsigned keep = (q >> 1) == dir ? 0xffffffffu : 0u; asm volatile("" : "+v"(keep));
#pragma unroll
    for (int j = 0; j < 4; ++j) { const int dcol = hh * DK + j * 16 + fr; unsigned pk[4];
#pragma unroll
        for (int i2 = 0; i2 < 4; ++i2) { const int r0 = 8 * (q & 1) + 2 * i2;
            const float a = P.ev_decay_up[((size_t)(li * 2 + dir) * RANK + r0) * KEY + dcol], b2 = P.ev_decay_up[((size_t)(li * 2 + dir) * RANK + r0 + 1) * KEY + dcol];
            pk[i2] = pk_bf16(a, b2) & keep; }
        g.b[j] = __builtin_bit_cast(bf16x8_t, (u32x4_t){pk[0], pk[1], pk[2], pk[3]});
        g.bias[j] = P.ev_decay_b[(size_t)(li * 2 + dir) * KEY + dcol]; }
}
__device__ __forceinline__ void gla_preact(const PG8_LAS bf16_t* lrs, const GlaUp& g, PG8_LAS float* laT, int t) {
    const int lane = t & 63, w = t >> 6, q = lane >> 4, fr = lane & 15, mt = w & 3, dir = w >> 2;
    const bf16x8_t af = *(const PG8_LAS bf16x8_t*)(lrs + (mt * 16 + fr) * LRS_ROW + 8 * q);
#pragma unroll
    for (int j = 0; j < 4; ++j) { const pg8::f32x4 acc = __builtin_amdgcn_mfma_f32_16x16x32_bf16(af, g.b[j], (pg8::f32x4){0.f, 0.f, 0.f, 0.f}, 0, 0, 0);
        f32x4_t la;
#pragma unroll
        for (int ii = 0; ii < 4; ++ii) { const float x = acc[ii] + g.bias[j]; la[ii] = (fminf(x, 0.f) - __logf(1.0f + __expf(-fabsf(x)))) * (1.0f / 16.0f); }
        *(PG8_LAS f32x4_t*)(laT + ((dir * 4 + j) * 16 + fr) * LAT_ROW + mt * 16 + 4 * q) = la; }
}
__device__ __forceinline__ void gla_local_cumsum(const PG8_LAS float* laT, int d, int tok_first, float (&csf)[8], float (&csb)[8]) {
    const f32x4_t a0 = *(const PG8_LAS f32x4_t*)(laT + d * LAT_ROW + tok_first), a1 = *(const PG8_LAS f32x4_t*)(laT + d * LAT_ROW + tok_first + 4);
    const f32x4_t b0 = *(const PG8_LAS f32x4_t*)(laT + (64 + d) * LAT_ROW + tok_first), b1 = *(const PG8_LAS f32x4_t*)(laT + (64 + d) * LAT_ROW + tok_first + 4);
#pragma unroll
    for (int i = 0; i < 4; ++i) { csf[i] = a0[i]; csf[4 + i] = a1[i]; csb[i] = b0[i]; csb[4 + i] = b1[i]; }
#pragma unroll
    for (int i = 1; i < 8; ++i) csf[i] += csf[i - 1];
#pragma unroll
    for (int i = 6; i >= 0; --i) csb[i] += csb[i + 1];
}
__device__ __forceinline__ unsigned st8_pack4(float a, float b, float c, float d) {
    return pg8::pack4_fp8(__builtin_amdgcn_fmed3f(a, -448.f, 448.f), __builtin_amdgcn_fmed3f(b, -448.f, 448.f), __builtin_amdgcn_fmed3f(c, -448.f, 448.f), __builtin_amdgcn_fmed3f(d, -448.f, 448.f)); }
__device__ __forceinline__ u32x4_t st8_to_bf16x8(u32x2_t w) {
    return (u32x4_t){pk_bf16(__builtin_amdgcn_cvt_f32_fp8((int)w.x, 0), __builtin_amdgcn_cvt_f32_fp8((int)w.x, 1)), pk_bf16(__builtin_amdgcn_cvt_f32_fp8((int)w.x, 2), __builtin_amdgcn_cvt_f32_fp8((int)w.x, 3)),
                      pk_bf16(__builtin_amdgcn_cvt_f32_fp8((int)w.y, 0), __builtin_amdgcn_cvt_f32_fp8((int)w.y, 1)), pk_bf16(__builtin_amdgcn_cvt_f32_fp8((int)w.y, 2), __builtin_amdgcn_cvt_f32_fp8((int)w.y, 3))}; }
struct GlaRegs { u32x2_t lr; bf16_t k[8], q[8], v[16], g[16]; u32x2_t s[2][2]; };
template <bool E3>
__device__ __forceinline__ void gla_load(const Params& P, int u, int hh, int t, GlaRegs& r) {
    const int rest = u >> 2, c = rest % NCH, b = rest / NCH, row0 = seqrow(b, c * CH);
    const int d = t & 63, sg = t >> 6, e = t & 127, jp = t >> 7;
    r.lr = *(const u32x2_t*)(P.z + (size_t)(row0 + (t >> 3)) * NZE + E_LRF + (t & 7) * 4);
#pragma unroll
    for (int i = 0; i < 8; ++i) { const bf16_t* zr = P.z + (size_t)(row0 + sg * 8 + i) * NZE + hh * DK + d; r.k[i] = zr[E_K]; if (E3) r.q[i] = zr[E_Q]; }
#pragma unroll
    for (int jj = 0; jj < 16; ++jj) r.v[jj] = P.z[(size_t)(row0 + jp * 16 + jj) * NZE + E_V + hh * DV + e];
    if (E3) {
        const int lane = t & 63, w = t >> 6, q = lane >> 4, fr = lane & 15, it = w & 3, wh = w >> 2;
#pragma unroll
        for (int ii = 0; ii < 4; ++ii)
#pragma unroll
            for (int el = 0; el < 4; ++el) r.g[ii * 4 + el] = P.z[(size_t)(row0 + it * 16 + 4 * q + ii) * NZE + E_G + hh * DV + (wh * 4 + el) * 16 + fr];
#pragma unroll
        for (int dir = 0; dir < 2; ++dir) { const unsigned char* Sb = (const unsigned char*)P.SinB + ((size_t)((dir * NB + b) * GH + hh) * NCH + c) * DV * DK;
#pragma unroll
            for (int i = 0; i < 2; ++i) r.s[dir][i] = *(const u32x2_t*)(Sb + (size_t)(t + 512 * i) * 8); }
    }
}
__device__ __forceinline__ void gla_store_common(const GlaRegs& r, PG8_LAS bf16_t* lrs, PG8_LAS bf16_t* vT, int t) {
    *(PG8_LAS u32x2_t*)(lrs + (t >> 3) * LRS_ROW + (t & 7) * 4) = r.lr;
    const int e = t & 127, jp = t >> 7;
#pragma unroll
    for (int jj = 0; jj < 16; jj += 2) *(PG8_LAS unsigned*)(vT + e * 72 + jp * 16 + jj) = (unsigned)r.v[jj] | ((unsigned)r.v[jj + 1] << 16);
}
constexpr int LRS1_ROW = 40;
struct GlaUp1 { bf16x8_t b; float bias[4]; };
__device__ __forceinline__ void gla_load_up1(const Params& P, int li, int hh, int t, GlaUp1& g) {
    const int lane = t & 63, w = t >> 6, q = lane >> 4, fr = lane & 15, dir = w >> 2, dt = w & 3;
    unsigned keep = (q >> 1) == dir ? 0xffffffffu : 0u; asm volatile("" : "+v"(keep));
    const int dcol = hh * DK + dt * 16 + fr; unsigned pk[4];
#pragma unroll
    for (int i2 = 0; i2 < 4; ++i2) { const int r0 = 8 * (q & 1) + 2 * i2;
        const float a = P.ev_decay_up[((size_t)(li * 2 + dir) * RANK + r0) * KEY + dcol], b2 = P.ev_decay_up[((size_t)(li * 2 + dir) * RANK + r0 + 1) * KEY + dcol];
        pk[i2] = pk_bf16(a, b2) & keep; }
    g.b = __builtin_bit_cast(bf16x8_t, (u32x4_t){pk[0], pk[1], pk[2], pk[3]});
#pragma unroll
    for (int ii = 0; ii < 4; ++ii) g.bias[ii] = P.ev_decay_b[(size_t)(li * 2 + dir) * KEY + hh * DK + dt * 16 + 4 * q + ii];
}
__device__ __forceinline__ void gla_decay_scan(const PG8_LAS bf16_t* lrs, const GlaUp1& g, int t, float (&bl)[4][4], float (&tot)[4]) {
    const int lane = t & 63, w = t >> 6, q = lane >> 4, fr = lane & 15, dir = w >> 2;
#pragma unroll
    for (int mt = 0; mt < 4; ++mt) { const bf16x8_t tf = *(const PG8_LAS bf16x8_t*)(lrs + (mt * 16 + fr) * LRS1_ROW + 8 * q);
        const pg8::f32x4 acc = __builtin_amdgcn_mfma_f32_16x16x32_bf16(g.b, tf, (pg8::f32x4){0.f, 0.f, 0.f, 0.f}, 0, 0, 0);
#pragma unroll
        for (int ii = 0; ii < 4; ++ii) { const float x = acc[ii] + g.bias[ii]; bl[mt][ii] = (fminf(x, 0.f) - __logf(1.0f + __expf(-fabsf(x)))) * (1.0f / 16.0f); } }
#pragma unroll
    for (int ii = 0; ii < 4; ++ii) tot[ii] = 0.f;
    if (dir == 0) {
#pragma unroll
        for (int mt = 0; mt < 4; ++mt)
#pragma unroll
            for (int ii = 0; ii < 4; ++ii) { float v = bl[mt][ii]; v = DPP_ADD(v, 0x111); v = DPP_ADD(v, 0x112); v = DPP_ADD(v, 0x114); v = DPP_ADD(v, 0x118);
                const float tt = bperm_f(v, lane | 15); bl[mt][ii] = v + tot[ii]; tot[ii] += tt; }
    } else {
#pragma unroll
        for (int mt = 3; mt >= 0; --mt)
#pragma unroll
            for (int ii = 0; ii < 4; ++ii) { float v = bl[mt][ii]; v = DPP_ADD(v, 0x101); v = DPP_ADD(v, 0x102); v = DPP_ADD(v, 0x104); v = DPP_ADD(v, 0x108);
                const float tt = bperm_f(v, lane & 48); bl[mt][ii] = v + tot[ii]; tot[ii] += tt; }
    }
}
struct GlaRegs1 { u32x2_t lr, k[4], q[4]; u32x4_t v[2]; u32x2_t s[2][2]; };
template <bool E3>
__device__ __forceinline__ void gla_load1(const Params& P, int u, int hh, int t, GlaRegs1& r) {
    const int rest = u >> 2, c = rest % NCH, b = rest / NCH, row0 = seqrow(b, c * CH);
    const int lane = t & 63, w = t >> 6, q = lane >> 4, fr = lane & 15, dt = w & 3;
    r.lr = *(const u32x2_t*)(P.z + (size_t)(row0 + (t >> 3)) * NZE + E_LRF + (t & 7) * 4);
#pragma unroll
    for (int mt = 0; mt < 4; ++mt) { const bf16_t* zr = P.z + (size_t)(row0 + mt * 16 + fr) * NZE + hh * DK + dt * 16 + 4 * q;
        r.k[mt] = *(const u32x2_t*)(zr + E_K); if (E3) r.q[mt] = *(const u32x2_t*)(zr + E_Q); }
#pragma unroll
    for (int i = 0; i < 2; ++i) { const int p = t + 512 * i, tok = p & 63, eg = p >> 6; r.v[i] = *(const u32x4_t*)(P.z + (size_t)(row0 + tok) * NZE + E_V + hh * DV + eg * 8); }
    if (E3) {
#pragma unroll
        for (int dir = 0; dir < 2; ++dir) { const unsigned char* Sb = (const unsigned char*)P.SinB + ((size_t)((dir * NB + b) * GH + hh) * NCH + c) * DV * DK;
#pragma unroll
            for (int i = 0; i < 2; ++i) r.s[dir][i] = *(const u32x2_t*)(Sb + (size_t)(t + 512 * i) * 8); }
    }
}
__device__ __forceinline__ void gla_store_common1(const GlaRegs1& r, PG8_LAS bf16_t* lrs, PG8_LAS bf16_t* vT, int t) {
    *(PG8_LAS u32x2_t*)(lrs + (t >> 3) * LRS1_ROW + (t & 7) * 4) = r.lr;
#pragma unroll
    for (int i = 0; i < 2; ++i) { const int p = t + 512 * i, tok = p & 63, eg = p >> 6; const unsigned wv[4] = {r.v[i].x, r.v[i].y, r.v[i].z, r.v[i].w};
#pragma unroll
        for (int j = 0; j < 4; ++j) { vT[(eg * 8 + 2 * j) * 72 + tok] = (bf16_t)(wv[j] & 0xffffu); vT[(eg * 8 + 2 * j + 1) * 72 + tok] = (bf16_t)(wv[j] >> 16); } }
}
__device__ __forceinline__ void fs_even1(const Params& P, int l, PG8_LAS unsigned char* lds, int t) {
    const int lane = t & 63, w = t >> 6, q = lane >> 4, fr = lane & 15, li = l >> 1, hh = blockIdx.x & 3, wdir = w >> 2, dt = w & 3;
    PG8_LAS bf16_t* vT = (PG8_LAS bf16_t*)lds;
    PG8_LAS bf16_t* kdT = (PG8_LAS bf16_t*)(lds + 18432);
    PG8_LAS bf16_t* lrs = (PG8_LAS bf16_t*)(lds + 18432 + 18432);
    PG8_LAS bf16_t* sst = (PG8_LAS bf16_t*)(lds + 18432 + 18432 + 5120);
    GlaUp1 gu; gla_load_up1(P, li, hh, t, gu);
    constexpr int NU = NB * NCH * 4;
    GlaRegs1 rg; if ((int)blockIdx.x < NU) gla_load1<false>(P, blockIdx.x, hh, t, rg);
    for (int u = blockIdx.x; u < NU; u += gridDim.x) {
        const int rest = u >> 2, c = rest % NCH, b = rest / NCH;
        gla_store_common1(rg, lrs, vT, t);
        u32x2_t kraw[4];
#pragma unroll
        for (int mt = 0; mt < 4; ++mt) kraw[mt] = rg.k[mt];
        __syncthreads();
        if (u + (int)gridDim.x < NU) gla_load1<false>(P, u + gridDim.x, hh, t, rg);
        {
            float bl[4][4], tot[4];
            gla_decay_scan(lrs, gu, t, bl, tot);
#pragma unroll
            for (int mt = 0; mt < 4; ++mt) { const unsigned kw[2] = {kraw[mt].x, kraw[mt].y};
#pragma unroll
                for (int ii = 0; ii < 4; ++ii) { const float kk = (ii & 1) ? __uint_as_float(kw[ii >> 1] & 0xffff0000u) : __uint_as_float(kw[ii >> 1] << 16);
                    kdT[wdir * 64 * 72 + (dt * 16 + 4 * q + ii) * 72 + mt * 16 + fr] = (bf16_t)pk_bf16(kk * __expf(tot[ii] - bl[mt][ii]), 0.f); } }
            if (fr == 0) { float* dv = P.decv + ((size_t)((wdir * NB + b) * GH + hh) * NCH + c) * DK + dt * 16 + 4 * q;
                *(f32x4_t*)dv = (f32x4_t){__expf(tot[0]), __expf(tot[1]), __expf(tot[2]), __expf(tot[3])}; }
        }
        __syncthreads();
#pragma unroll
        for (int dir = 0; dir < 2; ++dir) {
            pg8::f32x4 acc[4];
#pragma unroll
            for (int dt2 = 0; dt2 < 4; ++dt2) acc[dt2] = (pg8::f32x4){0.f, 0.f, 0.f, 0.f};
#pragma unroll
            for (int ks = 0; ks < 2; ++ks) { const bf16x8_t af = *(const PG8_LAS bf16x8_t*)(vT + (16 * w + fr) * 72 + ks * 32 + 8 * q);
#pragma unroll
                for (int dt2 = 0; dt2 < 4; ++dt2) { const bf16x8_t bfr = *(const PG8_LAS bf16x8_t*)(kdT + dir * 64 * 72 + (dt2 * 16 + fr) * 72 + ks * 32 + 8 * q);
                    acc[dt2] = __builtin_amdgcn_mfma_f32_16x16x32_bf16(af, bfr, acc[dt2], 0, 0, 0); } }
#pragma unroll
            for (int dt2 = 0; dt2 < 4; ++dt2)
#pragma unroll
                for (int ii = 0; ii < 4; ++ii) sst[dir * 128 * 72 + (16 * w + 4 * q + ii) * 72 + dt2 * 16 + fr] = (bf16_t)pk_bf16(acc[dt2][ii], 0.f);
        }
        __syncthreads();
#pragma unroll
        for (int dir = 0; dir < 2; ++dir) { unsigned char* Sb = (unsigned char*)P.Sd + ((size_t)((dir * NB + b) * GH + hh) * NCH + c) * DV * DK;
#pragma unroll
            for (int i = 0; i < 2; ++i) { const int f = t + 512 * i, e = f >> 3, d8 = (f & 7) * 8; const u32x4_t w = *(const PG8_LAS u32x4_t*)(sst + dir * 128 * 72 + e * 72 + d8);
                *(u32x2_t*)(Sb + (size_t)f * 8) = (u32x2_t){st8_pack4(__uint_as_float(w.x << 16), __uint_as_float(w.x & 0xffff0000u), __uint_as_float(w.y << 16), __uint_as_float(w.y & 0xffff0000u)),
                                                              st8_pack4(__uint_as_float(w.z << 16), __uint_as_float(w.z & 0xffff0000u), __uint_as_float(w.w << 16), __uint_as_float(w.w & 0xffff0000u))}; } }
        __syncthreads();
    }
}
__device__ __forceinline__ void fs_even2(const Params& P, int t) {
    for (int it = blockIdx.x * 512 + t; it < 2 * NB * GH * DV * (DK / 4); it += gridDim.x * 512) {
        const int d4 = it % (DK / 4), e = (it / (DK / 4)) % DV, hh = (it / (DK / 4 * DV)) % GH, b = (it / (DK / 4 * DV * GH)) % NB, dir = it / (DK / 4 * DV * GH * NB);
        const size_t cb0 = ((size_t)((dir * NB + b) * GH + hh) * NCH) * DV * DK + (size_t)e * DK + d4 * 4;
        const unsigned char* __restrict__ Sb = (const unsigned char*)P.Sd + cb0; unsigned char* __restrict__ So = (unsigned char*)P.SinB + cb0;
        const float* __restrict__ dv = P.decv + ((size_t)((dir * NB + b) * GH + hh) * NCH) * DK + d4 * 4;
        f32x4_t s = (f32x4_t){0.f, 0.f, 0.f, 0.f};
        static_assert(NCH % 4 == 0, "chunk steps are taken four at a time");
        auto chunk_of = [&](int step) { return dir == 0 ? step : (step < NCHC ? NCHC - 1 - step : NCH - 1 - (step - NCHC)); };
        unsigned tw[4], tn[4]; f32x4_t dc[4], dn[4];
#pragma unroll
        for (int j = 0; j < 4; ++j) { const int c = chunk_of(j); tw[j] = *(const unsigned*)(Sb + (size_t)c * DV * DK); dc[j] = *(const f32x4_t*)(dv + (size_t)c * DK); }
#pragma unroll 1
        for (int s0 = 0; s0 < NCH; s0 += 4) {
            if (s0 + 4 < NCH) {
#pragma unroll
                for (int j = 0; j < 4; ++j) { const int c = chunk_of(s0 + 4 + j); tn[j] = *(const unsigned*)(Sb + (size_t)c * DV * DK); dn[j] = *(const f32x4_t*)(dv + (size_t)c * DK); } }
#pragma unroll
            for (int j = 0; j < 4; ++j) { const int c = chunk_of(s0 + j);
                const f32x4_t tmp = (f32x4_t){__builtin_amdgcn_cvt_f32_fp8((int)tw[j], 0), __builtin_amdgcn_cvt_f32_fp8((int)tw[j], 1), __builtin_amdgcn_cvt_f32_fp8((int)tw[j], 2), __builtin_amdgcn_cvt_f32_fp8((int)tw[j], 3)};
                *(unsigned*)(So + (size_t)c * DV * DK) = st8_pack4(s[0], s[1], s[2], s[3]); s = dc[j] * s + tmp; }
#pragma unroll
            for (int j = 0; j < 4; ++j) { tw[j] = tn[j]; dc[j] = dn[j]; }
        }
    }
}
__device__ __forceinline__ void fs_even3(const Params& P, int l, PG8_LAS unsigned char* lds, int t) {
    const int lane = t & 63, w = t >> 6, q = lane >> 4, fr = lane & 15, li = l >> 1, hh = blockIdx.x & 3, d = t & 63, sg = t >> 6;
    PG8_LAS bf16_t* vT = (PG8_LAS bf16_t*)lds;
    PG8_LAS bf16_t* qd = (PG8_LAS bf16_t*)(lds + 18432);
    PG8_LAS bf16_t* kd = (PG8_LAS bf16_t*)(lds + 18432 + 18432);
    PG8_LAS bf16_t* sT = (PG8_LAS bf16_t*)(lds + 18432 * 3);
    PG8_LAS bf16_t* att = (PG8_LAS bf16_t*)(lds + 18432 * 5);
    PG8_LAS float* tot = (PG8_LAS float*)(lds + 18432 * 6);
    PG8_LAS float* ssq = tot + 1024;
    PG8_LAS bf16_t* lrs = (PG8_LAS bf16_t*)(lds + 18432 * 6 + 4096 + 512);
    GlaUp1 gu; gla_load_up1(P, li, hh, t, gu);
    const int it = w & 3, wh = w >> 2;
    float ng[4];
#pragma unroll
    for (int el = 0; el < 4; ++el) ng[el] = P.ev_norm_g[(size_t)li * W2 + hh * DV + (wh * 4 + el) * 16 + fr];
    constexpr int NU = NB * NCH * 4;
    GlaRegs1 rg; if ((int)blockIdx.x < NU) gla_load1<true>(P, blockIdx.x, hh, t, rg);
    for (int u = blockIdx.x; u < NU; u += gridDim.x) {
        const int rest = u >> 2, c = rest % NCH, b = rest / NCH, row0 = seqrow(b, c * CH);
        gla_store_common1(rg, lrs, vT, t);
#pragma unroll
        for (int dir = 0; dir < 2; ++dir)
#pragma unroll
            for (int i = 0; i < 2; ++i) { const int f = t + 512 * i, e = f >> 3, d8 = (f & 7) * 8; *(PG8_LAS u32x4_t*)(sT + dir * 128 * 72 + e * 72 + d8) = st8_to_bf16x8(rg.s[dir][i]); }
        u32x2_t kraw[4], qraw[4];
#pragma unroll
        for (int mt = 0; mt < 4; ++mt) { kraw[mt] = rg.k[mt]; qraw[mt] = rg.q[mt]; }
        __syncthreads();
        bf16_t graw[16];
#pragma unroll
        for (int ii = 0; ii < 4; ++ii)
#pragma unroll
            for (int el = 0; el < 4; ++el) graw[ii * 4 + el] = P.z[(size_t)(row0 + it * 16 + 4 * q + ii) * NZE + E_G + hh * DV + (wh * 4 + el) * 16 + fr];
        if (u + (int)gridDim.x < NU) gla_load1<true>(P, u + gridDim.x, hh, t, rg);
        {
            float bl[4][4], tot[4];
            gla_decay_scan(lrs, gu, t, bl, tot);
#pragma unroll
            for (int mt = 0; mt < 4; ++mt) { const unsigned kw[2] = {kraw[mt].x, kraw[mt].y}, qw[2] = {qraw[mt].x, qraw[mt].y}; float qv[4], kv[4];
#pragma unroll
                for (int ii = 0; ii < 4; ++ii) { const float kk = (ii & 1) ? __uint_as_float(kw[ii >> 1] & 0xffff0000u) : __uint_as_float(kw[ii >> 1] << 16);
                    const float qq = ((ii & 1) ? __uint_as_float(qw[ii >> 1] & 0xffff0000u) : __uint_as_float(qw[ii >> 1] << 16)) * 0.125f;
                    const float ef = __expf(bl[mt][ii]); qv[ii] = qq * ef; kv[ii] = kk * __builtin_amdgcn_rcpf(ef); }
                const int o = wh * 64 * 72 + (mt * 16 + fr) * 72 + it * 16 + 4 * q;
                *(PG8_LAS u32x2_t*)(qd + o) = (u32x2_t){pk_bf16(qv[0], qv[1]), pk_bf16(qv[2], qv[3])};
                *(PG8_LAS u32x2_t*)(kd + o) = (u32x2_t){pk_bf16(kv[0], kv[1]), pk_bf16(kv[2], kv[3])}; }
        }
        __syncthreads();
#pragma unroll
        for (int dir = 0; dir < 2; ++dir)
#pragma unroll
            for (int jl = 0; jl < 2; ++jl) { const int jt = wh * 2 + jl;
                pg8::f32x4 a4 = (pg8::f32x4){0.f, 0.f, 0.f, 0.f};
                if (dir == 0 ? (jt <= it) : (jt >= it)) {
#pragma unroll
                    for (int ks = 0; ks < 2; ++ks) { const bf16x8_t af = *(const PG8_LAS bf16x8_t*)(qd + dir * 64 * 72 + (it * 16 + fr) * 72 + ks * 32 + 8 * q);
                        const bf16x8_t bfr = *(const PG8_LAS bf16x8_t*)(kd + dir * 64 * 72 + (jt * 16 + fr) * 72 + ks * 32 + 8 * q);
                        a4 = __builtin_amdgcn_mfma_f32_16x16x32_bf16(af, bfr, a4, 0, 0, 0); } }
#pragma unroll
                for (int ii = 0; ii < 4; ++ii) { const int i = it * 16 + 4 * q + ii, j = jt * 16 + fr; const bool keep = dir == 0 ? (j <= i) : (j >= i);
                    att[dir * 64 * 72 + i * 72 + j] = (bf16_t)pk_bf16(keep ? a4[ii] : 0.f, 0.f); } }
        __syncthreads();
        pg8::f32x4 o[4];
#pragma unroll
        for (int el = 0; el < 4; ++el) o[el] = (pg8::f32x4){0.f, 0.f, 0.f, 0.f};
#pragma unroll
        for (int dir = 0; dir < 2; ++dir)
#pragma unroll
            for (int ks = 0; ks < 2; ++ks) { const bf16x8_t aa = *(const PG8_LAS bf16x8_t*)(att + dir * 64 * 72 + (it * 16 + fr) * 72 + ks * 32 + 8 * q);
                const bf16x8_t aq = *(const PG8_LAS bf16x8_t*)(qd + dir * 64 * 72 + (it * 16 + fr) * 72 + ks * 32 + 8 * q);
#pragma unroll
                for (int el = 0; el < 4; ++el) { const int et = wh * 4 + el;
                    const bf16x8_t bv = *(const PG8_LAS bf16x8_t*)(vT + (et * 16 + fr) * 72 + ks * 32 + 8 * q);
                    const bf16x8_t bs = *(const PG8_LAS bf16x8_t*)(sT + dir * 128 * 72 + (et * 16 + fr) * 72 + ks * 32 + 8 * q);
                    o[el] = __builtin_amdgcn_mfma_f32_16x16x32_bf16(aa, bv, o[el], 0, 0, 0);
                    o[el] = __builtin_amdgcn_mfma_f32_16x16x32_bf16(aq, bs, o[el], 0, 0, 0); } }
#pragma unroll
        for (int ii = 0; ii < 4; ++ii) { float s = 0.f;
#pragma unroll
            for (int el = 0; el < 4; ++el) s += o[el][ii] * o[el][ii];
            s = row16_sum(s);
            if (fr == 0) ssq[wh * 64 + it * 16 + 4 * q + ii] = s; }
        __syncthreads();
#pragma unroll
        for (int ii = 0; ii < 4; ++ii) { const int i = it * 16 + 4 * q + ii; const float rinv = 1.0f / sqrtf((ssq[i] + ssq[64 + i]) * (1.0f / DV) + EPS);
            const size_t row = (size_t)(row0 + i);
#pragma unroll
            for (int el = 0; el < 4; ++el) { const int e = hh * DV + (wh * 4 + el) * 16 + fr; const float gg = bf2f(graw[ii * 4 + el]);
                P.m[row * D + W2 + e] = (bf16_t)pk_bf16(o[el][ii] * rinv * ng[el] * fsilu(gg), 0.f); } }
    }
}
__device__ __forceinline__ void fs_even_conv(const Params& P, int l, int t) {
    const int li = l >> 1;
    for (int it = (int)((blockIdx.x + gridDim.x / 2) % gridDim.x) * 512 + t; it < (R / 4) * (W2 / 8); it += gridDim.x * 512) {
        const int rowb = (it / (W2 / 8)) * 4, c8 = (it % (W2 / 8)) * 8;
        bool lv, rv;
        if (rowb < RL) { const int pos = (rowb % T) % GRIDW; lv = pos > 0; rv = pos + 3 < GRIDW - 1; } else { const int tt = (rowb - RL) % TC; lv = tt > 0; rv = tt + 3 < TC - 1; }
        const bf16_t* zr = P.z + (size_t)rowb * NZE + c8;
        u32x4_t cg[6], xa[6], bg[4];
#pragma unroll
        for (int i = 0; i < 6; ++i) { const int dr = (i == 0 && !lv) ? 0 : (i == 5 && !rv) ? 3 : i - 1;
            cg[i] = *(const u32x4_t*)(zr + (ptrdiff_t)dr * NZE + E_CG); xa[i] = *(const u32x4_t*)(zr + (ptrdiff_t)dr * NZE + E_XA); }
#pragma unroll
        for (int i = 0; i < 4; ++i) bg[i] = *(const u32x4_t*)(zr + (size_t)i * NZE + E_BG);
        const float* cw = P.ev_conv_w + (size_t)li * 3 * W2 + c8; const float* cb = P.ev_conv_b + (size_t)li * W2 + c8;
        float w0[8], w1[8], w2[8], bb[8];
#pragma unroll
        for (int cc = 0; cc < 8; ++cc) { w0[cc] = cw[cc]; w1[cc] = cw[W2 + cc]; w2[cc] = cw[2 * W2 + cc]; bb[cc] = cb[cc]; }
        float p[6][8];
#pragma unroll
        for (int i = 0; i < 6; ++i) { const bool ok = (i == 0) ? lv : (i == 5) ? rv : true;
            const unsigned cv_[4] = {cg[i].x, cg[i].y, cg[i].z, cg[i].w}, xv_[4] = {xa[i].x, xa[i].y, xa[i].z, xa[i].w};
#pragma unroll
            for (int pp = 0; pp < 4; ++pp) { p[i][2 * pp] = ok ? __uint_as_float(cv_[pp] << 16) * __uint_as_float(xv_[pp] << 16) : 0.f;
                p[i][2 * pp + 1] = ok ? __uint_as_float(cv_[pp] & 0xffff0000u) * __uint_as_float(xv_[pp] & 0xffff0000u) : 0.f; } }
#pragma unroll
        for (int i = 0; i < 4; ++i) { const unsigned bv_[4] = {bg[i].x, bg[i].y, bg[i].z, bg[i].w}; float o[8];
#pragma unroll
            for (int cc = 0; cc < 8; ++cc) { const float bgf = (cc & 1) ? __uint_as_float(bv_[cc >> 1] & 0xffff0000u) : __uint_as_float(bv_[cc >> 1] << 16);
                o[cc] = bgf * (bb[cc] + w0[cc] * p[i][cc] + w1[cc] * p[i + 1][cc] + w2[cc] * p[i + 2][cc]); }
            u32x4_t ow; ow.x = pk_bf16(o[0], o[1]); ow.y = pk_bf16(o[2], o[3]); ow.z = pk_bf16(o[4], o[5]); ow.w = pk_bf16(o[6], o[7]);
            *(u32x4_t*)(P.m + (size_t)(rowb + i) * D + c8) = ow; }
    }
}
#endif

#ifdef CPU_EMU
#define GEMM_CALL(PAIR, A, Bt, G, Mg, N, K, epi) gemm_stage<PAIR>(A, Bt, G, Mg, N, K, epi)
DEV void do_stage(const Params& P, int l, int st) {
    const int tid_ = threadIdx.x;
#else
__device__ __forceinline__ void do_stage(const Params& P, int l, int st, PG8_LAS unsigned char* lds, int tid_in) {
#endif
#ifndef CPU_EMU
    int tid_ = tid_in; asm volatile("" : "+v"(tid_));
    if (st == ST_SILU) return;
    if (st == ST_MOD) { fs_wconv(P, lds, tid_); __syncthreads(); fs_mod(P, lds, tid_); return; }
    if (st == ST_ROW_MIX) { fs_row<0>(P, l, lds, tid_); return; }
    if (st == ST_ROW_FFN) { fs_row_ffn(P, l, lds, tid_); return; }
    if (st == ST_ROW_FINAL) { fs_row<2>(P, l, lds, tid_); return; }
    if (st == ST_SELECT_WCONV) { fs_select(P, l, lds, tid_); if (PROBE_SET == 14) { __syncthreads(); fs_select(P, l, lds, tid_); } fs_moe_wconv(P, l, lds, tid_, 1 << 30); return; }
    if (st == ST_GATHER2) { fs_gather(P, tid_); return; }
#define REP(kk, call) do { call; if (PROBE_SET == (kk)) { __syncthreads(); call; } } while (0)
    if (st == ST_EVEN1) { REP(6, fs_even1(P, l, lds, tid_)); return; }
    if (st == ST_EVEN2) { fs_even2(P, tid_); return; }
    if (st == ST_EVEN3) { fs_even3(P, l, lds, tid_); REP(8, fs_even_conv(P, l, tid_)); return; }
    if (st == ST_ODD1) { fs_odd_lru<false>(P, l, lds, tid_); return; }
    if (st == ST_ODD2) { fs_odd2(P, tid_); return; }
    if (st == ST_ODD3) {
        if (PROBE_SET == 70) { int nrep_; asm volatile("s_mov_b32 %0, 2" : "=s"(nrep_));
#pragma nounroll
            for (int rep_ = 0; rep_ < nrep_; ++rep_) { int tt_ = tid_; asm volatile("" : "+v"(tt_) :: "memory"); fs_odd_lru<true>(P, l, lds, tt_); __syncthreads(); } }
        else fs_odd_lru<true>(P, l, lds, tid_);
        REP(12, fs_odd_sg(P, l, lds, tid_)); return; }
#endif
    const int li = l >> 1;
    const bool even = (l & 1) == 0;
    const int ldz = even ? NZE : NZO;
    switch (st) {
    case ST_SILU: {
        GSL(i, (NB + 1) * D) { const int bb = (int)(i / D), k = (int)(i % D); const float v = bb < NB ? P.c[(size_t)bb * D + k] : P.c_ctx[k]; P.sbuf[i] = siluf_(v); }
    } break;
    case ST_MOD: {
        GSL(i, (long)DEPTH * (NB + 1) * MODW) {
            const int j = (int)(i % MODW), bb = (int)((i / MODW) % (NB + 1)), ll = (int)(i / ((long)MODW * (NB + 1)));
            float acc = P.ada_b[(size_t)ll * MODW + j];
            const float* w = P.ada_w + (size_t)ll * D * MODW + j; const float* s = P.sbuf + (size_t)bb * D;
            for (int k = 0; k < D; ++k) acc += s[k] * w[(size_t)k * MODW];
            P.mod[i] = acc;
        }
    } break;
    case ST_WCONV: {
        GSL(i, 2L * NZE * D) { const int q = (int)(i / ((long)NZE * D)), n = (int)((i / D) % NZE), k = (int)(i % D);
            P.wt_ev_in[i] = n < EV_IN ? f2bf(P.ev_w_in[((size_t)q * D + k) * EV_IN + n]) : (bf16_t)0; }
        GSL(i, 2L * NZO * D) { const int q = (int)(i / ((long)NZO * D)), n = (int)((i / D) % NZO), k = (int)(i % D);
            P.wt_od_in[i] = f2bf(P.od_w_in[((size_t)q * D + k) * NZO + n]); }
        GSL(i, 2L * D * D) { const int q = (int)(i / ((long)D * D)), n = (int)((i / D) % D), k = (int)(i % D);
            P.wt_ev_out[i] = f2bf(P.ev_w_out[((size_t)q * D + k) * D + n]);
            P.wt_od_out[i] = f2bf(P.od_w_out[((size_t)q * D + k) * D + n]); }
    } break;
    case ST_NORM_STATS_MIX: case ST_NORM_STATS_FFN: case ST_FINAL_STATS: {
        const int nrows = st == ST_FINAL_STATS ? RL : R;
        GSL(r, nrows) { const float* xr = st == ST_NORM_STATS_MIX ? xsrc_row(P, l, (int)r) : x_row(P, (int)r);
            float ss = 0.f; for (int j = 0; j < D; ++j) ss += xr[j] * xr[j];
            P.rinv[r] = rsq_(ss / D + EPS); }
    } break;
    case ST_NORM_APPLY_MIX: case ST_NORM_APPLY_FFN: {
        const bool mix = st == ST_NORM_APPLY_MIX;
        const float* g = (mix ? P.norm_mix_g : P.norm_ffn_g) + (size_t)l * D;
        GSL(i, (long)R * D) { const int r = (int)(i / D), j = (int)(i % D);
            const float* mr = modrow(P, l, row_bb(r));
            const float xv = mix ? xsrc_row(P, l, r)[j] : x_row(P, r)[j];
            const float hv = (xv * P.rinv[r] * g[j]) * (1.0f + mr[(mix ? 1 : 4) * D + j]) + mr[(mix ? 0 : 3) * D + j];
            P.h[i] = f2bf(hv); }
    } break;
    case ST_GEMM_IN: {
        const bf16_t* wt = even ? P.wt_ev_in + (size_t)li * NZE * D : P.wt_od_in + (size_t)li * NZO * D;
#ifdef CPU_EMU
        EpiZ_ e; e.z = P.z; e.ldz = ldz;
        GEMM_CALL(false, P.h, wt, 1, R, ldz, D, e);
#else
        pg8::Gemm g{P.h, wt, D}; pg8::StaticOrder S; S.init(R, ldz, (int)gridDim.x, (int)blockIdx.x);
        pg8::EpiZ8 e{P.z, ldz}; pg8::gemm_phase<false, false>(lds, g, S, e, tid_);
        fs_moe_wconv(P, l, lds, tid_, even ? WQ_QUOTA_IN_EVEN : WQ_QUOTA_IN_ODD);
#endif
    } break;
    case ST_E_LA: {
        GSL(i, 2L * NB * NCH * KEY) {
            const int col = (int)(i % KEY), c = (int)((i / KEY) % NCH), b = (int)((i / ((long)KEY * NCH)) % NB), dir = (int)(i / ((long)KEY * NCH * NB));
            const float* up = P.ev_decay_up + ((size_t)li * 2 + dir) * RANK * KEY;
            const float bias = P.ev_decay_b[((size_t)li * 2 + dir) * KEY + col];
            float acc = 0.f;
            for (int s = 0; s < CH; ++s) {
                const int sp = dir == 0 ? s : CH - 1 - s;
                const int row = seqrow(b, c * CH + sp);
                const bf16_t* lr = P.z + (size_t)row * ldz + (dir == 0 ? E_LRF : E_LRB);
                float xx = bias;
                for (int rr = 0; rr < RANK; ++rr) xx += bf2f(lr[rr]) * up[(size_t)rr * KEY + col];
                acc += logsigmoidf_(xx) * (1.0f / 16.0f);
                P.bcum[((size_t)dir * R + row) * KEY + col] = acc;
            }
        }
    } break;
    case ST_E_DS: {
        GSL(i, 2L * NB * GH * NCH * DK * DV) {
            const int e = (int)(i % DV), d = (int)((i / DV) % DK), c = (int)((i / ((long)DV * DK)) % NCH), hh = (int)((i / ((long)DV * DK * NCH)) % GH),
                      b = (int)((i / ((long)DV * DK * NCH * GH)) % NB), dir = (int)(i / ((long)DV * DK * NCH * GH * NB));
            const int rend = seqrow(b, c * CH + (dir == 0 ? CH - 1 : 0));
            const float bend = P.bcum[((size_t)dir * R + rend) * KEY + hh * DK + d];
            float acc = 0.f;
            for (int j = 0; j < CH; ++j) { const int row = seqrow(b, c * CH + j);
                const float kk = bf2f(P.z[(size_t)row * ldz + E_K + hh * DK + d]), vv = bf2f(P.z[(size_t)row * ldz + E_V + hh * DV + e]);
                acc += kk * expf(bend - P.bcum[((size_t)dir * R + row) * KEY + hh * DK + d]) * vv; }
            P.S[i] = acc;
        }
    } break;
    case ST_E_SCAN: {
        GSL(i, 2L * NB * GH * DK * DV) {
            const int e = (int)(i % DV), d = (int)((i / DV) % DK), hh = (int)((i / ((long)DV * DK)) % GH), b = (int)((i / ((long)DV * DK * GH)) % NB), dir = (int)(i / ((long)DV * DK * GH * NB));
            float s = 0.f;
            for (int step = 0; step < NCH; ++step) {
                const int c = dir == 0 ? step : (step < NCHC ? NCHC - 1 - step : NCH - 1 - (step - NCHC));
                const size_t idx = (((((size_t)dir * NB + b) * GH + hh) * NCH + c) * DK + d) * DV + e;
                const int rend = seqrow(b, c * CH + (dir == 0 ? CH - 1 : 0));
                const float dec = expf(P.bcum[((size_t)dir * R + rend) * KEY + hh * DK + d]);
                const float tmp = P.S[idx]; P.S[idx] = s; s = dec * s + tmp;
            }
        }
    } break;
    case ST_E_ATT: {
        const float scale = 1.0f / sqrtf((float)DK);
        GSL(i, 2L * NB * GH * NCH * CH * CH) {
            const int j = (int)(i % CH), ii = (int)((i / CH) % CH), c = (int)((i / ((long)CH * CH)) % NCH), hh = (int)((i / ((long)CH * CH * NCH)) % GH),
                      b = (int)((i / ((long)CH * CH * NCH * GH)) % NB), dir = (int)(i / ((long)CH * CH * NCH * GH * NB));
            float acc = 0.f;
            if (dir == 0 ? (j <= ii) : (j >= ii)) {
                const int ri = seqrow(b, c * CH + ii), rj = seqrow(b, c * CH + j);
                for (int d = 0; d < DK; ++d) {
                    const float qq = bf2f(P.z[(size_t)ri * ldz + E_Q + hh * DK + d]) * scale, kk = bf2f(P.z[(size_t)rj * ldz + E_K + hh * DK + d]);
                    acc += qq * kk * expf(P.bcum[((size_t)dir * R + ri) * KEY + hh * DK + d] - P.bcum[((size_t)dir * R + rj) * KEY + hh * DK + d]); }
            }
            P.att[i] = acc;
        }
    } break;
    case ST_E_O: {
        const float scale = 1.0f / sqrtf((float)DK);
        GSL(i, (long)NB * GH * NCH * CH * DV) {
            const int e = (int)(i % DV), ii = (int)((i / DV) % CH), c = (int)((i / ((long)DV * CH)) % NCH), hh = (int)((i / ((long)DV * CH * NCH)) % GH), b = (int)(i / ((long)DV * CH * NCH * GH));
            const int ri = seqrow(b, c * CH + ii);
            float acc = 0.f;
            for (int dir = 0; dir < 2; ++dir) {
                const size_t cb = ((((size_t)dir * NB + b) * GH + hh) * NCH + c);
                const float* at = P.att + (cb * CH + ii) * CH;
                for (int j = 0; j < CH; ++j) { const int rj = seqrow(b, c * CH + j); acc += at[j] * bf2f(P.z[(size_t)rj * ldz + E_V + hh * DV + e]); }
                const float* Sin = P.S + cb * DK * DV;
                for (int d = 0; d < DK; ++d) {
                    const float qq = bf2f(P.z[(size_t)ri * ldz + E_Q + hh * DK + d]) * scale;
                    acc += qq * expf(P.bcum[((size_t)dir * R + ri) * KEY + hh * DK + d]) * Sin[(size_t)d * DV + e]; }
            }
            P.o[(size_t)ri * W2 + hh * DV + e] = acc;
        }
    } break;
    case ST_E_READOUT: {
        const float* ng = P.ev_norm_g + (size_t)li * W2;
        GSL(i, (long)R * GH) { const int row = (int)(i / GH), hh = (int)(i % GH);
            const float* orow = P.o + (size_t)row * W2 + hh * DV;
            float ss = 0.f; for (int e = 0; e < DV; ++e) ss += orow[e] * orow[e];
            const float rinv = rsq_(ss / DV + EPS);
            for (int e = 0; e < DV; ++e) { const float g = bf2f(P.z[(size_t)row * ldz + E_G + hh * DV + e]);
                P.m[(size_t)row * D + W2 + hh * DV + e] = f2bf(orow[e] * rinv * ng[hh * DV + e] * siluf_(g)); }
        }
    } break;
    case ST_E_CONV: {
        const float* cw = P.ev_conv_w + (size_t)li * 3 * W2; const float* cb = P.ev_conv_b + (size_t)li * W2;
        GSL(i, (long)R * W2) { const int row = (int)(i / W2), col = (int)(i % W2);
            bool lv, rv;
            if (row < RL) { const int pos = (row % T) % GRIDW; lv = pos > 0; rv = pos < GRIDW - 1; }
            else { const int t = (row - RL) % TC; lv = t > 0; rv = t < TC - 1; }
            const bf16_t* zr = P.z + (size_t)row * ldz;
            float acc = cb[col] + cw[W2 + col] * (bf2f(zr[E_CG + col]) * bf2f(zr[E_XA + col]));
            if (lv) acc += cw[col] * (bf2f(zr[E_CG + col - ldz]) * bf2f(zr[E_XA + col - ldz]));
            if (rv) acc += cw[2 * W2 + col] * (bf2f(zr[E_CG + col + ldz]) * bf2f(zr[E_XA + col + ldz]));
            P.m[(size_t)row * D + col] = f2bf(bf2f(zr[E_BG + col]) * acc); }
    } break;
    case ST_O_XC: {
        const float* cw = P.od_conv_w + (size_t)li * 4 * W2; const float* cb = P.od_conv_b + (size_t)li * W2;
        GSL(i, (long)R * W2) { const int row = (int)(i / W2), col = (int)(i % W2);
            int t, len; if (row < RL) { t = row % T; len = T; } else { t = (row - RL) % TC; len = TC; }
            float acc = cb[col];
            for (int j = 0; j < 4; ++j) { const int tt = t - 2 + j; if (tt >= 0 && tt < len) acc += cw[j * W2 + col] * bf2f(P.z[(size_t)(row - 2 + j) * ldz + O_XB + col]); }
            P.xc[i] = acc; }
    } break;
    case ST_O_COEF: {
        GSL(i, 2L * R * W2) { const int col = (int)(i % W2), row = (int)((i / W2) % R), dir = (int)(i / ((long)W2 * R));
            const int hh = col / HD, jj = col % HD;
            const float* wa = P.od_gate_a_w + ((((size_t)li * 2 + dir) * 4 + hh) * HD) * HD + jj;
            const float* wx = P.od_gate_x_w + ((((size_t)li * 2 + dir) * 4 + hh) * HD) * HD + jj;
            const float* xr = P.xc + (size_t)row * W2 + hh * HD;
            float ra = P.od_gate_a_b[((size_t)li * 2 + dir) * W2 + col], rx = P.od_gate_x_b[((size_t)li * 2 + dir) * W2 + col];
            for (int k = 0; k < HD; ++k) { ra += xr[k] * wa[(size_t)k * HD]; rx += xr[k] * wx[(size_t)k * HD]; }
            const float rg = sigmoidf_(ra), ig = sigmoidf_(rx);
            const float log_a = -8.0f * rg * softplusf_(-P.od_lambda[((size_t)li * 2 + dir) * W2 + col]);
            P.A[i] = expf(log_a);
            P.Bc[i] = sqrtf(-expm1f(2.0f * log_a)) * (ig * P.xc[(size_t)row * W2 + col]); }
    } break;
    case ST_O_SCAN: {
        GSL(i, 2L * NB * W2) { const int col = (int)(i % W2), b = (int)((i / W2) % NB), dir = (int)(i / ((long)W2 * NB));
            float hc = 0.f;
            for (int step = 0; step < SEQ_ALL; ++step) {
                const int s = dir == 0 ? step : (step < TC ? TC - 1 - step : TC + (T - 1 - (step - TC)));
                const size_t idx = ((size_t)dir * R + seqrow(b, s)) * W2 + col;
                hc = P.A[idx] * hc + P.Bc[idx]; P.Bc[idx] = hc; }
        }
    } break;
    case ST_O_YREC: {
        GSL(i, (long)R * W2) { const int row = (int)(i / W2), col = (int)(i % W2);
            const float gb = bf2f(P.z[(size_t)row * ldz + O_GB + col]);
            P.m[(size_t)row * D + col] = f2bf((P.Bc[i] + P.Bc[(size_t)R * W2 + i]) * geluf_(gb)); }
    } break;
    case ST_O_SGSTAT: {
        GSL(r, R) { const bf16_t* vr = P.z + (size_t)r * ldz + O_V;
            float s = 0.f; for (int j = 0; j < W2; ++j) s += geluf_(bf2f(vr[j]));
            const float mean = s / W2; float vs = 0.f;
            for (int j = 0; j < W2; ++j) { const float dlt = geluf_(bf2f(vr[j])) - mean; vs += dlt * dlt; }
            P.sgstat[2 * r] = mean; P.sgstat[2 * r + 1] = rsq_(vs / W2 + EPS); }
    } break;
    case ST_O_VB: {
        const float* gn = P.od_sg_norm_g + (size_t)li * W2;
        GSL(i, (long)R * W2) { const int row = (int)(i / W2), col = (int)(i % W2);
            P.vb[i] = (geluf_(bf2f(P.z[(size_t)row * ldz + O_V + col])) - P.sgstat[2 * row]) * P.sgstat[2 * row + 1] * gn[col]; }
    } break;
    case ST_O_SGMIX: {
        GSL(i, (long)R * W2) { const int row = (int)(i / W2), col = (int)(i % W2);
            const int t = row < RL ? row % T : (row - RL) % TC;
            const int ii = t % SGC, base = row - ii, g = col / HD;
            const float* w = P.od_sg_w + (((size_t)li * 4 + g) * SGC + ii) * SGC;
            float acc = P.od_sg_b[((size_t)li * 4 + g) * SGC + ii];
            for (int j = 0; j < SGC; ++j) acc += w[j] * P.vb[(size_t)(base + j) * W2 + col];
            P.m[(size_t)row * D + W2 + col] = f2bf(geluf_(bf2f(P.z[(size_t)row * ldz + O_U + col])) * acc); }
    } break;
    case ST_GEMM_OUT: {
        const bf16_t* wt = (even ? P.wt_ev_out : P.wt_od_out) + (size_t)li * D * D;
#ifdef CPU_EMU
        EpiWout_ e; e.P = &P; e.l = l;
        GEMM_CALL(false, P.m, wt, 1, R, D, D, e);
#else
        pg8::Gemm g{P.m, wt, D}; pg8::StaticOrder S; S.init(l == DEPTH - 1 ? RL : R, D, (int)gridDim.x, (int)blockIdx.x);
        if (l == 0) { pg8::EpiWoutB<true> e{P.x, P.ctx, P.xb, P.mod + (size_t)l * (NB + 1) * MODW, P.ssqp}; pg8::gemm_phase<false, false>(lds, g, S, e, tid_); }
        else { pg8::EpiWoutB<false> e{nullptr, nullptr, P.xb, P.mod + (size_t)l * (NB + 1) * MODW, P.ssqp}; pg8::gemm_phase<false, false>(lds, g, S, e, tid_); }
        fs_moe_wconv(P, l, lds, tid_, (even ? WQ_QUOTA_IN_EVEN : WQ_QUOTA_IN_ODD) + WQ_QUOTA_OUT);
#endif
    } break;
    case ST_ROUTER_LOGIT: {
        const float* g = P.norm_ffn_g + (size_t)l * D; const float* wr = P.moe_router + (size_t)l * D * NE;
        GSL(i, (long)R * NE) { const int r = (int)(i / NE), e = (int)(i % NE);
            const float* mr = modrow(P, l, row_bb(r)); const float* xr = x_row(P, r); const float ri = P.rinv[r];
            float acc = 0.f;
            for (int j = 0; j < D; ++j) acc += ((xr[j] * ri * g[j]) * (1.0f + mr[4 * D + j]) + mr[3 * D + j]) * wr[(size_t)j * NE + e];
            P.logit[i] = acc; }
    } break;
    case ST_ROUTER_SOFTMAX: {
        GSL(r, R) { const float* lg = P.logit + (size_t)r * NE; float mx = lg[0]; for (int e = 1; e < NE; ++e) mx = fmaxf(mx, lg[e]);
            float s = 0.f;
            for (int e = 0; e < NE; ++e) s += expf(lg[e] - mx);
            for (int e = 0; e < NE; ++e) P.aff[(size_t)r * NE + e] = expf(lg[e] - mx) / s; }
    } break;
    case ST_MOE_WCONV: {
        const float* wg = P.moe_w_gate + (size_t)l * NE * D * D; const float* wu = P.moe_w_up + (size_t)l * NE * D * D; const float* wd = P.moe_w_down + (size_t)l * NE * D * D;
        GSL(i, (long)NE * 2 * D * D) { const int e = (int)(i / (2L * D * D)), cv = (int)((i / D) % (2 * D)), k = (int)(i % D);
            const int w = cv % 256, j = (cv / 256) * 128 + (w % 128);
            P.wt_gu[i] = f2bf((w >= 128 ? wu : wg)[((size_t)e * D + k) * D + j]); }
        GSL(i, (long)NE * D * D) { const int e = (int)(i / ((long)D * D)), n = (int)((i / D) % D), k = (int)(i % D);
            P.wt_dn[i] = f2bf(wd[((size_t)e * D + k) * D + n]); }
    } break;
    case ST_SELECT: {
        GSL(i, (long)R * NE) { const int e = (int)(i / R), r = (int)(i % R);
            int base, n, cap, slot0;
            if (r < RL) { const int b = r / T; base = b * T; n = T; cap = CAPL; slot0 = b * CAPL; }
            else { const int b = (r - RL) / TC; base = RL + b * TC; n = TC; cap = CAPC; slot0 = NB * CAPL + b * CAPC; }
            const float a = P.aff[(size_t)r * NE + e];
            int rank = 0;
            for (int t = 0; t < n; ++t) { const float o = P.aff[(size_t)(base + t) * NE + e]; rank += (o > a || (o == a && base + t < r)) ? 1 : 0; }
            if (rank < cap) { const int slot = e * SLOTS_E + slot0 + rank; P.sel_row[slot] = r; P.sel_g[slot] = a; P.inv[(size_t)r * NE + e] = slot; }
            else P.inv[(size_t)r * NE + e] = -1; }
    } break;
    case ST_GATHER: {
        GSL(i, (long)SLOTS * D) { const int slot = (int)(i / D), j = (int)(i % D); P.xg[i] = P.h[(size_t)P.sel_row[slot] * D + j]; }
    } break;
    case ST_GEMM_GU: {
#ifdef CPU_EMU
        EpiGU_ e; e.hid = P.hid;
        GEMM_CALL(true, P.xg, P.wt_gu, NE, SLOTS_E, 2 * D, D, e);
#else
        pg8::Gemm g{P.h, P.wt_gu, D}; pg8::GroupedOrder S; S.init(l == DEPTH - 1 ? NB * CAPL : SLOTS_E, SLOTS_E, 2 * D, NE, (int)gridDim.x, (int)blockIdx.x);
        PG8_LAS int* gix = (PG8_LAS int*)(lds + GEMM_LDS_BYTES + 16);
        for (int kk = tid_ >> 8; kk < GIX_UNITS; kk += 2) { pg8::Unit uu; if (S.next(kk, uu)) gix[kk * 256 + (tid_ & 255)] = P.sel_row[uu.pm * 256 + (tid_ & 255)]; }
        __syncthreads();
        pg8::EpiGU_F8 e{(unsigned char*)P.hid, 2 * D / 256}; pg8::gemm_phase<true, true>(lds, g, S, e, tid_, gix);
#endif
    } break;
    case ST_GEMM_DOWN: {
#ifdef CPU_EMU
        EpiDown_ e; e.out = P.outslot; e.selg = P.sel_g;
        GEMM_CALL(false, P.hid, P.wt_dn, NE, SLOTS_E, D, D, e);
#else
        pg8::Gemm g{P.hid, P.wt_dn, D}; pg8::GroupedOrder S; S.init(l == DEPTH - 1 ? NB * CAPL : SLOTS_E, SLOTS_E, D, NE, (int)gridDim.x, (int)blockIdx.x);
        pg8::EpiDown8 e{(unsigned char*)P.outslot, P.sel_g, D / 256, 1.0f / pg8::W8_SCALE}; pg8::gemm_phase<false, true>(lds, g, S, e, tid_);
#endif
    } break;
    case ST_COMBINE: {
        GSL(i, (long)R * D) { const int r = (int)(i / D), j = (int)(i % D);
            float s = 0.f;
            for (int e = 0; e < NE; ++e) { const int sl = P.inv[(size_t)r * NE + e]; if (sl >= 0) s += bf2f(P.outslot[(size_t)sl * D + j]); }
            float* xr = x_row(P, r); xr[j] += modrow(P, l, row_bb(r))[5 * D + j] * s; }
    } break;
    case ST_FINAL_APPLY: {
        GSL(i, (long)RL * D) { const int r = (int)(i / D), j = (int)(i % D); P.xlat[i] = P.xlat[i] * P.rinv[r] * P.norm_final_g[j]; }
    } break;
    default: break;
    }
}

template <class F> inline void stage_program(F&& run) {
    run(0, ST_SILU); run(0, ST_MOD); run(0, ST_WCONV);
    for (int l = 0; l < DEPTH; ++l) {
        run(l, ST_NORM_STATS_MIX); run(l, ST_NORM_APPLY_MIX); run(l, ST_GEMM_IN);
        if ((l & 1) == 0) { run(l, ST_E_LA); run(l, ST_E_DS); run(l, ST_E_SCAN); run(l, ST_E_ATT); run(l, ST_E_O); run(l, ST_E_READOUT); run(l, ST_E_CONV); }
        else { run(l, ST_O_XC); run(l, ST_O_COEF); run(l, ST_O_SCAN); run(l, ST_O_YREC); run(l, ST_O_SGSTAT); run(l, ST_O_VB); run(l, ST_O_SGMIX); }
        run(l, ST_GEMM_OUT);
        run(l, ST_NORM_STATS_FFN); run(l, ST_NORM_APPLY_FFN); run(l, ST_ROUTER_LOGIT); run(l, ST_ROUTER_SOFTMAX); run(l, ST_MOE_WCONV);
        run(l, ST_SELECT); run(l, ST_GATHER); run(l, ST_GEMM_GU); run(l, ST_GEMM_DOWN); run(l, ST_COMBINE);
    }
    run(0, ST_FINAL_STATS); run(0, ST_FINAL_APPLY);
}

struct KArgs { const float* in[32]; float* out; char* ws; };
#ifdef CPU_EMU
#define HD_ inline
#else
#define HD_ __host__ __device__ __forceinline__
#endif
struct Carver { char* base; size_t off; template <class Tp> HD_ Tp* take(size_t n) { off = (off + 255) & ~(size_t)255; Tp* p = (Tp*)(base + off); off += n * sizeof(Tp); return p; } };
HD_ size_t carve(Params& p, void* d_ws) {
    Carver cv{(char*)d_ws, 0};
    p.bar = cv.take<unsigned>(4096); p.wq = p.bar + 3584;
    p.mod = cv.take<float>((size_t)DEPTH * (NB + 1) * MODW); p.sbuf = cv.take<float>((size_t)(NB + 1) * D); p.xctx = cv.take<float>((size_t)RC * D);
    p.rinv = cv.take<float>(R); p.aff = cv.take<float>((size_t)R * NE); p.logit = cv.take<float>((size_t)R * NE); p.sel_g = cv.take<float>(SLOTS);
    p.sel_row = cv.take<int>(SLOTS); p.inv = cv.take<int>((size_t)R * NE);
    p.wt_ev_in = cv.take<bf16_t>(2ull * NZE * D); p.wt_od_in = cv.take<bf16_t>(2ull * NZO * D); p.wt_ev_out = cv.take<bf16_t>(2ull * D * D); p.wt_od_out = cv.take<bf16_t>(2ull * D * D);
    p.gwT = cv.take<bf16_t>(2ull * 2 * 2 * 4 * HD * HD); p.sgw = cv.take<bf16_t>(2ull * 4 * SGC * SGC); p.sumA = cv.take<float>(2ull * NB * NCH * W2); p.sumB = cv.take<float>(2ull * NB * NCH * W2); p.decv = cv.take<float>(2ull * NB * GH * NCH * DK); p.hinb = cv.take<float>(2ull * NB * NCH * W2); p.ssqp = cv.take<float>((size_t)R * 16);
    p.xb = cv.take<bf16_t>((size_t)R * D);
    p.wt_gu = cv.take<bf16_t>((size_t)NE * 2 * D * D); p.wt_dn = cv.take<bf16_t>((size_t)NE * D * D); p.h = cv.take<bf16_t>((size_t)R * D);
    const size_t u0 = (cv.off + 255) & ~(size_t)255;
    p.z = cv.take<bf16_t>((size_t)R * NZE); p.m = cv.take<bf16_t>((size_t)R * D);
    const size_t u1 = cv.off;
#ifdef CPU_EMU
    p.bcum = cv.take<float>(2ull * R * KEY); p.att = cv.take<float>(2ull * NB * GH * NCH * CH * CH); p.o = cv.take<float>((size_t)R * W2);
#endif
#ifdef CPU_EMU
    p.S = cv.take<float>(2ull * NB * GH * NCH * DK * DV);
#endif
    p.Sd = cv.take<bf16_t>(2ull * NB * GH * NCH * DK * DV); p.SinB = cv.take<bf16_t>(2ull * NB * GH * NCH * DK * DV);
    size_t end = cv.off;
    cv.off = u1;
    p.sgstat = cv.take<float>(2ull * R);
#ifdef CPU_EMU
    p.xc = cv.take<float>((size_t)R * W2); p.A = cv.take<float>(2ull * R * W2); p.Bc = cv.take<float>(2ull * R * W2); p.vb = cv.take<float>((size_t)R * W2);
#endif
    if (cv.off > end) end = cv.off;
    cv.off = u0;
    p.xg = cv.take<bf16_t>((size_t)SLOTS * D); p.hid = cv.take<bf16_t>((size_t)SLOTS * D); p.outslot = cv.take<bf16_t>((size_t)SLOTS * D);
    if (cv.off > end) end = cv.off;
    return end;
}
HD_ void fill_inputs(Params& p, const float* const* in, void* d_out) {
    p.x = in[0]; p.c = in[1]; p.ctx = in[2]; p.c_ctx = in[3]; p.ada_w = in[4]; p.ada_b = in[5]; p.norm_mix_g = in[6]; p.norm_ffn_g = in[7]; p.norm_final_g = in[8];
    p.ev_w_in = in[9]; p.ev_conv_w = in[10]; p.ev_conv_b = in[11]; p.ev_decay_up = in[12]; p.ev_decay_b = in[13]; p.ev_norm_g = in[14]; p.ev_w_out = in[15];
    p.od_w_in = in[16]; p.od_conv_w = in[17]; p.od_conv_b = in[18]; p.od_gate_a_w = in[19]; p.od_gate_a_b = in[20]; p.od_gate_x_w = in[21]; p.od_gate_x_b = in[22];
    p.od_lambda = in[23]; p.od_sg_norm_g = in[24]; p.od_sg_w = in[25]; p.od_sg_b = in[26]; p.od_w_out = in[27];
    p.moe_router = in[28]; p.moe_w_gate = in[29]; p.moe_w_up = in[30]; p.moe_w_down = in[31];
    p.xlat = (float*)d_out;
}

#ifndef CPU_EMU
#define XB_TMO      128
#define XB_XCNT(j)  (256  + 64 * (j))
#define XB_XSUB(j)  (1280 + 64 * (j))
#define XB_XGEN(j)  (2304 + 64 * (j))
#define XB_TOP      3328
#define XB_TOPGEN   3392
#define XCD_BAR_WORDS 3456
#define XB_SPIN_CAP (1u << 18)
#define LAS __attribute__((address_space(3)))

__device__ __forceinline__ unsigned xb_ld(unsigned* p)              { return __hip_atomic_load(p, __ATOMIC_RELAXED, __HIP_MEMORY_SCOPE_AGENT); }
__device__ __forceinline__ unsigned xb_add(unsigned* p, unsigned v) { return __hip_atomic_fetch_add(p, v, __ATOMIC_RELAXED, __HIP_MEMORY_SCOPE_AGENT); }
__device__ __forceinline__ unsigned xb_xcc_id() { return (unsigned)__builtin_amdgcn_s_getreg((3 << 11) | 20) & 0xFu; }
#define XB_SPIN(cond, bar) do { unsigned _sp = 0; while (cond) { __builtin_amdgcn_s_sleep(1); \
    if ((++_sp & 255u) == 0u) { if (xb_ld(&(bar)[XB_TMO])) break; if (_sp > XB_SPIN_CAP) { atomicAdd(&(bar)[XB_TMO], 1u); break; } } } } while (0)

struct XcdBarrier {
    unsigned* bar; unsigned x;
    volatile LAS unsigned* st;
};

__device__ __forceinline__ XcdBarrier xcd_barrier_post(unsigned* bar, volatile LAS unsigned* st, bool lead  ) {
    XcdBarrier b; b.bar = bar; b.x = xb_xcc_id(); b.st = st;
    if (lead) (void)xb_add(&bar[XB_XCNT(b.x)], 1u);
    return b;
}
__device__ __forceinline__ void xcd_barrier_complete(unsigned* bar, unsigned x, unsigned& nloc, unsigned& nx) {
    const unsigned G = gridDim.x * gridDim.y * gridDim.z;
    unsigned sum, cnt, mine, sp = 0u;
    for (;;) {
        sum = 0u; cnt = 0u; mine = 0u;
#pragma unroll
        for (unsigned j = 0; j < 16; ++j) { const unsigned c = xb_ld(&bar[XB_XCNT(j)]); sum += c; cnt += (c > 0u) ? 1u : 0u; mine = (j == x) ? c : mine; }
        if (sum == G) break;
        __builtin_amdgcn_s_sleep(1);
        if ((++sp & 255u) == 0u) { if (xb_ld(&bar[XB_TMO])) break; if (sp > XB_SPIN_CAP) { atomicAdd(&bar[XB_TMO], 1u); break; } }
    }
    nloc = mine > 0u ? mine : 1u; nx = cnt > 0u ? cnt : 1u;
}

__device__ __forceinline__ void xcd_barrier(const XcdBarrier& b, bool lead  ) {
    asm volatile("s_waitcnt vmcnt(0)" ::: "memory");
    __syncthreads();
    if (lead) {
        unsigned* bar = b.bar;
        __builtin_amdgcn_s_waitcnt(0);
        unsigned nloc = b.st[0], nx = b.st[1];
        if (nloc == 0u) { xcd_barrier_complete(bar, b.x, nloc, nx); b.st[0] = nloc; b.st[1] = nx; }
        const unsigned old = xb_add(&bar[XB_XSUB(b.x)], 1u);
        const unsigned gen = old / nloc;
        if (old + 1u == (gen + 1u) * nloc) {
            __builtin_amdgcn_fence(__ATOMIC_RELEASE, "agent");
            asm volatile("s_waitcnt vmcnt(0)" ::: "memory");
            const unsigned og = xb_add(&bar[XB_TOP], 1u);
            const unsigned tg = og / nx;
            if (og + 1u == (tg + 1u) * nx) xb_add(&bar[XB_TOPGEN], 1u);
            else XB_SPIN(xb_ld(&bar[XB_TOPGEN]) == tg, bar);
            __builtin_amdgcn_fence(__ATOMIC_ACQUIRE, "agent");
            xb_add(&bar[XB_XGEN(b.x)], 1u);
            asm volatile("s_waitcnt vmcnt(0)" ::: "memory");
        } else {
            XB_SPIN(xb_ld(&bar[XB_XGEN(b.x)]) == gen, bar);
            __builtin_amdgcn_fence(__ATOMIC_ACQUIRE, "agent");
            asm volatile("s_waitcnt vmcnt(0)" ::: "memory");
        }
    }
    __syncthreads();
}


typedef const __attribute__((address_space(4))) char* kargp_t;
__device__ __forceinline__ void load_params(Params& p, kargp_t kp) {
    const float* in[32];
#pragma unroll
    for (int i = 0; i < 32; ++i) in[i] = *(const float* const __attribute__((address_space(4)))*)(kp + 8 * i);
    float* out = *(float* const __attribute__((address_space(4)))*)(kp + 256);
    char* ws = *(char* const __attribute__((address_space(4)))*)(kp + 264);
    fill_inputs(p, in, out); carve(p, ws);
}
__device__ __forceinline__ constexpr bool probe_double(int st) {
    return PROBE_SET == 1 ? (st == ST_GEMM_IN || st == ST_GEMM_GU || st == ST_GEMM_DOWN)
         : PROBE_SET == 2 ? (st == ST_EVEN1 || st == ST_EVEN3)
         : PROBE_SET == 3 ? (st == ST_ODD1 || st == ST_ODD3)
         : PROBE_SET == 31 ? (st == ST_ODD1)
         : PROBE_SET == 33 ? (st == ST_EVEN1)
         : PROBE_SET == 4 ? (st == ST_ROW_FFN || st == ST_SELECT_WCONV)
         : PROBE_SET == 13 ? (st == ST_ROW_FFN)
         : PROBE_SET == 21 ? (st == ST_EVEN2 || st == ST_ODD2)
         : PROBE_SET == 5 ? (st == ST_MOD || st == ST_WCONV) : false;
}
__device__ __forceinline__ constexpr bool probe_echo(int st) {
    return PROBE_SET == 60 ? (st == ST_EVEN1 || st == ST_EVEN2 || st == ST_EVEN3)
         : PROBE_SET == 61 ? (st == ST_ODD1 || st == ST_ODD2 || st == ST_ODD3)
         : PROBE_SET == 62 ? (st == ST_ROW_MIX || st == ST_ROW_FFN || st == ST_SELECT_WCONV || st == ST_ROW_FINAL || st == ST_MOD)
         : PROBE_SET == 63 ? (st == ST_GEMM_IN || st == ST_GEMM_OUT)
         : PROBE_SET == 64 ? (st == ST_GEMM_GU || st == ST_GEMM_DOWN)
         : PROBE_SET == 65 ? (st == ST_EVEN1) : PROBE_SET == 66 ? (st == ST_EVEN3) : PROBE_SET == 67 ? (st == ST_ODD3) : PROBE_SET == 68 ? (st == ST_ROW_MIX) : false;
}
#define PHASE(l, st) do { unsigned zo_; asm volatile("s_mov_b32 %0, 0" : "=s"(zo_)); \
    Params P; load_params(P, (kargp_t)__builtin_amdgcn_kernarg_segment_ptr() + zo_); \
    const int tid_ph = wv_ * 64 + (int)__builtin_amdgcn_mbcnt_hi(~0u, __builtin_amdgcn_mbcnt_lo(~0u, 0u)); \
    unsigned long long te0_ = 0; if (probe_echo(st)) te0_ = __builtin_amdgcn_s_memtime(); \
    PHASE_BODY(l, st); \
    if (probe_echo(st)) { const unsigned long long te1_ = __builtin_amdgcn_s_memtime(); while (__builtin_amdgcn_s_memtime() - te1_ < 4ull * (te1_ - te0_)) __builtin_amdgcn_s_sleep(4); } } while (0)
#define PHASE_BODY(l, st) do { \
    do_stage(P, (l), (st), lds, tid_ph); if (probe_double(st) || (PROBE_SET == 22 && (l) == 0 && ((st) == ST_GEMM_OUT)) || (PROBE_SET == 23 && (l) == 0 && ((st) == ST_ROW_MIX))) { __syncthreads(); do_stage(P, (l), (st), lds, tid_ph); } xcd_barrier(bar, tid_ph == 0); } while (0)
#define LAYER_HEAD(l) PHASE(l, ST_ROW_MIX); PHASE(l, ST_GEMM_IN);
#define LAYER_TAIL(l) PHASE(l, ST_GEMM_OUT); PHASE(l, ST_ROW_FFN); PHASE(l, ST_SELECT_WCONV); PHASE(l, ST_GEMM_GU); PHASE(l, ST_GEMM_DOWN);
#define LAYER_EVEN(l) LAYER_HEAD(l) PHASE(l, ST_EVEN1); PHASE(l, ST_EVEN2); PHASE(l, ST_EVEN3); LAYER_TAIL(l)
#define LAYER_ODD(l) LAYER_HEAD(l) PHASE(l, ST_ODD1); PHASE(l, ST_ODD2); PHASE(l, ST_ODD3); LAYER_TAIL(l)
__global__ void __launch_bounds__(512, 2) k_all(KArgs ka) {
    extern __shared__ __attribute__((aligned(16))) unsigned char shm[];
    PG8_LAS unsigned char* lds = (PG8_LAS unsigned char*)shm;
    volatile LAS unsigned* xbw = (volatile LAS unsigned*)(lds + GEMM_LDS_BYTES);
    if (threadIdx.x == 0) { xbw[0] = 0u; xbw[1] = 0u; xbw[2] = 0u; xbw[3] = 0u; }
    __syncthreads();
    const int wv_ = __builtin_amdgcn_readfirstlane((int)(threadIdx.x >> 6));
    XcdBarrier bar = xcd_barrier_post((unsigned*)ka.ws, xbw, threadIdx.x == 0);
    PHASE(0, ST_MOD);
    LAYER_EVEN(0) LAYER_ODD(1) LAYER_EVEN(2) LAYER_ODD(3)
    PHASE(0, ST_ROW_FINAL);
}

extern "C" void kernel_launch(void* const* d_in, const int* in_sizes, int n_in, void* d_out, int out_size, void* d_ws, size_t ws_size, hipStream_t stream) {
    KArgs ka; memset(&ka, 0, sizeof(ka));
    for (int i = 0; i < 32; ++i) ka.in[i] = (const float*)d_in[i];
    ka.out = (float*)d_out; ka.ws = (char*)d_ws;
    Params p{}; fill_inputs(p, ka.in, d_out);
    const size_t need = carve(p, d_ws);
    if (need > ws_size) { fprintf(stderr, "workspace too small: need %zu have %zu\n", need, ws_size); return; }
    constexpr size_t kDynLds = DYN_LDS_BYTES;
    static int grid = 0;
    if (!grid) {
        int dev = 0, cus = 0, per_cu = 0;
        (void)hipGetDevice(&dev);
        (void)hipDeviceGetAttribute(&cus, hipDeviceAttributeMultiprocessorCount, dev);
        (void)hipFuncSetAttribute((const void*)k_all, hipFuncAttributeMaxDynamicSharedMemorySize, (int)kDynLds);
        (void)hipOccupancyMaxActiveBlocksPerMultiprocessor(&per_cu, k_all, 512, kDynLds);
        grid = cus * (per_cu < 1 ? per_cu : 1);
    }
    (void)hipMemsetAsync(p.bar, 0, 4096 * sizeof(unsigned), stream);
    hipLaunchKernelGGL(k_all, dim3(grid), dim3(512), kDynLds, stream, ka);
}
#endif
```

```cpp
#ifndef CPU_EMU
#include <hip/hip_runtime.h>
#include <cstdio>
#include <cstring>
#define DEV __device__ __forceinline__
#else
#define DEV inline
#endif
#include <cstdint>
#include <cstddef>

#ifndef D_MODEL
#define D_MODEL 1024
#define BATCH 8
#define SEQ 4096
#define CTXL 256
#endif

#ifndef PROBE_SET
#define PROBE_SET 0
#endif
typedef unsigned short bf16_t;
constexpr int D = D_MODEL, NB = BATCH, T = SEQ, TC = CTXL, DEPTH = 4;
constexpr int RL = NB * T, RC = NB * TC, R = RL + RC;
constexpr int W2 = D / 2;
constexpr int GH = 4, DV = W2 / GH, DK = DV / 2, KEY = GH * DK, RANK = 16, CH = 64, GRIDW = 64;
constexpr int EV_IN = 3 * W2 + KEY + W2 + KEY + W2 + 2 * RANK;
constexpr int NZE = ((EV_IN + 255) / 256) * 256, NZO = 4 * W2;
constexpr int E_BG = 0, E_CG = W2, E_XA = 2 * W2, E_Q = 3 * W2, E_G = E_Q + KEY, E_K = E_G + W2, E_V = E_K + KEY, E_LRF = E_V + W2, E_LRB = E_LRF + RANK;
constexpr int O_XB = 0, O_GB = W2, O_U = 2 * W2, O_V = 3 * W2;
constexpr int NE = 16, CAPL = 2 * T / NE, CAPC = 2 * TC / NE, SLOTS_E = NB * (CAPL + CAPC), SLOTS = NE * SLOTS_E;
constexpr int SEQ_ALL = TC + T, NCH = SEQ_ALL / CH, NCHC = TC / CH;
constexpr int SGC = 128, HD = W2 / 4;
constexpr float EPS = 1e-6f;
constexpr int MODW = 6 * D;

struct Params {
    const float *x, *c, *ctx, *c_ctx, *ada_w, *ada_b, *norm_mix_g, *norm_ffn_g, *norm_final_g;
    const float *ev_w_in, *ev_conv_w, *ev_conv_b, *ev_decay_up, *ev_decay_b, *ev_norm_g, *ev_w_out;
    const float *od_w_in, *od_conv_w, *od_conv_b, *od_gate_a_w, *od_gate_a_b, *od_gate_x_w, *od_gate_x_b, *od_lambda, *od_sg_norm_g, *od_sg_w, *od_sg_b, *od_w_out;
    const float *moe_router, *moe_w_gate, *moe_w_up, *moe_w_down;
    float* xlat;
    float *xctx, *mod, *sbuf, *rinv, *aff, *logit, *sel_g;
    int *sel_row, *inv;
    bf16_t *wt_ev_in, *wt_od_in, *wt_ev_out, *wt_od_out, *wt_gu, *wt_dn, *h, *gwT, *sgw, *rw16;
    float *sumA, *sumB, *decv, *hinb, *ssqp;
    bf16_t *z, *m;
    float *bcum, *S, *att, *o;
    float *xc, *A, *Bc, *sgstat, *vb;
    bf16_t *xg, *hid, *outslot;
    bf16_t *SinB, *Sd;
    bf16_t* xb;
    unsigned* bar; unsigned* wq;
};

DEV float bf2f(bf16_t v) { union { unsigned u; float f; } c; c.u = (unsigned)v << 16; return c.f; }
DEV bf16_t f2bf(float f) { union { unsigned u; float f; } c; c.f = f; unsigned u = c.u; u += 0x7fffu + ((u >> 16) & 1u); return (bf16_t)(u >> 16); }
DEV float sigmoidf_(float x) { return 1.0f / (1.0f + expf(-x)); }
DEV float siluf_(float x) { return x / (1.0f + expf(-x)); }
DEV float softplusf_(float x) { return fmaxf(x, 0.0f) + log1pf(expf(-fabsf(x))); }
DEV float logsigmoidf_(float x) { return fminf(x, 0.0f) - log1pf(expf(-fabsf(x))); }
DEV float geluf_(float x) { return 0.5f * x * (1.0f + tanhf(0.7978845608028654f * (x + 0.044715f * x * x * x))); }
DEV float rsq_(float x) { return 1.0f / sqrtf(x); }

DEV const float* xsrc_row(const Params& P, int l, int r) {
    if (l == 0) return r < RL ? P.x + (size_t)r * D : P.ctx + (size_t)(r - RL) * D;
    return r < RL ? P.xlat + (size_t)r * D : P.xctx + (size_t)(r - RL) * D;
}
DEV float* x_row(const Params& P, int r) { return r < RL ? P.xlat + (size_t)r * D : P.xctx + (size_t)(r - RL) * D; }
DEV int row_bb(int r) { return r < RL ? r / T : NB; }
DEV int seqrow(int b, int s) { return s < TC ? RL + b * TC + s : b * T + (s - TC); }
DEV const float* modrow(const Params& P, int l, int bb) { return P.mod + ((size_t)l * (NB + 1) + bb) * MODW; }

#define GSL(i, n) for (long i = (long)blockIdx.x * blockDim.x + tid_; i < (long)(n); i += (long)gridDim.x * blockDim.x)

enum {
    ST_SILU = 0, ST_MOD, ST_WCONV,
    ST_NORM_STATS_MIX, ST_NORM_APPLY_MIX, ST_GEMM_IN,
    ST_E_LA, ST_E_DS, ST_E_SCAN, ST_E_ATT, ST_E_O, ST_E_READOUT, ST_E_CONV,
    ST_O_XC, ST_O_COEF, ST_O_SCAN, ST_O_YREC, ST_O_SGSTAT, ST_O_VB, ST_O_SGMIX,
    ST_GEMM_OUT,
    ST_NORM_STATS_FFN, ST_NORM_APPLY_FFN, ST_ROUTER_LOGIT, ST_ROUTER_SOFTMAX, ST_MOE_WCONV, ST_SELECT, ST_GATHER, ST_GEMM_GU, ST_GEMM_DOWN, ST_COMBINE,
    ST_FINAL_STATS, ST_FINAL_APPLY,
    ST_ROW_MIX, ST_ROW_FFN, ST_ROW_FINAL, ST_SELECT_WCONV, ST_GATHER2, ST_ODD1, ST_ODD3, ST_EVEN1, ST_EVEN2, ST_EVEN3, ST_ODD2, ST_COUNT
};

struct EpiZ {
    bf16_t* z; int ldz;
    DEV void elem(int row, int col, float v) const { z[(size_t)row * ldz + col] = f2bf(v); }
};
struct EpiWout {
    const Params* P; int l;
    DEV void elem(int row, int col, float v) const {
        const float* mr = modrow(*P, l, row_bb(row));
        x_row(*P, row)[col] = xsrc_row(*P, l, row)[col] + mr[2 * D + col] * v;
    }
};
struct EpiGU {
    bf16_t* hid;
    DEV void pair(int row, int j, float g, float u) const { hid[(size_t)row * D + j] = f2bf(siluf_(g) * u); }
};
struct EpiDown {
    bf16_t* out; const float* selg;
    DEV void elem(int row, int col, float v) const { out[(size_t)row * D + col] = f2bf(v * selg[row]); }
};

#ifdef CPU_EMU
template <bool PAIR, class Epi>
void gemm_stage(const bf16_t* A, const bf16_t* Bt, int G, int Mg, int N, int K, const Epi& epi) {
    const int tid_ = threadIdx.x;
    GSL(i, (long)G * Mg) {
        const int g = (int)(i / Mg); const int row = (int)i;
        const bf16_t* a = A + (size_t)row * K;
        if (!PAIR) {
            for (int n = 0; n < N; ++n) { const bf16_t* b = Bt + ((size_t)g * N + n) * K; float s = 0.f; for (int k = 0; k < K; ++k) s += bf2f(a[k]) * bf2f(b[k]); epi.elem(row, n, s); }
        } else {
            for (int j = 0; j < N / 2; ++j) {
                const int cg = (j / 128) * 256 + (j % 128), cu = cg + 128;
                const bf16_t* bg = Bt + ((size_t)g * N + cg) * K; const bf16_t* bu = Bt + ((size_t)g * N + cu) * K;
                float sg = 0.f, su = 0.f; for (int k = 0; k < K; ++k) { sg += bf2f(a[k]) * bf2f(bg[k]); su += bf2f(a[k]) * bf2f(bu[k]); }
                epi.pair_(row, j, sg, su);
            }
        }
    }
}
#else
namespace pg8 {
#define PG8_LAS __attribute__((address_space(3)))
typedef short bf16x8 __attribute__((ext_vector_type(8)));
typedef float f32x4 __attribute__((ext_vector_type(4)));
typedef unsigned u32x4 __attribute__((ext_vector_type(4)));
constexpr int BM = 256, BK = 64, HALF = 128, HTB = HALF * BK * 2, STAGE_BYTES = 8 * HTB, NXCD = 8, WGM = 8;
__host__ __device__ __forceinline__ int lds_byte(int r, int c) { const int st = (r >> 4) * 2 + (c >> 5), rr = r & 15, cc = c & 31, ob = rr * 64 + cc * 2; return st * 1024 + (ob ^ (((ob >> 9) & 1) << 5)); }
__host__ __device__ __forceinline__ void stage_rc(int b, int& R_, int& C_) { const int st = b / 1024, sb = b % 1024, swz = sb ^ (((sb >> 9) & 1) << 5); R_ = (st >> 1) * 16 + swz / 64; C_ = (st & 1) * 32 + (swz % 64) / 2; }
__host__ __device__ __forceinline__ int perm32(int rho) { const int n = rho >> 4, i = rho & 15; return 8 * (i >> 2) + 4 * n + (i & 3); }
struct Unit { int pm, pn; };
struct Gemm { const bf16_t* A; const bf16_t* Bt; int K; };
struct StaticOrder {
    int nM, nN, nwg, G, c;
    __device__ __forceinline__ void init(int M, int N, int G_, int c_) { nM = M / BM; nN = N / BM; nwg = nM * nN; G = G_; c = c_; }
    __device__ __forceinline__ bool next(int i, Unit& u) const {
        const long L = (long)i * G + c; if (L >= nwg) return false;
        int wgid = (int)L; { const int q = nwg / NXCD, r = nwg % NXCD, xcd = wgid % NXCD, off = wgid / NXCD; wgid = (xcd < r ? xcd * (q + 1) : r * (q + 1) + (xcd - r) * q) + off; }
        const int nig = WGM * nN, gid = wgid / nig, fm = gid * WGM, gsz = (nM - fm) < WGM ? (nM - fm) : WGM;
        u.pm = fm + ((wgid % nig) % gsz); u.pn = (wgid % nig) / gsz; return true;
    }
    __device__ __forceinline__ void a_ready(const Unit&) const {}
    __device__ __forceinline__ void done(const Unit&) const {}
};
struct GroupedOrder {
    int nMg, nMs, nN, total, G, c;
    __device__ __forceinline__ void init(int Mg_used, int Mg_stride, int N, int groups, int G_, int c_) { nMg = Mg_used / BM; nMs = Mg_stride / BM; nN = N / BM; total = groups * nMg * nN; G = G_; c = c_; }
    __device__ __forceinline__ bool next(int i, Unit& u) const {
        const long L = (long)i * G + c; if (L >= total) return false;
        int wgid = (int)L; { const int q = total / NXCD, r = total % NXCD, xcd = wgid % NXCD, off = wgid / NXCD; wgid = (xcd < r ? xcd * (q + 1) : r * (q + 1) + (xcd - r) * q) + off; }
        const int per = nMg * nN, g = wgid / per, rem = wgid % per;
        const int nig = WGM * nN, gid = rem / nig, fm = gid * WGM, gsz = (nMg - fm) < WGM ? (nMg - fm) : WGM;
        const int pm_l = fm + ((rem % nig) % gsz), pn_l = (rem % nig) / gsz;
        u.pm = g * nMs + pm_l; u.pn = g * nN + pn_l; return true;
    }
    __device__ __forceinline__ void a_ready(const Unit&) const {}
    __device__ __forceinline__ void done(const Unit&) const {}
};
typedef __bf16 bf16x2_n __attribute__((ext_vector_type(2)));
typedef float f32x2_n __attribute__((ext_vector_type(2)));
__device__ __forceinline__ unsigned cvt_pk_bf16(float lo, float hi) { const f32x2_n v = {lo, hi}; const bf16x2_n r = __builtin_convertvector(v, bf16x2_n); return __builtin_bit_cast(unsigned, r); }

typedef int i32x4 __attribute__((ext_vector_type(4)));
typedef int i32x8 __attribute__((ext_vector_type(8)));
__device__ __forceinline__ i32x8 frag_cat(bf16x8 lo, bf16x8 hi) { return __builtin_shufflevector(__builtin_bit_cast(i32x4, lo), __builtin_bit_cast(i32x4, hi), 0, 1, 2, 3, 4, 5, 6, 7); }
template <bool FP8> struct Frags { bf16x8 At[4][2], B0[2][2], B1[2][2]; };
template <> struct Frags<true> { i32x8 At[4], B0[2], B1[2]; };
template <bool GATHER, bool FP8, class Epi, class Sched>
__device__ __forceinline__ void gemm_phase(PG8_LAS unsigned char* lds, const Gemm g, const Sched& S, const Epi& E, const int tid, const PG8_LAS int* gix = nullptr) {
    const int wid = __builtin_amdgcn_readfirstlane(tid >> 6), lane = tid & 63, wr = wid >> 2, wc = wid & 3, fr = lane & 15, fq = lane >> 4;
    const int K = g.K, rowb = FP8 ? K : 2 * K, nt = rowb / (BK * 2);
    unsigned voffA[2], voffB[2];
#pragma unroll
    for (int i = 0; i < 2; ++i) { int R_, C_; stage_rc(tid * 16 + i * 8192, R_, C_); const int Rb = Epi::PERM ? ((R_ & ~31) + perm32(R_ & 31)) : R_;
        voffA[i] = (unsigned)(R_ * rowb + C_ * 2); voffB[i] = (unsigned)(Rb * rowb + C_ * 2); }
    unsigned gv[2][2];
#define PG8_GV(kk) do { _Pragma("unroll") for (int _i = 0; _i < 2; ++_i) { int _R, _C; stage_rc(tid * 16 + _i * 8192, _R, _C); _Pragma("unroll") for (int _h = 0; _h < 2; ++_h) \
        gv[_h][_i] = (unsigned)gix[(kk) * 256 + _h * 128 + _R] * (unsigned)rowb + (unsigned)_C * 2u; } } while (0)
#define PG8_UBASE(p) ({ const char* _ub = (const char*)(p); asm volatile("" : "+s"(_ub)); _ub; })
#define PG8_STAGE_A(bufoff, hf, kb, nx) do { if constexpr (GATHER) { const char* _gb = PG8_UBASE((const char*)g.A + (kb)); _Pragma("unroll") for (int _i = 0; _i < 2; ++_i) \
        __builtin_amdgcn_global_load_lds((const unsigned*)(_gb + gv[hf][_i]), (PG8_LAS unsigned*)(lds + (bufoff) + ldsw + _i * 8192), 16, 0, 0); } \
      else { const char* _gb = PG8_UBASE(((nx) ? nA : cA) + (kb) + (hf) * hstep); _Pragma("unroll") for (int _i = 0; _i < 2; ++_i) \
        __builtin_amdgcn_global_load_lds((const unsigned*)(_gb + voffA[_i]), (PG8_LAS unsigned*)(lds + (bufoff) + ldsw + _i * 8192), 16, 0, 0); } } while (0)
    const size_t kstep = (size_t)(BK * 2);
    const size_t hstep = (size_t)HALF * rowb;
    const size_t tstep = 2 * hstep;
    const unsigned ldsw = (unsigned)wid * 1024u;
    const int aoffk0 = FP8 ? lds_byte(wr * 64 + fr, fq * 16) : lds_byte(wr * 64 + fr, fq * 8), aoffk1 = FP8 ? lds_byte(wr * 64 + fr, fq * 16 + 8) : aoffk0 + 1024;
    const int boffk0 = FP8 ? lds_byte(wc * 32 + fr, fq * 16) : lds_byte(wc * 32 + fr, fq * 8), boffk1 = FP8 ? lds_byte(wc * 32 + fr, fq * 16 + 8) : boffk0 + 1024;
#define PG8_SA(b, h) (((b) * 2 + (h)) * HTB)
#define PG8_SB(b, h) ((4 + (b) * 2 + (h)) * HTB)
#define PG8_STAGE(bufoff, gbase, voff) do { const char* _gb = PG8_UBASE(gbase); _Pragma("unroll") for (int _i = 0; _i < 2; ++_i) \
        __builtin_amdgcn_global_load_lds((const unsigned*)(_gb + (voff)[_i]), (PG8_LAS unsigned*)(lds + (bufoff) + ldsw + _i * 8192), 16, 0, 0); } while (0)
#define PG8_LD16(off) (*(const PG8_LAS bf16x8*)(lds + (off)))
#define PG8_LDA(dst, b, h) do { _Pragma("unroll") for (int m = 0; m < 4; ++m) { \
        if constexpr (FP8) F.dst[m] = frag_cat(PG8_LD16(PG8_SA(b, h) + aoffk0 + m * 2048), PG8_LD16(PG8_SA(b, h) + aoffk1 + m * 2048));     \
        else { F.dst[m][0] = PG8_LD16(PG8_SA(b, h) + aoffk0 + m * 2048); F.dst[m][1] = PG8_LD16(PG8_SA(b, h) + aoffk1 + m * 2048); } } } while (0)
#define PG8_LDB(dst, b, h) do { _Pragma("unroll") for (int n = 0; n < 2; ++n) { \
        if constexpr (FP8) F.dst[n] = frag_cat(PG8_LD16(PG8_SB(b, h) + boffk0 + n * 2048), PG8_LD16(PG8_SB(b, h) + boffk1 + n * 2048)); \
        else { F.dst[n][0] = PG8_LD16(PG8_SB(b, h) + boffk0 + n * 2048); F.dst[n][1] = PG8_LD16(PG8_SB(b, h) + boffk1 + n * 2048); } } } while (0)
#define PG8_MMA(ai, bj, At, Bt) do { __builtin_amdgcn_s_setprio(1); _Pragma("unroll") for (int m = 0; m < 4; ++m) _Pragma("unroll") for (int n = 0; n < 2; ++n) { \
        if constexpr (FP8) asm volatile("v_mfma_scale_f32_16x16x128_f8f6f4 %0, %1, %2, %0, %3, %3 op_sel_hi:[0,0,0]" : "+v"(acc[ai][bj][m][n]) : "v"(F.Bt[n]), "v"(F.At[m]), "v"(scale1)); \
        else { _Pragma("unroll") for (int k = 0; k < 2; ++k) acc[ai][bj][m][n] = __builtin_amdgcn_mfma_f32_16x16x32_bf16(F.Bt[n][k], F.At[m][k], acc[ai][bj][m][n], 0, 0, 0); } } \
        __builtin_amdgcn_s_setprio(0); } while (0)
#define PG8_WAIT_V(n) asm volatile("s_waitcnt vmcnt(" #n ")" ::: "memory")
#define PG8_WAIT_L(n) asm volatile("s_waitcnt lgkmcnt(" #n ")" ::: "memory")
#define PG8_BAR __builtin_amdgcn_s_barrier()
#define PG8_SCHED __builtin_amdgcn_sched_barrier(0)
    Unit cur, nxt; int ui = 0;
    if (!S.next(0, cur)) return;
    f32x4 acc[2][2][4][2];
#pragma unroll
    for (int a = 0; a < 2; ++a)
#pragma unroll
        for (int b = 0; b < 2; ++b)
#pragma unroll
            for (int m = 0; m < 4; ++m)
#pragma unroll
                for (int n = 0; n < 2; ++n) acc[a][b][m][n] = (f32x4){0.f, 0.f, 0.f, 0.f};
    Frags<FP8> F;
    int scale1 = 127; asm volatile("" : "+v"(scale1));
    const char* cA = (const char*)g.A + (size_t)cur.pm * tstep; const char* cB = (const char*)g.Bt + (size_t)cur.pn * tstep;
    const char* nA = cA;
    if constexpr (GATHER) { PG8_GV(0); }
    S.a_ready(cur);
    PG8_STAGE(PG8_SB(0, 0), cB, voffB); PG8_STAGE_A(PG8_SA(0, 0), 0, (size_t)0, false); PG8_STAGE(PG8_SB(0, 1), cB + hstep, voffB); PG8_STAGE_A(PG8_SA(0, 1), 1, (size_t)0, false);
    if (wr == 1) PG8_BAR;
    PG8_WAIT_V(4); PG8_BAR;
    PG8_STAGE(PG8_SB(1, 0), cB + kstep, voffB); PG8_STAGE_A(PG8_SA(1, 0), 0, kstep, false); PG8_STAGE(PG8_SB(1, 1), cB + hstep + kstep, voffB);
    PG8_WAIT_V(6); PG8_BAR;
    for (;;) {
        const bool has_next = S.next(ui + 1, nxt);
        nA = has_next ? (const char*)g.A + (size_t)nxt.pm * tstep : cA; const char* nB = has_next ? (const char*)g.Bt + (size_t)nxt.pn * tstep : cB;
        constexpr int KREP = PROBE_SET == 30 ? 2 : 1;
#pragma nounroll
        for (int t = 0; t < nt * KREP; t += 2) {
            const bool last = (t == nt * KREP - 2);
            const size_t ka1 = (size_t)((t + 1) % nt) * kstep, ka2 = last ? (size_t)0 : (size_t)((t + 2) % nt) * kstep, ka3 = ka2 + kstep;
            const char* b2 = last ? nB : cB + (size_t)((t + 2) % nt) * kstep;
            const char* b3 = b2 + kstep;
            if (last && has_next) S.a_ready(nxt);
            PG8_LDB(B0, 0, 0); PG8_SCHED; PG8_LDA(At, 0, 0); PG8_STAGE_A(PG8_SA(1, 1), 1, ka1, false);
            PG8_WAIT_L(8); PG8_BAR; PG8_WAIT_L(0); PG8_MMA(0, 0, At, B0); PG8_BAR; PG8_SCHED;
            if constexpr (GATHER) { if (last && has_next) { PG8_GV(ui + 1); } }
            PG8_LDB(B1, 0, 1); PG8_STAGE(PG8_SB(0, 0), b2, voffB);
            PG8_BAR; PG8_WAIT_L(0); PG8_MMA(0, 1, At, B1); PG8_BAR;
            PG8_LDA(At, 0, 1); PG8_STAGE_A(PG8_SA(0, 0), 0, ka2, last);
            PG8_BAR; PG8_WAIT_L(0); PG8_MMA(1, 0, At, B0); PG8_BAR; PG8_SCHED;
            PG8_STAGE(PG8_SB(0, 1), b2 + hstep, voffB);
            PG8_WAIT_V(6); PG8_BAR; PG8_MMA(1, 1, At, B1); PG8_BAR;
            PG8_LDB(B0, 1, 0); PG8_SCHED; PG8_LDA(At, 1, 0); PG8_STAGE_A(PG8_SA(0, 1), 1, ka2, last);
            PG8_WAIT_L(8); PG8_BAR; PG8_WAIT_L(0); PG8_MMA(0, 0, At, B0); PG8_BAR; PG8_SCHED;
            PG8_LDB(B1, 1, 1); PG8_STAGE(PG8_SB(1, 0), b3, voffB);
            PG8_BAR; PG8_WAIT_L(0); PG8_MMA(0, 1, At, B1); PG8_BAR;
            PG8_LDA(At, 1, 1); PG8_STAGE_A(PG8_SA(1, 0), 0, ka3, last);
            PG8_BAR; PG8_WAIT_L(0); PG8_MMA(1, 0, At, B0); PG8_BAR; PG8_SCHED;
            PG8_STAGE(PG8_SB(1, 1), b3 + hstep, voffB);
            PG8_WAIT_V(6); PG8_BAR; PG8_MMA(1, 1, At, B1); PG8_BAR;
        }
        if constexpr (KREP > 1) {
#pragma unroll
            for (int a = 0; a < 2; ++a)
#pragma unroll
                for (int b = 0; b < 2; ++b)
#pragma unroll
                    for (int m = 0; m < 4; ++m)
#pragma unroll
                        for (int n = 0; n < 2; ++n) acc[a][b][m][n] *= (1.0f / KREP); }
        if constexpr (FP8) asm volatile("s_nop 15\n\ts_nop 15" ::: "memory");
        { int tz = tid; asm volatile("" : "+v"(tz));
          const int wz = tz >> 6, lz = tz & 63; E(acc, cur, wz >> 2, wz & 3, lz & 15, lz >> 4); }
        S.done(cur);
        if (!has_next) break;
#pragma unroll
        for (int a = 0; a < 2; ++a)
#pragma unroll
            for (int b = 0; b < 2; ++b)
#pragma unroll
                for (int m = 0; m < 4; ++m)
#pragma unroll
                    for (int n = 0; n < 2; ++n) acc[a][b][m][n] = (f32x4){0.f, 0.f, 0.f, 0.f};
        cur = nxt; cA = nA; cB = nB; ++ui;

    }
    PG8_WAIT_V(0);
    if (wr == 0) PG8_BAR;
    PG8_BAR;
#undef PG8_SA
#undef PG8_SB
#undef PG8_STAGE
#undef PG8_STAGE_A
#undef PG8_UBASE
#undef PG8_GV
#undef PG8_LDA
#undef PG8_LDB
#undef PG8_MMA
#undef PG8_WAIT_V
#undef PG8_WAIT_L
#undef PG8_BAR
#undef PG8_SCHED
}

struct EpiZ8 {
    static constexpr bool PERM = true;
    bf16_t* O; int ldc;
    __device__ __forceinline__ void operator()(const f32x4 (&acc)[2][2][4][2], const Unit& u, int wr, int wc, int fr, int fq) const {
        const int row0 = u.pm * BM + wr * 64 + fr, col0 = u.pn * BM + wc * 32 + 8 * fq;
#pragma unroll
        for (int ai = 0; ai < 2; ++ai)
#pragma unroll
            for (int m = 0; m < 4; ++m) { bf16_t* rowp = O + (size_t)(row0 + ai * HALF + m * 16) * ldc + col0;
#pragma unroll
                for (int bj = 0; bj < 2; ++bj) { const f32x4 v0 = acc[ai][bj][m][0], v1 = acc[ai][bj][m][1];
                    u32x4 w; w.x = cvt_pk_bf16(v0[0], v0[1]); w.y = cvt_pk_bf16(v0[2], v0[3]); w.z = cvt_pk_bf16(v1[0], v1[1]); w.w = cvt_pk_bf16(v1[2], v1[3]);
                    *(u32x4*)(rowp + bj * HALF) = w; } }
    }
};
template <bool SRC32>
struct EpiWoutB {
    static constexpr bool PERM = true;
    const float* src_lat; const float* src_ctx; bf16_t* xb; const float* modl;
    float* ssqp;
    __device__ __forceinline__ void operator()(const f32x4 (&acc)[2][2][4][2], const Unit& u, int wr, int wc, int fr, int fq) const {
        const int rowt = u.pm * BM; const bool lat = rowt < RL; const int bb = lat ? rowt / T : NB;
        const float* sp = lat ? src_lat + (size_t)rowt * D : src_ctx + (size_t)(rowt - RL) * D;
        bf16_t* dp = xb + (size_t)rowt * D;
        const float* mr = modl + (size_t)bb * MODW + 2 * D;
        const int r0 = wr * 64 + fr, col0 = u.pn * BM + wc * 32 + 8 * fq;
        f32x4 mv[2][2];
#pragma unroll
        for (int bj = 0; bj < 2; ++bj)
#pragma unroll
            for (int n = 0; n < 2; ++n) mv[bj][n] = *(const f32x4*)(mr + col0 + bj * HALF + 4 * n);
#pragma unroll
        for (int ai = 0; ai < 2; ++ai)
#pragma unroll
            for (int m = 0; m < 4; ++m) { const size_t ro = (size_t)(r0 + ai * HALF + m * 16) * D + col0; float sq = 0.f;
#pragma unroll
                for (int bj = 0; bj < 2; ++bj) { f32x4 x0, x1;
                    if (SRC32) { x0 = *(const f32x4*)(sp + ro + bj * HALF); x1 = *(const f32x4*)(sp + ro + bj * HALF + 4); }
                    else { const u32x4 w = *(const u32x4*)(dp + ro + bj * HALF);
                        x0 = (f32x4){__uint_as_float(w.x << 16), __uint_as_float(w.x & 0xffff0000u), __uint_as_float(w.y << 16), __uint_as_float(w.y & 0xffff0000u)};
                        x1 = (f32x4){__uint_as_float(w.z << 16), __uint_as_float(w.z & 0xffff0000u), __uint_as_float(w.w << 16), __uint_as_float(w.w & 0xffff0000u)}; }
                    const f32x4 v0 = x0 + mv[bj][0] * acc[ai][bj][m][0], v1 = x1 + mv[bj][1] * acc[ai][bj][m][1];
                    u32x4 o; o.x = cvt_pk_bf16(v0[0], v0[1]); o.y = cvt_pk_bf16(v0[2], v0[3]); o.z = cvt_pk_bf16(v1[0], v1[1]); o.w = cvt_pk_bf16(v1[2], v1[3]);
                    *(u32x4*)(dp + ro + bj * HALF) = o;
                    const unsigned ow[4] = {o.x, o.y, o.z, o.w};
#pragma unroll
                    for (int j = 0; j < 4; ++j) { const float a = __uint_as_float(ow[j] << 16), b = __uint_as_float(ow[j] & 0xffff0000u); sq += a * a + b * b; } }
                sq += __builtin_bit_cast(float, __builtin_amdgcn_ds_bpermute(((16 * fq + fr) ^ 16) << 2, __builtin_bit_cast(int, sq)));
                sq += __builtin_bit_cast(float, __builtin_amdgcn_ds_bpermute(((16 * fq + fr) ^ 32) << 2, __builtin_bit_cast(int, sq)));
                if (fq == 0) ssqp[(size_t)(rowt + r0 + ai * HALF + m * 16) * 16 + (u.pn & 3) * 4 + wc] = sq; }
    }
};
__device__ __forceinline__ float silu_fast(float x) { return x * __builtin_amdgcn_rcpf(1.0f + __expf(-x)); }
struct EpiGU8 {
    static constexpr bool PERM = true;
    bf16_t* hid; int nN;
    __device__ __forceinline__ void operator()(const f32x4 (&acc)[2][2][4][2], const Unit& u, int wr, int wc, int fr, int fq) const {
        const int row0 = u.pm * BM + wr * 64 + fr, col0 = (u.pn % nN) * HALF + wc * 32 + 8 * fq;
#pragma unroll
        for (int ai = 0; ai < 2; ++ai)
#pragma unroll
            for (int m = 0; m < 4; ++m) { bf16_t* rowp = hid + (size_t)(row0 + ai * HALF + m * 16) * D + col0;
                float v[8];
#pragma unroll
                for (int n = 0; n < 2; ++n)
#pragma unroll
                    for (int i = 0; i < 4; ++i) v[n * 4 + i] = silu_fast(acc[ai][0][m][n][i]) * acc[ai][1][m][n][i];
                u32x4 w; w.x = cvt_pk_bf16(v[0], v[1]); w.y = cvt_pk_bf16(v[2], v[3]); w.z = cvt_pk_bf16(v[4], v[5]); w.w = cvt_pk_bf16(v[6], v[7]);
                *(u32x4*)rowp = w; }
    }
};
constexpr float W8_SCALE = 32.0f;
__device__ __forceinline__ unsigned pack4_fp8(float a, float b, float c, float d) { int w = __builtin_amdgcn_cvt_pk_fp8_f32(a, b, 0, false); w = __builtin_amdgcn_cvt_pk_fp8_f32(c, d, w, true); return (unsigned)w; }
struct EpiGU_F8 {
    static constexpr bool PERM = true;
    unsigned char* hid; int nN;
    __device__ __forceinline__ void operator()(const f32x4 (&acc)[2][2][4][2], const Unit& u, int wr, int wc, int fr, int fq) const {
        const int row0 = u.pm * BM + wr * 64 + fr, col0 = (u.pn % nN) * HALF + wc * 32 + 8 * fq;
        constexpr float inv = 1.0f / W8_SCALE;
#pragma unroll
        for (int ai = 0; ai < 2; ++ai)
#pragma unroll
            for (int m = 0; m < 4; ++m) { unsigned char* rowp = hid + (size_t)(row0 + ai * HALF + m * 16) * D + col0;
                float v[8];
#pragma unroll
                for (int n = 0; n < 2; ++n)
#pragma unroll
                    for (int i = 0; i < 4; ++i) v[n * 4 + i] = silu_fast(acc[ai][0][m][n][i] * inv) * (acc[ai][1][m][n][i] * inv);
                typedef unsigned u32x2v __attribute__((ext_vector_type(2)));
                *(u32x2v*)rowp = (u32x2v){pack4_fp8(v[0], v[1], v[2], v[3]), pack4_fp8(v[4], v[5], v[6], v[7])}; }
    }
};
constexpr float OUTSLOT_SCALE = 32.0f;
struct EpiDown8 {
    static constexpr bool PERM = true;
    unsigned char* O; const float* selg; int nN; float wscale;
    __device__ __forceinline__ void operator()(const f32x4 (&acc)[2][2][4][2], const Unit& u, int wr, int wc, int fr, int fq) const {
        const int row0 = u.pm * BM + wr * 64 + fr, col0 = (u.pn % nN) * BM + wc * 32 + 8 * fq;
#pragma unroll
        for (int ai = 0; ai < 2; ++ai)
#pragma unroll
            for (int m = 0; m < 4; ++m) { const int row = row0 + ai * HALF + m * 16; const float gs = selg[row] * wscale * OUTSLOT_SCALE; unsigned char* rowp = O + (size_t)row * D + col0;
#pragma unroll
                for (int bj = 0; bj < 2; ++bj) { f32x4 v0 = acc[ai][bj][m][0] * gs, v1 = acc[ai][bj][m][1] * gs;
#pragma unroll
                    for (int i = 0; i < 4; ++i) { v0[i] = __builtin_amdgcn_fmed3f(v0[i], -448.0f, 448.0f); v1[i] = __builtin_amdgcn_fmed3f(v1[i], -448.0f, 448.0f); }
                    typedef unsigned u32x2v __attribute__((ext_vector_type(2)));
                    *(u32x2v*)(rowp + bj * HALF) = (u32x2v){pack4_fp8(v0[0], v0[1], v0[2], v0[3]), pack4_fp8(v1[0], v1[1], v1[2], v1[3])}; } }
    }
};
}
constexpr int GEMM_LDS_BYTES = pg8::STAGE_BYTES;
constexpr int WQ_QUOTA_IN_EVEN = 700, WQ_QUOTA_IN_ODD = 5600, WQ_QUOTA_OUT = 8600;
constexpr int GIX_UNITS = 10;
constexpr int DYN_LDS_BYTES = GEMM_LDS_BYTES + 16 + GIX_UNITS * 256 * 4;
#endif

struct EpiZ_ : EpiZ { DEV void pair_(int, int, float, float) const {} };
struct EpiWout_ : EpiWout { DEV void pair_(int, int, float, float) const {} };
struct EpiDown_ : EpiDown { DEV void pair_(int, int, float, float) const {} };
struct EpiGU_ : EpiGU { DEV void elem(int, int, float) const {} DEV void pair_(int r, int j, float g, float u) const { pair(r, j, g, u); } };

#ifndef CPU_EMU
typedef float f32x4_t __attribute__((ext_vector_type(4)));
typedef unsigned u32x4_t __attribute__((ext_vector_type(4)));
typedef unsigned u32x2_t __attribute__((ext_vector_type(2)));
typedef float f32x2_t __attribute__((ext_vector_type(2)));
typedef short bf16x8_t __attribute__((ext_vector_type(8)));
__device__ __forceinline__ unsigned pk_bf16(float lo, float hi) { return pg8::cvt_pk_bf16(lo, hi); }
__device__ __forceinline__ int bperm_i(int v, int src_lane) { return __builtin_amdgcn_ds_bpermute(src_lane << 2, v); }
__device__ __forceinline__ float bperm_f(float v, int src_lane) { return __builtin_bit_cast(float, __builtin_amdgcn_ds_bpermute(src_lane << 2, __builtin_bit_cast(int, v))); }
__device__ __forceinline__ int lane_bcast_i(int v, int uniform_lane) { return __builtin_amdgcn_readlane(v, __builtin_amdgcn_readfirstlane(uniform_lane)); }
__device__ __forceinline__ float wave_sum_fast(float v);
__device__ __forceinline__ float wave_sum(float v) { return wave_sum_fast(v); }
__device__ __forceinline__ float fsigmoid(float x) { return __builtin_amdgcn_rcpf(1.0f + __expf(-x)); }
__device__ __forceinline__ float fsilu(float x) { return x * fsigmoid(x); }
__device__ __forceinline__ float fgelu(float x) { const float u = 0.7978845608028654f * (x + 0.044715f * x * x * x); return x * fsigmoid(2.0f * u); }

__device__ __forceinline__ void tconv_tile(const float* __restrict__ src, int src_ld, int scol0, int nvalid, bf16_t* __restrict__ dst, int dst_ld, int drow0, int k0, PG8_LAS float* tile  , int t) {
#pragma unroll
    for (int i = 0; i < 8; ++i) { const int e = t + 512 * i, kk = e >> 6, nn = e & 63;
        tile[kk * 65 + nn] = nn < nvalid ? src[(size_t)(k0 + kk) * src_ld + scol0 + nn] : 0.f; }
    __syncthreads();
    { const int nn = t >> 3, ks = t & 7; float v[8];
#pragma unroll
        for (int j = 0; j < 8; ++j) v[j] = tile[(ks * 8 + j) * 65 + nn];
        u32x4_t w; w.x = pk_bf16(v[0], v[1]); w.y = pk_bf16(v[2], v[3]); w.z = pk_bf16(v[4], v[5]); w.w = pk_bf16(v[6], v[7]);
        *(u32x4_t*)(dst + (size_t)(drow0 + nn) * dst_ld + k0 + ks * 8) = w; }
    __syncthreads();
}
__device__ __forceinline__ void fs_wconv(const Params& P, PG8_LAS unsigned char* lds, int t) {
    PG8_LAS float* tile = (PG8_LAS float*)lds;
    constexpr int KT = D / 64, T_EIN = (NZE / 64) * KT, T_OIN = (NZO / 64) * KT, T_OUT = (D / 64) * KT, PER_Q = T_EIN + T_OIN + 2 * T_OUT;
    for (int u = blockIdx.x; u < 2 * PER_Q; u += gridDim.x) {
        const int q = u / PER_Q; int r = u % PER_Q;
        if (r < T_EIN) { const int nt = r / KT, kt = r % KT; tconv_tile(P.ev_w_in + (size_t)q * D * EV_IN, EV_IN, nt * 64, EV_IN - nt * 64, P.wt_ev_in + (size_t)q * NZE * D, D, nt * 64, kt * 64, tile, t); continue; }
        r -= T_EIN;
        if (r < T_OIN) { const int nt = r / KT, kt = r % KT; tconv_tile(P.od_w_in + (size_t)q * D * NZO, NZO, nt * 64, 64, P.wt_od_in + (size_t)q * NZO * D, D, nt * 64, kt * 64, tile, t); continue; }
        r -= T_OIN;
        if (r < T_OUT) { const int nt = r / KT, kt = r % KT; tconv_tile(P.ev_w_out + (size_t)q * D * D, D, nt * 64, 64, P.wt_ev_out + (size_t)q * D * D, D, nt * 64, kt * 64, tile, t); continue; }
        r -= T_OUT;
        { const int nt = r / KT, kt = r % KT; tconv_tile(P.od_w_out + (size_t)q * D * D, D, nt * 64, 64, P.wt_od_out + (size_t)q * D * D, D, nt * 64, kt * 64, tile, t); }
    }
    for (int u = blockIdx.x; u < 32 * 4; u += gridDim.x) {
        const int mi = u >> 2, tt = u & 3, li = mi >> 4, dir = (mi >> 3) & 1, gate = (mi >> 2) & 1, hh = mi & 3;
        const float* src = (gate == 0 ? P.od_gate_a_w : P.od_gate_x_w) + (size_t)(((li * 2 + dir) * 4 + hh) * HD) * HD;
        tconv_tile(src, HD, (tt >> 1) * 64, 64, P.gwT + (size_t)mi * HD * HD, HD, (tt >> 1) * 64, (tt & 1) * 64, tile, t);
    }
    for (int i = blockIdx.x * 512 + t; i < 2 * 4 * SGC * SGC; i += gridDim.x * 512) P.sgw[i] = f2bf(P.od_sg_w[i]);
    for (int i = blockIdx.x * 512 + t; i < DEPTH * D * NE; i += gridDim.x * 512) { const int ll = i / (D * NE), c = (i / NE) % D, e = i % NE; const float w = P.moe_router[i];
        const unsigned ph = pk_bf16(w, 0.f) & 0xffffu; const float wl = w - __uint_as_float(ph << 16);
        P.rw16[((size_t)(ll * 2 + 0) * NE + e) * D + c] = (bf16_t)ph; P.rw16[((size_t)(ll * 2 + 1) * NE + e) * D + c] = (bf16_t)(pk_bf16(wl, 0.f) & 0xffffu); }
}
struct MoeTile { const float* src; unsigned char* dst; };
__device__ __forceinline__ MoeTile moe_tile(const Params& P, int l, int u) {
    constexpr int KT = D / 64, T_GU = (2 * D / 64) * KT, T_DN = (D / 64) * KT, PER_E = T_GU + T_DN;
    const int e = u / PER_E; int r = u % PER_E; MoeTile mt;
    if (r < T_GU) { const int nt = r / KT, kt = r % KT, cv0 = nt * 64, w = cv0 % 256, j0 = (cv0 / 256) * 128 + (w % 128);
        mt.src = (w >= 128 ? P.moe_w_up : P.moe_w_gate) + ((size_t)l * NE + e) * D * D + (size_t)(kt * 64) * D + j0; mt.dst = (unsigned char*)P.wt_gu + (size_t)e * 2 * D * D + (size_t)cv0 * D + kt * 64; }
    else { r -= T_GU; const int nt = r / KT, kt = r % KT;
        mt.src = P.moe_w_down + ((size_t)l * NE + e) * D * D + (size_t)(kt * 64) * D + nt * 64; mt.dst = (unsigned char*)P.wt_dn + (size_t)e * D * D + (size_t)(nt * 64) * D + kt * 64; }
    return mt;
}
__device__ __forceinline__ void fs_moe_wconv(const Params& P, int l, PG8_LAS unsigned char* lds, int t, int limit) {
    PG8_LAS float* tile = (PG8_LAS float*)lds;
    PG8_LAS int* slot = (PG8_LAS int*)(lds + 2 * 64 * 65 * 4);
    constexpr int NT = NE * ((2 * D / 64) + (D / 64)) * (D / 64);
    if (limit > NT) limit = NT;
    const int kk0 = t >> 6, nn = t & 63;
    unsigned* ctr = P.wq + l;
    if (t == 0) { const unsigned c0 = __hip_atomic_load(ctr, __ATOMIC_RELAXED, __HIP_MEMORY_SCOPE_AGENT);
        slot[0] = (int)c0 >= limit ? NT : (int)__hip_atomic_fetch_add(ctr, 2u, __ATOMIC_RELAXED, __HIP_MEMORY_SCOPE_AGENT); }
    __syncthreads();
    for (int it = 0;; ++it) {
        const int u0 = slot[it & 1];
        if (u0 >= NT) break;
        int unext = NT;
        if (t == 0 && u0 + 2 < limit) unext = (int)__hip_atomic_fetch_add(ctr, 2u, __ATOMIC_RELAXED, __HIP_MEMORY_SCOPE_AGENT);
        const MoeTile m0 = moe_tile(P, l, u0), m1 = moe_tile(P, l, u0 + 1 < NT ? u0 + 1 : u0);
        float v0[8], v1[8];
#pragma unroll
        for (int i = 0; i < 8; ++i) { v0[i] = m0.src[(size_t)(kk0 + 8 * i) * D + nn]; v1[i] = m1.src[(size_t)(kk0 + 8 * i) * D + nn]; }
#pragma unroll
        for (int i = 0; i < 8; ++i) { tile[(kk0 + 8 * i) * 65 + nn] = v0[i]; tile[64 * 65 + (kk0 + 8 * i) * 65 + nn] = v1[i]; }
        if (t == 0) slot[(it + 1) & 1] = unext;
        __syncthreads();
        { const int n2 = t >> 3, ks = t & 7; float o[8], p[8];
#pragma unroll
            for (int j = 0; j < 8; ++j) { o[j] = tile[(ks * 8 + j) * 65 + n2]; p[j] = tile[64 * 65 + (ks * 8 + j) * 65 + n2]; }
            constexpr float ws = pg8::W8_SCALE;
            u32x2_t w; w.x = pg8::pack4_fp8(o[0] * ws, o[1] * ws, o[2] * ws, o[3] * ws); w.y = pg8::pack4_fp8(o[4] * ws, o[5] * ws, o[6] * ws, o[7] * ws);
            *(u32x2_t*)(m0.dst + (size_t)n2 * D + ks * 8) = w;
            if (u0 + 1 < NT) { w.x = pg8::pack4_fp8(p[0] * ws, p[1] * ws, p[2] * ws, p[3] * ws); w.y = pg8::pack4_fp8(p[4] * ws, p[5] * ws, p[6] * ws, p[7] * ws); *(u32x2_t*)(m1.dst + (size_t)n2 * D + ks * 8) = w; } }
        __syncthreads();
    }
    __syncthreads();
}
__device__ __forceinline__ void fs_mod(const Params& P, PG8_LAS unsigned char* lds, int t) {
    PG8_LAS float* sb = (PG8_LAS float*)lds;
    PG8_LAS float* red = sb + (NB + 1) * D;
    for (int i = t; i < (NB + 1) * D; i += 512) { const int bb = i / D, kk = i % D; const float v = bb < NB ? P.c[(size_t)bb * D + kk] : P.c_ctx[kk]; sb[i] = v / (1.0f + expf(-v)); }
    __syncthreads();
    constexpr int CB = MODW / 128;
    const int c4 = t & 31, ks = t >> 5;
    for (int u = blockIdx.x; u < DEPTH * CB; u += gridDim.x) {
        const int ll = u / CB, j0 = (u % CB) * 128 + c4 * 4;
        const float* w = P.ada_w + (size_t)ll * D * MODW + j0;
        f32x4_t acc[NB + 1];
#pragma unroll
        for (int bb = 0; bb <= NB; ++bb) acc[bb] = (f32x4_t){0.f, 0.f, 0.f, 0.f};
#pragma unroll 8
        for (int kk = ks * 64; kk < ks * 64 + 64; ++kk) { const f32x4_t wv = *(const f32x4_t*)(w + (size_t)kk * MODW);
#pragma unroll
            for (int bb = 0; bb <= NB; ++bb) acc[bb] += wv * sb[bb * D + kk]; }
#pragma unroll
        for (int bb = 0; bb <= NB; ++bb)
#pragma unroll
            for (int i = 0; i < 4; ++i) red[(ks * 32 + c4) * 36 + bb * 4 + i] = acc[bb][i];
        __syncthreads();
        for (int o = t; o < (NB + 1) * 128; o += 512) { const int bb = o / 128, col = o % 128, cc4 = col >> 2, ci = col & 3;
            float s = P.ada_b[(size_t)ll * MODW + (u % CB) * 128 + col];
#pragma unroll
            for (int k2 = 0; k2 < 16; ++k2) s += red[(k2 * 32 + cc4) * 36 + bb * 4 + ci];
            P.mod[((size_t)ll * (NB + 1) + bb) * MODW + (u % CB) * 128 + col] = s; }
        __syncthreads();
    }
}
#define DPP_ADD(v, ctrl) ((v) + __builtin_bit_cast(float, __builtin_amdgcn_update_dpp(0, __builtin_bit_cast(int, (v)), (ctrl), 0xF, 0xF, true)))
__device__ __forceinline__ float row16_sum(float v) {
    v = DPP_ADD(v, 0xB1);
    v = DPP_ADD(v, 0x4E);
    v = DPP_ADD(v, 0x141);
    v = DPP_ADD(v, 0x140);
    return v;
}
__device__ __forceinline__ float wave_sum_fast(float v) {
    v = row16_sum(v);
    const int iv = __builtin_bit_cast(int, v);
    return __builtin_bit_cast(float, __builtin_amdgcn_readlane(iv, 0)) + __builtin_bit_cast(float, __builtin_amdgcn_readlane(iv, 16)) +
           __builtin_bit_cast(float, __builtin_amdgcn_readlane(iv, 32)) + __builtin_bit_cast(float, __builtin_amdgcn_readlane(iv, 48));
}
template <int MODE>
__device__ __forceinline__ void fs_row(const Params& P, int l, PG8_LAS unsigned char* lds, int t) {
    const int lane = t & 63, wid = t >> 6;
    PG8_LAS float* wrT = (PG8_LAS float*)lds;
    if (MODE == 1) {
        const float* wr = P.moe_router + (size_t)l * D * NE;
        for (int i = t; i < D * NE; i += 512) { const int c = i / NE, e = i % NE; wrT[e * D + c] = wr[i]; }
        __syncthreads();
    }
    const bool combine = (MODE == 0 && l > 0) || MODE == 2;
    const int lc = MODE == 2 ? DEPTH - 1 : l - 1;
    const float* gvec = MODE == 0 ? P.norm_mix_g + (size_t)l * D : MODE == 1 ? P.norm_ffn_g + (size_t)l * D : P.norm_final_g;
    const int nrows = (MODE == 2 || (MODE == 1 && l == DEPTH - 1)) ? RL : R;
    const int nwaves = gridDim.x * 8, rpw = (nrows + nwaves - 1) / nwaves, rbeg = (blockIdx.x * 8 + wid) * rpw, rend = (rbeg + rpw < nrows) ? rbeg + rpw : nrows;
    const bool in32 = (MODE == 0 && l == 0);
    auto xload = [&](int r, u32x4_t (&raw)[4]) {
        if (in32) { const float* xs = r < RL ? P.x + (size_t)r * D : P.ctx + (size_t)(r - RL) * D;
#pragma unroll
            for (int i = 0; i < 4; ++i) raw[i] = *(const u32x4_t*)(xs + lane * 4 + i * 256); }
        else { const bf16_t* xs = P.xb + (size_t)r * D;
#pragma unroll
            for (int i = 0; i < 4; ++i) { const u32x2_t w = *(const u32x2_t*)(xs + lane * 4 + i * 256); raw[i].x = w.x; raw[i].y = w.y; } } };
    f32x4_t gv[4];
#pragma unroll
    for (int i = 0; i < 4; ++i) gv[i] = *(const f32x4_t*)(gvec + lane * 4 + i * 256);
    f32x4_t scv[4], shv[4], m5v[4]; int bbc = -1;
    u32x4_t xn[4]; int inv0 = -1, inv1 = -1, inv2 = -1;
    int pw0[4] = {0, 0, 0, 0}, pw1[4] = {0, 0, 0, 0};
    auto slot_prefetch = [&](int invv) {
        const unsigned long long mk = __ballot(invv >= 0) & 0xffffull;
        if (mk) { const int e0 = __builtin_ctzll(mk); const unsigned long long m2 = mk & (mk - 1); const int s0 = lane_bcast_i(invv, e0);
            const unsigned char* o0 = (const unsigned char*)P.outslot + (size_t)s0 * D + lane * 4;
#pragma unroll
            for (int i = 0; i < 4; ++i) pw0[i] = *(const int*)(o0 + i * 256);
            if (m2) { const int e1 = __builtin_ctzll(m2); const int s1 = lane_bcast_i(invv, e1); const unsigned char* o1 = (const unsigned char*)P.outslot + (size_t)s1 * D + lane * 4;
#pragma unroll
                for (int i = 0; i < 4; ++i) pw1[i] = *(const int*)(o1 + i * 256); } } };
    if (rbeg < rend) { xload(rbeg, xn);
        if (combine) { inv0 = P.inv[(size_t)rbeg * NE + (lane & 15)]; if (rbeg + 1 < rend) inv1 = P.inv[(size_t)(rbeg + 1) * NE + (lane & 15)]; if (rbeg + 2 < rend) inv2 = P.inv[(size_t)(rbeg + 2) * NE + (lane & 15)];
            slot_prefetch(inv0); } }
    for (int r = rbeg; r < rend; ++r) {
        const bool lat = r < RL; const int bb = lat ? r / T : NB;
        f32x4_t xv[4];
#pragma unroll
        for (int i = 0; i < 4; ++i) { if (in32) xv[i] = __builtin_bit_cast(f32x4_t, xn[i]);
            else xv[i] = (f32x4_t){__uint_as_float(xn[i].x << 16), __uint_as_float(xn[i].x & 0xffff0000u), __uint_as_float(xn[i].y << 16), __uint_as_float(xn[i].y & 0xffff0000u)}; }
        const int myinv = inv0;
        int cw0[4], cw1[4];
#pragma unroll
        for (int i = 0; i < 4; ++i) { cw0[i] = pw0[i]; cw1[i] = pw1[i]; }
        if (r + 1 < rend) { xload(r + 1, xn);
            if (combine) { slot_prefetch(inv1); inv0 = inv1; inv1 = inv2; if (r + 3 < rend) inv2 = P.inv[(size_t)(r + 3) * NE + (lane & 15)]; } }
        if (bb != bbc) { bbc = bb;
            if (MODE != 2) { const float* mr = modrow(P, l, bb) + lane * 4;
#pragma unroll
                for (int i = 0; i < 4; ++i) { scv[i] = *(const f32x4_t*)(mr + (MODE == 0 ? 1 : 4) * D + i * 256) + 1.0f; shv[i] = *(const f32x4_t*)(mr + (MODE == 0 ? 0 : 3) * D + i * 256); } }
            if (combine) { const float* m5 = modrow(P, lc, bb) + 5 * D + lane * 4;
#pragma unroll
                for (int i = 0; i < 4; ++i) m5v[i] = *(const f32x4_t*)(m5 + i * 256); } }
        if (combine) {
            f32x4_t sum[4];
#pragma unroll
            for (int i = 0; i < 4; ++i) sum[i] = (f32x4_t){0.f, 0.f, 0.f, 0.f};
            unsigned long long msk = __ballot(myinv >= 0) & 0xffffull;
            constexpr float fs = 1.0f / pg8::OUTSLOT_SCALE;
            if (msk) {
                msk &= msk - 1; const bool two = msk != 0; msk &= msk - 1; const float f1 = two ? fs : 0.0f;
#pragma unroll
                for (int i = 0; i < 4; ++i) {
                    sum[i][0] += fs * __builtin_amdgcn_cvt_f32_fp8(cw0[i], 0) + f1 * __builtin_amdgcn_cvt_f32_fp8(cw1[i], 0); sum[i][1] += fs * __builtin_amdgcn_cvt_f32_fp8(cw0[i], 1) + f1 * __builtin_amdgcn_cvt_f32_fp8(cw1[i], 1);
                    sum[i][2] += fs * __builtin_amdgcn_cvt_f32_fp8(cw0[i], 2) + f1 * __builtin_amdgcn_cvt_f32_fp8(cw1[i], 2); sum[i][3] += fs * __builtin_amdgcn_cvt_f32_fp8(cw0[i], 3) + f1 * __builtin_amdgcn_cvt_f32_fp8(cw1[i], 3); }
            }
            while (msk) {
                const int e0 = __builtin_ctzll(msk); msk &= msk - 1; const bool two = msk != 0; const int e1 = two ? __builtin_ctzll(msk) : e0; msk &= msk - 1;
                const int s0 = lane_bcast_i(myinv, e0), s1 = lane_bcast_i(myinv, e1);
                const unsigned char* o0 = (const unsigned char*)P.outslot + (size_t)s0 * D + lane * 4; const unsigned char* o1 = (const unsigned char*)P.outslot + (size_t)s1 * D + lane * 4;
                int w0[4], w1[4];
#pragma unroll
                for (int i = 0; i < 4; ++i) { w0[i] = *(const int*)(o0 + i * 256); w1[i] = *(const int*)(o1 + i * 256); }
                const float f1 = two ? fs : 0.0f;
#pragma unroll
                for (int i = 0; i < 4; ++i) {
                    sum[i][0] += fs * __builtin_amdgcn_cvt_f32_fp8(w0[i], 0) + f1 * __builtin_amdgcn_cvt_f32_fp8(w1[i], 0); sum[i][1] += fs * __builtin_amdgcn_cvt_f32_fp8(w0[i], 1) + f1 * __builtin_amdgcn_cvt_f32_fp8(w1[i], 1);
                    sum[i][2] += fs * __builtin_amdgcn_cvt_f32_fp8(w0[i], 2) + f1 * __builtin_amdgcn_cvt_f32_fp8(w1[i], 2); sum[i][3] += fs * __builtin_amdgcn_cvt_f32_fp8(w0[i], 3) + f1 * __builtin_amdgcn_cvt_f32_fp8(w1[i], 3); }
            }
            bf16_t* xd = P.xb + (size_t)r * D;
#pragma unroll
            for (int i = 0; i < 4; ++i) { xv[i] += m5v[i] * sum[i];
                if (MODE != 2) { u32x2_t w; w.x = pk_bf16(xv[i][0], xv[i][1]); w.y = pk_bf16(xv[i][2], xv[i][3]); *(u32x2_t*)(xd + lane * 4 + i * 256) = w;
                    xv[i] = (f32x4_t){__uint_as_float(w.x << 16), __uint_as_float(w.x & 0xffff0000u), __uint_as_float(w.y << 16), __uint_as_float(w.y & 0xffff0000u)}; } }
        }
        float ss = 0.f;
#pragma unroll
        for (int i = 0; i < 4; ++i) ss += xv[i][0] * xv[i][0] + xv[i][1] * xv[i][1] + xv[i][2] * xv[i][2] + xv[i][3] * xv[i][3];
        ss = wave_sum_fast(ss);
        const float rinv = 1.0f / sqrtf(ss * (1.0f / D) + EPS);
        if (MODE == 2) {
#pragma unroll
            for (int i = 0; i < 4; ++i) *(f32x4_t*)(P.xlat + (size_t)r * D + lane * 4 + i * 256) = xv[i] * rinv * gv[i];
            continue;
        }
        f32x4_t hv[4];
#pragma unroll
        for (int i = 0; i < 4; ++i) { hv[i] = (xv[i] * rinv * gv[i]) * scv[i] + shv[i];
            if (MODE == 1) *(unsigned*)((unsigned char*)P.h + (size_t)r * D + lane * 4 + i * 256) = pg8::pack4_fp8(hv[i][0], hv[i][1], hv[i][2], hv[i][3]);
            else { u32x2_t w; w.x = pk_bf16(hv[i][0], hv[i][1]); w.y = pk_bf16(hv[i][2], hv[i][3]); *(u32x2_t*)(P.h + (size_t)r * D + lane * 4 + i * 256) = w; } }
        if (MODE == 1) {
            float lg[NE];
#pragma unroll
            for (int e = 0; e < NE; ++e) { f32x4_t a4 = hv[0] * *(const PG8_LAS f32x4_t*)(wrT + e * D + lane * 4);
#pragma unroll
                for (int i = 1; i < 4; ++i) a4 += hv[i] * *(const PG8_LAS f32x4_t*)(wrT + e * D + lane * 4 + i * 256);
                lg[e] = wave_sum_fast((a4[0] + a4[1]) + (a4[2] + a4[3]));
                asm volatile("" ::: "memory"); }
            float mx = lg[0];
#pragma unroll
            for (int e = 1; e < NE; ++e) mx = fmaxf(mx, lg[e]);
            float s = 0.f, mine = 0.f;
#pragma unroll
            for (int e = 0; e < NE; ++e) { const float ex = __expf(lg[e] - mx); s += ex; mine = (lane == e) ? ex : mine; }
            if (lane < NE) P.aff[(size_t)lane * R + r] = mine / s;
        }
    }
}
__device__ __forceinline__ float row16_max(float v) {
#define DPP_MAX(v, ctrl) fmaxf((v), __builtin_bit_cast(float, __builtin_amdgcn_update_dpp(__builtin_bit_cast(int, (v)), __builtin_bit_cast(int, (v)), (ctrl), 0xF, 0xF, false)))
    v = DPP_MAX(v, 0xB1); v = DPP_MAX(v, 0x4E); v = DPP_MAX(v, 0x141); v = DPP_MAX(v, 0x140);
#undef DPP_MAX
    return v;
}
__device__ __forceinline__ void fs_row_ffn(const Params& P, int l, PG8_LAS unsigned char* lds, int t) {
    const int lane = t & 63, wid = t >> 6, rl = lane & 15, kg = lane >> 4;
    constexpr int WROW = D + 8;
    PG8_LAS bf16_t* wThi = (PG8_LAS bf16_t*)lds;
    PG8_LAS bf16_t* wTlo = wThi + NE * WROW;
    PG8_LAS float* gsv = (PG8_LAS float*)(lds + 2 * NE * WROW * 2);
    PG8_LAS float* shv = gsv + D;
    PG8_LAS float* red = shv + D;
    PG8_LAS float* cbv = red + 32 * NE;
    const float* wr = P.moe_router + (size_t)l * D * NE; const float* gvec = P.norm_ffn_g + (size_t)l * D;
    { const bf16_t* rw = P.rw16 + (size_t)l * 2 * NE * D;
        u32x4_t pc[8];
#pragma unroll
        for (int j = 0; j < 8; ++j) pc[j] = *(const u32x4_t*)(rw + (size_t)(t + 512 * j) * 8);
#pragma unroll
        for (int j = 0; j < 8; ++j) { const int p = t + 512 * j, hl = p >> 11, e = (p >> 7) & 15, c8 = (p & 127) * 8; *(PG8_LAS u32x4_t*)((hl ? wTlo : wThi) + e * WROW + c8) = pc[j]; } }
    const int nrows = (l == DEPTH - 1) ? RL : R, ntiles = nrows / 16, nwaves = gridDim.x * 8;
    const int nextra = ntiles - nwaves;
    for (int k0 = 0; k0 < 2; ++k0) {
        if (k0 == 1 && (int)blockIdx.x >= nextra) break;
        const int tl = k0 == 0 ? (int)blockIdx.x * 8 + wid : (wid == 0 ? nwaves + (int)blockIdx.x : ntiles), r0 = tl * 16;
        const int rb = k0 == 0 ? (int)blockIdx.x * 128 : (nwaves + (int)blockIdx.x) * 16, bb = rb < RL ? rb / T : NB;
        const bool active = tl < ntiles; const int r0c = active ? r0 : 0;
        const bf16_t* xrow = P.xb + (size_t)(r0c + rl) * D + kg * 16;
        auto load8 = [&](int kb, u32x4_t (&xg)[8]) {
#pragma unroll
            for (int j = 0; j < 8; ++j) xg[j] = *(const u32x4_t*)(xrow + ((kb * 8 + j) >> 1) * 64 + ((kb * 8 + j) & 1) * 8); };
        u32x4_t xa[8], xc[8];
        f32x4_t sq0, sq1, sq2, sq3; { const f32x4_t* sp = (const f32x4_t*)(P.ssqp + (size_t)(r0c + rl) * 16); sq0 = sp[0]; sq1 = sp[1]; sq2 = sp[2]; sq3 = sp[3]; }
        load8(0, xa);
        __syncthreads();
        { const float* mr = modrow(P, l, bb);
            for (int c = t; c < D; c += 512) { gsv[c] = gvec[c] * (1.0f + mr[4 * D + c]); shv[c] = mr[3 * D + c]; } }
        __syncthreads();
        { const int e = t & 15, part = t >> 4; float s = 0.f;
#pragma unroll 8
            for (int c = part * 32; c < part * 32 + 32; ++c) s += shv[c] * (bf2f(wThi[e * WROW + c]) + bf2f(wTlo[e * WROW + c]));
            red[part * NE + e] = s; }
        __syncthreads();
        if (t < NE) { float s = 0.f;
#pragma unroll
            for (int p2 = 0; p2 < 32; ++p2) s += red[p2 * NE + t];
            cbv[t] = s; }
        __syncthreads();
        if (!active) continue;
        unsigned char* hrow = (unsigned char*)P.h + (size_t)(r0 + rl) * D + kg * 16;
        float rinv;
        { const float ss = ((sq0[0] + sq0[1]) + (sq0[2] + sq0[3])) + ((sq1[0] + sq1[1]) + (sq1[2] + sq1[3])) + ((sq2[0] + sq2[1]) + (sq2[2] + sq2[3])) + ((sq3[0] + sq3[1]) + (sq3[2] + sq3[3]));
            rinv = 1.0f / sqrtf(ss * (1.0f / D) + EPS); }
        pg8::f32x4 acc = (pg8::f32x4){0.f, 0.f, 0.f, 0.f};
        u32x2_t hpair;
        auto step = [&](int ks, const u32x4_t& xv) {
            const int c0 = (ks >> 1) * 64 + kg * 16 + (ks & 1) * 8;
            const f32x4_t g0 = *(const PG8_LAS f32x4_t*)(gsv + c0), g1 = *(const PG8_LAS f32x4_t*)(gsv + c0 + 4), s0 = *(const PG8_LAS f32x4_t*)(shv + c0), s1 = *(const PG8_LAS f32x4_t*)(shv + c0 + 4);
            const bf16x8_t bh = *(const PG8_LAS bf16x8_t*)(wThi + rl * WROW + c0), bl = *(const PG8_LAS bf16x8_t*)(wTlo + rl * WROW + c0);
            const unsigned xw[4] = {xv.x, xv.y, xv.z, xv.w};
            float a[8], hv[8];
#pragma unroll
            for (int j = 0; j < 4; ++j) { const float x0 = __uint_as_float(xw[j] << 16), x1 = __uint_as_float(xw[j] & 0xffff0000u);
                a[2 * j] = x0 * (j < 2 ? g0[2 * j] : g1[2 * j - 4]); a[2 * j + 1] = x1 * (j < 2 ? g0[2 * j + 1] : g1[2 * j - 3]);
                hv[2 * j] = a[2 * j] * rinv + (j < 2 ? s0[2 * j] : s1[2 * j - 4]); hv[2 * j + 1] = a[2 * j + 1] * rinv + (j < 2 ? s0[2 * j + 1] : s1[2 * j - 3]); }
            u32x2_t w8; w8.x = pg8::pack4_fp8(hv[0], hv[1], hv[2], hv[3]); w8.y = pg8::pack4_fp8(hv[4], hv[5], hv[6], hv[7]);
            if (ks & 1) *(u32x4_t*)(hrow + (ks >> 1) * 64) = (u32x4_t){hpair.x, hpair.y, w8.x, w8.y}; else hpair = w8;
            unsigned hw[4], lw[4];
#pragma unroll
            for (int j = 0; j < 4; ++j) { hw[j] = pk_bf16(a[2 * j], a[2 * j + 1]);
                lw[j] = pk_bf16(a[2 * j] - __uint_as_float(hw[j] << 16), a[2 * j + 1] - __uint_as_float(hw[j] & 0xffff0000u)); }
            const bf16x8_t fah = __builtin_bit_cast(bf16x8_t, (u32x4_t){hw[0], hw[1], hw[2], hw[3]}), fal = __builtin_bit_cast(bf16x8_t, (u32x4_t){lw[0], lw[1], lw[2], lw[3]});
            acc = __builtin_amdgcn_mfma_f32_16x16x32_bf16(fah, bh, acc, 0, 0, 0);
            acc = __builtin_amdgcn_mfma_f32_16x16x32_bf16(fah, bl, acc, 0, 0, 0);
            acc = __builtin_amdgcn_mfma_f32_16x16x32_bf16(fal, bh, acc, 0, 0, 0);
            asm volatile("" ::: "memory"); };
#pragma nounroll
        for (int kb = 0; kb < 4; kb += 2) {
            load8(kb + 1, xc);
#pragma unroll
            for (int j = 0; j < 8; ++j) step(kb * 8 + j, xa[j]);
            if (kb + 2 < 4) load8(kb + 2, xa);
#pragma unroll
            for (int j = 0; j < 8; ++j) step((kb + 1) * 8 + j, xc[j]);
        }
        {
            const float cb = cbv[rl]; float aff[4];
#pragma unroll
            for (int i = 0; i < 4; ++i) { const float lg = bperm_f(rinv, 4 * kg + i) * acc[i] + cb;
                const float mx = row16_max(lg), ex = __expf(lg - mx), sm = row16_sum(ex); aff[i] = ex / sm; }
            *(f32x4_t*)(P.aff + (size_t)rl * R + r0 + 4 * kg) = (f32x4_t){aff[0], aff[1], aff[2], aff[3]};
        }
    }
    __syncthreads();
}
template <int KPT>
__device__ __forceinline__ void select_list(const Params& P, const float* a, int n, int cap, int base, int slot0, int e, PG8_LAS unsigned* sm, int t) {
    PG8_LAS unsigned* hist = sm;
    PG8_LAS unsigned* ctl = sm + 256;
    const int lane = t & 63, wid = t >> 6;
    unsigned key[KPT]; bool have[KPT];
#pragma unroll
    for (int j = 0; j < KPT; ++j) { const int i = t * KPT + j; have[j] = i < n; key[j] = have[j] ? __float_as_uint(a[i]) : 0u; }
    unsigned prefix = 0u, rem = (unsigned)cap;
#pragma unroll 1
    for (int pass = 0; pass < 4; ++pass) {
        const int shift = 24 - 8 * pass;
        if (t < 256) hist[t] = 0u;
        __syncthreads();
#pragma unroll
        for (int j = 0; j < KPT; ++j) if (have[j] && (pass == 0 || (key[j] >> (shift + 8)) == prefix)) (void)__hip_atomic_fetch_add(&hist[(key[j] >> shift) & 255u], 1u, __ATOMIC_RELAXED, __HIP_MEMORY_SCOPE_WORKGROUP);
        __syncthreads();
        if (wid == 0) {
            unsigned c[4]; unsigned s = 0u;
#pragma unroll
            for (int q = 0; q < 4; ++q) { c[q] = hist[255 - 4 * lane - q]; s += c[q]; }
            unsigned inc = s;
#pragma unroll
            for (int o = 1; o < 64; o <<= 1) { const unsigned v = (unsigned)bperm_i((int)inc, (lane - o) & 63); if (lane >= o) inc += v; }
            unsigned cum = inc - s;
#pragma unroll
            for (int q = 0; q < 4; ++q) { if (cum < rem && rem <= cum + c[q]) { ctl[0] = (prefix << 8) | (unsigned)(255 - 4 * lane - q); ctl[1] = rem - cum; ctl[2] = c[q]; } cum += c[q]; }
        }
        __syncthreads();
        prefix = ctl[0]; rem = ctl[1];
    }
    const unsigned T_ = prefix, need_eq = rem, cnt_eq = ctl[2];
    int nsel = 0, ntie = 0;
#pragma unroll
    for (int j = 0; j < KPT; ++j) { nsel += (have[j] && key[j] > T_) ? 1 : 0; ntie += (have[j] && key[j] == T_) ? 1 : 0; }
    int incs = nsel, inct = ntie;
#pragma unroll
    for (int o = 1; o < 64; o <<= 1) { const int v1 = bperm_i(incs, (lane - o) & 63), v2 = bperm_i(inct, (lane - o) & 63); if (lane >= o) { incs += v1; inct += v2; } }
    if (lane == 63) { ctl[4 + wid] = (unsigned)incs; ctl[16 + wid] = (unsigned)inct; }
    __syncthreads();
    int bs = 0, bt = 0;
#pragma unroll
    for (int w2 = 0; w2 < 8; ++w2) { if (w2 < wid) { bs += (int)ctl[4 + w2]; bt += (int)ctl[16 + w2]; } }
    int gpos = bs + incs - nsel, tpos = bt + inct - ntie;
    (void)cnt_eq;
#pragma unroll
    for (int j = 0; j < KPT; ++j) if (have[j]) { const int row = base + t * KPT + j;
        const bool gt = key[j] > T_, tie = key[j] == T_, take = gt || (tie && tpos < (int)need_eq);
        const int pos = gpos + (tpos < (int)need_eq ? tpos : (int)need_eq);
        if (take) { P.sel_row[slot0 + pos] = row; P.sel_g[slot0 + pos] = __uint_as_float(key[j]); P.inv[(size_t)row * NE + e] = slot0 + pos; }
        else P.inv[(size_t)row * NE + e] = -1;
        gpos += gt ? 1 : 0; tpos += tie ? 1 : 0; }
    __syncthreads();
}
__device__ __forceinline__ void fs_select(const Params& P, int l, PG8_LAS unsigned char* lds, int t) {
    PG8_LAS unsigned* sm = (PG8_LAS unsigned*)lds;
    for (int li = blockIdx.x; li < (l == DEPTH - 1 ? 1 : 2) * NB * NE; li += gridDim.x) {
        const bool lat = li < NB * NE; const int q = lat ? li : li - NB * NE, b = q / NE, e = q % NE;
        const int base = lat ? b * T : RL + b * TC, slot0 = e * SLOTS_E + (lat ? b * CAPL : NB * CAPL + b * CAPC);
        const float* a = P.aff + (size_t)e * R + base;
        if (lat) select_list<T / 512>(P, a, T, CAPL, base, slot0, e, sm, t);
        else select_list<1>(P, a, TC, CAPC, base, slot0, e, sm, t);
    }
}
__device__ __forceinline__ void fs_gather(const Params& P, int t) {
    const int lane = t & 63, wid = t >> 6;
    for (int s = blockIdx.x * 8 + wid; s < SLOTS; s += gridDim.x * 8) {
        const bf16_t* src = P.h + (size_t)P.sel_row[s] * D + lane * 8; bf16_t* dst = P.xg + (size_t)s * D + lane * 8;
        const u32x4_t v0 = *(const u32x4_t*)src, v1 = *(const u32x4_t*)(src + 512);
        *(u32x4_t*)dst = v0; *(u32x4_t*)(dst + 512) = v1;
    }
}
__device__ __forceinline__ float neg_expm1_fast(float x) {
    const float p = x * (1.0f + x * (0.5f + x * (1.0f / 6.0f + x * (1.0f / 24.0f + x * (1.0f / 120.0f + x * (1.0f / 720.0f))))));
    return x > -0.25f ? -p : 1.0f - __expf(x);
}
struct LruRegs { unsigned x[11], g[8]; float hin; };
template <bool FINAL>
__device__ __forceinline__ void lru_load(const Params& P, int u, int hh, int t, LruRegs& r) {
    const int rest = u >> 2, c = rest % NCH, b = rest / NCH;
    const int row0 = seqrow(b, c * CH), seglo = c < NCHC ? RL + b * TC : b * T, seghi = seglo + (c < NCHC ? TC : T);
    const int cp = t & 63, tg = t >> 6, r0 = row0 + tg * 8 - 2;
    const bf16_t* zc = P.z + O_XB + hh * HD + 2 * cp;
#pragma unroll
    for (int i = 0; i < 11; ++i) { int rr = r0 + i; rr = rr < seglo ? seglo : rr; rr = rr >= seghi ? seghi - 1 : rr; r.x[i] = *(const unsigned*)(zc + (size_t)rr * NZO); }
    if (FINAL) {
        const bf16_t* zg = P.z + O_GB + hh * HD + 2 * cp;
#pragma unroll
        for (int i = 0; i < 8; ++i) r.g[i] = *(const unsigned*)(zg + (size_t)(row0 + tg * 8 + i) * NZO);
        r.hin = t < 256 ? P.hinb[((size_t)((t >> 7) * NB + b) * NCH + c) * W2 + hh * HD + (t & 127)] : 0.f;
    }
}
template <bool FINAL>
__device__ __forceinline__ void fs_odd_lru(const Params& P, int l, PG8_LAS unsigned char* lds, int t) {
    const int lane = t & 63, w = t >> 6, q = lane >> 4, fr = lane & 15;
    const int li = l >> 1, hh = blockIdx.x & 3, jch = 16 * w + fr, chg = hh * HD + jch;
    PG8_LAS bf16_t* xcb = (PG8_LAS bf16_t*)lds;
    constexpr int XROW = 132;
    PG8_LAS float* xcf = (PG8_LAS float*)(lds + 17408);
    PG8_LAS float* hs = (PG8_LAS float*)(lds + 17408 + 33792);
    PG8_LAS float* hin = (PG8_LAS float*)(lds + 17408 + 67584);
    PG8_LAS bf16_t* gbs = (PG8_LAS bf16_t*)(lds + 17408 + 67584 + 1024);
    bf16x8_t bw[2][2][4];
#pragma unroll
    for (int dir = 0; dir < 2; ++dir)
#pragma unroll
        for (int gate = 0; gate < 2; ++gate)
#pragma unroll
            for (int ks = 0; ks < 4; ++ks) bw[dir][gate][ks] = *(const bf16x8_t*)(P.gwT + ((size_t)((((li * 2 + dir) * 2 + gate) * 4 + hh) * HD + jch)) * HD + ks * 32 + 8 * q);
    constexpr float L2E = 1.4426950408889634f;
    float ba[2], bx[2], sp[2];
#pragma unroll
    for (int dir = 0; dir < 2; ++dir) { ba[dir] = -L2E * P.od_gate_a_b[(size_t)(li * 2 + dir) * W2 + chg]; bx[dir] = -L2E * P.od_gate_x_b[(size_t)(li * 2 + dir) * W2 + chg];
        sp[dir] = L2E * -8.0f * softplusf_(-P.od_lambda[(size_t)(li * 2 + dir) * W2 + chg]); }
    const int cp = t & 63, tg = t >> 6;
    float cw[4][2], cbv[2];
#pragma unroll
    for (int h2 = 0; h2 < 2; ++h2) { cbv[h2] = P.od_conv_b[(size_t)li * W2 + hh * HD + 2 * cp + h2];
#pragma unroll
        for (int j = 0; j < 4; ++j) cw[j][h2] = P.od_conv_w[(size_t)(li * 4 + j) * W2 + hh * HD + 2 * cp + h2]; }
    constexpr int NU = NB * NCH * 4;
    LruRegs rg; if ((int)blockIdx.x < NU) lru_load<FINAL>(P, blockIdx.x, hh, t, rg);
    for (int u = blockIdx.x; u < NU; u += gridDim.x) {
        const int rest = u >> 2, c = rest % NCH, b = rest / NCH;
        const int row0 = seqrow(b, c * CH), seglo = c < NCHC ? RL + b * TC : b * T, seghi = seglo + (c < NCHC ? TC : T);
        {
            const int r0 = row0 + tg * 8 - 2;
            f32x2_t xv[11];
#pragma unroll
            for (int i = 0; i < 11; ++i) { const unsigned w = (r0 + i >= seglo && r0 + i < seghi) ? rg.x[i] : 0u; xv[i] = (f32x2_t){__uint_as_float(w << 16), __uint_as_float(w & 0xffff0000u)}; }
            const f32x2_t cb2v = (f32x2_t){cbv[0], cbv[1]}, cw0 = (f32x2_t){cw[0][0], cw[0][1]}, cw1 = (f32x2_t){cw[1][0], cw[1][1]}, cw2 = (f32x2_t){cw[2][0], cw[2][1]}, cw3 = (f32x2_t){cw[3][0], cw[3][1]};
#pragma unroll
            for (int i = 0; i < 8; ++i) { const int tok = tg * 8 + i;
                const f32x2_t xc = cb2v + cw0 * xv[i] + cw1 * xv[i + 1] + cw2 * xv[i + 2] + cw3 * xv[i + 3];
                *(PG8_LAS f32x2_t*)(xcf + tok * XROW + 2 * cp) = xc; *(PG8_LAS unsigned*)(xcb + tok * 136 + 2 * cp) = pk_bf16(xc.x, xc.y); }
            if (FINAL) {
#pragma unroll
                for (int i = 0; i < 8; ++i) *(PG8_LAS unsigned*)(gbs + (tg * 8 + i) * 128 + 2 * cp) = rg.g[i];
                if (t < 256) hin[t] = rg.hin; }
        }
        __syncthreads();
        if (u + (int)gridDim.x < NU) lru_load<FINAL>(P, u + gridDim.x, hh, t, rg);
#pragma unroll
        for (int dir = 0; dir < 2; ++dir) {
            pg8::f32x4 aa[4], ax[4];
#pragma unroll
            for (int mt = 0; mt < 4; ++mt) { aa[mt] = (pg8::f32x4){0.f, 0.f, 0.f, 0.f}; ax[mt] = (pg8::f32x4){0.f, 0.f, 0.f, 0.f}; }
#pragma unroll
            for (int ks = 0; ks < 4; ++ks)
#pragma unroll
                for (int mt = 0; mt < 4; ++mt) { const bf16x8_t af = *(const PG8_LAS bf16x8_t*)(xcb + (mt * 16 + fr) * 136 + ks * 32 + 8 * q);
                    aa[mt] = __builtin_amdgcn_mfma_f32_16x16x32_bf16(af, bw[dir][0][ks], aa[mt], 0, 0, 0);
                    ax[mt] = __builtin_amdgcn_mfma_f32_16x16x32_bf16(af, bw[dir][1][ks], ax[mt], 0, 0, 0); }
            float Ac = 1.f, Bc = FINAL ? hin[dir * 128 + jch] : 0.f;
#pragma unroll
            for (int mm = 0; mm < 4; ++mm) { const int mt = dir == 0 ? mm : 3 - mm;
                float ca[4], cb2[4];
#pragma unroll
                for (int ip = 0; ip < 2; ++ip) { const int i0 = 2 * ip;
                    const f32x2_t xv = (f32x2_t){xcf[(mt * 16 + 4 * q + i0) * XROW + jch], xcf[(mt * 16 + 4 * q + i0 + 1) * XROW + jch]};
                    const f32x2_t ta = (f32x2_t){aa[mt][i0], aa[mt][i0 + 1]} * (f32x2_t){-L2E, -L2E} + (f32x2_t){ba[dir], ba[dir]};
                    const f32x2_t tx = (f32x2_t){ax[mt][i0], ax[mt][i0 + 1]} * (f32x2_t){-L2E, -L2E} + (f32x2_t){bx[dir], bx[dir]};
                    const f32x2_t da = (f32x2_t){__builtin_amdgcn_exp2f(ta.x), __builtin_amdgcn_exp2f(ta.y)} + (f32x2_t){1.0f, 1.0f};
                    const f32x2_t dx = (f32x2_t){__builtin_amdgcn_exp2f(tx.x), __builtin_amdgcn_exp2f(tx.y)} + (f32x2_t){1.0f, 1.0f};
                    const f32x2_t rg2 = (f32x2_t){__builtin_amdgcn_rcpf(da.x), __builtin_amdgcn_rcpf(da.y)}, ig2 = (f32x2_t){__builtin_amdgcn_rcpf(dx.x), __builtin_amdgcn_rcpf(dx.y)};
                    const f32x2_t l2 = rg2 * (f32x2_t){sp[dir], sp[dir]};
                    const f32x2_t a2 = (f32x2_t){__builtin_amdgcn_exp2f(l2.x), __builtin_amdgcn_exp2f(l2.y)};
                    const f32x2_t om = (f32x2_t){1.0f, 1.0f} - a2 * a2;
                    const f32x2_t sq = (f32x2_t){__builtin_amdgcn_sqrtf(fmaxf(om.x, 0.f)), __builtin_amdgcn_sqrtf(fmaxf(om.y, 0.f))};
                    const f32x2_t cb = sq * (ig2 * xv);
                    ca[i0] = a2.x; ca[i0 + 1] = a2.y; cb2[i0] = cb.x; cb2[i0 + 1] = cb.y; }
                float Al = 1.f, Bl = 0.f;
#pragma unroll
                for (int ii = 0; ii < 4; ++ii) { const int i = dir == 0 ? ii : 3 - ii; Al = ca[i] * Al; Bl = ca[i] * Bl + cb2[i]; }
                float hq = Bc;
#pragma unroll
                for (int qq = 0; qq < 4; ++qq) { const int qs = dir == 0 ? qq : 3 - qq;
                    const float Aq = bperm_f(Al, fr + 16 * qs), Bq = bperm_f(Bl, fr + 16 * qs);
                    const bool before = dir == 0 ? (qs < q) : (qs > q);
                    if (FINAL) hq = before ? Aq * hq + Bq : hq;
                    Ac = Aq * Ac; Bc = Aq * Bc + Bq; }
                if (FINAL) {
                    float h = hq;
#pragma unroll
                    for (int ii = 0; ii < 4; ++ii) { const int i = dir == 0 ? ii : 3 - ii; h = ca[i] * h + cb2[i];
                        PG8_LAS float* hp = hs + (mt * 16 + 4 * q + i) * XROW + jch; if (dir == 0) *hp = h; else *hp += h; }
                }
            }
            if (!FINAL && q == 0) { const size_t si = ((size_t)(dir * NB + b) * NCH + c) * W2 + chg; P.sumA[si] = Ac; P.sumB[si] = Bc; }
        }
        __syncthreads();
        if (FINAL) {
            const int r = row0 + tg * 8;
#pragma unroll
            for (int i = 0; i < 8; ++i) { const f32x2_t hv = *(const PG8_LAS f32x2_t*)(hs + (tg * 8 + i) * XROW + 2 * cp); const unsigned gw = *(const PG8_LAS unsigned*)(gbs + (tg * 8 + i) * 128 + 2 * cp);
                const f32x2_t gx = (f32x2_t){__uint_as_float(gw << 16), __uint_as_float(gw & 0xffff0000u)};
                const f32x2_t ag = gx * (gx * gx * (f32x2_t){0.044715f, 0.044715f} + (f32x2_t){1.0f, 1.0f}) * (f32x2_t){-2.0f * 1.4426950408889634f * 0.7978845608028654f, -2.0f * 1.4426950408889634f * 0.7978845608028654f};
                const f32x2_t dg = (f32x2_t){__builtin_amdgcn_exp2f(ag.x), __builtin_amdgcn_exp2f(ag.y)} + (f32x2_t){1.0f, 1.0f};
                const f32x2_t yv = hv * gx * (f32x2_t){__builtin_amdgcn_rcpf(dg.x), __builtin_amdgcn_rcpf(dg.y)};
                *(unsigned*)(P.m + (size_t)(r + i) * D + hh * HD + 2 * cp) = pk_bf16(yv.x, yv.y); }
            __syncthreads();
        }
    }
}
__device__ __forceinline__ void fs_sgstat(const Params& P, int lane, int wid, int nw);
__device__ __forceinline__ void fs_odd2(const Params& P, int t) {
    if (t >= 64) { fs_sgstat(P, t & 63, (t >> 6) - 1, 7); return; }
    if (t >= 32) return;
    static_assert(NCH % 17 == 0, "chunk steps are taken 17 at a time");
    for (int it = blockIdx.x * 32 + t; it < 2 * NB * W2; it += gridDim.x * 32) {
        const int ch = it % W2, b = (it / W2) % NB, dir = it / (W2 * NB);
        const size_t base = ((size_t)(dir * NB + b) * NCH) * W2 + ch;
        const float* __restrict__ sA = P.sumA + base; const float* __restrict__ sB = P.sumB + base; float* __restrict__ hb = P.hinb + base;
        float h = 0.f;
#pragma unroll 1
        for (int s0 = 0; s0 < NCH; s0 += 17) {
            float A[17], B[17];
#pragma unroll
            for (int j = 0; j < 17; ++j) { const int step = s0 + j, c = dir == 0 ? step : (step < NCHC ? NCHC - 1 - step : NCH - 1 - (step - NCHC)); A[j] = sA[(size_t)c * W2]; B[j] = sB[(size_t)c * W2]; }
#pragma unroll
            for (int j = 0; j < 17; ++j) { const int step = s0 + j, c = dir == 0 ? step : (step < NCHC ? NCHC - 1 - step : NCH - 1 - (step - NCHC)); hb[(size_t)c * W2] = h; h = A[j] * h + B[j]; }
        }
    }
}
__device__ __forceinline__ void fs_sgstat(const Params& P, int lane, int wid, int nw  ) {
    const int stride = gridDim.x * nw;
    for (int r0 = blockIdx.x * nw + wid; r0 < R; r0 += 4 * stride) {
        u32x4_t w[4];
#pragma unroll
        for (int j = 0; j < 4; ++j) { const int r = r0 + j * stride < R ? r0 + j * stride : r0; w[j] = *(const u32x4_t*)(P.z + (size_t)r * NZO + O_V + lane * 8); }
#pragma unroll
        for (int j = 0; j < 4; ++j) { const int r = r0 + j * stride;
            const unsigned ww[4] = {w[j].x, w[j].y, w[j].z, w[j].w};
            float g[8];
#pragma unroll
            for (int i = 0; i < 4; ++i) { g[2 * i] = fgelu(__uint_as_float(ww[i] << 16)); g[2 * i + 1] = fgelu(__uint_as_float(ww[i] & 0xffff0000u)); }
            float s = 0.f;
#pragma unroll
            for (int i = 0; i < 8; ++i) s += g[i];
            const float mean = wave_sum(s) * (1.0f / W2);
            float vs = 0.f;
#pragma unroll
            for (int i = 0; i < 8; ++i) { const float d = g[i] - mean; vs += d * d; }
            vs = wave_sum(vs);
            if (lane == 0 && r < R) { P.sgstat[2 * r] = mean; P.sgstat[2 * r + 1] = 1.0f / sqrtf(vs * (1.0f / W2) + EPS); } }
    }
}
__device__ __forceinline__ void fs_odd_sg(const Params& P, int l, PG8_LAS unsigned char* lds, int t) {
    const int lane = t & 63, w = t >> 6, q = lane >> 4, fr = lane & 15, li = l >> 1, g = blockIdx.x & 3;
    PG8_LAS bf16_t* vbT = (PG8_LAS bf16_t*)lds;
    bf16x8_t aw[4];
#pragma unroll
    for (int ks = 0; ks < 4; ++ks) aw[ks] = *(const bf16x8_t*)(P.sgw + ((size_t)((li * 4 + g) * SGC + 16 * w + fr)) * SGC + ks * 32 + 8 * q);
    float sgb[4];
#pragma unroll
    for (int ii = 0; ii < 4; ++ii) sgb[ii] = P.od_sg_b[(size_t)(li * 4 + g) * SGC + 16 * w + 4 * q + ii];
    const int cc = t & 127, jp = t >> 7; const float gn = P.od_sg_norm_g[(size_t)li * W2 + g * HD + cc];
    for (int u = (blockIdx.x + gridDim.x / 2) % gridDim.x; u < (R / SGC) * 4; u += gridDim.x) {
        const int base = (u >> 2) * SGC;
        { const bf16_t* zv = P.z + O_V + g * HD + cc;
            bf16_t vr[32]; f32x4_t sv[16];
#pragma unroll
            for (int jj = 0; jj < 16; ++jj) { const int r0 = base + (jp * 16 + jj) * 2;
                vr[2 * jj] = zv[(size_t)r0 * NZO]; vr[2 * jj + 1] = zv[(size_t)(r0 + 1) * NZO]; sv[jj] = *(const f32x4_t*)(P.sgstat + 2 * r0); }
#pragma unroll
            for (int jj = 0; jj < 16; ++jj) { const int j = (jp * 16 + jj) * 2;
                const float v0 = (fgelu(bf2f(vr[2 * jj])) - sv[jj][0]) * sv[jj][1] * gn;
                const float v1 = (fgelu(bf2f(vr[2 * jj + 1])) - sv[jj][2]) * sv[jj][3] * gn;
                *(PG8_LAS unsigned*)(vbT + cc * 136 + j) = pk_bf16(v0, v1); } }
        __syncthreads();
        bf16_t ur[32];
#pragma unroll
        for (int ct = 0; ct < 8; ++ct)
#pragma unroll
            for (int ii = 0; ii < 4; ++ii) ur[ct * 4 + ii] = P.z[(size_t)(base + 16 * w + 4 * q + ii) * NZO + O_U + g * HD + ct * 16 + fr];
        pg8::f32x4 acc[8];
#pragma unroll
        for (int ct = 0; ct < 8; ++ct) acc[ct] = (pg8::f32x4){0.f, 0.f, 0.f, 0.f};
#pragma unroll
        for (int ks = 0; ks < 4; ++ks)
#pragma unroll
            for (int ct = 0; ct < 8; ++ct) { const bf16x8_t bf = *(const PG8_LAS bf16x8_t*)(vbT + (ct * 16 + fr) * 136 + ks * 32 + 8 * q);
                acc[ct] = __builtin_amdgcn_mfma_f32_16x16x32_bf16(aw[ks], bf, acc[ct], 0, 0, 0); }
#pragma unroll
        for (int ct = 0; ct < 8; ++ct)
#pragma unroll
            for (int ii = 0; ii < 4; ++ii) { const int row = base + 16 * w + 4 * q + ii, c = g * HD + ct * 16 + fr;
                const float uu = bf2f(ur[ct * 4 + ii]);
                P.m[(size_t)row * D + W2 + c] = f2bf(fgelu(uu) * (acc[ct][ii] + sgb[ii])); }
        __syncthreads();
    }
}
constexpr int LRS_ROW = 40;
constexpr int LAT_ROW = 68;
struct GlaUp { bf16x8_t b[4]; float bias[4]; };
__device__ __forceinline__ void gla_load_up(const Params& P, int li, int hh, int t, GlaUp& g) {
    const int lane = t & 63, w = t >> 6, q = lane >> 4, fr = lane & 15, dir = w >> 2;
    unsigned keep = (q >> 1) == dir ? 0xffffffffu : 0u; asm volatile("" : "+v"(keep));
#pragma unroll
    for (int j = 0; j < 4; ++j) { const int dcol = hh * DK + j * 16 + fr; unsigned pk[4];
#pragma unroll
        for (int i2 = 0; i2 < 4; ++i2) { const int r0 = 8 * (q & 1) + 2 * i2;
            const float a = P.ev_decay_up[((size_t)(li * 2 + dir) * RANK + r0) * KEY + dcol], b2 = P.ev_decay_up[((size_t)(li * 2 + dir) * RANK + r0 + 1) * KEY + dcol];
            pk[i2] = pk_bf16(a, b2) & keep; }
        g.b[j] = __builtin_bit_cast(bf16x8_t, (u32x4_t){pk[0], pk[1], pk[2], pk[3]});
        g.bias[j] = P.ev_decay_b[(size_t)(li * 2 + dir) * KEY + dcol]; }
}
__device__ __forceinline__ void gla_preact(const PG8_LAS bf16_t* lrs, const GlaUp& g, PG8_LAS float* laT, int t) {
    const int lane = t & 63, w = t >> 6, q = lane >> 4, fr = lane & 15, mt = w & 3, dir = w >> 2;
    const bf16x8_t af = *(const PG8_LAS bf16x8_t*)(lrs + (mt * 16 + fr) * LRS_ROW + 8 * q);
#pragma unroll
    for (int j = 0; j < 4; ++j) { const pg8::f32x4 acc = __builtin_amdgcn_mfma_f32_16x16x32_bf16(af, g.b[j], (pg8::f32x4){0.f, 0.f, 0.f, 0.f}, 0, 0, 0);
        f32x4_t la;
#pragma unroll
        for (int ii = 0; ii < 4; ++ii) { const float x = acc[ii] + g.bias[j]; la[ii] = (fminf(x, 0.f) - __logf(1.0f + __expf(-fabsf(x)))) * (1.0f / 16.0f); }
        *(PG8_LAS f32x4_t*)(laT + ((dir * 4 + j) * 16 + fr) * LAT_ROW + mt * 16 + 4 * q) = la; }
}
__device__ __forceinline__ void gla_local_cumsum(const PG8_LAS float* laT, int d, int tok_first, float (&csf)[8], float (&csb)[8]) {
    const f32x4_t a0 = *(const PG8_LAS f32x4_t*)(laT + d * LAT_ROW + tok_first), a1 = *(const PG8_LAS f32x4_t*)(laT + d * LAT_ROW + tok_first + 4);
    const f32x4_t b0 = *(const PG8_LAS f32x4_t*)(laT + (64 + d) * LAT_ROW + tok_first), b1 = *(const PG8_LAS f32x4_t*)(laT + (64 + d) * LAT_ROW + tok_first + 4);
#pragma unroll
    for (int i = 0; i < 4; ++i) { csf[i] = a0[i]; csf[4 + i] = a1[i]; csb[i] = b0[i]; csb[4 + i] = b1[i]; }
#pragma unroll
    for (int i = 1; i < 8; ++i) csf[i] += csf[i - 1];
#pragma unroll
    for (int i = 6; i >= 0; --i) csb[i] += csb[i + 1];
}
__device__ __forceinline__ unsigned st8_pack4(float a, float b, float c, float d) {
    return pg8::pack4_fp8(__builtin_amdgcn_fmed3f(a, -448.f, 448.f), __builtin_amdgcn_fmed3f(b, -448.f, 448.f), __builtin_amdgcn_fmed3f(c, -448.f, 448.f), __builtin_amdgcn_fmed3f(d, -448.f, 448.f)); }
__device__ __forceinline__ u32x4_t st8_to_bf16x8(u32x2_t w) {
    return (u32x4_t){pk_bf16(__builtin_amdgcn_cvt_f32_fp8((int)w.x, 0), __builtin_amdgcn_cvt_f32_fp8((int)w.x, 1)), pk_bf16(__builtin_amdgcn_cvt_f32_fp8((int)w.x, 2), __builtin_amdgcn_cvt_f32_fp8((int)w.x, 3)),
                      pk_bf16(__builtin_amdgcn_cvt_f32_fp8((int)w.y, 0), __builtin_amdgcn_cvt_f32_fp8((int)w.y, 1)), pk_bf16(__builtin_amdgcn_cvt_f32_fp8((int)w.y, 2), __builtin_amdgcn_cvt_f32_fp8((int)w.y, 3))}; }
struct GlaRegs { u32x2_t lr; bf16_t k[8], q[8], v[16], g[16]; u32x2_t s[2][2]; };
template <bool E3>
__device__ __forceinline__ void gla_load(const Params& P, int u, int hh, int t, GlaRegs& r) {
    const int rest = u >> 2, c = rest % NCH, b = rest / NCH, row0 = seqrow(b, c * CH);
    const int d = t & 63, sg = t >> 6, e = t & 127, jp = t >> 7;
    r.lr = *(const u32x2_t*)(P.z + (size_t)(row0 + (t >> 3)) * NZE + E_LRF + (t & 7) * 4);
#pragma unroll
    for (int i = 0; i < 8; ++i) { const bf16_t* zr = P.z + (size_t)(row0 + sg * 8 + i) * NZE + hh * DK + d; r.k[i] = zr[E_K]; if (E3) r.q[i] = zr[E_Q]; }
#pragma unroll
    for (int jj = 0; jj < 16; ++jj) r.v[jj] = P.z[(size_t)(row0 + jp * 16 + jj) * NZE + E_V + hh * DV + e];
    if (E3) {
        const int lane = t & 63, w = t >> 6, q = lane >> 4, fr = lane & 15, it = w & 3, wh = w >> 2;
#pragma unroll
        for (int ii = 0; ii < 4; ++ii)
#pragma unroll
            for (int el = 0; el < 4; ++el) r.g[ii * 4 + el] = P.z[(size_t)(row0 + it * 16 + 4 * q + ii) * NZE + E_G + hh * DV + (wh * 4 + el) * 16 + fr];
#pragma unroll
        for (int dir = 0; dir < 2; ++dir) { const unsigned char* Sb = (const unsigned char*)P.SinB + ((size_t)((dir * NB + b) * GH + hh) * NCH + c) * DV * DK;
#pragma unroll
            for (int i = 0; i < 2; ++i) r.s[dir][i] = *(const u32x2_t*)(Sb + (size_t)(t + 512 * i) * 8); }
    }
}
__device__ __forceinline__ void gla_store_common(const GlaRegs& r, PG8_LAS bf16_t* lrs, PG8_LAS bf16_t* vT, int t) {
    *(PG8_LAS u32x2_t*)(lrs + (t >> 3) * LRS_ROW + (t & 7) * 4) = r.lr;
    const int e = t & 127, jp = t >> 7;
#pragma unroll
    for (int jj = 0; jj < 16; jj += 2) *(PG8_LAS unsigned*)(vT + e * 72 + jp * 16 + jj) = (unsigned)r.v[jj] | ((unsigned)r.v[jj + 1] << 16);
}
constexpr int LRS1_ROW = 40;
struct GlaUp1 { bf16x8_t b; float bias[4]; };
__device__ __forceinline__ void gla_load_up1(const Params& P, int li, int hh, int t, GlaUp1& g) {
    const int lane = t & 63, w = t >> 6, q = lane >> 4, fr = lane & 15, dir = w >> 2, dt = w & 3;
    unsigned keep = (q >> 1) == dir ? 0xffffffffu : 0u; asm volatile("" : "+v"(keep));
    const int dcol = hh * DK + dt * 16 + fr; unsigned pk[4];
#pragma unroll
    for (int i2 = 0; i2 < 4; ++i2) { const int r0 = 8 * (q & 1) + 2 * i2;
        const float a = P.ev_decay_up[((size_t)(li * 2 + dir) * RANK + r0) * KEY + dcol], b2 = P.ev_decay_up[((size_t)(li * 2 + dir) * RANK + r0 + 1) * KEY + dcol];
        pk[i2] = pk_bf16(a, b2) & keep; }
    g.b = __builtin_bit_cast(bf16x8_t, (u32x4_t){pk[0], pk[1], pk[2], pk[3]});
#pragma unroll
    for (int ii = 0; ii < 4; ++ii) g.bias[ii] = P.ev_decay_b[(size_t)(li * 2 + dir) * KEY + hh * DK + dt * 16 + 4 * q + ii];
}
__device__ __forceinline__ void gla_decay_scan(const PG8_LAS bf16_t* lrs, const GlaUp1& g, int t, float (&bl)[4][4], float (&tot)[4]) {
    const int lane = t & 63, w = t >> 6, q = lane >> 4, fr = lane & 15, dir = w >> 2;
#pragma unroll
    for (int mt = 0; mt < 4; ++mt) { const bf16x8_t tf = *(const PG8_LAS bf16x8_t*)(lrs + (mt * 16 + fr) * LRS1_ROW + 8 * q);
        const pg8::f32x4 acc = __builtin_amdgcn_mfma_f32_16x16x32_bf16(g.b, tf, (pg8::f32x4){0.f, 0.f, 0.f, 0.f}, 0, 0, 0);
#pragma unroll
        for (int ii = 0; ii < 4; ++ii) { const float x = acc[ii] + g.bias[ii]; bl[mt][ii] = (fminf(x, 0.f) - __logf(1.0f + __expf(-fabsf(x)))) * (1.0f / 16.0f); } }
#pragma unroll
    for (int ii = 0; ii < 4; ++ii) tot[ii] = 0.f;
    if (dir == 0) {
#pragma unroll
        for (int mt = 0; mt < 4; ++mt)
#pragma unroll
            for (int ii = 0; ii < 4; ++ii) { float v = bl[mt][ii]; v = DPP_ADD(v, 0x111); v = DPP_ADD(v, 0x112); v = DPP_ADD(v, 0x114); v = DPP_ADD(v, 0x118);
                const float tt = bperm_f(v, lane | 15); bl[mt][ii] = v + tot[ii]; tot[ii] += tt; }
    } else {
#pragma unroll
        for (int mt = 3; mt >= 0; --mt)
#pragma unroll
            for (int ii = 0; ii < 4; ++ii) { float v = bl[mt][ii]; v = DPP_ADD(v, 0x101); v = DPP_ADD(v, 0x102); v = DPP_ADD(v, 0x104); v = DPP_ADD(v, 0x108);
                const float tt = bperm_f(v, lane & 48); bl[mt][ii] = v + tot[ii]; tot[ii] += tt; }
    }
}
struct GlaRegs1 { u32x2_t lr, k[4], q[4]; u32x4_t v[2]; u32x2_t s[2][2]; };
template <bool E3>
__device__ __forceinline__ void gla_load1(const Params& P, int u, int hh, int t, GlaRegs1& r) {
    const int rest = u >> 2, c = rest % NCH, b = rest / NCH, row0 = seqrow(b, c * CH);
    const int lane = t & 63, w = t >> 6, q = lane >> 4, fr = lane & 15, dt = w & 3;
    r.lr = *(const u32x2_t*)(P.z + (size_t)(row0 + (t >> 3)) * NZE + E_LRF + (t & 7) * 4);
#pragma unroll
    for (int mt = 0; mt < 4; ++mt) { const bf16_t* zr = P.z + (size_t)(row0 + mt * 16 + fr) * NZE + hh * DK + dt * 16 + 4 * q;
        r.k[mt] = *(const u32x2_t*)(zr + E_K); if (E3) r.q[mt] = *(const u32x2_t*)(zr + E_Q); }
#pragma unroll
    for (int i = 0; i < 2; ++i) { const int p = t + 512 * i, tok = p & 63, eg = p >> 6; r.v[i] = *(const u32x4_t*)(P.z + (size_t)(row0 + tok) * NZE + E_V + hh * DV + eg * 8); }
    if (E3) {
#pragma unroll
        for (int dir = 0; dir < 2; ++dir) { const unsigned char* Sb = (const unsigned char*)P.SinB + ((size_t)((dir * NB + b) * GH + hh) * NCH + c) * DV * DK;
#pragma unroll
            for (int i = 0; i < 2; ++i) r.s[dir][i] = *(const u32x2_t*)(Sb + (size_t)(t + 512 * i) * 8); }
    }
}
__device__ __forceinline__ void gla_store_common1(const GlaRegs1& r, PG8_LAS bf16_t* lrs, PG8_LAS bf16_t* vT, int t) {
    *(PG8_LAS u32x2_t*)(lrs + (t >> 3) * LRS1_ROW + (t & 7) * 4) = r.lr;
#pragma unroll
    for (int i = 0; i < 2; ++i) { const int p = t + 512 * i, tok = p & 63, eg = p >> 6; const unsigned wv[4] = {r.v[i].x, r.v[i].y, r.v[i].z, r.v[i].w};
#pragma unroll
        for (int j = 0; j < 4; ++j) { vT[(eg * 8 + 2 * j) * 72 + tok] = (bf16_t)(wv[j] & 0xffffu); vT[(eg * 8 + 2 * j + 1) * 72 + tok] = (bf16_t)(wv[j] >> 16); } }
}
__device__ __forceinline__ void fs_even1(const Params& P, int l, PG8_LAS unsigned char* lds, int t) {
    const int lane = t & 63, w = t >> 6, q = lane >> 4, fr = lane & 15, li = l >> 1, hh = blockIdx.x & 3, wdir = w >> 2, dt = w & 3;
    PG8_LAS bf16_t* vT = (PG8_LAS bf16_t*)lds;
    PG8_LAS bf16_t* kdT = (PG8_LAS bf16_t*)(lds + 18432);
    PG8_LAS bf16_t* lrs = (PG8_LAS bf16_t*)(lds + 18432 + 18432);
    PG8_LAS bf16_t* sst = (PG8_LAS bf16_t*)(lds + 18432 + 18432 + 5120);
    GlaUp1 gu; gla_load_up1(P, li, hh, t, gu);
    constexpr int NU = NB * NCH * 4;
    GlaRegs1 rg; if ((int)blockIdx.x < NU) gla_load1<false>(P, blockIdx.x, hh, t, rg);
    for (int u = blockIdx.x; u < NU; u += gridDim.x) {
        const int rest = u >> 2, c = rest % NCH, b = rest / NCH;
        gla_store_common1(rg, lrs, vT, t);
        u32x2_t kraw[4];
#pragma unroll
        for (int mt = 0; mt < 4; ++mt) kraw[mt] = rg.k[mt];
        __syncthreads();
        if (u + (int)gridDim.x < NU) gla_load1<false>(P, u + gridDim.x, hh, t, rg);
        {
            float bl[4][4], tot[4];
            gla_decay_scan(lrs, gu, t, bl, tot);
#pragma unroll
            for (int mt = 0; mt < 4; ++mt) { const unsigned kw[2] = {kraw[mt].x, kraw[mt].y};
#pragma unroll
                for (int ii = 0; ii < 4; ++ii) { const float kk = (ii & 1) ? __uint_as_float(kw[ii >> 1] & 0xffff0000u) : __uint_as_float(kw[ii >> 1] << 16);
                    kdT[wdir * 64 * 72 + (dt * 16 + 4 * q + ii) * 72 + mt * 16 + fr] = (bf16_t)pk_bf16(kk * __expf(tot[ii] - bl[mt][ii]), 0.f); } }
            if (fr == 0) { float* dv = P.decv + ((size_t)((wdir * NB + b) * GH + hh) * NCH + c) * DK + dt * 16 + 4 * q;
                *(f32x4_t*)dv = (f32x4_t){__expf(tot[0]), __expf(tot[1]), __expf(tot[2]), __expf(tot[3])}; }
        }
        __syncthreads();
#pragma unroll
        for (int dir = 0; dir < 2; ++dir) {
            pg8::f32x4 acc[4];
#pragma unroll
            for (int dt2 = 0; dt2 < 4; ++dt2) acc[dt2] = (pg8::f32x4){0.f, 0.f, 0.f, 0.f};
#pragma unroll
            for (int ks = 0; ks < 2; ++ks) { const bf16x8_t af = *(const PG8_LAS bf16x8_t*)(vT + (16 * w + fr) * 72 + ks * 32 + 8 * q);
#pragma unroll
                for (int dt2 = 0; dt2 < 4; ++dt2) { const bf16x8_t bfr = *(const PG8_LAS bf16x8_t*)(kdT + dir * 64 * 72 + (dt2 * 16 + fr) * 72 + ks * 32 + 8 * q);
                    acc[dt2] = __builtin_amdgcn_mfma_f32_16x16x32_bf16(af, bfr, acc[dt2], 0, 0, 0); } }
#pragma unroll
            for (int dt2 = 0; dt2 < 4; ++dt2)
#pragma unroll
                for (int ii = 0; ii < 4; ++ii) sst[dir * 128 * 72 + (16 * w + 4 * q + ii) * 72 + dt2 * 16 + fr] = (bf16_t)pk_bf16(acc[dt2][ii], 0.f);
        }
        __syncthreads();
#pragma unroll
        for (int dir = 0; dir < 2; ++dir) { unsigned char* Sb = (unsigned char*)P.Sd + ((size_t)((dir * NB + b) * GH + hh) * NCH + c) * DV * DK;
#pragma unroll
            for (int i = 0; i < 2; ++i) { const int f = t + 512 * i, e = f >> 3, d8 = (f & 7) * 8; const u32x4_t w = *(const PG8_LAS u32x4_t*)(sst + dir * 128 * 72 + e * 72 + d8);
                *(u32x2_t*)(Sb + (size_t)f * 8) = (u32x2_t){st8_pack4(__uint_as_float(w.x << 16), __uint_as_float(w.x & 0xffff0000u), __uint_as_float(w.y << 16), __uint_as_float(w.y & 0xffff0000u)),
                                                              st8_pack4(__uint_as_float(w.z << 16), __uint_as_float(w.z & 0xffff0000u), __uint_as_float(w.w << 16), __uint_as_float(w.w & 0xffff0000u))}; } }
        __syncthreads();
    }
}
__device__ __forceinline__ void fs_even2(const Params& P, int t) {
    for (int it = blockIdx.x * 512 + t; it < 2 * NB * GH * DV * (DK / 4); it += gridDim.x * 512) {
        const int d4 = it % (DK / 4), e = (it / (DK / 4)) % DV, hh = (it / (DK / 4 * DV)) % GH, b = (it / (DK / 4 * DV * GH)) % NB, dir = it / (DK / 4 * DV * GH * NB);
        const size_t cb0 = ((size_t)((dir * NB + b) * GH + hh) * NCH) * DV * DK + (size_t)e * DK + d4 * 4;
        const unsigned char* __restrict__ Sb = (const unsigned char*)P.Sd + cb0; unsigned char* __restrict__ So = (unsigned char*)P.SinB + cb0;
        const float* __restrict__ dv = P.decv + ((size_t)((dir * NB + b) * GH + hh) * NCH) * DK + d4 * 4;
        f32x4_t s = (f32x4_t){0.f, 0.f, 0.f, 0.f};
        static_assert(NCH % 4 == 0, "chunk steps are taken four at a time");
        auto chunk_of = [&](int step) { return dir == 0 ? step : (step < NCHC ? NCHC - 1 - step : NCH - 1 - (step - NCHC)); };
        unsigned tw[4], tn[4]; f32x4_t dc[4], dn[4];
#pragma unroll
        for (int j = 0; j < 4; ++j) { const int c = chunk_of(j); tw[j] = *(const unsigned*)(Sb + (size_t)c * DV * DK); dc[j] = *(const f32x4_t*)(dv + (size_t)c * DK); }
#pragma unroll 1
        for (int s0 = 0; s0 < NCH; s0 += 4) {
            if (s0 + 4 < NCH) {
#pragma unroll
                for (int j = 0; j < 4; ++j) { const int c = chunk_of(s0 + 4 + j); tn[j] = *(const unsigned*)(Sb + (size_t)c * DV * DK); dn[j] = *(const f32x4_t*)(dv + (size_t)c * DK); } }
#pragma unroll
            for (int j = 0; j < 4; ++j) { const int c = chunk_of(s0 + j);
                const f32x4_t tmp = (f32x4_t){__builtin_amdgcn_cvt_f32_fp8((int)tw[j], 0), __builtin_amdgcn_cvt_f32_fp8((int)tw[j], 1), __builtin_amdgcn_cvt_f32_fp8((int)tw[j], 2), __builtin_amdgcn_cvt_f32_fp8((int)tw[j], 3)};
                *(unsigned*)(So + (size_t)c * DV * DK) = st8_pack4(s[0], s[1], s[2], s[3]); s = dc[j] * s + tmp; }
#pragma unroll
            for (int j = 0; j < 4; ++j) { tw[j] = tn[j]; dc[j] = dn[j]; }
        }
    }
}
__device__ __forceinline__ void fs_even3(const Params& P, int l, PG8_LAS unsigned char* lds, int t) {
    const int lane = t & 63, w = t >> 6, q = lane >> 4, fr = lane & 15, li = l >> 1, hh = blockIdx.x & 3, d = t & 63, sg = t >> 6;
    PG8_LAS bf16_t* vT = (PG8_LAS bf16_t*)lds;
    PG8_LAS bf16_t* qd = (PG8_LAS bf16_t*)(lds + 18432);
    PG8_LAS bf16_t* kd = (PG8_LAS bf16_t*)(lds + 18432 + 18432);
    PG8_LAS bf16_t* sT = (PG8_LAS bf16_t*)(lds + 18432 * 3);
    PG8_LAS bf16_t* att = (PG8_LAS bf16_t*)(lds + 18432 * 5);
    PG8_LAS float* tot = (PG8_LAS float*)(lds + 18432 * 6);
    PG8_LAS float* ssq = tot + 1024;
    PG8_LAS bf16_t* lrs = (PG8_LAS bf16_t*)(lds + 18432 * 6 + 4096 + 512);
    GlaUp1 gu; gla_load_up1(P, li, hh, t, gu);
    const int it = w & 3, wh = w >> 2;
    float ng[4];
#pragma unroll
    for (int el = 0; el < 4; ++el) ng[el] = P.ev_norm_g[(size_t)li * W2 + hh * DV + (wh * 4 + el) * 16 + fr];
    constexpr int NU = NB * NCH * 4;
    GlaRegs1 rg; if ((int)blockIdx.x < NU) gla_load1<true>(P, blockIdx.x, hh, t, rg);
    for (int u = blockIdx.x; u < NU; u += gridDim.x) {
        const int rest = u >> 2, c = rest % NCH, b = rest / NCH, row0 = seqrow(b, c * CH);
        gla_store_common1(rg, lrs, vT, t);
#pragma unroll
        for (int dir = 0; dir < 2; ++dir)
#pragma unroll
            for (int i = 0; i < 2; ++i) { const int f = t + 512 * i, e = f >> 3, d8 = (f & 7) * 8; *(PG8_LAS u32x4_t*)(sT + dir * 128 * 72 + e * 72 + d8) = st8_to_bf16x8(rg.s[dir][i]); }
        u32x2_t kraw[4], qraw[4];
#pragma unroll
        for (int mt = 0; mt < 4; ++mt) { kraw[mt] = rg.k[mt]; qraw[mt] = rg.q[mt]; }
        __syncthreads();
        bf16_t graw[16];
#pragma unroll
        for (int ii = 0; ii < 4; ++ii)
#pragma unroll
            for (int el = 0; el < 4; ++el) graw[ii * 4 + el] = P.z[(size_t)(row0 + it * 16 + 4 * q + ii) * NZE + E_G + hh * DV + (wh * 4 + el) * 16 + fr];
        if (u + (int)gridDim.x < NU) gla_load1<true>(P, u + gridDim.x, hh, t, rg);
        {
            float bl[4][4], tot[4];
            gla_decay_scan(lrs, gu, t, bl, tot);
#pragma unroll
            for (int mt = 0; mt < 4; ++mt) { const unsigned kw[2] = {kraw[mt].x, kraw[mt].y}, qw[2] = {qraw[mt].x, qraw[mt].y}; float qv[4], kv[4];
#pragma unroll
                for (int ii = 0; ii < 4; ++ii) { const float kk = (ii & 1) ? __uint_as_float(kw[ii >> 1] & 0xffff0000u) : __uint_as_float(kw[ii >> 1] << 16);
                    const float qq = ((ii & 1) ? __uint_as_float(qw[ii >> 1] & 0xffff0000u) : __uint_as_float(qw[ii >> 1] << 16)) * 0.125f;
                    const float ef = __expf(bl[mt][ii]); qv[ii] = qq * ef; kv[ii] = kk * __builtin_amdgcn_rcpf(ef); }
                const int o = wh * 64 * 72 + (mt * 16 + fr) * 72 + it * 16 + 4 * q;
                *(PG8_LAS u32x2_t*)(qd + o) = (u32x2_t){pk_bf16(qv[0], qv[1]), pk_bf16(qv[2], qv[3])};
                *(PG8_LAS u32x2_t*)(kd + o) = (u32x2_t){pk_bf16(kv[0], kv[1]), pk_bf16(kv[2], kv[3])}; }
        }
        __syncthreads();
#pragma unroll
        for (int dir = 0; dir < 2; ++dir)
#pragma unroll
            for (int jl = 0; jl < 2; ++jl) { const int jt = wh * 2 + jl;
                pg8::f32x4 a4 = (pg8::f32x4){0.f, 0.f, 0.f, 0.f};
                if (dir == 0 ? (jt <= it) : (jt >= it)) {
#pragma unroll
                    for (int ks = 0; ks < 2; ++ks) { const bf16x8_t af = *(const PG8_LAS bf16x8_t*)(qd + dir * 64 * 72 + (it * 16 + fr) * 72 + ks * 32 + 8 * q);
                        const bf16x8_t bfr = *(const PG8_LAS bf16x8_t*)(kd + dir * 64 * 72 + (jt * 16 + fr) * 72 + ks * 32 + 8 * q);
                        a4 = __builtin_amdgcn_mfma_f32_16x16x32_bf16(af, bfr, a4, 0, 0, 0); } }
#pragma unroll
                for (int ii = 0; ii < 4; ++ii) { const int i = it * 16 + 4 * q + ii, j = jt * 16 + fr; const bool keep = dir == 0 ? (j <= i) : (j >= i);
                    att[dir * 64 * 72 + i * 72 + j] = (bf16_t)pk_bf16(keep ? a4[ii] : 0.f, 0.f); } }
        __syncthreads();
        pg8::f32x4 o[4];
#pragma unroll
        for (int el = 0; el < 4; ++el) o[el] = (pg8::f32x4){0.f, 0.f, 0.f, 0.f};
#pragma unroll
        for (int dir = 0; dir < 2; ++dir)
#pragma unroll
            for (int ks = 0; ks < 2; ++ks) { const bf16x8_t aa = *(const PG8_LAS bf16x8_t*)(att + dir * 64 * 72 + (it * 16 + fr) * 72 + ks * 32 + 8 * q);
                const bf16x8_t aq = *(const PG8_LAS bf16x8_t*)(qd + dir * 64 * 72 + (it * 16 + fr) * 72 + ks * 32 + 8 * q);
#pragma unroll
                for (int el = 0; el < 4; ++el) { const int et = wh * 4 + el;
                    const bf16x8_t bv = *(const PG8_LAS bf16x8_t*)(vT + (et * 16 + fr) * 72 + ks * 32 + 8 * q);
                    const bf16x8_t bs = *(const PG8_LAS bf16x8_t*)(sT + dir * 128 * 72 + (et * 16 + fr) * 72 + ks * 32 + 8 * q);
                    o[el] = __builtin_amdgcn_mfma_f32_16x16x32_bf16(aa, bv, o[el], 0, 0, 0);
                    o[el] = __builtin_amdgcn_mfma_f32_16x16x32_bf16(aq, bs, o[el], 0, 0, 0); } }
#pragma unroll
        for (int ii = 0; ii < 4; ++ii) { float s = 0.f;
#pragma unroll
            for (int el = 0; el < 4; ++el) s += o[el][ii] * o[el][ii];
            s = row16_sum(s);
            if (fr == 0) ssq[wh * 64 + it * 16 + 4 * q + ii] = s; }
        __syncthreads();
#pragma unroll
        for (int ii = 0; ii < 4; ++ii) { const int i = it * 16 + 4 * q + ii; const float rinv = 1.0f / sqrtf((ssq[i] + ssq[64 + i]) * (1.0f / DV) + EPS);
            const size_t row = (size_t)(row0 + i);
#pragma unroll
            for (int el = 0; el < 4; ++el) { const int e = hh * DV + (wh * 4 + el) * 16 + fr; const float gg = bf2f(graw[ii * 4 + el]);
                P.m[row * D + W2 + e] = (bf16_t)pk_bf16(o[el][ii] * rinv * ng[el] * fsilu(gg), 0.f); } }
    }
}
__device__ __forceinline__ void fs_even_conv(const Params& P, int l, int t) {
    const int li = l >> 1;
    for (int it = (int)((blockIdx.x + gridDim.x / 2) % gridDim.x) * 512 + t; it < (R / 4) * (W2 / 8); it += gridDim.x * 512) {
        const int rowb = (it / (W2 / 8)) * 4, c8 = (it % (W2 / 8)) * 8;
        bool lv, rv;
        if (rowb < RL) { const int pos = (rowb % T) % GRIDW; lv = pos > 0; rv = pos + 3 < GRIDW - 1; } else { const int tt = (rowb - RL) % TC; lv = tt > 0; rv = tt + 3 < TC - 1; }
        const bf16_t* zr = P.z + (size_t)rowb * NZE + c8;
        u32x4_t cg[6], xa[6], bg[4];
#pragma unroll
        for (int i = 0; i < 6; ++i) { const int dr = (i == 0 && !lv) ? 0 : (i == 5 && !rv) ? 3 : i - 1;
            cg[i] = *(const u32x4_t*)(zr + (ptrdiff_t)dr * NZE + E_CG); xa[i] = *(const u32x4_t*)(zr + (ptrdiff_t)dr * NZE + E_XA); }
#pragma unroll
        for (int i = 0; i < 4; ++i) bg[i] = *(const u32x4_t*)(zr + (size_t)i * NZE + E_BG);
        const float* cw = P.ev_conv_w + (size_t)li * 3 * W2 + c8; const float* cb = P.ev_conv_b + (size_t)li * W2 + c8;
        float w0[8], w1[8], w2[8], bb[8];
#pragma unroll
        for (int cc = 0; cc < 8; ++cc) { w0[cc] = cw[cc]; w1[cc] = cw[W2 + cc]; w2[cc] = cw[2 * W2 + cc]; bb[cc] = cb[cc]; }
        float p[6][8];
#pragma unroll
        for (int i = 0; i < 6; ++i) { const bool ok = (i == 0) ? lv : (i == 5) ? rv : true;
            const unsigned cv_[4] = {cg[i].x, cg[i].y, cg[i].z, cg[i].w}, xv_[4] = {xa[i].x, xa[i].y, xa[i].z, xa[i].w};
#pragma unroll
            for (int pp = 0; pp < 4; ++pp) { p[i][2 * pp] = ok ? __uint_as_float(cv_[pp] << 16) * __uint_as_float(xv_[pp] << 16) : 0.f;
                p[i][2 * pp + 1] = ok ? __uint_as_float(cv_[pp] & 0xffff0000u) * __uint_as_float(xv_[pp] & 0xffff0000u) : 0.f; } }
#pragma unroll
        for (int i = 0; i < 4; ++i) { const unsigned bv_[4] = {bg[i].x, bg[i].y, bg[i].z, bg[i].w}; float o[8];
#pragma unroll
            for (int cc = 0; cc < 8; ++cc) { const float bgf = (cc & 1) ? __uint_as_float(bv_[cc >> 1] & 0xffff0000u) : __uint_as_float(bv_[cc >> 1] << 16);
                o[cc] = bgf * (bb[cc] + w0[cc] * p[i][cc] + w1[cc] * p[i + 1][cc] + w2[cc] * p[i + 2][cc]); }
            u32x4_t ow; ow.x = pk_bf16(o[0], o[1]); ow.y = pk_bf16(o[2], o[3]); ow.z = pk_bf16(o[4], o[5]); ow.w = pk_bf16(o[6], o[7]);
            *(u32x4_t*)(P.m + (size_t)(rowb + i) * D + c8) = ow; }
    }
}
#endif

#ifdef CPU_EMU
#define GEMM_CALL(PAIR, A, Bt, G, Mg, N, K, epi) gemm_stage<PAIR>(A, Bt, G, Mg, N, K, epi)
DEV void do_stage(const Params& P, int l, int st) {
    const int tid_ = threadIdx.x;
#else
__device__ __forceinline__ void do_stage(const Params& P, int l, int st, PG8_LAS unsigned char* lds, int tid_in) {
#endif
#ifndef CPU_EMU
    int tid_ = tid_in; asm volatile("" : "+v"(tid_));
    if (st == ST_SILU) return;
    if (st == ST_MOD) { fs_wconv(P, lds, tid_); __syncthreads(); fs_mod(P, lds, tid_); return; }
    if (st == ST_ROW_MIX) { fs_row<0>(P, l, lds, tid_); return; }
    if (st == ST_ROW_FFN) { fs_row_ffn(P, l, lds, tid_); return; }
    if (st == ST_ROW_FINAL) { fs_row<2>(P, l, lds, tid_); return; }
    if (st == ST_SELECT_WCONV) { fs_select(P, l, lds, tid_); if (PROBE_SET == 14) { __syncthreads(); fs_select(P, l, lds, tid_); } fs_moe_wconv(P, l, lds, tid_, 1 << 30); return; }
    if (st == ST_GATHER2) { fs_gather(P, tid_); return; }
#define REP(kk, call) do { call; if (PROBE_SET == (kk)) { __syncthreads(); call; } } while (0)
    if (st == ST_EVEN1) { REP(6, fs_even1(P, l, lds, tid_)); return; }
    if (st == ST_EVEN2) { fs_even2(P, tid_); return; }
    if (st == ST_EVEN3) { fs_even3(P, l, lds, tid_); REP(8, fs_even_conv(P, l, tid_)); return; }
    if (st == ST_ODD1) { fs_odd_lru<false>(P, l, lds, tid_); return; }
    if (st == ST_ODD2) { fs_odd2(P, tid_); return; }
    if (st == ST_ODD3) {
        if (PROBE_SET == 70) { int nrep_; asm volatile("s_mov_b32 %0, 2" : "=s"(nrep_));
#pragma nounroll
            for (int rep_ = 0; rep_ < nrep_; ++rep_) { int tt_ = tid_; asm volatile("" : "+v"(tt_) :: "memory"); fs_odd_lru<true>(P, l, lds, tt_); __syncthreads(); } }
        else fs_odd_lru<true>(P, l, lds, tid_);
        REP(12, fs_odd_sg(P, l, lds, tid_)); return; }
#endif
    const int li = l >> 1;
    const bool even = (l & 1) == 0;
    const int ldz = even ? NZE : NZO;
    switch (st) {
    case ST_SILU: {
        GSL(i, (NB + 1) * D) { const int bb = (int)(i / D), k = (int)(i % D); const float v = bb < NB ? P.c[(size_t)bb * D + k] : P.c_ctx[k]; P.sbuf[i] = siluf_(v); }
    } break;
    case ST_MOD: {
        GSL(i, (long)DEPTH * (NB + 1) * MODW) {
            const int j = (int)(i % MODW), bb = (int)((i / MODW) % (NB + 1)), ll = (int)(i / ((long)MODW * (NB + 1)));
            float acc = P.ada_b[(size_t)ll * MODW + j];
            const float* w = P.ada_w + (size_t)ll * D * MODW + j; const float* s = P.sbuf + (size_t)bb * D;
            for (int k = 0; k < D; ++k) acc += s[k] * w[(size_t)k * MODW];
            P.mod[i] = acc;
        }
    } break;
    case ST_WCONV: {
        GSL(i, 2L * NZE * D) { const int q = (int)(i / ((long)NZE * D)), n = (int)((i / D) % NZE), k = (int)(i % D);
            P.wt_ev_in[i] = n < EV_IN ? f2bf(P.ev_w_in[((size_t)q * D + k) * EV_IN + n]) : (bf16_t)0; }
        GSL(i, 2L * NZO * D) { const int q = (int)(i / ((long)NZO * D)), n = (int)((i / D) % NZO), k = (int)(i % D);
            P.wt_od_in[i] = f2bf(P.od_w_in[((size_t)q * D + k) * NZO + n]); }
        GSL(i, 2L * D * D) { const int q = (int)(i / ((long)D * D)), n = (int)((i / D) % D), k = (int)(i % D);
            P.wt_ev_out[i] = f2bf(P.ev_w_out[((size_t)q * D + k) * D + n]);
            P.wt_od_out[i] = f2bf(P.od_w_out[((size_t)q * D + k) * D + n]); }
    } break;
    case ST_NORM_STATS_MIX: case ST_NORM_STATS_FFN: case ST_FINAL_STATS: {
        const int nrows = st == ST_FINAL_STATS ? RL : R;
        GSL(r, nrows) { const float* xr = st == ST_NORM_STATS_MIX ? xsrc_row(P, l, (int)r) : x_row(P, (int)r);
            float ss = 0.f; for (int j = 0; j < D; ++j) ss += xr[j] * xr[j];
            P.rinv[r] = rsq_(ss / D + EPS); }
    } break;
    case ST_NORM_APPLY_MIX: case ST_NORM_APPLY_FFN: {
        const bool mix = st == ST_NORM_APPLY_MIX;
        const float* g = (mix ? P.norm_mix_g : P.norm_ffn_g) + (size_t)l * D;
        GSL(i, (long)R * D) { const int r = (int)(i / D), j = (int)(i % D);
            const float* mr = modrow(P, l, row_bb(r));
            const float xv = mix ? xsrc_row(P, l, r)[j] : x_row(P, r)[j];
            const float hv = (xv * P.rinv[r] * g[j]) * (1.0f + mr[(mix ? 1 : 4) * D + j]) + mr[(mix ? 0 : 3) * D + j];
            P.h[i] = f2bf(hv); }
    } break;
    case ST_GEMM_IN: {
        const bf16_t* wt = even ? P.wt_ev_in + (size_t)li * NZE * D : P.wt_od_in + (size_t)li * NZO * D;
#ifdef CPU_EMU
        EpiZ_ e; e.z = P.z; e.ldz = ldz;
        GEMM_CALL(false, P.h, wt, 1, R, ldz, D, e);
#else
        pg8::Gemm g{P.h, wt, D}; pg8::StaticOrder S; S.init(R, ldz, (int)gridDim.x, (int)blockIdx.x);
        pg8::EpiZ8 e{P.z, ldz}; pg8::gemm_phase<false, false>(lds, g, S, e, tid_);
        fs_moe_wconv(P, l, lds, tid_, even ? WQ_QUOTA_IN_EVEN : WQ_QUOTA_IN_ODD);
#endif
    } break;
    case ST_E_LA: {
        GSL(i, 2L * NB * NCH * KEY) {
            const int col = (int)(i % KEY), c = (int)((i / KEY) % NCH), b = (int)((i / ((long)KEY * NCH)) % NB), dir = (int)(i / ((long)KEY * NCH * NB));
            const float* up = P.ev_decay_up + ((size_t)li * 2 + dir) * RANK * KEY;
            const float bias = P.ev_decay_b[((size_t)li * 2 + dir) * KEY + col];
            float acc = 0.f;
            for (int s = 0; s < CH; ++s) {
                const int sp = dir == 0 ? s : CH - 1 - s;
                const int row = seqrow(b, c * CH + sp);
                const bf16_t* lr = P.z + (size_t)row * ldz + (dir == 0 ? E_LRF : E_LRB);
                float xx = bias;
                for (int rr = 0; rr < RANK; ++rr) xx += bf2f(lr[rr]) * up[(size_t)rr * KEY + col];
                acc += logsigmoidf_(xx) * (1.0f / 16.0f);
                P.bcum[((size_t)dir * R + row) * KEY + col] = acc;
            }
        }
    } break;
    case ST_E_DS: {
        GSL(i, 2L * NB * GH * NCH * DK * DV) {
            const int e = (int)(i % DV), d = (int)((i / DV) % DK), c = (int)((i / ((long)DV * DK)) % NCH), hh = (int)((i / ((long)DV * DK * NCH)) % GH),
                      b = (int)((i / ((long)DV * DK * NCH * GH)) % NB), dir = (int)(i / ((long)DV * DK * NCH * GH * NB));
            const int rend = seqrow(b, c * CH + (dir == 0 ? CH - 1 : 0));
            const float bend = P.bcum[((size_t)dir * R + rend) * KEY + hh * DK + d];
            float acc = 0.f;
            for (int j = 0; j < CH; ++j) { const int row = seqrow(b, c * CH + j);
                const float kk = bf2f(P.z[(size_t)row * ldz + E_K + hh * DK + d]), vv = bf2f(P.z[(size_t)row * ldz + E_V + hh * DV + e]);
                acc += kk * expf(bend - P.bcum[((size_t)dir * R + row) * KEY + hh * DK + d]) * vv; }
            P.S[i] = acc;
        }
    } break;
    case ST_E_SCAN: {
        GSL(i, 2L * NB * GH * DK * DV) {
            const int e = (int)(i % DV), d = (int)((i / DV) % DK), hh = (int)((i / ((long)DV * DK)) % GH), b = (int)((i / ((long)DV * DK * GH)) % NB), dir = (int)(i / ((long)DV * DK * GH * NB));
            float s = 0.f;
            for (int step = 0; step < NCH; ++step) {
                const int c = dir == 0 ? step : (step < NCHC ? NCHC - 1 - step : NCH - 1 - (step - NCHC));
                const size_t idx = (((((size_t)dir * NB + b) * GH + hh) * NCH + c) * DK + d) * DV + e;
                const int rend = seqrow(b, c * CH + (dir == 0 ? CH - 1 : 0));
                const float dec = expf(P.bcum[((size_t)dir * R + rend) * KEY + hh * DK + d]);
                const float tmp = P.S[idx]; P.S[idx] = s; s = dec * s + tmp;
            }
        }
    } break;
    case ST_E_ATT: {
        const float scale = 1.0f / sqrtf((float)DK);
        GSL(i, 2L * NB * GH * NCH * CH * CH) {
            const int j = (int)(i % CH), ii = (int)((i / CH) % CH), c = (int)((i / ((long)CH * CH)) % NCH), hh = (int)((i / ((long)CH * CH * NCH)) % GH),
                      b = (int)((i / ((long)CH * CH * NCH * GH)) % NB), dir = (int)(i / ((long)CH * CH * NCH * GH * NB));
            float acc = 0.f;
            if (dir == 0 ? (j <= ii) : (j >= ii)) {
                const int ri = seqrow(b, c * CH + ii), rj = seqrow(b, c * CH + j);
                for (int d = 0; d < DK; ++d) {
                    const float qq = bf2f(P.z[(size_t)ri * ldz + E_Q + hh * DK + d]) * scale, kk = bf2f(P.z[(size_t)rj * ldz + E_K + hh * DK + d]);
                    acc += qq * kk * expf(P.bcum[((size_t)dir * R + ri) * KEY + hh * DK + d] - P.bcum[((size_t)dir * R + rj) * KEY + hh * DK + d]); }
            }
            P.att[i] = acc;
        }
    } break;
    case ST_E_O: {
        const float scale = 1.0f / sqrtf((float)DK);
        GSL(i, (long)NB * GH * NCH * CH * DV) {
            const int e = (int)(i % DV), ii = (int)((i / DV) % CH), c = (int)((i / ((long)DV * CH)) % NCH), hh = (int)((i / ((long)DV * CH * NCH)) % GH), b = (int)(i / ((long)DV * CH * NCH * GH));
            const int ri = seqrow(b, c * CH + ii);
            float acc = 0.f;
            for (int dir = 0; dir < 2; ++dir) {
                const size_t cb = ((((size_t)dir * NB + b) * GH + hh) * NCH + c);
                const float* at = P.att + (cb * CH + ii) * CH;
                for (int j = 0; j < CH; ++j) { const int rj = seqrow(b, c * CH + j); acc += at[j] * bf2f(P.z[(size_t)rj * ldz + E_V + hh * DV + e]); }
                const float* Sin = P.S + cb * DK * DV;
                for (int d = 0; d < DK; ++d) {
                    const float qq = bf2f(P.z[(size_t)ri * ldz + E_Q + hh * DK + d]) * scale;
                    acc += qq * expf(P.bcum[((size_t)dir * R + ri) * KEY + hh * DK + d]) * Sin[(size_t)d * DV + e]; }
            }
            P.o[(size_t)ri * W2 + hh * DV + e] = acc;
        }
    } break;
    case ST_E_READOUT: {
        const float* ng = P.ev_norm_g + (size_t)li * W2;
        GSL(i, (long)R * GH) { const int row = (int)(i / GH), hh = (int)(i % GH);
            const float* orow = P.o + (size_t)row * W2 + hh * DV;
            float ss = 0.f; for (int e = 0; e < DV; ++e) ss += orow[e] * orow[e];
            const float rinv = rsq_(ss / DV + EPS);
            for (int e = 0; e < DV; ++e) { const float g = bf2f(P.z[(size_t)row * ldz + E_G + hh * DV + e]);
                P.m[(size_t)row * D + W2 + hh * DV + e] = f2bf(orow[e] * rinv * ng[hh * DV + e] * siluf_(g)); }
        }
    } break;
    case ST_E_CONV: {
        const float* cw = P.ev_conv_w + (size_t)li * 3 * W2; const float* cb = P.ev_conv_b + (size_t)li * W2;
        GSL(i, (long)R * W2) { const int row = (int)(i / W2), col = (int)(i % W2);
            bool lv, rv;
            if (row < RL) { const int pos = (row % T) % GRIDW; lv = pos > 0; rv = pos < GRIDW - 1; }
            else { const int t = (row - RL) % TC; lv = t > 0; rv = t < TC - 1; }
            const bf16_t* zr = P.z + (size_t)row * ldz;
            float acc = cb[col] + cw[W2 + col] * (bf2f(zr[E_CG + col]) * bf2f(zr[E_XA + col]));
            if (lv) acc += cw[col] * (bf2f(zr[E_CG + col - ldz]) * bf2f(zr[E_XA + col - ldz]));
            if (rv) acc += cw[2 * W2 + col] * (bf2f(zr[E_CG + col + ldz]) * bf2f(zr[E_XA + col + ldz]));
            P.m[(size_t)row * D + col] = f2bf(bf2f(zr[E_BG + col]) * acc); }
    } break;
    case ST_O_XC: {
        const float* cw = P.od_conv_w + (size_t)li * 4 * W2; const float* cb = P.od_conv_b + (size_t)li * W2;
        GSL(i, (long)R * W2) { const int row = (int)(i / W2), col = (int)(i % W2);
            int t, len; if (row < RL) { t = row % T; len = T; } else { t = (row - RL) % TC; len = TC; }
            float acc = cb[col];
            for (int j = 0; j < 4; ++j) { const int tt = t - 2 + j; if (tt >= 0 && tt < len) acc += cw[j * W2 + col] * bf2f(P.z[(size_t)(row - 2 + j) * ldz + O_XB + col]); }
            P.xc[i] = acc; }
    } break;
    case ST_O_COEF: {
        GSL(i, 2L * R * W2) { const int col = (int)(i % W2), row = (int)((i / W2) % R), dir = (int)(i / ((long)W2 * R));
            const int hh = col / HD, jj = col % HD;
            const float* wa = P.od_gate_a_w + ((((size_t)li * 2 + dir) * 4 + hh) * HD) * HD + jj;
            const float* wx = P.od_gate_x_w + ((((size_t)li * 2 + dir) * 4 + hh) * HD) * HD + jj;
            const float* xr = P.xc + (size_t)row * W2 + hh * HD;
            float ra = P.od_gate_a_b[((size_t)li * 2 + dir) * W2 + col], rx = P.od_gate_x_b[((size_t)li * 2 + dir) * W2 + col];
            for (int k = 0; k < HD; ++k) { ra += xr[k] * wa[(size_t)k * HD]; rx += xr[k] * wx[(size_t)k * HD]; }
            const float rg = sigmoidf_(ra), ig = sigmoidf_(rx);
            const float log_a = -8.0f * rg * softplusf_(-P.od_lambda[((size_t)li * 2 + dir) * W2 + col]);
            P.A[i] = expf(log_a);
            P.Bc[i] = sqrtf(-expm1f(2.0f * log_a)) * (ig * P.xc[(size_t)row * W2 + col]); }
    } break;
    case ST_O_SCAN: {
        GSL(i, 2L * NB * W2) { const int col = (int)(i % W2), b = (int)((i / W2) % NB), dir = (int)(i / ((long)W2 * NB));
            float hc = 0.f;
            for (int step = 0; step < SEQ_ALL; ++step) {
                const int s = dir == 0 ? step : (step < TC ? TC - 1 - step : TC + (T - 1 - (step - TC)));
                const size_t idx = ((size_t)dir * R + seqrow(b, s)) * W2 + col;
                hc = P.A[idx] * hc + P.Bc[idx]; P.Bc[idx] = hc; }
        }
    } break;
    case ST_O_YREC: {
        GSL(i, (long)R * W2) { const int row = (int)(i / W2), col = (int)(i % W2);
            const float gb = bf2f(P.z[(size_t)row * ldz + O_GB + col]);
            P.m[(size_t)row * D + col] = f2bf((P.Bc[i] + P.Bc[(size_t)R * W2 + i]) * geluf_(gb)); }
    } break;
    case ST_O_SGSTAT: {
        GSL(r, R) { const bf16_t* vr = P.z + (size_t)r * ldz + O_V;
            float s = 0.f; for (int j = 0; j < W2; ++j) s += geluf_(bf2f(vr[j]));
            const float mean = s / W2; float vs = 0.f;
            for (int j = 0; j < W2; ++j) { const float dlt = geluf_(bf2f(vr[j])) - mean; vs += dlt * dlt; }
            P.sgstat[2 * r] = mean; P.sgstat[2 * r + 1] = rsq_(vs / W2 + EPS); }
    } break;
    case ST_O_VB: {
        const float* gn = P.od_sg_norm_g + (size_t)li * W2;
        GSL(i, (long)R * W2) { const int row = (int)(i / W2), col = (int)(i % W2);
            P.vb[i] = (geluf_(bf2f(P.z[(size_t)row * ldz + O_V + col])) - P.sgstat[2 * row]) * P.sgstat[2 * row + 1] * gn[col]; }
    } break;
    case ST_O_SGMIX: {
        GSL(i, (long)R * W2) { const int row = (int)(i / W2), col = (int)(i % W2);
            const int t = row < RL ? row % T : (row - RL) % TC;
            const int ii = t % SGC, base = row - ii, g = col / HD;
            const float* w = P.od_sg_w + (((size_t)li * 4 + g) * SGC + ii) * SGC;
            float acc = P.od_sg_b[((size_t)li * 4 + g) * SGC + ii];
            for (int j = 0; j < SGC; ++j) acc += w[j] * P.vb[(size_t)(base + j) * W2 + col];
            P.m[(size_t)row * D + W2 + col] = f2bf(geluf_(bf2f(P.z[(size_t)row * ldz + O_U + col])) * acc); }
    } break;
    case ST_GEMM_OUT: {
        const bf16_t* wt = (even ? P.wt_ev_out : P.wt_od_out) + (size_t)li * D * D;
#ifdef CPU_EMU
        EpiWout_ e; e.P = &P; e.l = l;
        GEMM_CALL(false, P.m, wt, 1, R, D, D, e);
#else
        pg8::Gemm g{P.m, wt, D}; pg8::StaticOrder S; S.init(l == DEPTH - 1 ? RL : R, D, (int)gridDim.x, (int)blockIdx.x);
        if (l == 0) { pg8::EpiWoutB<true> e{P.x, P.ctx, P.xb, P.mod + (size_t)l * (NB + 1) * MODW, P.ssqp}; pg8::gemm_phase<false, false>(lds, g, S, e, tid_); }
        else { pg8::EpiWoutB<false> e{nullptr, nullptr, P.xb, P.mod + (size_t)l * (NB + 1) * MODW, P.ssqp}; pg8::gemm_phase<false, false>(lds, g, S, e, tid_); }
        fs_moe_wconv(P, l, lds, tid_, (even ? WQ_QUOTA_IN_EVEN : WQ_QUOTA_IN_ODD) + WQ_QUOTA_OUT);
#endif
    } break;
    case ST_ROUTER_LOGIT: {
        const float* g = P.norm_ffn_g + (size_t)l * D; const float* wr = P.moe_router + (size_t)l * D * NE;
        GSL(i, (long)R * NE) { const int r = (int)(i / NE), e = (int)(i % NE);
            const float* mr = modrow(P, l, row_bb(r)); const float* xr = x_row(P, r); const float ri = P.rinv[r];
            float acc = 0.f;
            for (int j = 0; j < D; ++j) acc += ((xr[j] * ri * g[j]) * (1.0f + mr[4 * D + j]) + mr[3 * D + j]) * wr[(size_t)j * NE + e];
            P.logit[i] = acc; }
    } break;
    case ST_ROUTER_SOFTMAX: {
        GSL(r, R) { const float* lg = P.logit + (size_t)r * NE; float mx = lg[0]; for (int e = 1; e < NE; ++e) mx = fmaxf(mx, lg[e]);
            float s = 0.f;
            for (int e = 0; e < NE; ++e) s += expf(lg[e] - mx);
            for (int e = 0; e < NE; ++e) P.aff[(size_t)r * NE + e] = expf(lg[e] - mx) / s; }
    } break;
    case ST_MOE_WCONV: {
        const float* wg = P.moe_w_gate + (size_t)l * NE * D * D; const float* wu = P.moe_w_up + (size_t)l * NE * D * D; const float* wd = P.moe_w_down + (size_t)l * NE * D * D;
        GSL(i, (long)NE * 2 * D * D) { const int e = (int)(i / (2L * D * D)), cv = (int)((i / D) % (2 * D)), k = (int)(i % D);
            const int w = cv % 256, j = (cv / 256) * 128 + (w % 128);
            P.wt_gu[i] = f2bf((w >= 128 ? wu : wg)[((size_t)e * D + k) * D + j]); }
        GSL(i, (long)NE * D * D) { const int e = (int)(i / ((long)D * D)), n = (int)((i / D) % D), k = (int)(i % D);
            P.wt_dn[i] = f2bf(wd[((size_t)e * D + k) * D + n]); }
    } break;
    case ST_SELECT: {
        GSL(i, (long)R * NE) { const int e = (int)(i / R), r = (int)(i % R);
            int base, n, cap, slot0;
            if (r < RL) { const int b = r / T; base = b * T; n = T; cap = CAPL; slot0 = b * CAPL; }
            else { const int b = (r - RL) / TC; base = RL + b * TC; n = TC; cap = CAPC; slot0 = NB * CAPL + b * CAPC; }
            const float a = P.aff[(size_t)r * NE + e];
            int rank = 0;
            for (int t = 0; t < n; ++t) { const float o = P.aff[(size_t)(base + t) * NE + e]; rank += (o > a || (o == a && base + t < r)) ? 1 : 0; }
            if (rank < cap) { const int slot = e * SLOTS_E + slot0 + rank; P.sel_row[slot] = r; P.sel_g[slot] = a; P.inv[(size_t)r * NE + e] = slot; }
            else P.inv[(size_t)r * NE + e] = -1; }
    } break;
    case ST_GATHER: {
        GSL(i, (long)SLOTS * D) { const int slot = (int)(i / D), j = (int)(i % D); P.xg[i] = P.h[(size_t)P.sel_row[slot] * D + j]; }
    } break;
    case ST_GEMM_GU: {
#ifdef CPU_EMU
        EpiGU_ e; e.hid = P.hid;
        GEMM_CALL(true, P.xg, P.wt_gu, NE, SLOTS_E, 2 * D, D, e);
#else
        pg8::Gemm g{P.h, P.wt_gu, D}; pg8::GroupedOrder S; S.init(l == DEPTH - 1 ? NB * CAPL : SLOTS_E, SLOTS_E, 2 * D, NE, (int)gridDim.x, (int)blockIdx.x);
        PG8_LAS int* gix = (PG8_LAS int*)(lds + GEMM_LDS_BYTES + 16);
        for (int kk = tid_ >> 8; kk < GIX_UNITS; kk += 2) { pg8::Unit uu; if (S.next(kk, uu)) gix[kk * 256 + (tid_ & 255)] = P.sel_row[uu.pm * 256 + (tid_ & 255)]; }
        __syncthreads();
        pg8::EpiGU_F8 e{(unsigned char*)P.hid, 2 * D / 256}; pg8::gemm_phase<true, true>(lds, g, S, e, tid_, gix);
#endif
    } break;
    case ST_GEMM_DOWN: {
#ifdef CPU_EMU
        EpiDown_ e; e.out = P.outslot; e.selg = P.sel_g;
        GEMM_CALL(false, P.hid, P.wt_dn, NE, SLOTS_E, D, D, e);
#else
        pg8::Gemm g{P.hid, P.wt_dn, D}; pg8::GroupedOrder S; S.init(l == DEPTH - 1 ? NB * CAPL : SLOTS_E, SLOTS_E, D, NE, (int)gridDim.x, (int)blockIdx.x);
        pg8::EpiDown8 e{(unsigned char*)P.outslot, P.sel_g, D / 256, 1.0f / pg8::W8_SCALE}; pg8::gemm_phase<false, true>(lds, g, S, e, tid_);
#endif
    } break;
    case ST_COMBINE: {
        GSL(i, (long)R * D) { const int r = (int)(i / D), j = (int)(i % D);
            float s = 0.f;
            for (int e = 0; e < NE; ++e) { const int sl = P.inv[(size_t)r * NE + e]; if (sl >= 0) s += bf2f(P.outslot[(size_t)sl * D + j]); }
            float* xr = x_row(P, r); xr[j] += modrow(P, l, row_bb(r))[5 * D + j] * s; }
    } break;
    case ST_FINAL_APPLY: {
        GSL(i, (long)RL * D) { const int r = (int)(i / D), j = (int)(i % D); P.xlat[i] = P.xlat[i] * P.rinv[r] * P.norm_final_g[j]; }
    } break;
    default: break;
    }
}

template <class F> inline void stage_program(F&& run) {
    run(0, ST_SILU); run(0, ST_MOD); run(0, ST_WCONV);
    for (int l = 0; l < DEPTH; ++l) {
        run(l, ST_NORM_STATS_MIX); run(l, ST_NORM_APPLY_MIX); run(l, ST_GEMM_IN);
        if ((l & 1) == 0) { run(l, ST_E_LA); run(l, ST_E_DS); run(l, ST_E_SCAN); run(l, ST_E_ATT); run(l, ST_E_O); run(l, ST_E_READOUT); run(l, ST_E_CONV); }
        else { run(l, ST_O_XC); run(l, ST_O_COEF); run(l, ST_O_SCAN); run(l, ST_O_YREC); run(l, ST_O_SGSTAT); run(l, ST_O_VB); run(l, ST_O_SGMIX); }
        run(l, ST_GEMM_OUT);
        run(l, ST_NORM_STATS_FFN); run(l, ST_NORM_APPLY_FFN); run(l, ST_ROUTER_LOGIT); run(l, ST_ROUTER_SOFTMAX); run(l, ST_MOE_WCONV);
        run(l, ST_SELECT); run(l, ST_GATHER); run(l, ST_GEMM_GU); run(l, ST_GEMM_DOWN); run(l, ST_COMBINE);
    }
    run(0, ST_FINAL_STATS); run(0, ST_FINAL_APPLY);
}

struct KArgs { const float* in[32]; float* out; char* ws; };
#ifdef CPU_EMU
#define HD_ inline
#else
#define HD_ __host__ __device__ __forceinline__
#endif
struct Carver { char* base; size_t off; template <class Tp> HD_ Tp* take(size_t n) { off = (off + 255) & ~(size_t)255; Tp* p = (Tp*)(base + off); off += n * sizeof(Tp); return p; } };
HD_ size_t carve(Params& p, void* d_ws) {
    Carver cv{(char*)d_ws, 0};
    p.bar = cv.take<unsigned>(4096); p.wq = p.bar + 3584;
    p.mod = cv.take<float>((size_t)DEPTH * (NB + 1) * MODW); p.sbuf = cv.take<float>((size_t)(NB + 1) * D); p.xctx = cv.take<float>((size_t)RC * D);
    p.rinv = cv.take<float>(R); p.aff = cv.take<float>((size_t)R * NE); p.logit = cv.take<float>((size_t)R * NE); p.sel_g = cv.take<float>(SLOTS);
    p.sel_row = cv.take<int>(SLOTS); p.inv = cv.take<int>((size_t)R * NE);
    p.wt_ev_in = cv.take<bf16_t>(2ull * NZE * D); p.wt_od_in = cv.take<bf16_t>(2ull * NZO * D); p.wt_ev_out = cv.take<bf16_t>(2ull * D * D); p.wt_od_out = cv.take<bf16_t>(2ull * D * D);
    p.rw16 = cv.take<bf16_t>((size_t)DEPTH * 2 * NE * D); p.gwT = cv.take<bf16_t>(2ull * 2 * 2 * 4 * HD * HD); p.sgw = cv.take<bf16_t>(2ull * 4 * SGC * SGC); p.sumA = cv.take<float>(2ull * NB * NCH * W2); p.sumB = cv.take<float>(2ull * NB * NCH * W2); p.decv = cv.take<float>(2ull * NB * GH * NCH * DK); p.hinb = cv.take<float>(2ull * NB * NCH * W2); p.ssqp = cv.take<float>((size_t)R * 16);
    p.xb = cv.take<bf16_t>((size_t)R * D);
    p.wt_gu = cv.take<bf16_t>((size_t)NE * 2 * D * D); p.wt_dn = cv.take<bf16_t>((size_t)NE * D * D); p.h = cv.take<bf16_t>((size_t)R * D);
    const size_t u0 = (cv.off + 255) & ~(size_t)255;
    p.z = cv.take<bf16_t>((size_t)R * NZE); p.m = cv.take<bf16_t>((size_t)R * D);
    const size_t u1 = cv.off;
#ifdef CPU_EMU
    p.bcum = cv.take<float>(2ull * R * KEY); p.att = cv.take<float>(2ull * NB * GH * NCH * CH * CH); p.o = cv.take<float>((size_t)R * W2);
#endif
#ifdef CPU_EMU
    p.S = cv.take<float>(2ull * NB * GH * NCH * DK * DV);
#endif
    p.Sd = cv.take<bf16_t>(2ull * NB * GH * NCH * DK * DV); p.SinB = cv.take<bf16_t>(2ull * NB * GH * NCH * DK * DV);
    size_t end = cv.off;
    cv.off = u1;
    p.sgstat = cv.take<float>(2ull * R);
#ifdef CPU_EMU
    p.xc = cv.take<float>((size_t)R * W2); p.A = cv.take<float>(2ull * R * W2); p.Bc = cv.take<float>(2ull * R * W2); p.vb = cv.take<float>((size_t)R * W2);
#endif
    if (cv.off > end) end = cv.off;
    cv.off = u0;
    p.xg = cv.take<bf16_t>((size_t)SLOTS * D); p.hid = cv.take<bf16_t>((size_t)SLOTS * D); p.outslot = cv.take<bf16_t>((size_t)SLOTS * D);
    if (cv.off > end) end = cv.off;
    return end;
}
HD_ void fill_inputs(Params& p, const float* const* in, void* d_out) {
    p.x = in[0]; p.c = in[1]; p.ctx = in[2]; p.c_ctx = in[3]; p.ada_w = in[4]; p.ada_b = in[5]; p.norm_mix_g = in[6]; p.norm_ffn_g = in[7]; p.norm_final_g = in[8];
    p.ev_w_in = in[9]; p.ev_conv_w = in[10]; p.ev_conv_b = in[11]; p.ev_decay_up = in[12]; p.ev_decay_b = in[13]; p.ev_norm_g = in[14]; p.ev_w_out = in[15];
    p.od_w_in = in[16]; p.od_conv_w = in[17]; p.od_conv_b = in[18]; p.od_gate_a_w = in[19]; p.od_gate_a_b = in[20]; p.od_gate_x_w = in[21]; p.od_gate_x_b = in[22];
    p.od_lambda = in[23]; p.od_sg_norm_g = in[24]; p.od_sg_w = in[25]; p.od_sg_b = in[26]; p.od_w_out = in[27];
    p.moe_router = in[28]; p.moe_w_gate = in[29]; p.moe_w_up = in[30]; p.moe_w_down = in[31];
    p.xlat = (float*)d_out;
}

#ifndef CPU_EMU
#define XB_TMO      128
#define XB_XCNT(j)  (256  + 64 * (j))
#define XB_XSUB(j)  (1280 + 64 * (j))
#define XB_XGEN(j)  (2304 + 64 * (j))
#define XB_TOP      3328
#define XB_TOPGEN   3392
#define XCD_BAR_WORDS 3456
#define XB_SPIN_CAP (1u << 18)
#define LAS __attribute__((address_space(3)))

__device__ __forceinline__ unsigned xb_ld(unsigned* p)              { return __hip_atomic_load(p, __ATOMIC_RELAXED, __HIP_MEMORY_SCOPE_AGENT); }
__device__ __forceinline__ unsigned xb_add(unsigned* p, unsigned v) { return __hip_atomic_fetch_add(p, v, __ATOMIC_RELAXED, __HIP_MEMORY_SCOPE_AGENT); }
__device__ __forceinline__ unsigned xb_xcc_id() { return (unsigned)__builtin_amdgcn_s_getreg((3 << 11) | 20) & 0xFu; }
#define XB_SPIN(cond, bar) do { unsigned _sp = 0; while (cond) { __builtin_amdgcn_s_sleep(1); \
    if ((++_sp & 255u) == 0u) { if (xb_ld(&(bar)[XB_TMO])) break; if (_sp > XB_SPIN_CAP) { atomicAdd(&(bar)[XB_TMO], 1u); break; } } } } while (0)

struct XcdBarrier {
    unsigned* bar; unsigned x;
    volatile LAS unsigned* st;
};

__device__ __forceinline__ XcdBarrier xcd_barrier_post(unsigned* bar, volatile LAS unsigned* st, bool lead  ) {
    XcdBarrier b; b.bar = bar; b.x = xb_xcc_id(); b.st = st;
    if (lead) (void)xb_add(&bar[XB_XCNT(b.x)], 1u);
    return b;
}
__device__ __forceinline__ void xcd_barrier_complete(unsigned* bar, unsigned x, unsigned& nloc, unsigned& nx) {
    const unsigned G = gridDim.x * gridDim.y * gridDim.z;
    unsigned sum, cnt, mine, sp = 0u;
    for (;;) {
        sum = 0u; cnt = 0u; mine = 0u;
#pragma unroll
        for (unsigned j = 0; j < 16; ++j) { const unsigned c = xb_ld(&bar[XB_XCNT(j)]); sum += c; cnt += (c > 0u) ? 1u : 0u; mine = (j == x) ? c : mine; }
        if (sum == G) break;
        __builtin_amdgcn_s_sleep(1);
        if ((++sp & 255u) == 0u) { if (xb_ld(&bar[XB_TMO])) break; if (sp > XB_SPIN_CAP) { atomicAdd(&bar[XB_TMO], 1u); break; } }
    }
    nloc = mine > 0u ? mine : 1u; nx = cnt > 0u ? cnt : 1u;
}

__device__ __forceinline__ void xcd_barrier(const XcdBarrier& b, bool lead  ) {
    asm volatile("s_waitcnt vmcnt(0)" ::: "memory");
    __syncthreads();
    if (lead) {
        unsigned* bar = b.bar;
        __builtin_amdgcn_s_waitcnt(0);
        unsigned nloc = b.st[0], nx = b.st[1];
        if (nloc == 0u) { xcd_barrier_complete(bar, b.x, nloc, nx); b.st[0] = nloc; b.st[1] = nx; }
        const unsigned old = xb_add(&bar[XB_XSUB(b.x)], 1u);
        const unsigned gen = old / nloc;
        if (old + 1u == (gen + 1u) * nloc) {
            __builtin_amdgcn_fence(__ATOMIC_RELEASE, "agent");
            asm volatile("s_waitcnt vmcnt(0)" ::: "memory");
            const unsigned og = xb_add(&bar[XB_TOP], 1u);
            const unsigned tg = og / nx;
            if (og + 1u == (tg + 1u) * nx) xb_add(&bar[XB_TOPGEN], 1u);
            else XB_SPIN(xb_ld(&bar[XB_TOPGEN]) == tg, bar);
            __builtin_amdgcn_fence(__ATOMIC_ACQUIRE, "agent");
            xb_add(&bar[XB_XGEN(b.x)], 1u);
            asm volatile("s_waitcnt vmcnt(0)" ::: "memory");
        } else {
            XB_SPIN(xb_ld(&bar[XB_XGEN(b.x)]) == gen, bar);
            __builtin_amdgcn_fence(__ATOMIC_ACQUIRE, "agent");
            asm volatile("s_waitcnt vmcnt(0)" ::: "memory");
        }
    }
    __syncthreads();
}


typedef const __attribute__((address_space(4))) char* kargp_t;
__device__ __forceinline__ void load_params(Params& p, kargp_t kp) {
    const float* in[32];
#pragma unroll
    for (int i = 0; i < 32; ++i) in[i] = *(const float* const __attribute__((address_space(4)))*)(kp + 8 * i);
    float* out = *(float* const __attribute__((address_space(4)))*)(kp + 256);
    char* ws = *(char* const __attribute__((address_space(4)))*)(kp + 264);
    fill_inputs(p, in, out); carve(p, ws);
}
__device__ __forceinline__ constexpr bool probe_double(int st) {
    return PROBE_SET == 1 ? (st == ST_GEMM_IN || st == ST_GEMM_GU || st == ST_GEMM_DOWN)
         : PROBE_SET == 2 ? (st == ST_EVEN1 || st == ST_EVEN3)
         : PROBE_SET == 3 ? (st == ST_ODD1 || st == ST_ODD3)
         : PROBE_SET == 31 ? (st == ST_ODD1)
         : PROBE_SET == 33 ? (st == ST_EVEN1)
         : PROBE_SET == 4 ? (st == ST_ROW_FFN || st == ST_SELECT_WCONV)
         : PROBE_SET == 13 ? (st == ST_ROW_FFN)
         : PROBE_SET == 21 ? (st == ST_EVEN2 || st == ST_ODD2)
         : PROBE_SET == 5 ? (st == ST_MOD || st == ST_WCONV) : false;
}
__device__ __forceinline__ constexpr bool probe_echo(int st) {
    return PROBE_SET == 60 ? (st == ST_EVEN1 || st == ST_EVEN2 || st == ST_EVEN3)
         : PROBE_SET == 61 ? (st == ST_ODD1 || st == ST_ODD2 || st == ST_ODD3)
         : PROBE_SET == 62 ? (st == ST_ROW_MIX || st == ST_ROW_FFN || st == ST_SELECT_WCONV || st == ST_ROW_FINAL || st == ST_MOD)
         : PROBE_SET == 63 ? (st == ST_GEMM_IN || st == ST_GEMM_OUT)
         : PROBE_SET == 64 ? (st == ST_GEMM_GU || st == ST_GEMM_DOWN)
         : PROBE_SET == 65 ? (st == ST_EVEN1) : PROBE_SET == 66 ? (st == ST_EVEN3) : PROBE_SET == 67 ? (st == ST_ODD3) : PROBE_SET == 68 ? (st == ST_ROW_MIX) : false;
}
#define PHASE(l, st) do { unsigned zo_; asm volatile("s_mov_b32 %0, 0" : "=s"(zo_)); \
    Params P; load_params(P, (kargp_t)__builtin_amdgcn_kernarg_segment_ptr() + zo_); \
    const int tid_ph = wv_ * 64 + (int)__builtin_amdgcn_mbcnt_hi(~0u, __builtin_amdgcn_mbcnt_lo(~0u, 0u)); \
    unsigned long long te0_ = 0; if (probe_echo(st)) te0_ = __builtin_amdgcn_s_memtime(); \
    PHASE_BODY(l, st); \
    if (probe_echo(st)) { const unsigned long long te1_ = __builtin_amdgcn_s_memtime(); while (__builtin_amdgcn_s_memtime() - te1_ < 4ull * (te1_ - te0_)) __builtin_amdgcn_s_sleep(4); } } while (0)
#define PHASE_BODY(l, st) do { \
    do_stage(P, (l), (st), lds, tid_ph); if (probe_double(st) || (PROBE_SET == 22 && (l) == 0 && ((st) == ST_GEMM_OUT)) || (PROBE_SET == 23 && (l) == 0 && ((st) == ST_ROW_MIX))) { __syncthreads(); do_stage(P, (l), (st), lds, tid_ph); } xcd_barrier(bar, tid_ph == 0); } while (0)
#define LAYER_HEAD(l) PHASE(l, ST_ROW_MIX); PHASE(l, ST_GEMM_IN);
#define LAYER_TAIL(l) PHASE(l, ST_GEMM_OUT); PHASE(l, ST_ROW_FFN); PHASE(l, ST_SELECT_WCONV); PHASE(l, ST_GEMM_GU); PHASE(l, ST_GEMM_DOWN);
#define LAYER_EVEN(l) LAYER_HEAD(l) PHASE(l, ST_EVEN1); PHASE(l, ST_EVEN2); PHASE(l, ST_EVEN3); LAYER_TAIL(l)
#define LAYER_ODD(l) LAYER_HEAD(l) PHASE(l, ST_ODD1); PHASE(l, ST_ODD2); PHASE(l, ST_ODD3); LAYER_TAIL(l)
__global__ void __launch_bounds__(512, 2) k_all(KArgs ka) {
    extern __shared__ __attribute__((aligned(16))) unsigned char shm[];
    PG8_LAS unsigned char* lds = (PG8_LAS unsigned char*)shm;
    volatile LAS unsigned* xbw = (volatile LAS unsigned*)(lds + GEMM_LDS_BYTES);
    if (threadIdx.x == 0) { xbw[0] = 0u; xbw[1] = 0u; xbw[2] = 0u; xbw[3] = 0u; }
    __syncthreads();
    const int wv_ = __builtin_amdgcn_readfirstlane((int)(threadIdx.x >> 6));
    XcdBarrier bar = xcd_barrier_post((unsigned*)ka.ws, xbw, threadIdx.x == 0);
    PHASE(0, ST_MOD);
    LAYER_EVEN(0) LAYER_ODD(1) LAYER_EVEN(2) LAYER_ODD(3)
    PHASE(0, ST_ROW_FINAL);
}

extern "C" void kernel_launch(void* const* d_in, const int* in_sizes, int n_in, void* d_out, int out_size, void* d_ws, size_t ws_size, hipStream_t stream) {
    KArgs ka; memset(&ka, 0, sizeof(ka));
    for (int i = 0; i < 32; ++i) ka.in[i] = (const float*)d_in[i];
    ka.out = (float*)d_out; ka.ws = (char*)d_ws;
    Params p{}; fill_inputs(p, ka.in, d_out);
    const size_t need = carve(p, d_ws);
    if (need > ws_size) { fprintf(stderr, "workspace too small: need %zu have %zu\n", need, ws_size); return; }
    constexpr size_t kDynLds = DYN_LDS_BYTES;
    static int grid = 0;
    if (!grid) {
        int dev = 0, cus = 0, per_cu = 0;
        (void)hipGetDevice(&dev);
        (void)hipDeviceGetAttribute(&cus, hipDeviceAttributeMultiprocessorCount, dev);
        (void)hipFuncSetAttribute((const void*)k_all, hipFuncAttributeMaxDynamicSharedMemorySize, (int)kDynLds);
        (void)hipOccupancyMaxActiveBlocksPerMultiprocessor(&per_cu, k_all, 512, kDynLds);
        grid = cus * (per_cu < 1 ? per_cu : 1);
    }
    (void)hipMemsetAsync(p.bar, 0, 4096 * sizeof(unsigned), stream);
    hipLaunchKernelGGL(k_all, dim3(grid), dim3(512), kDynLds, stream, ka);
}
#endif
```

```cpp
#ifndef CPU_EMU
#include <hip/hip_runtime.h>
#include <cstdio>
#include <cstring>
#define DEV __device__ __forceinline__
#else
#define DEV inline
#endif
#include <cstdint>
#include <cstddef>

#ifndef D_MODEL
#define D_MODEL 1024
#define BATCH 8
#define SEQ 4096
#define CTXL 256
#endif

#ifndef PROBE_SET
#define PROBE_SET 0
#endif
typedef unsigned short bf16_t;
constexpr int D = D_MODEL, NB = BATCH, T = SEQ, TC = CTXL, DEPTH = 4;
constexpr int RL = NB * T, RC = NB * TC, R = RL + RC;
constexpr int W2 = D / 2;
constexpr int GH = 4, DV = W2 / GH, DK = DV / 2, KEY = GH * DK, RANK = 16, CH = 64, GRIDW = 64;
constexpr int EV_IN = 3 * W2 + KEY + W2 + KEY + W2 + 2 * RANK;
constexpr int NZE = ((EV_IN + 255) / 256) * 256, NZO = 4 * W2;
constexpr int E_BG = 0, E_CG = W2, E_XA = 2 * W2, E_Q = 3 * W2, E_G = E_Q + KEY, E_K = E_G + W2, E_V = E_K + KEY, E_LRF = E_V + W2, E_LRB = E_LRF + RANK;
constexpr int O_XB = 0, O_GB = W2, O_U = 2 * W2, O_V = 3 * W2;
constexpr int NE = 16, CAPL = 2 * T / NE, CAPC = 2 * TC / NE, SLOTS_E = NB * (CAPL + CAPC), SLOTS = NE * SLOTS_E;
constexpr int SEQ_ALL = TC + T, NCH = SEQ_ALL / CH, NCHC = TC / CH;
constexpr int SGC = 128, HD = W2 / 4;
constexpr float EPS = 1e-6f;
constexpr int MODW = 6 * D;

struct Params {
    const float *x, *c, *ctx, *c_ctx, *ada_w, *ada_b, *norm_mix_g, *norm_ffn_g, *norm_final_g;
    const float *ev_w_in, *ev_conv_w, *ev_conv_b, *ev_decay_up, *ev_decay_b, *ev_norm_g, *ev_w_out;
    const float *od_w_in, *od_conv_w, *od_conv_b, *od_gate_a_w, *od_gate_a_b, *od_gate_x_w, *od_gate_x_b, *od_lambda, *od_sg_norm_g, *od_sg_w, *od_sg_b, *od_w_out;
    const float *moe_router, *moe_w_gate, *moe_w_up, *moe_w_down;
    float* xlat;
    float *xctx, *mod, *sbuf, *rinv, *aff, *logit, *sel_g;
    int *sel_row, *inv;
    bf16_t *wt_ev_in, *wt_od_in, *wt_ev_out, *wt_od_out, *wt_gu, *wt_dn, *h, *gwT, *sgw, *rw16;
    float *sumA, *sumB, *decv, *hinb, *ssqp;
    bf16_t *z, *m;
    float *bcum, *S, *att, *o;
    float *xc, *A, *Bc, *sgstat, *vb;
    bf16_t *xg, *hid, *outslot;
    bf16_t *SinB, *Sd;
    bf16_t* xb;
    unsigned* bar; unsigned* wq;
};

DEV float bf2f(bf16_t v) { union { unsigned u; float f; } c; c.u = (unsigned)v << 16; return c.f; }
DEV bf16_t f2bf(float f) { union { unsigned u; float f; } c; c.f = f; unsigned u = c.u; u += 0x7fffu + ((u >> 16) & 1u); return (bf16_t)(u >> 16); }
DEV float sigmoidf_(float x) { return 1.0f / (1.0f + expf(-x)); }
DEV float siluf_(float x) { return x / (1.0f + expf(-x)); }
DEV float softplusf_(float x) { return fmaxf(x, 0.0f) + log1pf(expf(-fabsf(x))); }
DEV float logsigmoidf_(float x) { return fminf(x, 0.0f) - log1pf(expf(-fabsf(x))); }
DEV float geluf_(float x) { return 0.5f * x * (1.0f + tanhf(0.7978845608028654f * (x + 0.044715f * x * x * x))); }
DEV float rsq_(float x) { return 1.0f / sqrtf(x); }

DEV const float* xsrc_row(const Params& P, int l, int r) {
    if (l == 0) return r < RL ? P.x + (size_t)r * D : P.ctx + (size_t)(r - RL) * D;
    return r < RL ? P.xlat + (size_t)r * D : P.xctx + (size_t)(r - RL) * D;
}
DEV float* x_row(const Params& P, int r) { return r < RL ? P.xlat + (size_t)r * D : P.xctx + (size_t)(r - RL) * D; }
DEV int row_bb(int r) { return r < RL ? r / T : NB; }
DEV int seqrow(int b, int s) { return s < TC ? RL + b * TC + s : b * T + (s - TC); }
DEV const float* modrow(const Params& P, int l, int bb) { return P.mod + ((size_t)l * (NB + 1) + bb) * MODW; }

#define GSL(i, n) for (long i = (long)blockIdx.x * blockDim.x + tid_; i < (long)(n); i += (long)gridDim.x * blockDim.x)

enum {
    ST_SILU = 0, ST_MOD, ST_WCONV,
    ST_NORM_STATS_MIX, ST_NORM_APPLY_MIX, ST_GEMM_IN,
    ST_E_LA, ST_E_DS, ST_E_SCAN, ST_E_ATT, ST_E_O, ST_E_READOUT, ST_E_CONV,
    ST_O_XC, ST_O_COEF, ST_O_SCAN, ST_O_YREC, ST_O_SGSTAT, ST_O_VB, ST_O_SGMIX,
    ST_GEMM_OUT,
    ST_NORM_STATS_FFN, ST_NORM_APPLY_FFN, ST_ROUTER_LOGIT, ST_ROUTER_SOFTMAX, ST_MOE_WCONV, ST_SELECT, ST_GATHER, ST_GEMM_GU, ST_GEMM_DOWN, ST_COMBINE,
    ST_FINAL_STATS, ST_FINAL_APPLY,
    ST_ROW_MIX, ST_ROW_FFN, ST_ROW_FINAL, ST_SELECT_WCONV, ST_GATHER2, ST_ODD1, ST_ODD3, ST_EVEN1, ST_EVEN2, ST_EVEN3, ST_ODD2, ST_COUNT
};

struct EpiZ {
    bf16_t* z; int ldz;
    DEV void elem(int row, int col, float v) const { z[(size_t)row * ldz + col] = f2bf(v); }
};
struct EpiWout {
    const Params* P; int l;
    DEV void elem(int row, int col, float v) const {
        const float* mr = modrow(*P, l, row_bb(row));
        x_row(*P, row)[col] = xsrc_row(*P, l, row)[col] + mr[2 * D + col] * v;
    }
};
struct EpiGU {
    bf16_t* hid;
    DEV void pair(int row, int j, float g, float u) const { hid[(size_t)row * D + j] = f2bf(siluf_(g) * u); }
};
struct EpiDown {
    bf16_t* out; const float* selg;
    DEV void elem(int row, int col, float v) const { out[(size_t)row * D + col] = f2bf(v * selg[row]); }
};

#ifdef CPU_EMU
template <bool PAIR, class Epi>
void gemm_stage(const bf16_t* A, const bf16_t* Bt, int G, int Mg, int N, int K, const Epi& epi) {
    const int tid_ = threadIdx.x;
    GSL(i, (long)G * Mg) {
        const int g = (int)(i / Mg); const int row = (int)i;
        const bf16_t* a = A + (size_t)row * K;
        if (!PAIR) {
            for (int n = 0; n < N; ++n) { const bf16_t* b = Bt + ((size_t)g * N + n) * K; float s = 0.f; for (int k = 0; k < K; ++k) s += bf2f(a[k]) * bf2f(b[k]); epi.elem(row, n, s); }
        } else {
            for (int j = 0; j < N / 2; ++j) {
                const int cg = (j / 128) * 256 + (j % 128), cu = cg + 128;
                const bf16_t* bg = Bt + ((size_t)g * N + cg) * K; const bf16_t* bu = Bt + ((size_t)g * N + cu) * K;
                float sg = 0.f, su = 0.f; for (int k = 0; k < K; ++k) { sg += bf2f(a[k]) * bf2f(bg[k]); su += bf2f(a[k]) * bf2f(bu[k]); }
                epi.pair_(row, j, sg, su);
            }
        }
    }
}
#else
namespace pg8 {
#define PG8_LAS __attribute__((address_space(3)))
typedef short bf16x8 __attribute__((ext_vector_type(8)));
typedef float f32x4 __attribute__((ext_vector_type(4)));
typedef unsigned u32x4 __attribute__((ext_vector_type(4)));
constexpr int BM = 256, BK = 64, HALF = 128, HTB = HALF * BK * 2, STAGE_BYTES = 8 * HTB, NXCD = 8, WGM = 8;
__host__ __device__ __forceinline__ int lds_byte(int r, int c) { const int st = (r >> 4) * 2 + (c >> 5), rr = r & 15, cc = c & 31, ob = rr * 64 + cc * 2; return st * 1024 + (ob ^ (((ob >> 9) & 1) << 5)); }
__host__ __device__ __forceinline__ void stage_rc(int b, int& R_, int& C_) { const int st = b / 1024, sb = b % 1024, swz = sb ^ (((sb >> 9) & 1) << 5); R_ = (st >> 1) * 16 + swz / 64; C_ = (st & 1) * 32 + (swz % 64) / 2; }
__host__ __device__ __forceinline__ int perm32(int rho) { const int n = rho >> 4, i = rho & 15; return 8 * (i >> 2) + 4 * n + (i & 3); }
struct Unit { int pm, pn; };
struct Gemm { const bf16_t* A; const bf16_t* Bt; int K; };
struct StaticOrder {
    int nM, nN, nwg, G, c;
    __device__ __forceinline__ void init(int M, int N, int G_, int c_) { nM = M / BM; nN = N / BM; nwg = nM * nN; G = G_; c = c_; }
    __device__ __forceinline__ bool next(int i, Unit& u) const {
        const long L = (long)i * G + c; if (L >= nwg) return false;
        int wgid = (int)L; { const int q = nwg / NXCD, r = nwg % NXCD, xcd = wgid % NXCD, off = wgid / NXCD; wgid = (xcd < r ? xcd * (q + 1) : r * (q + 1) + (xcd - r) * q) + off; }
        const int nig = WGM * nN, gid = wgid / nig, fm = gid * WGM, gsz = (nM - fm) < WGM ? (nM - fm) : WGM;
        u.pm = fm + ((wgid % nig) % gsz); u.pn = (wgid % nig) / gsz; return true;
    }
    __device__ __forceinline__ void a_ready(const Unit&) const {}
    __device__ __forceinline__ void done(const Unit&) const {}
};
struct GroupedOrder {
    int nMg, nMs, nN, total, G, c;
    __device__ __forceinline__ void init(int Mg_used, int Mg_stride, int N, int groups, int G_, int c_) { nMg = Mg_used / BM; nMs = Mg_stride / BM; nN = N / BM; total = groups * nMg * nN; G = G_; c = c_; }
    __device__ __forceinline__ bool next(int i, Unit& u) const {
        const long L = (long)i * G + c; if (L >= total) return false;
        int wgid = (int)L; { const int q = total / NXCD, r = total % NXCD, xcd = wgid % NXCD, off = wgid / NXCD; wgid = (xcd < r ? xcd * (q + 1) : r * (q + 1) + (xcd - r) * q) + off; }
        const int per = nMg * nN, g = wgid / per, rem = wgid % per;
        const int nig = WGM * nN, gid = rem / nig, fm = gid * WGM, gsz = (nMg - fm) < WGM ? (nMg - fm) : WGM;
        const int pm_l = fm + ((rem % nig) % gsz), pn_l = (rem % nig) / gsz;
        u.pm = g * nMs + pm_l; u.pn = g * nN + pn_l; return true;
    }
    __device__ __forceinline__ void a_ready(const Unit&) const {}
    __device__ __forceinline__ void done(const Unit&) const {}
};
typedef __bf16 bf16x2_n __attribute__((ext_vector_type(2)));
typedef float f32x2_n __attribute__((ext_vector_type(2)));
__device__ __forceinline__ unsigned cvt_pk_bf16(float lo, float hi) { const f32x2_n v = {lo, hi}; const bf16x2_n r = __builtin_convertvector(v, bf16x2_n); return __builtin_bit_cast(unsigned, r); }

typedef int i32x4 __attribute__((ext_vector_type(4)));
typedef int i32x8 __attribute__((ext_vector_type(8)));
__device__ __forceinline__ i32x8 frag_cat(bf16x8 lo, bf16x8 hi) { return __builtin_shufflevector(__builtin_bit_cast(i32x4, lo), __builtin_bit_cast(i32x4, hi), 0, 1, 2, 3, 4, 5, 6, 7); }
template <bool FP8> struct Frags { bf16x8 At[4][2], B0[2][2], B1[2][2]; };
template <> struct Frags<true> { i32x8 At[4], B0[2], B1[2]; };
template <bool GATHER, bool FP8, class Epi, class Sched>
__device__ __forceinline__ void gemm_phase(PG8_LAS unsigned char* lds, const Gemm g, const Sched& S, const Epi& E, const int tid, const PG8_LAS int* gix = nullptr) {
    const int wid = __builtin_amdgcn_readfirstlane(tid >> 6), lane = tid & 63, wr = wid >> 2, wc = wid & 3, fr = lane & 15, fq = lane >> 4;
    const int K = g.K, rowb = FP8 ? K : 2 * K, nt = rowb / (BK * 2);
    unsigned voffA[2], voffB[2];
#pragma unroll
    for (int i = 0; i < 2; ++i) { int R_, C_; stage_rc(tid * 16 + i * 8192, R_, C_); const int Rb = Epi::PERM ? ((R_ & ~31) + perm32(R_ & 31)) : R_;
        voffA[i] = (unsigned)(R_ * rowb + C_ * 2); voffB[i] = (unsigned)(Rb * rowb + C_ * 2); }
    unsigned gv[2][2];
#define PG8_GV(kk) do { _Pragma("unroll") for (int _i = 0; _i < 2; ++_i) { int _R, _C; stage_rc(tid * 16 + _i * 8192, _R, _C); _Pragma("unroll") for (int _h = 0; _h < 2; ++_h) \
        gv[_h][_i] = (unsigned)gix[(kk) * 256 + _h * 128 + _R] * (unsigned)rowb + (unsigned)_C * 2u; } } while (0)
#define PG8_UBASE(p) ({ const char* _ub = (const char*)(p); asm volatile("" : "+s"(_ub)); _ub; })
#define PG8_STAGE_A(bufoff, hf, kb, nx) do { if constexpr (GATHER) { const char* _gb = PG8_UBASE((const char*)g.A + (kb)); _Pragma("unroll") for (int _i = 0; _i < 2; ++_i) \
        __builtin_amdgcn_global_load_lds((const unsigned*)(_gb + gv[hf][_i]), (PG8_LAS unsigned*)(lds + (bufoff) + ldsw + _i * 8192), 16, 0, 0); } \
      else { const char* _gb = PG8_UBASE(((nx) ? nA : cA) + (kb) + (hf) * hstep); _Pragma("unroll") for (int _i = 0; _i < 2; ++_i) \
        __builtin_amdgcn_global_load_lds((const unsigned*)(_gb + voffA[_i]), (PG8_LAS unsigned*)(lds + (bufoff) + ldsw + _i * 8192), 16, 0, 0); } } while (0)
    const size_t kstep = (size_t)(BK * 2);
    const size_t hstep = (size_t)HALF * rowb;
    const size_t tstep = 2 * hstep;
    const unsigned ldsw = (unsigned)wid * 1024u;
    const int aoffk0 = FP8 ? lds_byte(wr * 64 + fr, fq * 16) : lds_byte(wr * 64 + fr, fq * 8), aoffk1 = FP8 ? lds_byte(wr * 64 + fr, fq * 16 + 8) : aoffk0 + 1024;
    const int boffk0 = FP8 ? lds_byte(wc * 32 + fr, fq * 16) : lds_byte(wc * 32 + fr, fq * 8), boffk1 = FP8 ? lds_byte(wc * 32 + fr, fq * 16 + 8) : boffk0 + 1024;
#define PG8_SA(b, h) (((b) * 2 + (h)) * HTB)
#define PG8_SB(b, h) ((4 + (b) * 2 + (h)) * HTB)
#define PG8_STAGE(bufoff, gbase, voff) do { const char* _gb = PG8_UBASE(gbase); _Pragma("unroll") for (int _i = 0; _i < 2; ++_i) \
        __builtin_amdgcn_global_load_lds((const unsigned*)(_gb + (voff)[_i]), (PG8_LAS unsigned*)(lds + (bufoff) + ldsw + _i * 8192), 16, 0, 0); } while (0)
#define PG8_LD16(off) (*(const PG8_LAS bf16x8*)(lds + (off)))
#define PG8_LDA(dst, b, h) do { _Pragma("unroll") for (int m = 0; m < 4; ++m) { \
        if constexpr (FP8) F.dst[m] = frag_cat(PG8_LD16(PG8_SA(b, h) + aoffk0 + m * 2048), PG8_LD16(PG8_SA(b, h) + aoffk1 + m * 2048));     \
        else { F.dst[m][0] = PG8_LD16(PG8_SA(b, h) + aoffk0 + m * 2048); F.dst[m][1] = PG8_LD16(PG8_SA(b, h) + aoffk1 + m * 2048); } } } while (0)
#define PG8_LDB(dst, b, h) do { _Pragma("unroll") for (int n = 0; n < 2; ++n) { \
        if constexpr (FP8) F.dst[n] = frag_cat(PG8_LD16(PG8_SB(b, h) + boffk0 + n * 2048), PG8_LD16(PG8_SB(b, h) + boffk1 + n * 2048)); \
        else { F.dst[n][0] = PG8_LD16(PG8_SB(b, h) + boffk0 + n * 2048); F.dst[n][1] = PG8_LD16(PG8_SB(b, h) + boffk1 + n * 2048); } } } while (0)
#define PG8_MMA(ai, bj, At, Bt) do { __builtin_amdgcn_s_setprio(1); _Pragma("unroll") for (int m = 0; m < 4; ++m) _Pragma("unroll") for (int n = 0; n < 2; ++n) { \
        if constexpr (FP8) asm volatile("v_mfma_scale_f32_16x16x128_f8f6f4 %0, %1, %2, %0, %3, %3 op_sel_hi:[0,0,0]" : "+v"(acc[ai][bj][m][n]) : "v"(F.Bt[n]), "v"(F.At[m]), "v"(scale1)); \
        else { _Pragma("unroll") for (int k = 0; k < 2; ++k) acc[ai][bj][m][n] = __builtin_amdgcn_mfma_f32_16x16x32_bf16(F.Bt[n][k], F.At[m][k], acc[ai][bj][m][n], 0, 0, 0); } } \
        __builtin_amdgcn_s_setprio(0); } while (0)
#define PG8_WAIT_V(n) asm volatile("s_waitcnt vmcnt(" #n ")" ::: "memory")
#define PG8_WAIT_L(n) asm volatile("s_waitcnt lgkmcnt(" #n ")" ::: "memory")
#define PG8_BAR __builtin_amdgcn_s_barrier()
#define PG8_SCHED __builtin_amdgcn_sched_barrier(0)
    Unit cur, nxt; int ui = 0;
    if (!S.next(0, cur)) return;
    f32x4 acc[2][2][4][2];
#pragma unroll
    for (int a = 0; a < 2; ++a)
#pragma unroll
        for (int b = 0; b < 2; ++b)
#pragma unroll
            for (int m = 0; m < 4; ++m)
#pragma unroll
                for (int n = 0; n < 2; ++n) acc[a][b][m][n] = (f32x4){0.f, 0.f, 0.f, 0.f};
    Frags<FP8> F;
    int scale1 = 127; asm volatile("" : "+v"(scale1));
    const char* cA = (const char*)g.A + (size_t)cur.pm * tstep; const char* cB = (const char*)g.Bt + (size_t)cur.pn * tstep;
    const char* nA = cA;
    if constexpr (GATHER) { PG8_GV(0); }
    S.a_ready(cur);
    PG8_STAGE(PG8_SB(0, 0), cB, voffB); PG8_STAGE_A(PG8_SA(0, 0), 0, (size_t)0, false); PG8_STAGE(PG8_SB(0, 1), cB + hstep, voffB); PG8_STAGE_A(PG8_SA(0, 1), 1, (size_t)0, false);
    if (wr == 1) PG8_BAR;
    PG8_WAIT_V(4); PG8_BAR;
    PG8_STAGE(PG8_SB(1, 0), cB + kstep, voffB); PG8_STAGE_A(PG8_SA(1, 0), 0, kstep, false); PG8_STAGE(PG8_SB(1, 1), cB + hstep + kstep, voffB);
    PG8_WAIT_V(6); PG8_BAR;
    for (;;) {
        const bool has_next = S.next(ui + 1, nxt);
        nA = has_next ? (const char*)g.A + (size_t)nxt.pm * tstep : cA; const char* nB = has_next ? (const char*)g.Bt + (size_t)nxt.pn * tstep : cB;
        constexpr int KREP = PROBE_SET == 30 ? 2 : 1;
#pragma nounroll
        for (int t = 0; t < nt * KREP; t += 2) {
            const bool last = (t == nt * KREP - 2);
            const size_t ka1 = (size_t)((t + 1) % nt) * kstep, ka2 = last ? (size_t)0 : (size_t)((t + 2) % nt) * kstep, ka3 = ka2 + kstep;
            const char* b2 = last ? nB : cB + (size_t)((t + 2) % nt) * kstep;
            const char* b3 = b2 + kstep;
            if (last && has_next) S.a_ready(nxt);
            PG8_LDB(B0, 0, 0); PG8_SCHED; PG8_LDA(At, 0, 0); PG8_STAGE_A(PG8_SA(1, 1), 1, ka1, false);
            PG8_WAIT_L(8); PG8_BAR; PG8_WAIT_L(0); PG8_MMA(0, 0, At, B0); PG8_BAR; PG8_SCHED;
            if constexpr (GATHER) { if (last && has_next) { PG8_GV(ui + 1); } }
            PG8_LDB(B1, 0, 1); PG8_STAGE(PG8_SB(0, 0), b2, voffB);
            PG8_BAR; PG8_WAIT_L(0); PG8_MMA(0, 1, At, B1); PG8_BAR;
            PG8_LDA(At, 0, 1); PG8_STAGE_A(PG8_SA(0, 0), 0, ka2, last);
            PG8_BAR; PG8_WAIT_L(0); PG8_MMA(1, 0, At, B0); PG8_BAR; PG8_SCHED;
            PG8_STAGE(PG8_SB(0, 1), b2 + hstep, voffB);
            PG8_WAIT_V(6); PG8_BAR; PG8_MMA(1, 1, At, B1); PG8_BAR;
            PG8_LDB(B0, 1, 0); PG8_SCHED; PG8_LDA(At, 1, 0); PG8_STAGE_A(PG8_SA(0, 1), 1, ka2, last);
            PG8_WAIT_L(8); PG8_BAR; PG8_WAIT_L(0); PG8_MMA(0, 0, At, B0); PG8_BAR; PG8_SCHED;
            PG8_LDB(B1, 1, 1); PG8_STAGE(PG8_SB(1, 0), b3, voffB);
            PG8_BAR; PG8_WAIT_L(0); PG8_MMA(0, 1, At, B1); PG8_BAR;
            PG8_LDA(At, 1, 1); PG8_STAGE_A(PG8_SA(1, 0), 0, ka3, last);
            PG8_BAR; PG8_WAIT_L(0); PG8_MMA(1, 0, At, B0); PG8_BAR; PG8_SCHED;
            PG8_STAGE(PG8_SB(1, 1), b3 + hstep, voffB);
            PG8_WAIT_V(6); PG8_BAR; PG8_MMA(1, 1, At, B1); PG8_BAR;
        }
        if constexpr (KREP > 1) {
#pragma unroll
            for (int a = 0; a < 2; ++a)
#pragma unroll
                for (int b = 0; b < 2; ++b)
#pragma unroll
                    for (int m = 0; m < 4; ++m)
#pragma unroll
                        for (int n = 0; n < 2; ++n) acc[a][b][m][n] *= (1.0f / KREP); }
        if constexpr (FP8) asm volatile("s_nop 15\n\ts_nop 15" ::: "memory");
        { int tz = tid; asm volatile("" : "+v"(tz));
          const int wz = tz >> 6, lz = tz & 63; E(acc, cur, wz >> 2, wz & 3, lz & 15, lz >> 4); }
        S.done(cur);
        if (!has_next) break;
#pragma unroll
        for (int a = 0; a < 2; ++a)
#pragma unroll
            for (int b = 0; b < 2; ++b)
#pragma unroll
                for (int m = 0; m < 4; ++m)
#pragma unroll
                    for (int n = 0; n < 2; ++n) acc[a][b][m][n] = (f32x4){0.f, 0.f, 0.f, 0.f};
        cur = nxt; cA = nA; cB = nB; ++ui;

    }
    PG8_WAIT_V(0);
    if (wr == 0) PG8_BAR;
    PG8_BAR;
#undef PG8_SA
#undef PG8_SB
#undef PG8_STAGE
#undef PG8_STAGE_A
#undef PG8_UBASE
#undef PG8_GV
#undef PG8_LDA
#undef PG8_LDB
#undef PG8_MMA
#undef PG8_WAIT_V
#undef PG8_WAIT_L
#undef PG8_BAR
#undef PG8_SCHED
}

struct EpiZ8 {
    static constexpr bool PERM = true;
    bf16_t* O; int ldc;
    __device__ __forceinline__ void operator()(const f32x4 (&acc)[2][2][4][2], const Unit& u, int wr, int wc, int fr, int fq) const {
        const int row0 = u.pm * BM + wr * 64 + fr, col0 = u.pn * BM + wc * 32 + 8 * fq;
#pragma unroll
        for (int ai = 0; ai < 2; ++ai)
#pragma unroll
            for (int m = 0; m < 4; ++m) { bf16_t* rowp = O + (size_t)(row0 + ai * HALF + m * 16) * ldc + col0;
#pragma unroll
                for (int bj = 0; bj < 2; ++bj) { const f32x4 v0 = acc[ai][bj][m][0], v1 = acc[ai][bj][m][1];
                    u32x4 w; w.x = cvt_pk_bf16(v0[0], v0[1]); w.y = cvt_pk_bf16(v0[2], v0[3]); w.z = cvt_pk_bf16(v1[0], v1[1]); w.w = cvt_pk_bf16(v1[2], v1[3]);
                    *(u32x4*)(rowp + bj * HALF) = w; } }
    }
};
template <bool SRC32>
struct EpiWoutB {
    static constexpr bool PERM = true;
    const float* src_lat; const float* src_ctx; bf16_t* xb; const float* modl;
    float* ssqp;
    __device__ __forceinline__ void operator()(const f32x4 (&acc)[2][2][4][2], const Unit& u, int wr, int wc, int fr, int fq) const {
        const int rowt = u.pm * BM; const bool lat = rowt < RL; const int bb = lat ? rowt / T : NB;
        const float* sp = lat ? src_lat + (size_t)rowt * D : src_ctx + (size_t)(rowt - RL) * D;
        bf16_t* dp = xb + (size_t)rowt * D;
        const float* mr = modl + (size_t)bb * MODW + 2 * D;
        const int r0 = wr * 64 + fr, col0 = u.pn * BM + wc * 32 + 8 * fq;
        f32x4 mv[2][2];
#pragma unroll
        for (int bj = 0; bj < 2; ++bj)
#pragma unroll
            for (int n = 0; n < 2; ++n) mv[bj][n] = *(const f32x4*)(mr + col0 + bj * HALF + 4 * n);
#pragma unroll
        for (int ai = 0; ai < 2; ++ai)
#pragma unroll
            for (int m = 0; m < 4; ++m) { const size_t ro = (size_t)(r0 + ai * HALF + m * 16) * D + col0; float sq = 0.f;
#pragma unroll
                for (int bj = 0; bj < 2; ++bj) { f32x4 x0, x1;
                    if (SRC32) { x0 = *(const f32x4*)(sp + ro + bj * HALF); x1 = *(const f32x4*)(sp + ro + bj * HALF + 4); }
                    else { const u32x4 w = *(const u32x4*)(dp + ro + bj * HALF);
                        x0 = (f32x4){__uint_as_float(w.x << 16), __uint_as_float(w.x & 0xffff0000u), __uint_as_float(w.y << 16), __uint_as_float(w.y & 0xffff0000u)};
                        x1 = (f32x4){__uint_as_float(w.z << 16), __uint_as_float(w.z & 0xffff0000u), __uint_as_float(w.w << 16), __uint_as_float(w.w & 0xffff0000u)}; }
                    const f32x4 v0 = x0 + mv[bj][0] * acc[ai][bj][m][0], v1 = x1 + mv[bj][1] * acc[ai][bj][m][1];
                    u32x4 o; o.x = cvt_pk_bf16(v0[0], v0[1]); o.y = cvt_pk_bf16(v0[2], v0[3]); o.z = cvt_pk_bf16(v1[0], v1[1]); o.w = cvt_pk_bf16(v1[2], v1[3]);
                    *(u32x4*)(dp + ro + bj * HALF) = o;
                    const unsigned ow[4] = {o.x, o.y, o.z, o.w};
#pragma unroll
                    for (int j = 0; j < 4; ++j) { const float a = __uint_as_float(ow[j] << 16), b = __uint_as_float(ow[j] & 0xffff0000u); sq += a * a + b * b; } }
                sq += __builtin_bit_cast(float, __builtin_amdgcn_ds_bpermute(((16 * fq + fr) ^ 16) << 2, __builtin_bit_cast(int, sq)));
                sq += __builtin_bit_cast(float, __builtin_amdgcn_ds_bpermute(((16 * fq + fr) ^ 32) << 2, __builtin_bit_cast(int, sq)));
                if (fq == 0) ssqp[(size_t)(rowt + r0 + ai * HALF + m * 16) * 16 + (u.pn & 3) * 4 + wc] = sq; }
    }
};
__device__ __forceinline__ float silu_fast(float x) { return x * __builtin_amdgcn_rcpf(1.0f + __expf(-x)); }
struct EpiGU8 {
    static constexpr bool PERM = true;
    bf16_t* hid; int nN;
    __device__ __forceinline__ void operator()(const f32x4 (&acc)[2][2][4][2], const Unit& u, int wr, int wc, int fr, int fq) const {
        const int row0 = u.pm * BM + wr * 64 + fr, col0 = (u.pn % nN) * HALF + wc * 32 + 8 * fq;
#pragma unroll
        for (int ai = 0; ai < 2; ++ai)
#pragma unroll
            for (int m = 0; m < 4; ++m) { bf16_t* rowp = hid + (size_t)(row0 + ai * HALF + m * 16) * D + col0;
                float v[8];
#pragma unroll
                for (int n = 0; n < 2; ++n)
#pragma unroll
                    for (int i = 0; i < 4; ++i) v[n * 4 + i] = silu_fast(acc[ai][0][m][n][i]) * acc[ai][1][m][n][i];
                u32x4 w; w.x = cvt_pk_bf16(v[0], v[1]); w.y = cvt_pk_bf16(v[2], v[3]); w.z = cvt_pk_bf16(v[4], v[5]); w.w = cvt_pk_bf16(v[6], v[7]);
                *(u32x4*)rowp = w; }
    }
};
constexpr float W8_SCALE = 32.0f;
__device__ __forceinline__ unsigned pack4_fp8(float a, float b, float c, float d) { int w = __builtin_amdgcn_cvt_pk_fp8_f32(a, b, 0, false); w = __builtin_amdgcn_cvt_pk_fp8_f32(c, d, w, true); return (unsigned)w; }
struct EpiGU_F8 {
    static constexpr bool PERM = true;
    unsigned char* hid; int nN;
    __device__ __forceinline__ void operator()(const f32x4 (&acc)[2][2][4][2], const Unit& u, int wr, int wc, int fr, int fq) const {
        const int row0 = u.pm * BM + wr * 64 + fr, col0 = (u.pn % nN) * HALF + wc * 32 + 8 * fq;
        constexpr float inv = 1.0f / W8_SCALE;
#pragma unroll
        for (int ai = 0; ai < 2; ++ai)
#pragma unroll
            for (int m = 0; m < 4; ++m) { unsigned char* rowp = hid + (size_t)(row0 + ai * HALF + m * 16) * D + col0;
                float v[8];
#pragma unroll
                for (int n = 0; n < 2; ++n)
#pragma unroll
                    for (int i = 0; i < 4; ++i) v[n * 4 + i] = silu_fast(acc[ai][0][m][n][i] * inv) * (acc[ai][1][m][n][i] * inv);
                typedef unsigned u32x2v __attribute__((ext_vector_type(2)));
                *(u32x2v*)rowp = (u32x2v){pack4_fp8(v[0], v[1], v[2], v[3]), pack4_fp8(v[4], v[5], v[6], v[7])}; }
    }
};
constexpr float OUTSLOT_SCALE = 32.0f;
struct EpiDown8 {
    static constexpr bool PERM = true;
    unsigned char* O; const float* selg; int nN; float wscale;
    __device__ __forceinline__ void operator()(const f32x4 (&acc)[2][2][4][2], const Unit& u, int wr, int wc, int fr, int fq) const {
        const int row0 = u.pm * BM + wr * 64 + fr, col0 = (u.pn % nN) * BM + wc * 32 + 8 * fq;
#pragma unroll
        for (int ai = 0; ai < 2; ++ai)
#pragma unroll
            for (int m = 0; m < 4; ++m) { const int row = row0 + ai * HALF + m * 16; const float gs = selg[row] * wscale * OUTSLOT_SCALE; unsigned char* rowp = O + (size_t)row * D + col0;
#pragma unroll
                for (int bj = 0; bj < 2; ++bj) { f32x4 v0 = acc[ai][bj][m][0] * gs, v1 = acc[ai][bj][m][1] * gs;
#pragma unroll
                    for (int i = 0; i < 4; ++i) { v0[i] = __builtin_amdgcn_fmed3f(v0[i], -448.0f, 448.0f); v1[i] = __builtin_amdgcn_fmed3f(v1[i], -448.0f, 448.0f); }
                    typedef unsigned u32x2v __attribute__((ext_vector_type(2)));
                    *(u32x2v*)(rowp + bj * HALF) = (u32x2v){pack4_fp8(v0[0], v0[1], v0[2], v0[3]), pack4_fp8(v1[0], v1[1], v1[2], v1[3])}; } }
    }
};
}
constexpr int GEMM_LDS_BYTES = pg8::STAGE_BYTES;
constexpr int WQ_QUOTA_IN_EVEN = 700, WQ_QUOTA_IN_ODD = 5600, WQ_QUOTA_OUT = 8600;
constexpr int GIX_UNITS = 10;
constexpr int DYN_LDS_BYTES = GEMM_LDS_BYTES + 16 + GIX_UNITS * 256 * 4;
#endif

struct EpiZ_ : EpiZ { DEV void pair_(int, int, float, float) const {} };
struct EpiWout_ : EpiWout { DEV void pair_(int, int, float, float) const {} };
struct EpiDown_ : EpiDown { DEV void pair_(int, int, float, float) const {} };
struct EpiGU_ : EpiGU { DEV void elem(int, int, float) const {} DEV void pair_(int r, int j, float g, float u) const { pair(r, j, g, u); } };

#ifndef CPU_EMU
typedef float f32x4_t __attribute__((ext_vector_type(4)));
typedef unsigned u32x4_t __attribute__((ext_vector_type(4)));
typedef unsigned u32x2_t __attribute__((ext_vector_type(2)));
typedef float f32x2_t __attribute__((ext_vector_type(2)));
typedef short bf16x8_t __attribute__((ext_vector_type(8)));
__device__ __forceinline__ unsigned pk_bf16(float lo, float hi) { return pg8::cvt_pk_bf16(lo, hi); }
__device__ __forceinline__ int bperm_i(int v, int src_lane) { return __builtin_amdgcn_ds_bpermute(src_lane << 2, v); }
__device__ __forceinline__ float bperm_f(float v, int src_lane) { return __builtin_bit_cast(float, __builtin_amdgcn_ds_bpermute(src_lane << 2, __builtin_bit_cast(int, v))); }
__device__ __forceinline__ int lane_bcast_i(int v, int uniform_lane) { return __builtin_amdgcn_readlane(v, __builtin_amdgcn_readfirstlane(uniform_lane)); }
__device__ __forceinline__ float wave_sum_fast(float v);
__device__ __forceinline__ float wave_sum(float v) { return wave_sum_fast(v); }
__device__ __forceinline__ float fsigmoid(float x) { return __builtin_amdgcn_rcpf(1.0f + __expf(-x)); }
__device__ __forceinline__ float fsilu(float x) { return x * fsigmoid(x); }
__device__ __forceinline__ float fgelu(float x) { const float u = 0.7978845608028654f * (x + 0.044715f * x * x * x); return x * fsigmoid(2.0f * u); }

__device__ __forceinline__ void tconv_tile(const float* __restrict__ src, int src_ld, int scol0, int nvalid, bf16_t* __restrict__ dst, int dst_ld, int drow0, int k0, PG8_LAS float* tile  , int t) {
#pragma unroll
    for (int i = 0; i < 8; ++i) { const int e = t + 512 * i, kk = e >> 6, nn = e & 63;
        tile[kk * 65 + nn] = nn < nvalid ? src[(size_t)(k0 + kk) * src_ld + scol0 + nn] : 0.f; }
    __syncthreads();
    { const int nn = t >> 3, ks = t & 7; float v[8];
#pragma unroll
        for (int j = 0; j < 8; ++j) v[j] = tile[(ks * 8 + j) * 65 + nn];
        u32x4_t w; w.x = pk_bf16(v[0], v[1]); w.y = pk_bf16(v[2], v[3]); w.z = pk_bf16(v[4], v[5]); w.w = pk_bf16(v[6], v[7]);
        *(u32x4_t*)(dst + (size_t)(drow0 + nn) * dst_ld + k0 + ks * 8) = w; }
    __syncthreads();
}
struct WcDesc { const float* src; int ld, nvalid; bf16_t* dst; };
__device__ __forceinline__ WcDesc wconv_desc(const Params& P, int u) {
    constexpr int KT = D / 64, T_EIN = (NZE / 64) * KT, T_OIN = (NZO / 64) * KT, T_OUT = (D / 64) * KT, PER_Q = T_EIN + T_OIN + 2 * T_OUT;
    const int q = u / PER_Q; int r = u % PER_Q; WcDesc d;
    if (r < T_EIN) { const int nt = r / KT, kt = r % KT; d.src = P.ev_w_in + (size_t)q * D * EV_IN + (size_t)(kt * 64) * EV_IN + nt * 64; d.ld = EV_IN; d.nvalid = EV_IN - nt * 64; d.dst = P.wt_ev_in + (size_t)q * NZE * D + (size_t)(nt * 64) * D + kt * 64; return d; }
    r -= T_EIN;
    if (r < T_OIN) { const int nt = r / KT, kt = r % KT; d.src = P.od_w_in + (size_t)q * D * NZO + (size_t)(kt * 64) * NZO + nt * 64; d.ld = NZO; d.nvalid = 64; d.dst = P.wt_od_in + (size_t)q * NZO * D + (size_t)(nt * 64) * D + kt * 64; return d; }
    r -= T_OIN;
    const bool ev = r < T_OUT; if (!ev) r -= T_OUT;
    { const int nt = r / KT, kt = r % KT; d.src = (ev ? P.ev_w_out : P.od_w_out) + (size_t)q * D * D + (size_t)(kt * 64) * D + nt * 64; d.ld = D; d.nvalid = 64; d.dst = (ev ? P.wt_ev_out : P.wt_od_out) + (size_t)q * D * D + (size_t)(nt * 64) * D + kt * 64; }
    return d;
}
__device__ __forceinline__ void fs_wconv(const Params& P, PG8_LAS unsigned char* lds, int t) {
    PG8_LAS float* tile = (PG8_LAS float*)lds;
    PG8_LAS int* slot = (PG8_LAS int*)(lds + 2 * 64 * 65 * 4);
    constexpr int KT = D / 64, NT = 2 * ((NZE / 64) * KT + (NZO / 64) * KT + 2 * (D / 64) * KT);
    unsigned* ctr = P.wq + DEPTH;
    const int kk0 = t >> 6, nn = t & 63;
    if (t == 0) slot[0] = (int)__hip_atomic_fetch_add(ctr, 2u, __ATOMIC_RELAXED, __HIP_MEMORY_SCOPE_AGENT);
    __syncthreads();
    for (int it = 0;; ++it) {
        const int u0 = slot[it & 1];
        if (u0 >= NT) break;
        int unext = NT;
        if (t == 0) unext = (int)__hip_atomic_fetch_add(ctr, 2u, __ATOMIC_RELAXED, __HIP_MEMORY_SCOPE_AGENT);
        const WcDesc d0 = wconv_desc(P, u0), d1 = wconv_desc(P, u0 + 1 < NT ? u0 + 1 : u0);
        float v0[8], v1[8];
#pragma unroll
        for (int i = 0; i < 8; ++i) { v0[i] = nn < d0.nvalid ? d0.src[(size_t)(kk0 + 8 * i) * d0.ld + nn] : 0.f; v1[i] = nn < d1.nvalid ? d1.src[(size_t)(kk0 + 8 * i) * d1.ld + nn] : 0.f; }
#pragma unroll
        for (int i = 0; i < 8; ++i) { tile[(kk0 + 8 * i) * 65 + nn] = v0[i]; tile[64 * 65 + (kk0 + 8 * i) * 65 + nn] = v1[i]; }
        if (t == 0) slot[(it + 1) & 1] = unext;
        __syncthreads();
        { const int n2 = t >> 3, ks = t & 7; float o[8], p[8];
#pragma unroll
            for (int j = 0; j < 8; ++j) { o[j] = tile[(ks * 8 + j) * 65 + n2]; p[j] = tile[64 * 65 + (ks * 8 + j) * 65 + n2]; }
            u32x4_t w; w.x = pk_bf16(o[0], o[1]); w.y = pk_bf16(o[2], o[3]); w.z = pk_bf16(o[4], o[5]); w.w = pk_bf16(o[6], o[7]);
            *(u32x4_t*)(d0.dst + (size_t)n2 * D + ks * 8) = w;
            if (u0 + 1 < NT) { w.x = pk_bf16(p[0], p[1]); w.y = pk_bf16(p[2], p[3]); w.z = pk_bf16(p[4], p[5]); w.w = pk_bf16(p[6], p[7]); *(u32x4_t*)(d1.dst + (size_t)n2 * D + ks * 8) = w; } }
        __syncthreads();
    }
    __syncthreads();
    for (int u = blockIdx.x; u < 32 * 4; u += gridDim.x) {
        const int mi = u >> 2, tt = u & 3, li = mi >> 4, dir = (mi >> 3) & 1, gate = (mi >> 2) & 1, hh = mi & 3;
        const float* src = (gate == 0 ? P.od_gate_a_w : P.od_gate_x_w) + (size_t)(((li * 2 + dir) * 4 + hh) * HD) * HD;
        tconv_tile(src, HD, (tt >> 1) * 64, 64, P.gwT + (size_t)mi * HD * HD, HD, (tt >> 1) * 64, (tt & 1) * 64, tile, t);
    }
    for (int i = blockIdx.x * 512 + t; i < 2 * 4 * SGC * SGC; i += gridDim.x * 512) P.sgw[i] = f2bf(P.od_sg_w[i]);
    for (int i = blockIdx.x * 512 + t; i < DEPTH * D * NE; i += gridDim.x * 512) { const int ll = i / (D * NE), c = (i / NE) % D, e = i % NE; const float w = P.moe_router[i];
        const unsigned ph = pk_bf16(w, 0.f) & 0xffffu; const float wl = w - __uint_as_float(ph << 16);
        P.rw16[((size_t)(ll * 2 + 0) * NE + e) * D + c] = (bf16_t)ph; P.rw16[((size_t)(ll * 2 + 1) * NE + e) * D + c] = (bf16_t)(pk_bf16(wl, 0.f) & 0xffffu); }
}
struct MoeTile { const float* src; unsigned char* dst; };
__device__ __forceinline__ MoeTile moe_tile(const Params& P, int l, int u) {
    constexpr int KT = D / 64, T_GU = (2 * D / 64) * KT, T_DN = (D / 64) * KT, PER_E = T_GU + T_DN;
    const int e = u / PER_E; int r = u % PER_E; MoeTile mt;
    if (r < T_GU) { const int nt = r / KT, kt = r % KT, cv0 = nt * 64, w = cv0 % 256, j0 = (cv0 / 256) * 128 + (w % 128);
        mt.src = (w >= 128 ? P.moe_w_up : P.moe_w_gate) + ((size_t)l * NE + e) * D * D + (size_t)(kt * 64) * D + j0; mt.dst = (unsigned char*)P.wt_gu + (size_t)e * 2 * D * D + (size_t)cv0 * D + kt * 64; }
    else { r -= T_GU; const int nt = r / KT, kt = r % KT;
        mt.src = P.moe_w_down + ((size_t)l * NE + e) * D * D + (size_t)(kt * 64) * D + nt * 64; mt.dst = (unsigned char*)P.wt_dn + (size_t)e * D * D + (size_t)(nt * 64) * D + kt * 64; }
    return mt;
}
__device__ __forceinline__ void fs_moe_wconv(const Params& P, int l, PG8_LAS unsigned char* lds, int t, int limit) {
    PG8_LAS float* tile = (PG8_LAS float*)lds;
    PG8_LAS int* slot = (PG8_LAS int*)(lds + 2 * 64 * 65 * 4);
    constexpr int NT = NE * ((2 * D / 64) + (D / 64)) * (D / 64);
    if (limit > NT) limit = NT;
    const int kk0 = t >> 6, nn = t & 63;
    unsigned* ctr = P.wq + l;
    if (t == 0) { const unsigned c0 = __hip_atomic_load(ctr, __ATOMIC_RELAXED, __HIP_MEMORY_SCOPE_AGENT);
        slot[0] = (int)c0 >= limit ? NT : (int)__hip_atomic_fetch_add(ctr, 2u, __ATOMIC_RELAXED, __HIP_MEMORY_SCOPE_AGENT); }
    __syncthreads();
    for (int it = 0;; ++it) {
        const int u0 = slot[it & 1];
        if (u0 >= NT) break;
        int unext = NT;
        if (t == 0 && u0 + 2 < limit) unext = (int)__hip_atomic_fetch_add(ctr, 2u, __ATOMIC_RELAXED, __HIP_MEMORY_SCOPE_AGENT);
        const MoeTile m0 = moe_tile(P, l, u0), m1 = moe_tile(P, l, u0 + 1 < NT ? u0 + 1 : u0);
        float v0[8], v1[8];
#pragma unroll
        for (int i = 0; i < 8; ++i) { v0[i] = m0.src[(size_t)(kk0 + 8 * i) * D + nn]; v1[i] = m1.src[(size_t)(kk0 + 8 * i) * D + nn]; }
#pragma unroll
        for (int i = 0; i < 8; ++i) { tile[(kk0 + 8 * i) * 65 + nn] = v0[i]; tile[64 * 65 + (kk0 + 8 * i) * 65 + nn] = v1[i]; }
        if (t == 0) slot[(it + 1) & 1] = unext;
        __syncthreads();
        { const int n2 = t >> 3, ks = t & 7; float o[8], p[8];
#pragma unroll
            for (int j = 0; j < 8; ++j) { o[j] = tile[(ks * 8 + j) * 65 + n2]; p[j] = tile[64 * 65 + (ks * 8 + j) * 65 + n2]; }
            constexpr float ws = pg8::W8_SCALE;
            u32x2_t w; w.x = pg8::pack4_fp8(o[0] * ws, o[1] * ws, o[2] * ws, o[3] * ws); w.y = pg8::pack4_fp8(o[4] * ws, o[5] * ws, o[6] * ws, o[7] * ws);
            *(u32x2_t*)(m0.dst + (size_t)n2 * D + ks * 8) = w;
            if (u0 + 1 < NT) { w.x = pg8::pack4_fp8(p[0] * ws, p[1] * ws, p[2] * ws, p[3] * ws); w.y = pg8::pack4_fp8(p[4] * ws, p[5] * ws, p[6] * ws, p[7] * ws); *(u32x2_t*)(m1.dst + (size_t)n2 * D + ks * 8) = w; } }
        __syncthreads();
    }
    __syncthreads();
}
__device__ __forceinline__ void fs_mod(const Params& P, PG8_LAS unsigned char* lds, int t) {
    PG8_LAS float* sb = (PG8_LAS float*)lds;
    PG8_LAS float* red = sb + (NB + 1) * D;
    for (int i = t; i < (NB + 1) * D; i += 512) { const int bb = i / D, kk = i % D; const float v = bb < NB ? P.c[(size_t)bb * D + kk] : P.c_ctx[kk]; sb[i] = v / (1.0f + expf(-v)); }
    __syncthreads();
    constexpr int CB = MODW / 128;
    const int c4 = t & 31, ks = t >> 5;
    for (int u = blockIdx.x; u < DEPTH * CB; u += gridDim.x) {
        const int ll = u / CB, j0 = (u % CB) * 128 + c4 * 4;
        const float* w = P.ada_w + (size_t)ll * D * MODW + j0;
        f32x4_t acc[NB + 1];
#pragma unroll
        for (int bb = 0; bb <= NB; ++bb) acc[bb] = (f32x4_t){0.f, 0.f, 0.f, 0.f};
#pragma unroll 8
        for (int kk = ks * 64; kk < ks * 64 + 64; ++kk) { const f32x4_t wv = *(const f32x4_t*)(w + (size_t)kk * MODW);
#pragma unroll
            for (int bb = 0; bb <= NB; ++bb) acc[bb] += wv * sb[bb * D + kk]; }
#pragma unroll
        for (int bb = 0; bb <= NB; ++bb)
#pragma unroll
            for (int i = 0; i < 4; ++i) red[(ks * 32 + c4) * 36 + bb * 4 + i] = acc[bb][i];
        __syncthreads();
        for (int o = t; o < (NB + 1) * 128; o += 512) { const int bb = o / 128, col = o % 128, cc4 = col >> 2, ci = col & 3;
            float s = P.ada_b[(size_t)ll * MODW + (u % CB) * 128 + col];
#pragma unroll
            for (int k2 = 0; k2 < 16; ++k2) s += red[(k2 * 32 + cc4) * 36 + bb * 4 + ci];
            P.mod[((size_t)ll * (NB + 1) + bb) * MODW + (u % CB) * 128 + col] = s; }
        __syncthreads();
    }
}
#define DPP_ADD(v, ctrl) ((v) + __builtin_bit_cast(float, __builtin_amdgcn_update_dpp(0, __builtin_bit_cast(int, (v)), (ctrl), 0xF, 0xF, true)))
__device__ __forceinline__ float row16_sum(float v) {
    v = DPP_ADD(v, 0xB1);
    v = DPP_ADD(v, 0x4E);
    v = DPP_ADD(v, 0x141);
    v = DPP_ADD(v, 0x140);
    return v;
}
__device__ __forceinline__ float wave_sum_fast(float v) {
    v = row16_sum(v);
    const int iv = __builtin_bit_cast(int, v);
    return __builtin_bit_cast(float, __builtin_amdgcn_readlane(iv, 0)) + __builtin_bit_cast(float, __builtin_amdgcn_readlane(iv, 16)) +
           __builtin_bit_cast(float, __builtin_amdgcn_readlane(iv, 32)) + __builtin_bit_cast(float, __builtin_amdgcn_readlane(iv, 48));
}
template <int MODE>
__device__ __forceinline__ void fs_row(const Params& P, int l, PG8_LAS unsigned char* lds, int t) {
    const int lane = t & 63, wid = t >> 6;
    PG8_LAS float* wrT = (PG8_LAS float*)lds;
    if (MODE == 1) {
        const float* wr = P.moe_router + (size_t)l * D * NE;
        for (int i = t; i < D * NE; i += 512) { const int c = i / NE, e = i % NE; wrT[e * D + c] = wr[i]; }
        __syncthreads();
    }
    const bool combine = (MODE == 0 && l > 0) || MODE == 2;
    const int lc = MODE == 2 ? DEPTH - 1 : l - 1;
    const float* gvec = MODE == 0 ? P.norm_mix_g + (size_t)l * D : MODE == 1 ? P.norm_ffn_g + (size_t)l * D : P.norm_final_g;
    const int nrows = (MODE == 2 || (MODE == 1 && l == DEPTH - 1)) ? RL : R;
    const int nwaves = gridDim.x * 8, rpw = (nrows + nwaves - 1) / nwaves, rbeg = (blockIdx.x * 8 + wid) * rpw, rend = (rbeg + rpw < nrows) ? rbeg + rpw : nrows;
    const bool in32 = (MODE == 0 && l == 0);
    auto xload = [&](int r, u32x4_t (&raw)[4]) {
        if (in32) { const float* xs = r < RL ? P.x + (size_t)r * D : P.ctx + (size_t)(r - RL) * D;
#pragma unroll
            for (int i = 0; i < 4; ++i) raw[i] = *(const u32x4_t*)(xs + lane * 4 + i * 256); }
        else { const bf16_t* xs = P.xb + (size_t)r * D;
#pragma unroll
            for (int i = 0; i < 4; ++i) { const u32x2_t w = *(const u32x2_t*)(xs + lane * 4 + i * 256); raw[i].x = w.x; raw[i].y = w.y; } } };
    f32x4_t gv[4];
#pragma unroll
    for (int i = 0; i < 4; ++i) gv[i] = *(const f32x4_t*)(gvec + lane * 4 + i * 256);
    f32x4_t scv[4], shv[4], m5v[4]; int bbc = -1;
    u32x4_t xn[4]; int inv0 = -1, inv1 = -1, inv2 = -1;
    int pw0[4] = {0, 0, 0, 0}, pw1[4] = {0, 0, 0, 0};
    auto slot_prefetch = [&](int invv) {
        const unsigned long long mk = __ballot(invv >= 0) & 0xffffull;
        if (mk) { const int e0 = __builtin_ctzll(mk); const unsigned long long m2 = mk & (mk - 1); const int s0 = lane_bcast_i(invv, e0);
            const unsigned char* o0 = (const unsigned char*)P.outslot + (size_t)s0 * D + lane * 4;
#pragma unroll
            for (int i = 0; i < 4; ++i) pw0[i] = *(const int*)(o0 + i * 256);
            if (m2) { const int e1 = __builtin_ctzll(m2); const int s1 = lane_bcast_i(invv, e1); const unsigned char* o1 = (const unsigned char*)P.outslot + (size_t)s1 * D + lane * 4;
#pragma unroll
                for (int i = 0; i < 4; ++i) pw1[i] = *(const int*)(o1 + i * 256); } } };
    if (rbeg < rend) { xload(rbeg, xn);
        if (combine) { inv0 = P.inv[(size_t)rbeg * NE + (lane & 15)]; if (rbeg + 1 < rend) inv1 = P.inv[(size_t)(rbeg + 1) * NE + (lane & 15)]; if (rbeg + 2 < rend) inv2 = P.inv[(size_t)(rbeg + 2) * NE + (lane & 15)];
            slot_prefetch(inv0); } }
    for (int r = rbeg; r < rend; ++r) {
        const bool lat = r < RL; const int bb = lat ? r / T : NB;
        f32x4_t xv[4];
#pragma unroll
        for (int i = 0; i < 4; ++i) { if (in32) xv[i] = __builtin_bit_cast(f32x4_t, xn[i]);
            else xv[i] = (f32x4_t){__uint_as_float(xn[i].x << 16), __uint_as_float(xn[i].x & 0xffff0000u), __uint_as_float(xn[i].y << 16), __uint_as_float(xn[i].y & 0xffff0000u)}; }
        const int myinv = inv0;
        int cw0[4], cw1[4];
#pragma unroll
        for (int i = 0; i < 4; ++i) { cw0[i] = pw0[i]; cw1[i] = pw1[i]; }
        if (r + 1 < rend) { xload(r + 1, xn);
            if (combine) { slot_prefetch(inv1); inv0 = inv1; inv1 = inv2; if (r + 3 < rend) inv2 = P.inv[(size_t)(r + 3) * NE + (lane & 15)]; } }
        if (bb != bbc) { bbc = bb;
            if (MODE != 2) { const float* mr = modrow(P, l, bb) + lane * 4;
#pragma unroll
                for (int i = 0; i < 4; ++i) { scv[i] = *(const f32x4_t*)(mr + (MODE == 0 ? 1 : 4) * D + i * 256) + 1.0f; shv[i] = *(const f32x4_t*)(mr + (MODE == 0 ? 0 : 3) * D + i * 256); } }
            if (combine) { const float* m5 = modrow(P, lc, bb) + 5 * D + lane * 4;
#pragma unroll
                for (int i = 0; i < 4; ++i) m5v[i] = *(const f32x4_t*)(m5 + i * 256); } }
        if (combine) {
            f32x4_t sum[4];
#pragma unroll
            for (int i = 0; i < 4; ++i) sum[i] = (f32x4_t){0.f, 0.f, 0.f, 0.f};
            unsigned long long msk = __ballot(myinv >= 0) & 0xffffull;
            constexpr float fs = 1.0f / pg8::OUTSLOT_SCALE;
            if (msk) {
                msk &= msk - 1; const bool two = msk != 0; msk &= msk - 1; const float f1 = two ? fs : 0.0f;
#pragma unroll
                for (int i = 0; i < 4; ++i) {
                    sum[i][0] += fs * __builtin_amdgcn_cvt_f32_fp8(cw0[i], 0) + f1 * __builtin_amdgcn_cvt_f32_fp8(cw1[i], 0); sum[i][1] += fs * __builtin_amdgcn_cvt_f32_fp8(cw0[i], 1) + f1 * __builtin_amdgcn_cvt_f32_fp8(cw1[i], 1);
                    sum[i][2] += fs * __builtin_amdgcn_cvt_f32_fp8(cw0[i], 2) + f1 * __builtin_amdgcn_cvt_f32_fp8(cw1[i], 2); sum[i][3] += fs * __builtin_amdgcn_cvt_f32_fp8(cw0[i], 3) + f1 * __builtin_amdgcn_cvt_f32_fp8(cw1[i], 3); }
            }
            while (msk) {
                const int e0 = __builtin_ctzll(msk); msk &= msk - 1; const bool two = msk != 0; const int e1 = two ? __builtin_ctzll(msk) : e0; msk &= msk - 1;
                const int s0 = lane_bcast_i(myinv, e0), s1 = lane_bcast_i(myinv, e1);
                const unsigned char* o0 = (const unsigned char*)P.outslot + (size_t)s0 * D + lane * 4; const unsigned char* o1 = (const unsigned char*)P.outslot + (size_t)s1 * D + lane * 4;
                int w0[4], w1[4];
#pragma unroll
                for (int i = 0; i < 4; ++i) { w0[i] = *(const int*)(o0 + i * 256); w1[i] = *(const int*)(o1 + i * 256); }
                const float f1 = two ? fs : 0.0f;
#pragma unroll
                for (int i = 0; i < 4; ++i) {
                    sum[i][0] += fs * __builtin_amdgcn_cvt_f32_fp8(w0[i], 0) + f1 * __builtin_amdgcn_cvt_f32_fp8(w1[i], 0); sum[i][1] += fs * __builtin_amdgcn_cvt_f32_fp8(w0[i], 1) + f1 * __builtin_amdgcn_cvt_f32_fp8(w1[i], 1);
                    sum[i][2] += fs * __builtin_amdgcn_cvt_f32_fp8(w0[i], 2) + f1 * __builtin_amdgcn_cvt_f32_fp8(w1[i], 2); sum[i][3] += fs * __builtin_amdgcn_cvt_f32_fp8(w0[i], 3) + f1 * __builtin_amdgcn_cvt_f32_fp8(w1[i], 3); }
            }
            bf16_t* xd = P.xb + (size_t)r * D;
#pragma unroll
            for (int i = 0; i < 4; ++i) { xv[i] += m5v[i] * sum[i];
                if (MODE != 2) { u32x2_t w; w.x = pk_bf16(xv[i][0], xv[i][1]); w.y = pk_bf16(xv[i][2], xv[i][3]); *(u32x2_t*)(xd + lane * 4 + i * 256) = w;
                    xv[i] = (f32x4_t){__uint_as_float(w.x << 16), __uint_as_float(w.x & 0xffff0000u), __uint_as_float(w.y << 16), __uint_as_float(w.y & 0xffff0000u)}; } }
        }
        float ss = 0.f;
#pragma unroll
        for (int i = 0; i < 4; ++i) ss += xv[i][0] * xv[i][0] + xv[i][1] * xv[i][1] + xv[i][2] * xv[i][2] + xv[i][3] * xv[i][3];
        ss = wave_sum_fast(ss);
        const float rinv = 1.0f / sqrtf(ss * (1.0f / D) + EPS);
        if (MODE == 2) {
#pragma unroll
            for (int i = 0; i < 4; ++i) *(f32x4_t*)(P.xlat + (size_t)r * D + lane * 4 + i * 256) = xv[i] * rinv * gv[i];
            continue;
        }
        f32x4_t hv[4];
#pragma unroll
        for (int i = 0; i < 4; ++i) { hv[i] = (xv[i] * rinv * gv[i]) * scv[i] + shv[i];
            if (MODE == 1) *(unsigned*)((unsigned char*)P.h + (size_t)r * D + lane * 4 + i * 256) = pg8::pack4_fp8(hv[i][0], hv[i][1], hv[i][2], hv[i][3]);
            else { u32x2_t w; w.x = pk_bf16(hv[i][0], hv[i][1]); w.y = pk_bf16(hv[i][2], hv[i][3]); *(u32x2_t*)(P.h + (size_t)r * D + lane * 4 + i * 256) = w; } }
        if (MODE == 1) {
            float lg[NE];
#pragma unroll
            for (int e = 0; e < NE; ++e) { f32x4_t a4 = hv[0] * *(const PG8_LAS f32x4_t*)(wrT + e * D + lane * 4);
#pragma unroll
                for (int i = 1; i < 4; ++i) a4 += hv[i] * *(const PG8_LAS f32x4_t*)(wrT + e * D + lane * 4 + i * 256);
                lg[e] = wave_sum_fast((a4[0] + a4[1]) + (a4[2] + a4[3]));
                asm volatile("" ::: "memory"); }
            float mx = lg[0];
#pragma unroll
            for (int e = 1; e < NE; ++e) mx = fmaxf(mx, lg[e]);
            float s = 0.f, mine = 0.f;
#pragma unroll
            for (int e = 0; e < NE; ++e) { const float ex = __expf(lg[e] - mx); s += ex; mine = (lane == e) ? ex : mine; }
            if (lane < NE) P.aff[(size_t)lane * R + r] = mine / s;
        }
    }
}
__device__ __forceinline__ float row16_max(float v) {
#define DPP_MAX(v, ctrl) fmaxf((v), __builtin_bit_cast(float, __builtin_amdgcn_update_dpp(__builtin_bit_cast(int, (v)), __builtin_bit_cast(int, (v)), (ctrl), 0xF, 0xF, false)))
    v = DPP_MAX(v, 0xB1); v = DPP_MAX(v, 0x4E); v = DPP_MAX(v, 0x141); v = DPP_MAX(v, 0x140);
#undef DPP_MAX
    return v;
}
__device__ __forceinline__ void fs_row_ffn(const Params& P, int l, PG8_LAS unsigned char* lds, int t) {
    const int lane = t & 63, wid = t >> 6, rl = lane & 15, kg = lane >> 4;
    constexpr int WROW = D + 8;
    PG8_LAS bf16_t* wThi = (PG8_LAS bf16_t*)lds;
    PG8_LAS bf16_t* wTlo = wThi + NE * WROW;
    PG8_LAS float* gsv = (PG8_LAS float*)(lds + 2 * NE * WROW * 2);
    PG8_LAS float* shv = gsv + D;
    PG8_LAS float* red = shv + D;
    PG8_LAS float* cbv = red + 32 * NE;
    const float* wr = P.moe_router + (size_t)l * D * NE; const float* gvec = P.norm_ffn_g + (size_t)l * D;
    { const bf16_t* rw = P.rw16 + (size_t)l * 2 * NE * D;
        u32x4_t pc[8];
#pragma unroll
        for (int j = 0; j < 8; ++j) pc[j] = *(const u32x4_t*)(rw + (size_t)(t + 512 * j) * 8);
#pragma unroll
        for (int j = 0; j < 8; ++j) { const int p = t + 512 * j, hl = p >> 11, e = (p >> 7) & 15, c8 = (p & 127) * 8; *(PG8_LAS u32x4_t*)((hl ? wTlo : wThi) + e * WROW + c8) = pc[j]; } }
    const int nrows = (l == DEPTH - 1) ? RL : R, ntiles = nrows / 16, nwaves = gridDim.x * 8;
    const int nextra = ntiles - nwaves;
    for (int k0 = 0; k0 < 2; ++k0) {
        if (k0 == 1 && (int)blockIdx.x >= nextra) break;
        const int tl = k0 == 0 ? (int)blockIdx.x * 8 + wid : (wid == 0 ? nwaves + (int)blockIdx.x : ntiles), r0 = tl * 16;
        const int rb = k0 == 0 ? (int)blockIdx.x * 128 : (nwaves + (int)blockIdx.x) * 16, bb = rb < RL ? rb / T : NB;
        const bool active = tl < ntiles; const int r0c = active ? r0 : 0;
        const bf16_t* xrow = P.xb + (size_t)(r0c + rl) * D + kg * 16;
        auto load8 = [&](int kb, u32x4_t (&xg)[8]) {
#pragma unroll
            for (int j = 0; j < 8; ++j) xg[j] = *(const u32x4_t*)(xrow + ((kb * 8 + j) >> 1) * 64 + ((kb * 8 + j) & 1) * 8); };
        u32x4_t xa[8], xc[8];
        f32x4_t sq0, sq1, sq2, sq3; { const f32x4_t* sp = (const f32x4_t*)(P.ssqp + (size_t)(r0c + rl) * 16); sq0 = sp[0]; sq1 = sp[1]; sq2 = sp[2]; sq3 = sp[3]; }
        load8(0, xa);
        __syncthreads();
        { const float* mr = modrow(P, l, bb);
            for (int c = t; c < D; c += 512) { gsv[c] = gvec[c] * (1.0f + mr[4 * D + c]); shv[c] = mr[3 * D + c]; } }
        __syncthreads();
        { const int e = t & 15, part = t >> 4; float s = 0.f;
#pragma unroll 8
            for (int c = part * 32; c < part * 32 + 32; ++c) s += shv[c] * (bf2f(wThi[e * WROW + c]) + bf2f(wTlo[e * WROW + c]));
            red[part * NE + e] = s; }
        __syncthreads();
        if (t < NE) { float s = 0.f;
#pragma unroll
            for (int p2 = 0; p2 < 32; ++p2) s += red[p2 * NE + t];
            cbv[t] = s; }
        __syncthreads();
        if (!active) continue;
        unsigned char* hrow = (unsigned char*)P.h + (size_t)(r0 + rl) * D + kg * 16;
        float rinv;
        { const float ss = ((sq0[0] + sq0[1]) + (sq0[2] + sq0[3])) + ((sq1[0] + sq1[1]) + (sq1[2] + sq1[3])) + ((sq2[0] + sq2[1]) + (sq2[2] + sq2[3])) + ((sq3[0] + sq3[1]) + (sq3[2] + sq3[3]));
            rinv = 1.0f / sqrtf(ss * (1.0f / D) + EPS); }
        pg8::f32x4 acc = (pg8::f32x4){0.f, 0.f, 0.f, 0.f};
        u32x2_t hpair;
        auto step = [&](int ks, const u32x4_t& xv) {
            const int c0 = (ks >> 1) * 64 + kg * 16 + (ks & 1) * 8;
            const f32x4_t g0 = *(const PG8_LAS f32x4_t*)(gsv + c0), g1 = *(const PG8_LAS f32x4_t*)(gsv + c0 + 4), s0 = *(const PG8_LAS f32x4_t*)(shv + c0), s1 = *(const PG8_LAS f32x4_t*)(shv + c0 + 4);
            const bf16x8_t bh = *(const PG8_LAS bf16x8_t*)(wThi + rl * WROW + c0), bl = *(const PG8_LAS bf16x8_t*)(wTlo + rl * WROW + c0);
            const unsigned xw[4] = {xv.x, xv.y, xv.z, xv.w};
            float a[8], hv[8];
#pragma unroll
            for (int j = 0; j < 4; ++j) { const float x0 = __uint_as_float(xw[j] << 16), x1 = __uint_as_float(xw[j] & 0xffff0000u);
                a[2 * j] = x0 * (j < 2 ? g0[2 * j] : g1[2 * j - 4]); a[2 * j + 1] = x1 * (j < 2 ? g0[2 * j + 1] : g1[2 * j - 3]);
                hv[2 * j] = a[2 * j] * rinv + (j < 2 ? s0[2 * j] : s1[2 * j - 4]); hv[2 * j + 1] = a[2 * j + 1] * rinv + (j < 2 ? s0[2 * j + 1] : s1[2 * j - 3]); }
            u32x2_t w8; w8.x = pg8::pack4_fp8(hv[0], hv[1], hv[2], hv[3]); w8.y = pg8::pack4_fp8(hv[4], hv[5], hv[6], hv[7]);
            if (ks & 1) *(u32x4_t*)(hrow + (ks >> 1) * 64) = (u32x4_t){hpair.x, hpair.y, w8.x, w8.y}; else hpair = w8;
            unsigned hw[4], lw[4];
#pragma unroll
            for (int j = 0; j < 4; ++j) { hw[j] = pk_bf16(a[2 * j], a[2 * j + 1]);
                lw[j] = pk_bf16(a[2 * j] - __uint_as_float(hw[j] << 16), a[2 * j + 1] - __uint_as_float(hw[j] & 0xffff0000u)); }
            const bf16x8_t fah = __builtin_bit_cast(bf16x8_t, (u32x4_t){hw[0], hw[1], hw[2], hw[3]}), fal = __builtin_bit_cast(bf16x8_t, (u32x4_t){lw[0], lw[1], lw[2], lw[3]});
            acc = __builtin_amdgcn_mfma_f32_16x16x32_bf16(fah, bh, acc, 0, 0, 0);
            acc = __builtin_amdgcn_mfma_f32_16x16x32_bf16(fah, bl, acc, 0, 0, 0);
            acc = __builtin_amdgcn_mfma_f32_16x16x32_bf16(fal, bh, acc, 0, 0, 0);
            asm volatile("" ::: "memory"); };
#pragma nounroll
        for (int kb = 0; kb < 4; kb += 2) {
            load8(kb + 1, xc);
#pragma unroll
            for (int j = 0; j < 8; ++j) step(kb * 8 + j, xa[j]);
            if (kb + 2 < 4) load8(kb + 2, xa);
#pragma unroll
            for (int j = 0; j < 8; ++j) step((kb + 1) * 8 + j, xc[j]);
        }
        {
            const float cb = cbv[rl]; float aff[4];
#pragma unroll
            for (int i = 0; i < 4; ++i) { const float lg = bperm_f(rinv, 4 * kg + i) * acc[i] + cb;
                const float mx = row16_max(lg), ex = __expf(lg - mx), sm = row16_sum(ex); aff[i] = ex / sm; }
            *(f32x4_t*)(P.aff + (size_t)rl * R + r0 + 4 * kg) = (f32x4_t){aff[0], aff[1], aff[2], aff[3]};
        }
    }
    __syncthreads();
}
template <int KPT>
__device__ __forceinline__ void select_list(const Params& P, const float* a, int n, int cap, int base, int slot0, int e, PG8_LAS unsigned* sm, int t) {
    PG8_LAS unsigned* hist = sm;
    PG8_LAS unsigned* ctl = sm + 256;
    const int lane = t & 63, wid = t >> 6;
    unsigned key[KPT]; bool have[KPT];
#pragma unroll
    for (int j = 0; j < KPT; ++j) { const int i = t * KPT + j; have[j] = i < n; key[j] = have[j] ? __float_as_uint(a[i]) : 0u; }
    unsigned prefix = 0u, rem = (unsigned)cap;
#pragma unroll 1
    for (int pass = 0; pass < 4; ++pass) {
        const int shift = 24 - 8 * pass;
        if (t < 256) hist[t] = 0u;
        __syncthreads();
#pragma unroll
        for (int j = 0; j < KPT; ++j) if (have[j] && (pass == 0 || (key[j] >> (shift + 8)) == prefix)) (void)__hip_atomic_fetch_add(&hist[(key[j] >> shift) & 255u], 1u, __ATOMIC_RELAXED, __HIP_MEMORY_SCOPE_WORKGROUP);
        __syncthreads();
        if (wid == 0) {
            unsigned c[4]; unsigned s = 0u;
#pragma unroll
            for (int q = 0; q < 4; ++q) { c[q] = hist[255 - 4 * lane - q]; s += c[q]; }
            unsigned inc = s;
#pragma unroll
            for (int o = 1; o < 64; o <<= 1) { const unsigned v = (unsigned)bperm_i((int)inc, (lane - o) & 63); if (lane >= o) inc += v; }
            unsigned cum = inc - s;
#pragma unroll
            for (int q = 0; q < 4; ++q) { if (cum < rem && rem <= cum + c[q]) { ctl[0] = (prefix << 8) | (unsigned)(255 - 4 * lane - q); ctl[1] = rem - cum; ctl[2] = c[q]; } cum += c[q]; }
        }
        __syncthreads();
        prefix = ctl[0]; rem = ctl[1];
    }
    const unsigned T_ = prefix, need_eq = rem, cnt_eq = ctl[2];
    int nsel = 0, ntie = 0;
#pragma unroll
    for (int j = 0; j < KPT; ++j) { nsel += (have[j] && key[j] > T_) ? 1 : 0; ntie += (have[j] && key[j] == T_) ? 1 : 0; }
    int incs = nsel, inct = ntie;
#pragma unroll
    for (int o = 1; o < 64; o <<= 1) { const int v1 = bperm_i(incs, (lane - o) & 63), v2 = bperm_i(inct, (lane - o) & 63); if (lane >= o) { incs += v1; inct += v2; } }
    if (lane == 63) { ctl[4 + wid] = (unsigned)incs; ctl[16 + wid] = (unsigned)inct; }
    __syncthreads();
    int bs = 0, bt = 0;
#pragma unroll
    for (int w2 = 0; w2 < 8; ++w2) { if (w2 < wid) { bs += (int)ctl[4 + w2]; bt += (int)ctl[16 + w2]; } }
    int gpos = bs + incs - nsel, tpos = bt + inct - ntie;
    (void)cnt_eq;
#pragma unroll
    for (int j = 0; j < KPT; ++j) if (have[j]) { const int row = base + t * KPT + j;
        const bool gt = key[j] > T_, tie = key[j] == T_, take = gt || (tie && tpos < (int)need_eq);
        const int pos = gpos + (tpos < (int)need_eq ? tpos : (int)need_eq);
        if (take) { P.sel_row[slot0 + pos] = row; P.sel_g[slot0 + pos] = __uint_as_float(key[j]); P.inv[(size_t)row * NE + e] = slot0 + pos; }
        else P.inv[(size_t)row * NE + e] = -1;
        gpos += gt ? 1 : 0; tpos += tie ? 1 : 0; }
    __syncthreads();
}
__device__ __forceinline__ void fs_select(const Params& P, int l, PG8_LAS unsigned char* lds, int t) {
    PG8_LAS unsigned* sm = (PG8_LAS unsigned*)lds;
    for (int li = blockIdx.x; li < (l == DEPTH - 1 ? 1 : 2) * NB * NE; li += gridDim.x) {
        const bool lat = li < NB * NE; const int q = lat ? li : li - NB * NE, b = q / NE, e = q % NE;
        const int base = lat ? b * T : RL + b * TC, slot0 = e * SLOTS_E + (lat ? b * CAPL : NB * CAPL + b * CAPC);
        const float* a = P.aff + (size_t)e * R + base;
        if (lat) select_list<T / 512>(P, a, T, CAPL, base, slot0, e, sm, t);
        else select_list<1>(P, a, TC, CAPC, base, slot0, e, sm, t);
    }
}
__device__ __forceinline__ void fs_gather(const Params& P, int t) {
    const int lane = t & 63, wid = t >> 6;
    for (int s = blockIdx.x * 8 + wid; s < SLOTS; s += gridDim.x * 8) {
        const bf16_t* src = P.h + (size_t)P.sel_row[s] * D + lane * 8; bf16_t* dst = P.xg + (size_t)s * D + lane * 8;
        const u32x4_t v0 = *(const u32x4_t*)src, v1 = *(const u32x4_t*)(src + 512);
        *(u32x4_t*)dst = v0; *(u32x4_t*)(dst + 512) = v1;
    }
}
__device__ __forceinline__ float neg_expm1_fast(float x) {
    const float p = x * (1.0f + x * (0.5f + x * (1.0f / 6.0f + x * (1.0f / 24.0f + x * (1.0f / 120.0f + x * (1.0f / 720.0f))))));
    return x > -0.25f ? -p : 1.0f - __expf(x);
}
struct LruRegs { unsigned x[11], g[8]; float hin; };
template <bool FINAL>
__device__ __forceinline__ void lru_load(const Params& P, int u, int hh, int t, LruRegs& r) {
    const int rest = u >> 2, c = rest % NCH, b = rest / NCH;
    const int row0 = seqrow(b, c * CH), seglo = c < NCHC ? RL + b * TC : b * T, seghi = seglo + (c < NCHC ? TC : T);
    const int cp = t & 63, tg = t >> 6, r0 = row0 + tg * 8 - 2;
    const bf16_t* zc = P.z + O_XB + hh * HD + 2 * cp;
#pragma unroll
    for (int i = 0; i < 11; ++i) { int rr = r0 + i; rr = rr < seglo ? seglo : rr; rr = rr >= seghi ? seghi - 1 : rr; r.x[i] = *(const unsigned*)(zc + (size_t)rr * NZO); }
    if (FINAL) {
        const bf16_t* zg = P.z + O_GB + hh * HD + 2 * cp;
#pragma unroll
        for (int i = 0; i < 8; ++i) r.g[i] = *(const unsigned*)(zg + (size_t)(row0 + tg * 8 + i) * NZO);
        r.hin = t < 256 ? P.hinb[((size_t)((t >> 7) * NB + b) * NCH + c) * W2 + hh * HD + (t & 127)] : 0.f;
    }
}
template <bool FINAL>
__device__ __forceinline__ void fs_odd_lru(const Params& P, int l, PG8_LAS unsigned char* lds, int t) {
    const int lane = t & 63, w = t >> 6, q = lane >> 4, fr = lane & 15;
    const int li = l >> 1, hh = blockIdx.x & 3, jch = 16 * w + fr, chg = hh * HD + jch;
    PG8_LAS bf16_t* xcb = (PG8_LAS bf16_t*)lds;
    constexpr int XROW = 132;
    PG8_LAS float* xcf = (PG8_LAS float*)(lds + 17408);
    PG8_LAS float* hs = (PG8_LAS float*)(lds + 17408 + 33792);
    PG8_LAS float* hin = (PG8_LAS float*)(lds + 17408 + 67584);
    PG8_LAS bf16_t* gbs = (PG8_LAS bf16_t*)(lds + 17408 + 67584 + 1024);
    bf16x8_t bw[2][2][4];
#pragma unroll
    for (int dir = 0; dir < 2; ++dir)
#pragma unroll
        for (int gate = 0; gate < 2; ++gate)
#pragma unroll
            for (int ks = 0; ks < 4; ++ks) bw[dir][gate][ks] = *(const bf16x8_t*)(P.gwT + ((size_t)((((li * 2 + dir) * 2 + gate) * 4 + hh) * HD + jch)) * HD + ks * 32 + 8 * q);
    constexpr float L2E = 1.4426950408889634f;
    float ba[2], bx[2], sp[2];
#pragma unroll
    for (int dir = 0; dir < 2; ++dir) { ba[dir] = -L2E * P.od_gate_a_b[(size_t)(li * 2 + dir) * W2 + chg]; bx[dir] = -L2E * P.od_gate_x_b[(size_t)(li * 2 + dir) * W2 + chg];
        sp[dir] = L2E * -8.0f * softplusf_(-P.od_lambda[(size_t)(li * 2 + dir) * W2 + chg]); }
    const int cp = t & 63, tg = t >> 6;
    float cw[4][2], cbv[2];
#pragma unroll
    for (int h2 = 0; h2 < 2; ++h2) { cbv[h2] = P.od_conv_b[(size_t)li * W2 + hh * HD + 2 * cp + h2];
#pragma unroll
        for (int j = 0; j < 4; ++j) cw[j][h2] = P.od_conv_w[(size_t)(li * 4 + j) * W2 + hh * HD + 2 * cp + h2]; }
    constexpr int NU = NB * NCH * 4;
    LruRegs rg; if ((int)blockIdx.x < NU) lru_load<FINAL>(P, blockIdx.x, hh, t, rg);
    for (int u = blockIdx.x; u < NU; u += gridDim.x) {
        const int rest = u >> 2, c = rest % NCH, b = rest / NCH;
        const int row0 = seqrow(b, c * CH), seglo = c < NCHC ? RL + b * TC : b * T, seghi = seglo + (c < NCHC ? TC : T);
        {
            const int r0 = row0 + tg * 8 - 2;
            f32x2_t xv[11];
#pragma unroll
            for (int i = 0; i < 11; ++i) { const unsigned w = (r0 + i >= seglo && r0 + i < seghi) ? rg.x[i] : 0u; xv[i] = (f32x2_t){__uint_as_float(w << 16), __uint_as_float(w & 0xffff0000u)}; }
            const f32x2_t cb2v = (f32x2_t){cbv[0], cbv[1]}, cw0 = (f32x2_t){cw[0][0], cw[0][1]}, cw1 = (f32x2_t){cw[1][0], cw[1][1]}, cw2 = (f32x2_t){cw[2][0], cw[2][1]}, cw3 = (f32x2_t){cw[3][0], cw[3][1]};
#pragma unroll
            for (int i = 0; i < 8; ++i) { const int tok = tg * 8 + i;
                const f32x2_t xc = cb2v + cw0 * xv[i] + cw1 * xv[i + 1] + cw2 * xv[i + 2] + cw3 * xv[i + 3];
                *(PG8_LAS f32x2_t*)(xcf + tok * XROW + 2 * cp) = xc; *(PG8_LAS unsigned*)(xcb + tok * 136 + 2 * cp) = pk_bf16(xc.x, xc.y); }
            if (FINAL) {
#pragma unroll
                for (int i = 0; i < 8; ++i) *(PG8_LAS unsigned*)(gbs + (tg * 8 + i) * 128 + 2 * cp) = rg.g[i];
                if (t < 256) hin[t] = rg.hin; }
        }
        __syncthreads();
        if (u + (int)gridDim.x < NU) lru_load<FINAL>(P, u + gridDim.x, hh, t, rg);
#pragma unroll
        for (int dir = 0; dir < 2; ++dir) {
            pg8::f32x4 aa[4], ax[4];
#pragma unroll
            for (int mt = 0; mt < 4; ++mt) { aa[mt] = (pg8::f32x4){0.f, 0.f, 0.f, 0.f}; ax[mt] = (pg8::f32x4){0.f, 0.f, 0.f, 0.f}; }
#pragma unroll
            for (int ks = 0; ks < 4; ++ks)
#pragma unroll
                for (int mt = 0; mt < 4; ++mt) { const bf16x8_t af = *(const PG8_LAS bf16x8_t*)(xcb + (mt * 16 + fr) * 136 + ks * 32 + 8 * q);
                    aa[mt] = __builtin_amdgcn_mfma_f32_16x16x32_bf16(af, bw[dir][0][ks], aa[mt], 0, 0, 0);
                    ax[mt] = __builtin_amdgcn_mfma_f32_16x16x32_bf16(af, bw[dir][1][ks], ax[mt], 0, 0, 0); }
            float Ac = 1.f, Bc = FINAL ? hin[dir * 128 + jch] : 0.f;
#pragma unroll
            for (int mm = 0; mm < 4; ++mm) { const int mt = dir == 0 ? mm : 3 - mm;
                float ca[4], cb2[4];
#pragma unroll
                for (int ip = 0; ip < 2; ++ip) { const int i0 = 2 * ip;
                    const f32x2_t xv = (f32x2_t){xcf[(mt * 16 + 4 * q + i0) * XROW + jch], xcf[(mt * 16 + 4 * q + i0 + 1) * XROW + jch]};
                    const f32x2_t ta = (f32x2_t){aa[mt][i0], aa[mt][i0 + 1]} * (f32x2_t){-L2E, -L2E} + (f32x2_t){ba[dir], ba[dir]};
                    const f32x2_t tx = (f32x2_t){ax[mt][i0], ax[mt][i0 + 1]} * (f32x2_t){-L2E, -L2E} + (f32x2_t){bx[dir], bx[dir]};
                    const f32x2_t da = (f32x2_t){__builtin_amdgcn_exp2f(ta.x), __builtin_amdgcn_exp2f(ta.y)} + (f32x2_t){1.0f, 1.0f};
                    const f32x2_t dx = (f32x2_t){__builtin_amdgcn_exp2f(tx.x), __builtin_amdgcn_exp2f(tx.y)} + (f32x2_t){1.0f, 1.0f};
                    const f32x2_t rg2 = (f32x2_t){__builtin_amdgcn_rcpf(da.x), __builtin_amdgcn_rcpf(da.y)}, ig2 = (f32x2_t){__builtin_amdgcn_rcpf(dx.x), __builtin_amdgcn_rcpf(dx.y)};
                    const f32x2_t l2 = rg2 * (f32x2_t){sp[dir], sp[dir]};
                    const f32x2_t a2 = (f32x2_t){__builtin_amdgcn_exp2f(l2.x), __builtin_amdgcn_exp2f(l2.y)};
                    const f32x2_t om = (f32x2_t){1.0f, 1.0f} - a2 * a2;
                    const f32x2_t sq = (f32x2_t){__builtin_amdgcn_sqrtf(fmaxf(om.x, 0.f)), __builtin_amdgcn_sqrtf(fmaxf(om.y, 0.f))};
                    const f32x2_t cb = sq * (ig2 * xv);
                    ca[i0] = a2.x; ca[i0 + 1] = a2.y; cb2[i0] = cb.x; cb2[i0 + 1] = cb.y; }
                float Al = 1.f, Bl = 0.f;
#pragma unroll
                for (int ii = 0; ii < 4; ++ii) { const int i = dir == 0 ? ii : 3 - ii; Al = ca[i] * Al; Bl = ca[i] * Bl + cb2[i]; }
                float hq = Bc;
#pragma unroll
                for (int qq = 0; qq < 4; ++qq) { const int qs = dir == 0 ? qq : 3 - qq;
                    const float Aq = bperm_f(Al, fr + 16 * qs), Bq = bperm_f(Bl, fr + 16 * qs);
                    const bool before = dir == 0 ? (qs < q) : (qs > q);
                    if (FINAL) hq = before ? Aq * hq + Bq : hq;
                    Ac = Aq * Ac; Bc = Aq * Bc + Bq; }
                if (FINAL) {
                    float h = hq;
#pragma unroll
                    for (int ii = 0; ii < 4; ++ii) { const int i = dir == 0 ? ii : 3 - ii; h = ca[i] * h + cb2[i];
                        PG8_LAS float* hp = hs + (mt * 16 + 4 * q + i) * XROW + jch; if (dir == 0) *hp = h; else *hp += h; }
                }
            }
            if (!FINAL && q == 0) { const size_t si = ((size_t)(dir * NB + b) * NCH + c) * W2 + chg; P.sumA[si] = Ac; P.sumB[si] = Bc; }
        }
        __syncthreads();
        if (FINAL) {
            const int r = row0 + tg * 8;
#pragma unroll
            for (int i = 0; i < 8; ++i) { const f32x2_t hv = *(const PG8_LAS f32x2_t*)(hs + (tg * 8 + i) * XROW + 2 * cp); const unsigned gw = *(const PG8_LAS unsigned*)(gbs + (tg * 8 + i) * 128 + 2 * cp);
                const f32x2_t gx = (f32x2_t){__uint_as_float(gw << 16), __uint_as_float(gw & 0xffff0000u)};
                const f32x2_t ag = gx * (gx * gx * (f32x2_t){0.044715f, 0.044715f} + (f32x2_t){1.0f, 1.0f}) * (f32x2_t){-2.0f * 1.4426950408889634f * 0.7978845608028654f, -2.0f * 1.4426950408889634f * 0.7978845608028654f};
                const f32x2_t dg = (f32x2_t){__builtin_amdgcn_exp2f(ag.x), __builtin_amdgcn_exp2f(ag.y)} + (f32x2_t){1.0f, 1.0f};
                const f32x2_t yv = hv * gx * (f32x2_t){__builtin_amdgcn_rcpf(dg.x), __builtin_amdgcn_rcpf(dg.y)};
                *(unsigned*)(P.m + (size_t)(r + i) * D + hh * HD + 2 * cp) = pk_bf16(yv.x, yv.y); }
            __syncthreads();
        }
    }
}
__device__ __forceinline__ void fs_sgstat(const Params& P, int lane, int wid, int nw);
__device__ __forceinline__ void fs_odd2(const Params& P, int t) {
    if (t >= 64) { fs_sgstat(P, t & 63, (t >> 6) - 1, 7); return; }
    if (t >= 32) return;
    static_assert(NCH % 17 == 0, "chunk steps are taken 17 at a time");
    for (int it = blockIdx.x * 32 + t; it < 2 * NB * W2; it += gridDim.x * 32) {
        const int ch = it % W2, b = (it / W2) % NB, dir = it / (W2 * NB);
        const size_t base = ((size_t)(dir * NB + b) * NCH) * W2 + ch;
        const float* __restrict__ sA = P.sumA + base; const float* __restrict__ sB = P.sumB + base; float* __restrict__ hb = P.hinb + base;
        float h = 0.f;
#pragma unroll 1
        for (int s0 = 0; s0 < NCH; s0 += 17) {
            float A[17], B[17];
#pragma unroll
            for (int j = 0; j < 17; ++j) { const int step = s0 + j, c = dir == 0 ? step : (step < NCHC ? NCHC - 1 - step : NCH - 1 - (step - NCHC)); A[j] = sA[(size_t)c * W2]; B[j] = sB[(size_t)c * W2]; }
#pragma unroll
            for (int j = 0; j < 17; ++j) { const int step = s0 + j, c = dir == 0 ? step : (step < NCHC ? NCHC - 1 - step : NCH - 1 - (step - NCHC)); hb[(size_t)c * W2] = h; h = A[j] * h + B[j]; }
        }
    }
}
__device__ __forceinline__ void fs_sgstat(const Params& P, int lane, int wid, int nw  ) {
    const int stride = gridDim.x * nw;
    for (int r0 = blockIdx.x * nw + wid; r0 < R; r0 += 4 * stride) {
        u32x4_t w[4];
#pragma unroll
        for (int j = 0; j < 4; ++j) { const int r = r0 + j * stride < R ? r0 + j * stride : r0; w[j] = *(const u32x4_t*)(P.z + (size_t)r * NZO + O_V + lane * 8); }
#pragma unroll
        for (int j = 0; j < 4; ++j) { const int r = r0 + j * stride;
            const unsigned ww[4] = {w[j].x, w[j].y, w[j].z, w[j].w};
            float g[8];
#pragma unroll
            for (int i = 0; i < 4; ++i) { g[2 * i] = fgelu(__uint_as_float(ww[i] << 16)); g[2 * i + 1] = fgelu(__uint_as_float(ww[i] & 0xffff0000u)); }
            float s = 0.f;
#pragma unroll
            for (int i = 0; i < 8; ++i) s += g[i];
            const float mean = wave_sum(s) * (1.0f / W2);
            float vs = 0.f;
#pragma unroll
            for (int i = 0; i < 8; ++i) { const float d = g[i] - mean; vs += d * d; }
            vs = wave_sum(vs);
            if (lane == 0 && r < R) { P.sgstat[2 * r] = mean; P.sgstat[2 * r + 1] = 1.0f / sqrtf(vs * (1.0f / W2) + EPS); } }
    }
}
__device__ __forceinline__ void fs_odd_sg(const Params& P, int l, PG8_LAS unsigned char* lds, int t) {
    const int lane = t & 63, w = t >> 6, q = lane >> 4, fr = lane & 15, li = l >> 1, g = blockIdx.x & 3;
    PG8_LAS bf16_t* vbT = (PG8_LAS bf16_t*)lds;
    bf16x8_t aw[4];
#pragma unroll
    for (int ks = 0; ks < 4; ++ks) aw[ks] = *(const bf16x8_t*)(P.sgw + ((size_t)((li * 4 + g) * SGC + 16 * w + fr)) * SGC + ks * 32 + 8 * q);
    float sgb[4];
#pragma unroll
    for (int ii = 0; ii < 4; ++ii) sgb[ii] = P.od_sg_b[(size_t)(li * 4 + g) * SGC + 16 * w + 4 * q + ii];
    const int cc = t & 127, jp = t >> 7; const float gn = P.od_sg_norm_g[(size_t)li * W2 + g * HD + cc];
    for (int u = (blockIdx.x + gridDim.x / 2) % gridDim.x; u < (R / SGC) * 4; u += gridDim.x) {
        const int base = (u >> 2) * SGC;
        { const bf16_t* zv = P.z + O_V + g * HD + cc;
            bf16_t vr[32]; f32x4_t sv[16];
#pragma unroll
            for (int jj = 0; jj < 16; ++jj) { const int r0 = base + (jp * 16 + jj) * 2;
                vr[2 * jj] = zv[(size_t)r0 * NZO]; vr[2 * jj + 1] = zv[(size_t)(r0 + 1) * NZO]; sv[jj] = *(const f32x4_t*)(P.sgstat + 2 * r0); }
#pragma unroll
            for (int jj = 0; jj < 16; ++jj) { const int j = (jp * 16 + jj) * 2;
                const float v0 = (fgelu(bf2f(vr[2 * jj])) - sv[jj][0]) * sv[jj][1] * gn;
                const float v1 = (fgelu(bf2f(vr[2 * jj + 1])) - sv[jj][2]) * sv[jj][3] * gn;
                *(PG8_LAS unsigned*)(vbT + cc * 136 + j) = pk_bf16(v0, v1); } }
        __syncthreads();
        bf16_t ur[32];
#pragma unroll
        for (int ct = 0; ct < 8; ++ct)
#pragma unroll
            for (int ii = 0; ii < 4; ++ii) ur[ct * 4 + ii] = P.z[(size_t)(base + 16 * w + 4 * q + ii) * NZO + O_U + g * HD + ct * 16 + fr];
        pg8::f32x4 acc[8];
#pragma unroll
        for (int ct = 0; ct < 8; ++ct) acc[ct] = (pg8::f32x4){0.f, 0.f, 0.f, 0.f};
#pragma unroll
        for (int ks = 0; ks < 4; ++ks)
#pragma unroll
            for (int ct = 0; ct < 8; ++ct) { const bf16x8_t bf = *(const PG8_LAS bf16x8_t*)(vbT + (ct * 16 + fr) * 136 + ks * 32 + 8 * q);
                acc[ct] = __builtin_amdgcn_mfma_f32_16x16x32_bf16(aw[ks], bf, acc[ct], 0, 0, 0); }
#pragma unroll
        for (int ct = 0; ct < 8; ++ct)
#pragma unroll
            for (int ii = 0; ii < 4; ++ii) { const int row = base + 16 * w + 4 * q + ii, c = g * HD + ct * 16 + fr;
                const float uu = bf2f(ur[ct * 4 + ii]);
                P.m[(size_t)row * D + W2 + c] = f2bf(fgelu(uu) * (acc[ct][ii] + sgb[ii])); }
        __syncthreads();
    }
}
constexpr int LRS_ROW = 40;
constexpr int LAT_ROW = 68;
struct GlaUp { bf16x8_t b[4]; float bias[4]; };
__device__ __forceinline__ void gla_load_up(const Params& P, int li, int hh, int t, GlaUp& g) {
    const int lane = t & 63, w = t >> 6, q = lane >> 4, fr = lane & 15, dir = w >> 2;
    unsigned keep = (q >> 1) == dir ? 0xffffffffu : 0u; asm volatile("" : "+v"(keep));
#pragma unroll
    for (int j = 0; j < 4; ++j) { const int dcol = hh * DK + j * 16 + fr; unsigned pk[4];
#pragma unroll
        for (int i2 = 0; i2 < 4; ++i2) { const int r0 = 8 * (q & 1) + 2 * i2;
            const float a = P.ev_decay_up[((size_t)(li * 2 + dir) * RANK + r0) * KEY + dcol], b2 = P.ev_decay_up[((size_t)(li * 2 + dir) * RANK + r0 + 1) * KEY + dcol];
            pk[i2] = pk_bf16(a, b2) & keep; }
        g.b[j] = __builtin_bit_cast(bf16x8_t, (u32x4_t){pk[0], pk[1], pk[2], pk[3]});
        g.bias[j] = P.ev_decay_b[(size_t)(li * 2 + dir) * KEY + dcol]; }
}
__device__ __forceinline__ void gla_preact(const PG8_LAS bf16_t* lrs, const GlaUp& g, PG8_LAS float* laT, int t) {
    const int lane = t & 63, w = t >> 6, q = lane >> 4, fr = lane & 15, mt = w & 3, dir = w >> 2;
    const bf16x8_t af = *(const PG8_LAS bf16x8_t*)(lrs + (mt * 16 + fr) * LRS_ROW + 8 * q);
#pragma unroll
    for (int j = 0; j < 4; ++j) { const pg8::f32x4 acc = __builtin_amdgcn_mfma_f32_16x16x32_bf16(af, g.b[j], (pg8::f32x4){0.f, 0.f, 0.f, 0.f}, 0, 0, 0);
        f32x4_t la;
#pragma unroll
        for (int ii = 0; ii < 4; ++ii) { const float x = acc[ii] + g.bias[j]; la[ii] = (fminf(x, 0.f) - __logf(1.0f + __expf(-fabsf(x)))) * (1.0f / 16.0f); }
        *(PG8_LAS f32x4_t*)(laT + ((dir * 4 + j) * 16 + fr) * LAT_ROW + mt * 16 + 4 * q) = la; }
}
__device__ __forceinline__ void gla_local_cumsum(const PG8_LAS float* laT, int d, int tok_first, float (&csf)[8], float (&csb)[8]) {
    const f32x4_t a0 = *(const PG8_LAS f32x4_t*)(laT + d * LAT_ROW + tok_first), a1 = *(const PG8_LAS f32x4_t*)(laT + d * LAT_ROW + tok_first + 4);
    const f32x4_t b0 = *(const PG8_LAS f32x4_t*)(laT + (64 + d) * LAT_ROW + tok_first), b1 = *(const PG8_LAS f32x4_t*)(laT + (64 + d) * LAT_ROW + tok_first + 4);
#pragma unroll
    for (int i = 0; i < 4; ++i) { csf[i] = a0[i]; csf[4 + i] = a1[i]; csb[i] = b0[i]; csb[4 + i] = b1[i]; }
#pragma unroll
    for (int i = 1; i < 8; ++i) csf[i] += csf[i - 1];
#pragma unroll
    for (int i = 6; i >= 0; --i) csb[i] += csb[i + 1];
}
__device__ __forceinline__ unsigned st8_pack4(float a, float b, float c, float d) {
    return pg8::pack4_fp8(__builtin_amdgcn_fmed3f(a, -448.f, 448.f), __builtin_amdgcn_fmed3f(b, -448.f, 448.f), __builtin_amdgcn_fmed3f(c, -448.f, 448.f), __builtin_amdgcn_fmed3f(d, -448.f, 448.f)); }
__device__ __forceinline__ u32x4_t st8_to_bf16x8(u32x2_t w) {
    return (u32x4_t){pk_bf16(__builtin_amdgcn_cvt_f32_fp8((int)w.x, 0), __builtin_amdgcn_cvt_f32_fp8((int)w.x, 1)), pk_bf16(__builtin_amdgcn_cvt_f32_fp8((int)w.x, 2), __builtin_amdgcn_cvt_f32_fp8((int)w.x, 3)),
                      pk_bf16(__builtin_amdgcn_cvt_f32_fp8((int)w.y, 0), __builtin_amdgcn_cvt_f32_fp8((int)w.y, 1)), pk_bf16(__builtin_amdgcn_cvt_f32_fp8((int)w.y, 2), __builtin_amdgcn_cvt_f32_fp8((int)w.y, 3))}; }
struct GlaRegs { u32x2_t lr; bf16_t k[8], q[8], v[16], g[16]; u32x2_t s[2][2]; };
template <bool E3>
__device__ __forceinline__ void gla_load(const Params& P, int u, int hh, int t, GlaRegs& r) {
    const int rest = u >> 2, c = rest % NCH, b = rest / NCH, row0 = seqrow(b, c * CH);
    const int d = t & 63, sg = t >> 6, e = t & 127, jp = t >> 7;
    r.lr = *(const u32x2_t*)(P.z + (size_t)(row0 + (t >> 3)) * NZE + E_LRF + (t & 7) * 4);
#pragma unroll
    for (int i = 0; i < 8; ++i) { const bf16_t* zr = P.z + (size_t)(row0 + sg * 8 + i) * NZE + hh * DK + d; r.k[i] = zr[E_K]; if (E3) r.q[i] = zr[E_Q]; }
#pragma unroll
    for (int jj = 0; jj < 16; ++jj) r.v[jj] = P.z[(size_t)(row0 + jp * 16 + jj) * NZE + E_V + hh * DV + e];
    if (E3) {
        const int lane = t & 63, w = t >> 6, q = lane >> 4, fr = lane & 15, it = w & 3, wh = w >> 2;
#pragma unroll
        for (int ii = 0; ii < 4; ++ii)
#pragma unroll
            for (int el = 0; el < 4; ++el) r.g[ii * 4 + el] = P.z[(size_t)(row0 + it * 16 + 4 * q + ii) * NZE + E_G + hh * DV + (wh * 4 + el) * 16 + fr];
#pragma unroll
        for (int dir = 0; dir < 2; ++dir) { const unsigned char* Sb = (const unsigned char*)P.SinB + ((size_t)((dir * NB + b) * GH + hh) * NCH + c) * DV * DK;
#pragma unroll
            for (int i = 0; i < 2; ++i) r.s[dir][i] = *(const u32x2_t*)(Sb + (size_t)(t + 512 * i) * 8); }
    }
}
__device__ __forceinline__ void gla_store_common(const GlaRegs& r, PG8_LAS bf16_t* lrs, PG8_LAS bf16_t* vT, int t) {
    *(PG8_LAS u32x2_t*)(lrs + (t >> 3) * LRS_ROW + (t & 7) * 4) = r.lr;
    const int e = t & 127, jp = t >> 7;
#pragma unroll
    for (int jj = 0; jj < 16; jj += 2) *(PG8_LAS unsigned*)(vT + e * 72 + jp * 16 + jj) = (unsigned)r.v[jj] | ((unsigned)r.v[jj + 1] << 16);
}
constexpr int LRS1_ROW = 40;
struct GlaUp1 { bf16x8_t b; float bias[4]; };
__device__ __forceinline__ void gla_load_up1(const Params& P, int li, int hh, int t, GlaUp1& g) {
    const int lane = t & 63, w = t >> 6, q = lane >> 4, fr = lane & 15, dir = w >> 2, dt = w & 3;
    unsigned keep = (q >> 1) == dir ? 0xffffffffu : 0u; asm volatile("" : "+v"(keep));
    const int dcol = hh * DK + dt * 16 + fr; unsigned pk[4];
#pragma unroll
    for (int i2 = 0; i2 < 4; ++i2) { const int r0 = 8 * (q & 1) + 2 * i2;
        const float a = P.ev_decay_up[((size_t)(li * 2 + dir) * RANK + r0) * KEY + dcol], b2 = P.ev_decay_up[((size_t)(li * 2 + dir) * RANK + r0 + 1) * KEY + dcol];
        pk[i2] = pk_bf16(a, b2) & keep; }
    g.b = __builtin_bit_cast(bf16x8_t, (u32x4_t){pk[0], pk[1], pk[2], pk[3]});
#pragma unroll
    for (int ii = 0; ii < 4; ++ii) g.bias[ii] = P.ev_decay_b[(size_t)(li * 2 + dir) * KEY + hh * DK + dt * 16 + 4 * q + ii];
}
__device__ __forceinline__ void gla_decay_scan(const PG8_LAS bf16_t* lrs, const GlaUp1& g, int t, float (&bl)[4][4], float (&tot)[4]) {
    const int lane = t & 63, w = t >> 6, q = lane >> 4, fr = lane & 15, dir = w >> 2;
#pragma unroll
    for (int mt = 0; mt < 4; ++mt) { const bf16x8_t tf = *(const PG8_LAS bf16x8_t*)(lrs + (mt * 16 + fr) * LRS1_ROW + 8 * q);
        const pg8::f32x4 acc = __builtin_amdgcn_mfma_f32_16x16x32_bf16(g.b, tf, (pg8::f32x4){0.f, 0.f, 0.f, 0.f}, 0, 0, 0);
#pragma unroll
        for (int ii = 0; ii < 4; ++ii) { const float x = acc[ii] + g.bias[ii]; bl[mt][ii] = (fminf(x, 0.f) - __logf(1.0f + __expf(-fabsf(x)))) * (1.0f / 16.0f); } }
#pragma unroll
    for (int ii = 0; ii < 4; ++ii) tot[ii] = 0.f;
    if (dir == 0) {
#pragma unroll
        for (int mt = 0; mt < 4; ++mt)
#pragma unroll
            for (int ii = 0; ii < 4; ++ii) { float v = bl[mt][ii]; v = DPP_ADD(v, 0x111); v = DPP_ADD(v, 0x112); v = DPP_ADD(v, 0x114); v = DPP_ADD(v, 0x118);
                const float tt = bperm_f(v, lane | 15); bl[mt][ii] = v + tot[ii]; tot[ii] += tt; }
    } else {
#pragma unroll
        for (int mt = 3; mt >= 0; --mt)
#pragma unroll
            for (int ii = 0; ii < 4; ++ii) { float v = bl[mt][ii]; v = DPP_ADD(v, 0x101); v = DPP_ADD(v, 0x102); v = DPP_ADD(v, 0x104); v = DPP_ADD(v, 0x108);
                const float tt = bperm_f(v, lane & 48); bl[mt][ii] = v + tot[ii]; tot[ii] += tt; }
    }
}
struct GlaRegs1 { u32x2_t lr, k[4], q[4]; u32x4_t v[2]; u32x2_t s[2][2]; };
template <bool E3>
__device__ __forceinline__ void gla_load1(const Params& P, int u, int hh, int t, GlaRegs1& r) {
    const int rest = u >> 2, c = rest % NCH, b = rest / NCH, row0 = seqrow(b, c * CH);
    const int lane = t & 63, w = t >> 6, q = lane >> 4, fr = lane & 15, dt = w & 3;
    r.lr = *(const u32x2_t*)(P.z + (size_t)(row0 + (t >> 3)) * NZE + E_LRF + (t & 7) * 4);
#pragma unroll
    for (int mt = 0; mt < 4; ++mt) { const bf16_t* zr = P.z + (size_t)(row0 + mt * 16 + fr) * NZE + hh * DK + dt * 16 + 4 * q;
        r.k[mt] = *(const u32x2_t*)(zr + E_K); if (E3) r.q[mt] = *(const u32x2_t*)(zr + E_Q); }
#pragma unroll
    for (int i = 0; i < 2; ++i) { const int p = t + 512 * i, tok = p & 63, eg = p >> 6; r.v[i] = *(const u32x4_t*)(P.z + (size_t)(row0 + tok) * NZE + E_V + hh * DV + eg * 8); }
    if (E3) {
#pragma unroll
        for (int dir = 0; dir < 2; ++dir) { const unsigned char* Sb = (const unsigned char*)P.SinB + ((size_t)((dir * NB + b) * GH + hh) * NCH + c) * DV * DK;
#pragma unroll
            for (int i = 0; i < 2; ++i) r.s[dir][i] = *(const u32x2_t*)(Sb + (size_t)(t + 512 * i) * 8); }
    }
}
__device__ __forceinline__ void gla_store_common1(const GlaRegs1& r, PG8_LAS bf16_t* lrs, PG8_LAS bf16_t* vT, int t) {
    *(PG8_LAS u32x2_t*)(lrs + (t >> 3) * LRS1_ROW + (t & 7) * 4) = r.lr;
#pragma unroll
    for (int i = 0; i < 2; ++i) { const int p = t + 512 * i, tok = p & 63, eg = p >> 6; const unsigned wv[4] = {r.v[i].x, r.v[i].y, r.v[i].z, r.v[i].w};
#pragma unroll
        for (int j = 0; j < 4; ++j) { vT[(eg * 8 + 2 * j) * 72 + tok] = (bf16_t)(wv[j] & 0xffffu); vT[(eg * 8 + 2 * j + 1) * 72 + tok] = (bf16_t)(wv[j] >> 16); } }
}
__device__ __forceinline__ void fs_even1(const Params& P, int l, PG8_LAS unsigned char* lds, int t) {
    const int lane = t & 63, w = t >> 6, q = lane >> 4, fr = lane & 15, li = l >> 1, hh = blockIdx.x & 3, wdir = w >> 2, dt = w & 3;
    PG8_LAS bf16_t* vT = (PG8_LAS bf16_t*)lds;
    PG8_LAS bf16_t* kdT = (PG8_LAS bf16_t*)(lds + 18432);
    PG8_LAS bf16_t* lrs = (PG8_LAS bf16_t*)(lds + 18432 + 18432);
    PG8_LAS bf16_t* sst = (PG8_LAS bf16_t*)(lds + 18432 + 18432 + 5120);
    GlaUp1 gu; gla_load_up1(P, li, hh, t, gu);
    constexpr int NU = NB * NCH * 4;
    GlaRegs1 rg; if ((int)blockIdx.x < NU) gla_load1<false>(P, blockIdx.x, hh, t, rg);
    for (int u = blockIdx.x; u < NU; u += gridDim.x) {
        const int rest = u >> 2, c = rest % NCH, b = rest / NCH;
        gla_store_common1(rg, lrs, vT, t);
        u32x2_t kraw[4];
#pragma unroll
        for (int mt = 0; mt < 4; ++mt) kraw[mt] = rg.k[mt];
        __syncthreads();
        if (u + (int)gridDim.x < NU) gla_load1<false>(P, u + gridDim.x, hh, t, rg);
        {
            float bl[4][4], tot[4];
            gla_decay_scan(lrs, gu, t, bl, tot);
#pragma unroll
            for (int mt = 0; mt < 4; ++mt) { const unsigned kw[2] = {kraw[mt].x, kraw[mt].y};
#pragma unroll
                for (int ii = 0; ii < 4; ++ii) { const float kk = (ii & 1) ? __uint_as_float(kw[ii >> 1] & 0xffff0000u) : __uint_as_float(kw[ii >> 1] << 16);
                    kdT[wdir * 64 * 72 + (dt * 16 + 4 * q + ii) * 72 + mt * 16 + fr] = (bf16_t)pk_bf16(kk * __expf(tot[ii] - bl[mt][ii]), 0.f); } }
            if (fr == 0) { float* dv = P.decv + ((size_t)((wdir * NB + b) * GH + hh) * NCH + c) * DK + dt * 16 + 4 * q;
                *(f32x4_t*)dv = (f32x4_t){__expf(tot[0]), __expf(tot[1]), __expf(tot[2]), __expf(tot[3])}; }
        }
        __syncthreads();
#pragma unroll
        for (int dir = 0; dir < 2; ++dir) {
            pg8::f32x4 acc[4];
#pragma unroll
            for (int dt2 = 0; dt2 < 4; ++dt2) acc[dt2] = (pg8::f32x4){0.f, 0.f, 0.f, 0.f};
#pragma unroll
            for (int ks = 0; ks < 2; ++ks) { const bf16x8_t af = *(const PG8_LAS bf16x8_t*)(vT + (16 * w + fr) * 72 + ks * 32 + 8 * q);
#pragma unroll
                for (int dt2 = 0; dt2 < 4; ++dt2) { const bf16x8_t bfr = *(const PG8_LAS bf16x8_t*)(kdT + dir * 64 * 72 + (dt2 * 16 + fr) * 72 + ks * 32 + 8 * q);
                    acc[dt2] = __builtin_amdgcn_mfma_f32_16x16x32_bf16(af, bfr, acc[dt2], 0, 0, 0); } }
#pragma unroll
            for (int dt2 = 0; dt2 < 4; ++dt2)
#pragma unroll
                for (int ii = 0; ii < 4; ++ii) sst[dir * 128 * 72 + (16 * w + 4 * q + ii) * 72 + dt2 * 16 + fr] = (bf16_t)pk_bf16(acc[dt2][ii], 0.f);
        }
        __syncthreads();
#pragma unroll
        for (int dir = 0; dir < 2; ++dir) { unsigned char* Sb = (unsigned char*)P.Sd + ((size_t)((dir * NB + b) * GH + hh) * NCH + c) * DV * DK;
#pragma unroll
            for (int i = 0; i < 2; ++i) { const int f = t + 512 * i, e = f >> 3, d8 = (f & 7) * 8; const u32x4_t w = *(const PG8_LAS u32x4_t*)(sst + dir * 128 * 72 + e * 72 + d8);
                *(u32x2_t*)(Sb + (size_t)f * 8) = (u32x2_t){st8_pack4(__uint_as_float(w.x << 16), __uint_as_float(w.x & 0xffff0000u), __uint_as_float(w.y << 16), __uint_as_float(w.y & 0xffff0000u)),
                                                              st8_pack4(__uint_as_float(w.z << 16), __uint_as_float(w.z & 0xffff0000u), __uint_as_float(w.w << 16), __uint_as_float(w.w & 0xffff0000u))}; } }
        __syncthreads();
    }
}
__device__ __forceinline__ void fs_even2(const Params& P, int t) {
    for (int it = blockIdx.x * 512 + t; it < 2 * NB * GH * DV * (DK / 4); it += gridDim.x * 512) {
        const int d4 = it % (DK / 4), e = (it / (DK / 4)) % DV, hh = (it / (DK / 4 * DV)) % GH, b = (it / (DK / 4 * DV * GH)) % NB, dir = it / (DK / 4 * DV * GH * NB);
        const size_t cb0 = ((size_t)((dir * NB + b) * GH + hh) * NCH) * DV * DK + (size_t)e * DK + d4 * 4;
        const unsigned char* __restrict__ Sb = (const unsigned char*)P.Sd + cb0; unsigned char* __restrict__ So = (unsigned char*)P.SinB + cb0;
        const float* __restrict__ dv = P.decv + ((size_t)((dir * NB + b) * GH + hh) * NCH) * DK + d4 * 4;
        f32x4_t s = (f32x4_t){0.f, 0.f, 0.f, 0.f};
        static_assert(NCH % 4 == 0, "chunk steps are taken four at a time");
        auto chunk_of = [&](int step) { return dir == 0 ? step : (step < NCHC ? NCHC - 1 - step : NCH - 1 - (step - NCHC)); };
        unsigned tw[4], tn[4]; f32x4_t dc[4], dn[4];
#pragma unroll
        for (int j = 0; j < 4; ++j) { const int c = chunk_of(j); tw[j] = *(const unsigned*)(Sb + (size_t)c * DV * DK); dc[j] = *(const f32x4_t*)(dv + (size_t)c * DK); }
#pragma unroll 1
        for (int s0 = 0; s0 < NCH; s0 += 4) {
            if (s0 + 4 < NCH) {
#pragma unroll
                for (int j = 0; j < 4; ++j) { const int c = chunk_of(s0 + 4 + j); tn[j] = *(const unsigned*)(Sb + (size_t)c * DV * DK); dn[j] = *(const f32x4_t*)(dv + (size_t)c * DK); } }
#pragma unroll
            for (int j = 0; j < 4; ++j) { const int c = chunk_of(s0 + j);
                const f32x4_t tmp = (f32x4_t){__builtin_amdgcn_cvt_f32_fp8((int)tw[j], 0), __builtin_amdgcn_cvt_f32_fp8((int)tw[j], 1), __builtin_amdgcn_cvt_f32_fp8((int)tw[j], 2), __builtin_amdgcn_cvt_f32_fp8((int)tw[j], 3)};
                *(unsigned*)(So + (size_t)c * DV * DK) = st8_pack4(s[0], s[1], s[2], s[3]); s = dc[j] * s + tmp; }
#pragma unroll
            for (int j = 0; j < 4; ++j) { tw[j] = tn[j]; dc[j] = dn[j]; }
        }
    }
}
__device__ __forceinline__ void fs_even3(const Params& P, int l, PG8_LAS unsigned char* lds, int t) {
    const int lane = t & 63, w = t >> 6, q = lane >> 4, fr = lane & 15, li = l >> 1, hh = blockIdx.x & 3, d = t & 63, sg = t >> 6;
    PG8_LAS bf16_t* vT = (PG8_LAS bf16_t*)lds;
    PG8_LAS bf16_t* qd = (PG8_LAS bf16_t*)(lds + 18432);
    PG8_LAS bf16_t* kd = (PG8_LAS bf16_t*)(lds + 18432 + 18432);
    PG8_LAS bf16_t* sT = (PG8_LAS bf16_t*)(lds + 18432 * 3);
    PG8_LAS bf16_t* att = (PG8_LAS bf16_t*)(lds + 18432 * 5);
    PG8_LAS float* tot = (PG8_LAS float*)(lds + 18432 * 6);
    PG8_LAS float* ssq = tot + 1024;
    PG8_LAS bf16_t* lrs = (PG8_LAS bf16_t*)(lds + 18432 * 6 + 4096 + 512);
    GlaUp1 gu; gla_load_up1(P, li, hh, t, gu);
    const int it = w & 3, wh = w >> 2;
    float ng[4];
#pragma unroll
    for (int el = 0; el < 4; ++el) ng[el] = P.ev_norm_g[(size_t)li * W2 + hh * DV + (wh * 4 + el) * 16 + fr];
    constexpr int NU = NB * NCH * 4;
    GlaRegs1 rg; if ((int)blockIdx.x < NU) gla_load1<true>(P, blockIdx.x, hh, t, rg);
    for (int u = blockIdx.x; u < NU; u += gridDim.x) {
        const int rest = u >> 2, c = rest % NCH, b = rest / NCH, row0 = seqrow(b, c * CH);
        gla_store_common1(rg, lrs, vT, t);
#pragma unroll
        for (int dir = 0; dir < 2; ++dir)
#pragma unroll
            for (int i = 0; i < 2; ++i) { const int f = t + 512 * i, e = f >> 3, d8 = (f & 7) * 8; *(PG8_LAS u32x4_t*)(sT + dir * 128 * 72 + e * 72 + d8) = st8_to_bf16x8(rg.s[dir][i]); }
        u32x2_t kraw[4], qraw[4];
#pragma unroll
        for (int mt = 0; mt < 4; ++mt) { kraw[mt] = rg.k[mt]; qraw[mt] = rg.q[mt]; }
        __syncthreads();
        bf16_t graw[16];
#pragma unroll
        for (int ii = 0; ii < 4; ++ii)
#pragma unroll
            for (int el = 0; el < 4; ++el) graw[ii * 4 + el] = P.z[(size_t)(row0 + it * 16 + 4 * q + ii) * NZE + E_G + hh * DV + (wh * 4 + el) * 16 + fr];
        if (u + (int)gridDim.x < NU) gla_load1<true>(P, u + gridDim.x, hh, t, rg);
        {
            float bl[4][4], tot[4];
            gla_decay_scan(lrs, gu, t, bl, tot);
#pragma unroll
            for (int mt = 0; mt < 4; ++mt) { const unsigned kw[2] = {kraw[mt].x, kraw[mt].y}, qw[2] = {qraw[mt].x, qraw[mt].y}; float qv[4], kv[4];
#pragma unroll
                for (int ii = 0; ii < 4; ++ii) { const float kk = (ii & 1) ? __uint_as_float(kw[ii >> 1] & 0xffff0000u) : __uint_as_float(kw[ii >> 1] << 16);
                    const float qq = ((ii & 1) ? __uint_as_float(qw[ii >> 1] & 0xffff0000u) : __uint_as_float(qw[ii >> 1] << 16)) * 0.125f;
                    const float ef = __expf(bl[mt][ii]); qv[ii] = qq * ef; kv[ii] = kk * __builtin_amdgcn_rcpf(ef); }
                const int o = wh * 64 * 72 + (mt * 16 + fr) * 72 + it * 16 + 4 * q;
                *(PG8_LAS u32x2_t*)(qd + o) = (u32x2_t){pk_bf16(qv[0], qv[1]), pk_bf16(qv[2], qv[3])};
                *(PG8_LAS u32x2_t*)(kd + o) = (u32x2_t){pk_bf16(kv[0], kv[1]), pk_bf16(kv[2], kv[3])}; }
        }
        __syncthreads();
#pragma unroll
        for (int dir = 0; dir < 2; ++dir)
#pragma unroll
            for (int jl = 0; jl < 2; ++jl) { const int jt = wh * 2 + jl;
                pg8::f32x4 a4 = (pg8::f32x4){0.f, 0.f, 0.f, 0.f};
                if (dir == 0 ? (jt <= it) : (jt >= it)) {
#pragma unroll
                    for (int ks = 0; ks < 2; ++ks) { const bf16x8_t af = *(const PG8_LAS bf16x8_t*)(qd + dir * 64 * 72 + (it * 16 + fr) * 72 + ks * 32 + 8 * q);
                        const bf16x8_t bfr = *(const PG8_LAS bf16x8_t*)(kd + dir * 64 * 72 + (jt * 16 + fr) * 72 + ks * 32 + 8 * q);
                        a4 = __builtin_amdgcn_mfma_f32_16x16x32_bf16(af, bfr, a4, 0, 0, 0); } }
#pragma unroll
                for (int ii = 0; ii < 4; ++ii) { const int i = it * 16 + 4 * q + ii, j = jt * 16 + fr; const bool keep = dir == 0 ? (j <= i) : (j >= i);
                    att[dir * 64 * 72 + i * 72 + j] = (bf16_t)pk_bf16(keep ? a4[ii] : 0.f, 0.f); } }
        __syncthreads();
        pg8::f32x4 o[4];
#pragma unroll
        for (int el = 0; el < 4; ++el) o[el] = (pg8::f32x4){0.f, 0.f, 0.f, 0.f};
#pragma unroll
        for (int dir = 0; dir < 2; ++dir)
#pragma unroll
            for (int ks = 0; ks < 2; ++ks) { const bf16x8_t aa = *(const PG8_LAS bf16x8_t*)(att + dir * 64 * 72 + (it * 16 + fr) * 72 + ks * 32 + 8 * q);
                const bf16x8_t aq = *(const PG8_LAS bf16x8_t*)(qd + dir * 64 * 72 + (it * 16 + fr) * 72 + ks * 32 + 8 * q);
#pragma unroll
                for (int el = 0; el < 4; ++el) { const int et = wh * 4 + el;
                    const bf16x8_t bv = *(const PG8_LAS bf16x8_t*)(vT + (et * 16 + fr) * 72 + ks * 32 + 8 * q);
                    const bf16x8_t bs = *(const PG8_LAS bf16x8_t*)(sT + dir * 128 * 72 + (et * 16 + fr) * 72 + ks * 32 + 8 * q);
                    o[el] = __builtin_amdgcn_mfma_f32_16x16x32_bf16(aa, bv, o[el], 0, 0, 0);
                    o[el] = __builtin_amdgcn_mfma_f32_16x16x32_bf16(aq, bs, o[el], 0, 0, 0); } }
#pragma unroll
        for (int ii = 0; ii < 4; ++ii) { float s = 0.f;
#pragma unroll
            for (int el = 0; el < 4; ++el) s += o[el][ii] * o[el][ii];
            s = row16_sum(s);
            if (fr == 0) ssq[wh * 64 + it * 16 + 4 * q + ii] = s; }
        __syncthreads();
#pragma unroll
        for (int ii = 0; ii < 4; ++ii) { const int i = it * 16 + 4 * q + ii; const float rinv = 1.0f / sqrtf((ssq[i] + ssq[64 + i]) * (1.0f / DV) + EPS);
            const size_t row = (size_t)(row0 + i);
#pragma unroll
            for (int el = 0; el < 4; ++el) { const int e = hh * DV + (wh * 4 + el) * 16 + fr; const float gg = bf2f(graw[ii * 4 + el]);
                P.m[row * D + W2 + e] = (bf16_t)pk_bf16(o[el][ii] * rinv * ng[el] * fsilu(gg), 0.f); } }
    }
}
__device__ __forceinline__ void fs_even_conv(const Params& P, int l, int t) {
    const int li = l >> 1;
    for (int it = (int)((blockIdx.x + gridDim.x / 2) % gridDim.x) * 512 + t; it < (R / 4) * (W2 / 8); it += gridDim.x * 512) {
        const int rowb = (it / (W2 / 8)) * 4, c8 = (it % (W2 / 8)) * 8;
        bool lv, rv;
        if (rowb < RL) { const int pos = (rowb % T) % GRIDW; lv = pos > 0; rv = pos + 3 < GRIDW - 1; } else { const int tt = (rowb - RL) % TC; lv = tt > 0; rv = tt + 3 < TC - 1; }
        const bf16_t* zr = P.z + (size_t)rowb * NZE + c8;
        u32x4_t cg[6], xa[6], bg[4];
#pragma unroll
        for (int i = 0; i < 6; ++i) { const int dr = (i == 0 && !lv) ? 0 : (i == 5 && !rv) ? 3 : i - 1;
            cg[i] = *(const u32x4_t*)(zr + (ptrdiff_t)dr * NZE + E_CG); xa[i] = *(const u32x4_t*)(zr + (ptrdiff_t)dr * NZE + E_XA); }
#pragma unroll
        for (int i = 0; i < 4; ++i) bg[i] = *(const u32x4_t*)(zr + (size_t)i * NZE + E_BG);
        const float* cw = P.ev_conv_w + (size_t)li * 3 * W2 + c8; const float* cb = P.ev_conv_b + (size_t)li * W2 + c8;
        float w0[8], w1[8], w2[8], bb[8];
#pragma unroll
        for (int cc = 0; cc < 8; ++cc) { w0[cc] = cw[cc]; w1[cc] = cw[W2 + cc]; w2[cc] = cw[2 * W2 + cc]; bb[cc] = cb[cc]; }
        float p[6][8];
#pragma unroll
        for (int i = 0; i < 6; ++i) { const bool ok = (i == 0) ? lv : (i == 5) ? rv : true;
            const unsigned cv_[4] = {cg[i].x, cg[i].y, cg[i].z, cg[i].w}, xv_[4] = {xa[i].x, xa[i].y, xa[i].z, xa[i].w};
#pragma unroll
            for (int pp = 0; pp < 4; ++pp) { p[i][2 * pp] = ok ? __uint_as_float(cv_[pp] << 16) * __uint_as_float(xv_[pp] << 16) : 0.f;
                p[i][2 * pp + 1] = ok ? __uint_as_float(cv_[pp] & 0xffff0000u) * __uint_as_float(xv_[pp] & 0xffff0000u) : 0.f; } }
#pragma unroll
        for (int i = 0; i < 4; ++i) { const unsigned bv_[4] = {bg[i].x, bg[i].y, bg[i].z, bg[i].w}; float o[8];
#pragma unroll
            for (int cc = 0; cc < 8; ++cc) { const float bgf = (cc & 1) ? __uint_as_float(bv_[cc >> 1] & 0xffff0000u) : __uint_as_float(bv_[cc >> 1] << 16);
                o[cc] = bgf * (bb[cc] + w0[cc] * p[i][cc] + w1[cc] * p[i + 1][cc] + w2[cc] * p[i + 2][cc]); }
            u32x4_t ow; ow.x = pk_bf16(o[0], o[1]); ow.y = pk_bf16(o[2], o[3]); ow.z = pk_bf16(o[4], o[5]); ow.w = pk_bf16(o[6], o[7]);
            *(u32x4_t*)(P.m + (size_t)(rowb + i) * D + c8) = ow; }
    }
}
#endif

#ifdef CPU_EMU
#define GEMM_CALL(PAIR, A, Bt, G, Mg, N, K, epi) gemm_stage<PAIR>(A, Bt, G, Mg, N, K, epi)
DEV void do_stage(const Params& P, int l, int st) {
    const int tid_ = threadIdx.x;
#else
__device__ __forceinline__ void do_stage(const Params& P, int l, int st, PG8_LAS unsigned char* lds, int tid_in) {
#endif
#ifndef CPU_EMU
    int tid_ = tid_in; asm volatile("" : "+v"(tid_));
    if (st == ST_SILU) return;
    if (st == ST_MOD) { fs_mod(P, lds, tid_); __syncthreads(); fs_wconv(P, lds, tid_); return; }
    if (st == ST_ROW_MIX) { fs_row<0>(P, l, lds, tid_); return; }
    if (st == ST_ROW_FFN) { fs_row_ffn(P, l, lds, tid_); return; }
    if (st == ST_ROW_FINAL) { fs_row<2>(P, l, lds, tid_); return; }
    if (st == ST_SELECT_WCONV) { fs_select(P, l, lds, tid_); if (PROBE_SET == 14) { __syncthreads(); fs_select(P, l, lds, tid_); } fs_moe_wconv(P, l, lds, tid_, 1 << 30); return; }
    if (st == ST_GATHER2) { fs_gather(P, tid_); return; }
#define REP(kk, call) do { call; if (PROBE_SET == (kk)) { __syncthreads(); call; } } while (0)
    if (st == ST_EVEN1) { REP(6, fs_even1(P, l, lds, tid_)); return; }
    if (st == ST_EVEN2) { fs_even2(P, tid_); return; }
    if (st == ST_EVEN3) { fs_even3(P, l, lds, tid_); REP(8, fs_even_conv(P, l, tid_)); return; }
    if (st == ST_ODD1) { fs_odd_lru<false>(P, l, lds, tid_); return; }
    if (st == ST_ODD2) { fs_odd2(P, tid_); return; }
    if (st == ST_ODD3) {
        if (PROBE_SET == 70) { int nrep_; asm volatile("s_mov_b32 %0, 2" : "=s"(nrep_));
#pragma nounroll
            for (int rep_ = 0; rep_ < nrep_; ++rep_) { int tt_ = tid_; asm volatile("" : "+v"(tt_) :: "memory"); fs_odd_lru<true>(P, l, lds, tt_); __syncthreads(); } }
        else fs_odd_lru<true>(P, l, lds, tid_);
        REP(12, fs_odd_sg(P, l, lds, tid_)); return; }
#endif
    const int li = l >> 1;
    const bool even = (l & 1) == 0;
    const int ldz = even ? NZE : NZO;
    switch (st) {
    case ST_SILU: {
        GSL(i, (NB + 1) * D) { const int bb = (int)(i / D), k = (int)(i % D); const float v = bb < NB ? P.c[(size_t)bb * D + k] : P.c_ctx[k]; P.sbuf[i] = siluf_(v); }
    } break;
    case ST_MOD: {
        GSL(i, (long)DEPTH * (NB + 1) * MODW) {
            const int j = (int)(i % MODW), bb = (int)((i / MODW) % (NB + 1)), ll = (int)(i / ((long)MODW * (NB + 1)));
            float acc = P.ada_b[(size_t)ll * MODW + j];
            const float* w = P.ada_w + (size_t)ll * D * MODW + j; const float* s = P.sbuf + (size_t)bb * D;
            for (int k = 0; k < D; ++k) acc += s[k] * w[(size_t)k * MODW];
            P.mod[i] = acc;
        }
    } break;
    case ST_WCONV: {
        GSL(i, 2L * NZE * D) { const int q = (int)(i / ((long)NZE * D)), n = (int)((i / D) % NZE), k = (int)(i % D);
            P.wt_ev_in[i] = n < EV_IN ? f2bf(P.ev_w_in[((size_t)q * D + k) * EV_IN + n]) : (bf16_t)0; }
        GSL(i, 2L * NZO * D) { const int q = (int)(i / ((long)NZO * D)), n = (int)((i / D) % NZO), k = (int)(i % D);
            P.wt_od_in[i] = f2bf(P.od_w_in[((size_t)q * D + k) * NZO + n]); }
        GSL(i, 2L * D * D) { const int q = (int)(i / ((long)D * D)), n = (int)((i / D) % D), k = (int)(i % D);
            P.wt_ev_out[i] = f2bf(P.ev_w_out[((size_t)q * D + k) * D + n]);
            P.wt_od_out[i] = f2bf(P.od_w_out[((size_t)q * D + k) * D + n]); }
    } break;
    case ST_NORM_STATS_MIX: case ST_NORM_STATS_FFN: case ST_FINAL_STATS: {
        const int nrows = st == ST_FINAL_STATS ? RL : R;
        GSL(r, nrows) { const float* xr = st == ST_NORM_STATS_MIX ? xsrc_row(P, l, (int)r) : x_row(P, (int)r);
            float ss = 0.f; for (int j = 0; j < D; ++j) ss += xr[j] * xr[j];
            P.rinv[r] = rsq_(ss / D + EPS); }
    } break;
    case ST_NORM_APPLY_MIX: case ST_NORM_APPLY_FFN: {
        const bool mix = st == ST_NORM_APPLY_MIX;
        const float* g = (mix ? P.norm_mix_g : P.norm_ffn_g) + (size_t)l * D;
        GSL(i, (long)R * D) { const int r = (int)(i / D), j = (int)(i % D);
            const float* mr = modrow(P, l, row_bb(r));
            const float xv = mix ? xsrc_row(P, l, r)[j] : x_row(P, r)[j];
            const float hv = (xv * P.rinv[r] * g[j]) * (1.0f + mr[(mix ? 1 : 4) * D + j]) + mr[(mix ? 0 : 3) * D + j];
            P.h[i] = f2bf(hv); }
    } break;
    case ST_GEMM_IN: {
        const bf16_t* wt = even ? P.wt_ev_in + (size_t)li * NZE * D : P.wt_od_in + (size_t)li * NZO * D;
#ifdef CPU_EMU
        EpiZ_ e; e.z = P.z; e.ldz = ldz;
        GEMM_CALL(false, P.h, wt, 1, R, ldz, D, e);
#else
        pg8::Gemm g{P.h, wt, D}; pg8::StaticOrder S; S.init(R, ldz, (int)gridDim.x, (int)blockIdx.x);
        pg8::EpiZ8 e{P.z, ldz}; pg8::gemm_phase<false, false>(lds, g, S, e, tid_);
        fs_moe_wconv(P, l, lds, tid_, even ? WQ_QUOTA_IN_EVEN : WQ_QUOTA_IN_ODD);
#endif
    } break;
    case ST_E_LA: {
        GSL(i, 2L * NB * NCH * KEY) {
            const int col = (int)(i % KEY), c = (int)((i / KEY) % NCH), b = (int)((i / ((long)KEY * NCH)) % NB), dir = (int)(i / ((long)KEY * NCH * NB));
            const float* up = P.ev_decay_up + ((size_t)li * 2 + dir) * RANK * KEY;
            const float bias = P.ev_decay_b[((size_t)li * 2 + dir) * KEY + col];
            float acc = 0.f;
            for (int s = 0; s < CH; ++s) {
                const int sp = dir == 0 ? s : CH - 1 - s;
                const int row = seqrow(b, c * CH + sp);
                const bf16_t* lr = P.z + (size_t)row * ldz + (dir == 0 ? E_LRF : E_LRB);
                float xx = bias;
                for (int rr = 0; rr < RANK; ++rr) xx += bf2f(lr[rr]) * up[(size_t)rr * KEY + col];
                acc += logsigmoidf_(xx) * (1.0f / 16.0f);
                P.bcum[((size_t)dir * R + row) * KEY + col] = acc;
            }
        }
    } break;
    case ST_E_DS: {
        GSL(i, 2L * NB * GH * NCH * DK * DV) {
            const int e = (int)(i % DV), d = (int)((i / DV) % DK), c = (int)((i / ((long)DV * DK)) % NCH), hh = (int)((i / ((long)DV * DK * NCH)) % GH),
                      b = (int)((i / ((long)DV * DK * NCH * GH)) % NB), dir = (int)(i / ((long)DV * DK * NCH * GH * NB));
            const int rend = seqrow(b, c * CH + (dir == 0 ? CH - 1 : 0));
            const float bend = P.bcum[((size_t)dir * R + rend) * KEY + hh * DK + d];
            float acc = 0.f;
            for (int j = 0; j < CH; ++j) { const int row = seqrow(b, c * CH + j);
                const float kk = bf2f(P.z[(size_t)row * ldz + E_K + hh * DK + d]), vv = bf2f(P.z[(size_t)row * ldz + E_V + hh * DV + e]);
                acc += kk * expf(bend - P.bcum[((size_t)dir * R + row) * KEY + hh * DK + d]) * vv; }
            P.S[i] = acc;
        }
    } break;
    case ST_E_SCAN: {
        GSL(i, 2L * NB * GH * DK * DV) {
            const int e = (int)(i % DV), d = (int)((i / DV) % DK), hh = (int)((i / ((long)DV * DK)) % GH), b = (int)((i / ((long)DV * DK * GH)) % NB), dir = (int)(i / ((long)DV * DK * GH * NB));
            float s = 0.f;
            for (int step = 0; step < NCH; ++step) {
                const int c = dir == 0 ? step : (step < NCHC ? NCHC - 1 - step : NCH - 1 - (step - NCHC));
                const size_t idx = (((((size_t)dir * NB + b) * GH + hh) * NCH + c) * DK + d) * DV + e;
                const int rend = seqrow(b, c * CH + (dir == 0 ? CH - 1 : 0));
                const float dec = expf(P.bcum[((size_t)dir * R + rend) * KEY + hh * DK + d]);
                const float tmp = P.S[idx]; P.S[idx] = s; s = dec * s + tmp;
            }
        }
    } break;
    case ST_E_ATT: {
        const float scale = 1.0f / sqrtf((float)DK);
        GSL(i, 2L * NB * GH * NCH * CH * CH) {
            const int j = (int)(i % CH), ii = (int)((i / CH) % CH), c = (int)((i / ((long)CH * CH)) % NCH), hh = (int)((i / ((long)CH * CH * NCH)) % GH),
                      b = (int)((i / ((long)CH * CH * NCH * GH)) % NB), dir = (int)(i / ((long)CH * CH * NCH * GH * NB));
            float acc = 0.f;
            if (dir == 0 ? (j <= ii) : (j >= ii)) {
                const int ri = seqrow(b, c * CH + ii), rj = seqrow(b, c * CH + j);
                for (int d = 0; d < DK; ++d) {
                    const float qq = bf2f(P.z[(size_t)ri * ldz + E_Q + hh * DK + d]) * scale, kk = bf2f(P.z[(size_t)rj * ldz + E_K + hh * DK + d]);
                    acc += qq * kk * expf(P.bcum[((size_t)dir * R + ri) * KEY + hh * DK + d] - P.bcum[((size_t)dir * R + rj) * KEY + hh * DK + d]); }
            }
            P.att[i] = acc;
        }
    } break;
    case ST_E_O: {
        const float scale = 1.0f / sqrtf((float)DK);
        GSL(i, (long)NB * GH * NCH * CH * DV) {
            const int e = (int)(i % DV), ii = (int)((i / DV) % CH), c = (int)((i / ((long)DV * CH)) % NCH), hh = (int)((i / ((long)DV * CH * NCH)) % GH), b = (int)(i / ((long)DV * CH * NCH * GH));
            const int ri = seqrow(b, c * CH + ii);
            float acc = 0.f;
            for (int dir = 0; dir < 2; ++dir) {
                const size_t cb = ((((size_t)dir * NB + b) * GH + hh) * NCH + c);
                const float* at = P.att + (cb * CH + ii) * CH;
                for (int j = 0; j < CH; ++j) { const int rj = seqrow(b, c * CH + j); acc += at[j] * bf2f(P.z[(size_t)rj * ldz + E_V + hh * DV + e]); }
                const float* Sin = P.S + cb * DK * DV;
                for (int d = 0; d < DK; ++d) {
                    const float qq = bf2f(P.z[(size_t)ri * ldz + E_Q + hh * DK + d]) * scale;
                    acc += qq * expf(P.bcum[((size_t)dir * R + ri) * KEY + hh * DK + d]) * Sin[(size_t)d * DV + e]; }
            }
            P.o[(size_t)ri * W2 + hh * DV + e] = acc;
        }
    } break;
    case ST_E_READOUT: {
        const float* ng = P.ev_norm_g + (size_t)li * W2;
        GSL(i, (long)R * GH) { const int row = (int)(i / GH), hh = (int)(i % GH);
            const float* orow = P.o + (size_t)row * W2 + hh * DV;
            float ss = 0.f; for (int e = 0; e < DV; ++e) ss += orow[e] * orow[e];
            const float rinv = rsq_(ss / DV + EPS);
            for (int e = 0; e < DV; ++e) { const float g = bf2f(P.z[(size_t)row * ldz + E_G + hh * DV + e]);
                P.m[(size_t)row * D + W2 + hh * DV + e] = f2bf(orow[e] * rinv * ng[hh * DV + e] * siluf_(g)); }
        }
    } break;
    case ST_E_CONV: {
        const float* cw = P.ev_conv_w + (size_t)li * 3 * W2; const float* cb = P.ev_conv_b + (size_t)li * W2;
        GSL(i, (long)R * W2) { const int row = (int)(i / W2), col = (int)(i % W2);
            bool lv, rv;
            if (row < RL) { const int pos = (row % T) % GRIDW; lv = pos > 0; rv = pos < GRIDW - 1; }
            else { const int t = (row - RL) % TC; lv = t > 0; rv = t < TC - 1; }
            const bf16_t* zr = P.z + (size_t)row * ldz;
            float acc = cb[col] + cw[W2 + col] * (bf2f(zr[E_CG + col]) * bf2f(zr[E_XA + col]));
            if (lv) acc += cw[col] * (bf2f(zr[E_CG + col - ldz]) * bf2f(zr[E_XA + col - ldz]));
            if (rv) acc += cw[2 * W2 + col] * (bf2f(zr[E_CG + col + ldz]) * bf2f(zr[E_XA + col + ldz]));
            P.m[(size_t)row * D + col] = f2bf(bf2f(zr[E_BG + col]) * acc); }
    } break;
    case ST_O_XC: {
        const float* cw = P.od_conv_w + (size_t)li * 4 * W2; const float* cb = P.od_conv_b + (size_t)li * W2;
        GSL(i, (long)R * W2) { const int row = (int)(i / W2), col = (int)(i % W2);
            int t, len; if (row < RL) { t = row % T; len = T; } else { t = (row - RL) % TC; len = TC; }
            float acc = cb[col];
            for (int j = 0; j < 4; ++j) { const int tt = t - 2 + j; if (tt >= 0 && tt < len) acc += cw[j * W2 + col] * bf2f(P.z[(size_t)(row - 2 + j) * ldz + O_XB + col]); }
            P.xc[i] = acc; }
    } break;
    case ST_O_COEF: {
        GSL(i, 2L * R * W2) { const int col = (int)(i % W2), row = (int)((i / W2) % R), dir = (int)(i / ((long)W2 * R));
            const int hh = col / HD, jj = col % HD;
            const float* wa = P.od_gate_a_w + ((((size_t)li * 2 + dir) * 4 + hh) * HD) * HD + jj;
            const float* wx = P.od_gate_x_w + ((((size_t)li * 2 + dir) * 4 + hh) * HD) * HD + jj;
            const float* xr = P.xc + (size_t)row * W2 + hh * HD;
            float ra = P.od_gate_a_b[((size_t)li * 2 + dir) * W2 + col], rx = P.od_gate_x_b[((size_t)li * 2 + dir) * W2 + col];
            for (int k = 0; k < HD; ++k) { ra += xr[k] * wa[(size_t)k * HD]; rx += xr[k] * wx[(size_t)k * HD]; }
            const float rg = sigmoidf_(ra), ig = sigmoidf_(rx);
            const float log_a = -8.0f * rg * softplusf_(-P.od_lambda[((size_t)li * 2 + dir) * W2 + col]);
            P.A[i] = expf(log_a);
            P.Bc[i] = sqrtf(-expm1f(2.0f * log_a)) * (ig * P.xc[(size_t)row * W2 + col]); }
    } break;
    case ST_O_SCAN: {
        GSL(i, 2L * NB * W2) { const int col = (int)(i % W2), b = (int)((i / W2) % NB), dir = (int)(i / ((long)W2 * NB));
            float hc = 0.f;
            for (int step = 0; step < SEQ_ALL; ++step) {
                const int s = dir == 0 ? step : (step < TC ? TC - 1 - step : TC + (T - 1 - (step - TC)));
                const size_t idx = ((size_t)dir * R + seqrow(b, s)) * W2 + col;
                hc = P.A[idx] * hc + P.Bc[idx]; P.Bc[idx] = hc; }
        }
    } break;
    case ST_O_YREC: {
        GSL(i, (long)R * W2) { const int row = (int)(i / W2), col = (int)(i % W2);
            const float gb = bf2f(P.z[(size_t)row * ldz + O_GB + col]);
            P.m[(size_t)row * D + col] = f2bf((P.Bc[i] + P.Bc[(size_t)R * W2 + i]) * geluf_(gb)); }
    } break;
    case ST_O_SGSTAT: {
        GSL(r, R) { const bf16_t* vr = P.z + (size_t)r * ldz + O_V;
            float s = 0.f; for (int j = 0; j < W2; ++j) s += geluf_(bf2f(vr[j]));
            const float mean = s / W2; float vs = 0.f;
            for (int j = 0; j < W2; ++j) { const float dlt = geluf_(bf2f(vr[j])) - mean; vs += dlt * dlt; }
            P.sgstat[2 * r] = mean; P.sgstat[2 * r + 1] = rsq_(vs / W2 + EPS); }
    } break;
    case ST_O_VB: {
        const float* gn = P.od_sg_norm_g + (size_t)li * W2;
        GSL(i, (long)R * W2) { const int row = (int)(i / W2), col = (int)(i % W2);
            P.vb[i] = (geluf_(bf2f(P.z[(size_t)row * ldz + O_V + col])) - P.sgstat[2 * row]) * P.sgstat[2 * row + 1] * gn[col]; }
    } break;
    case ST_O_SGMIX: {
        GSL(i, (long)R * W2) { const int row = (int)(i / W2), col = (int)(i % W2);
            const int t = row < RL ? row % T : (row - RL) % TC;
            const int ii = t % SGC, base = row - ii, g = col / HD;
            const float* w = P.od_sg_w + (((size_t)li * 4 + g) * SGC + ii) * SGC;
            float acc = P.od_sg_b[((size_t)li * 4 + g) * SGC + ii];
            for (int j = 0; j < SGC; ++j) acc += w[j] * P.vb[(size_t)(base + j) * W2 + col];
            P.m[(size_t)row * D + W2 + col] = f2bf(geluf_(bf2f(P.z[(size_t)row * ldz + O_U + col])) * acc); }
    } break;
    case ST_GEMM_OUT: {
        const bf16_t* wt = (even ? P.wt_ev_out : P.wt_od_out) + (size_t)li * D * D;
#ifdef CPU_EMU
        EpiWout_ e; e.P = &P; e.l = l;
        GEMM_CALL(false, P.m, wt, 1, R, D, D, e);
#else
        pg8::Gemm g{P.m, wt, D}; pg8::StaticOrder S; S.init(l == DEPTH - 1 ? RL : R, D, (int)gridDim.x, (int)blockIdx.x);
        if (l == 0) { pg8::EpiWoutB<true> e{P.x, P.ctx, P.xb, P.mod + (size_t)l * (NB + 1) * MODW, P.ssqp}; pg8::gemm_phase<false, false>(lds, g, S, e, tid_); }
        else { pg8::EpiWoutB<false> e{nullptr, nullptr, P.xb, P.mod + (size_t)l * (NB + 1) * MODW, P.ssqp}; pg8::gemm_phase<false, false>(lds, g, S, e, tid_); }
        fs_moe_wconv(P, l, lds, tid_, (even ? WQ_QUOTA_IN_EVEN : WQ_QUOTA_IN_ODD) + WQ_QUOTA_OUT);
#endif
    } break;
    case ST_ROUTER_LOGIT: {
        const float* g = P.norm_ffn_g + (size_t)l * D; const float* wr = P.moe_router + (size_t)l * D * NE;
        GSL(i, (long)R * NE) { const int r = (int)(i / NE), e = (int)(i % NE);
            const float* mr = modrow(P, l, row_bb(r)); const float* xr = x_row(P, r); const float ri = P.rinv[r];
            float acc = 0.f;
            for (int j = 0; j < D; ++j) acc += ((xr[j] * ri * g[j]) * (1.0f + mr[4 * D + j]) + mr[3 * D + j]) * wr[(size_t)j * NE + e];
            P.logit[i] = acc; }
    } break;
    case ST_ROUTER_SOFTMAX: {
        GSL(r, R) { const float* lg = P.logit + (size_t)r * NE; float mx = lg[0]; for (int e = 1; e < NE; ++e) mx = fmaxf(mx, lg[e]);
            float s = 0.f;
            for (int e = 0; e < NE; ++e) s += expf(lg[e] - mx);
            for (int e = 0; e < NE; ++e) P.aff[(size_t)r * NE + e] = expf(lg[e] - mx) / s; }
    } break;
    case ST_MOE_WCONV: {
        const float* wg = P.moe_w_gate + (size_t)l * NE * D * D; const float* wu = P.moe_w_up + (size_t)l * NE * D * D; const float* wd = P.moe_w_down + (size_t)l * NE * D * D;
        GSL(i, (long)NE * 2 * D * D) { const int e = (int)(i / (2L * D * D)), cv = (int)((i / D) % (2 * D)), k = (int)(i % D);
            const int w = cv % 256, j = (cv / 256) * 128 + (w % 128);
            P.wt_gu[i] = f2bf((w >= 128 ? wu : wg)[((size_t)e * D + k) * D + j]); }
        GSL(i, (long)NE * D * D) { const int e = (int)(i / ((long)D * D)), n = (int)((i / D) % D), k = (int)(i % D);
            P.wt_dn[i] = f2bf(wd[((size_t)e * D + k) * D + n]); }
    } break;
    case ST_SELECT: {
        GSL(i, (long)R * NE) { const int e = (int)(i / R), r = (int)(i % R);
            int base, n, cap, slot0;
            if (r < RL) { const int b = r / T; base = b * T; n = T; cap = CAPL; slot0 = b * CAPL; }
            else { const int b = (r - RL) / TC; base = RL + b * TC; n = TC; cap = CAPC; slot0 = NB * CAPL + b * CAPC; }
            const float a = P.aff[(size_t)r * NE + e];
            int rank = 0;
            for (int t = 0; t < n; ++t) { const float o = P.aff[(size_t)(base + t) * NE + e]; rank += (o > a || (o == a && base + t < r)) ? 1 : 0; }
            if (rank < cap) { const int slot = e * SLOTS_E + slot0 + rank; P.sel_row[slot] = r; P.sel_g[slot] = a; P.inv[(size_t)r * NE + e] = slot; }
            else P.inv[(size_t)r * NE + e] = -1; }
    } break;
    case ST_GATHER: {
        GSL(i, (long)SLOTS * D) { const int slot = (int)(i / D), j = (int)(i % D); P.xg[i] = P.h[(size_t)P.sel_row[slot] * D + j]; }
    } break;
    case ST_GEMM_GU: {
#ifdef CPU_EMU
        EpiGU_ e; e.hid = P.hid;
        GEMM_CALL(true, P.xg, P.wt_gu, NE, SLOTS_E, 2 * D, D, e);
#else
        pg8::Gemm g{P.h, P.wt_gu, D}; pg8::GroupedOrder S; S.init(l == DEPTH - 1 ? NB * CAPL : SLOTS_E, SLOTS_E, 2 * D, NE, (int)gridDim.x, (int)blockIdx.x);
        PG8_LAS int* gix = (PG8_LAS int*)(lds + GEMM_LDS_BYTES + 16);
        for (int kk = tid_ >> 8; kk < GIX_UNITS; kk += 2) { pg8::Unit uu; if (S.next(kk, uu)) gix[kk * 256 + (tid_ & 255)] = P.sel_row[uu.pm * 256 + (tid_ & 255)]; }
        __syncthreads();
        pg8::EpiGU_F8 e{(unsigned char*)P.hid, 2 * D / 256}; pg8::gemm_phase<true, true>(lds, g, S, e, tid_, gix);
#endif
    } break;
    case ST_GEMM_DOWN: {
#ifdef CPU_EMU
        EpiDown_ e; e.out = P.outslot; e.selg = P.sel_g;
        GEMM_CALL(false, P.hid, P.wt_dn, NE, SLOTS_E, D, D, e);
#else
        pg8::Gemm g{P.hid, P.wt_dn, D}; pg8::GroupedOrder S; S.init(l == DEPTH - 1 ? NB * CAPL : SLOTS_E, SLOTS_E, D, NE, (int)gridDim.x, (int)blockIdx.x);
        pg8::EpiDown8 e{(unsigned char*)P.outslot, P.sel_g, D / 256, 1.0f / pg8::W8_SCALE}; pg8::gemm_phase<false, true>(lds, g, S, e, tid_);
#endif
    } break;
    case ST_COMBINE: {
        GSL(i, (long)R * D) { const int r = (int)(i / D), j = (int)(i % D);
            float s = 0.f;
            for (int e = 0; e < NE; ++e) { const int sl = P.inv[(size_t)r * NE + e]; if (sl >= 0) s += bf2f(P.outslot[(size_t)sl * D + j]); }
            float* xr = x_row(P, r); xr[j] += modrow(P, l, row_bb(r))[5 * D + j] * s; }
    } break;
    case ST_FINAL_APPLY: {
        GSL(i, (long)RL * D) { const int r = (int)(i / D), j = (int)(i % D); P.xlat[i] = P.xlat[i] * P.rinv[r] * P.norm_final_g[j]; }
    } break;
    default: break;
    }
}

template <class F> inline void stage_program(F&& run) {
    run(0, ST_SILU); run(0, ST_MOD); run(0, ST_WCONV);
    for (int l = 0; l < DEPTH; ++l) {
        run(l, ST_NORM_STATS_MIX); run(l, ST_NORM_APPLY_MIX); run(l, ST_GEMM_IN);
        if ((l & 1) == 0) { run(l, ST_E_LA); run(l, ST_E_DS); run(l, ST_E_SCAN); run(l, ST_E_ATT); run(l, ST_E_O); run(l, ST_E_READOUT); run(l, ST_E_CONV); }
        else { run(l, ST_O_XC); run(l, ST_O_COEF); run(l, ST_O_SCAN); run(l, ST_O_YREC); run(l, ST_O_SGSTAT); run(l, ST_O_VB); run(l, ST_O_SGMIX); }
        run(l, ST_GEMM_OUT);
        run(l, ST_NORM_STATS_FFN); run(l, ST_NORM_APPLY_FFN); run(l, ST_ROUTER_LOGIT); run(l, ST_ROUTER_SOFTMAX); run(l, ST_MOE_WCONV);
        run(l, ST_SELECT); run(l, ST_GATHER); run(l, ST_GEMM_GU); run(l, ST_GEMM_DOWN); run(l, ST_COMBINE);
    }
    run(0, ST_FINAL_STATS); run(0, ST_FINAL_APPLY);
}

struct KArgs { const float* in[32]; float* out; char* ws; };
#ifdef CPU_EMU
#define HD_ inline
#else
#define HD_ __host__ __device__ __forceinline__
#endif
struct Carver { char* base; size_t off; template <class Tp> HD_ Tp* take(size_t n) { off = (off + 255) & ~(size_t)255; Tp* p = (Tp*)(base + off); off += n * sizeof(Tp); return p; } };
HD_ size_t carve(Params& p, void* d_ws) {
    Carver cv{(char*)d_ws, 0};
    p.bar = cv.take<unsigned>(4096); p.wq = p.bar + 3584;
    p.mod = cv.take<float>((size_t)DEPTH * (NB + 1) * MODW); p.sbuf = cv.take<float>((size_t)(NB + 1) * D); p.xctx = cv.take<float>((size_t)RC * D);
    p.rinv = cv.take<float>(R); p.aff = cv.take<float>((size_t)R * NE); p.logit = cv.take<float>((size_t)R * NE); p.sel_g = cv.take<float>(SLOTS);
    p.sel_row = cv.take<int>(SLOTS); p.inv = cv.take<int>((size_t)R * NE);
    p.wt_ev_in = cv.take<bf16_t>(2ull * NZE * D); p.wt_od_in = cv.take<bf16_t>(2ull * NZO * D); p.wt_ev_out = cv.take<bf16_t>(2ull * D * D); p.wt_od_out = cv.take<bf16_t>(2ull * D * D);
    p.rw16 = cv.take<bf16_t>((size_t)DEPTH * 2 * NE * D); p.gwT = cv.take<bf16_t>(2ull * 2 * 2 * 4 * HD * HD); p.sgw = cv.take<bf16_t>(2ull * 4 * SGC * SGC); p.sumA = cv.take<float>(2ull * NB * NCH * W2); p.sumB = cv.take<float>(2ull * NB * NCH * W2); p.decv = cv.take<float>(2ull * NB * GH * NCH * DK); p.hinb = cv.take<float>(2ull * NB * NCH * W2); p.ssqp = cv.take<float>((size_t)R * 16);
    p.xb = cv.take<bf16_t>((size_t)R * D);
    p.wt_gu = cv.take<bf16_t>((size_t)NE * 2 * D * D); p.wt_dn = cv.take<bf16_t>((size_t)NE * D * D); p.h = cv.take<bf16_t>((size_t)R * D);
    const size_t u0 = (cv.off + 255) & ~(size_t)255;
    p.z = cv.take<bf16_t>((size_t)R * NZE); p.m = cv.take<bf16_t>((size_t)R * D);
    const size_t u1 = cv.off;
#ifdef CPU_EMU
    p.bcum = cv.take<float>(2ull * R * KEY); p.att = cv.take<float>(2ull * NB * GH * NCH * CH * CH); p.o = cv.take<float>((size_t)R * W2);
#endif
#ifdef CPU_EMU
    p.S = cv.take<float>(2ull * NB * GH * NCH * DK * DV);
#endif
    p.Sd = cv.take<bf16_t>(2ull * NB * GH * NCH * DK * DV); p.SinB = cv.take<bf16_t>(2ull * NB * GH * NCH * DK * DV);
    size_t end = cv.off;
    cv.off = u1;
    p.sgstat = cv.take<float>(2ull * R);
#ifdef CPU_EMU
    p.xc = cv.take<float>((size_t)R * W2); p.A = cv.take<float>(2ull * R * W2); p.Bc = cv.take<float>(2ull * R * W2); p.vb = cv.take<float>((size_t)R * W2);
#endif
    if (cv.off > end) end = cv.off;
    cv.off = u0;
    p.xg = cv.take<bf16_t>((size_t)SLOTS * D); p.hid = cv.take<bf16_t>((size_t)SLOTS * D); p.outslot = cv.take<bf16_t>((size_t)SLOTS * D);
    if (cv.off > end) end = cv.off;
    return end;
}
HD_ void fill_inputs(Params& p, const float* const* in, void* d_out) {
    p.x = in[0]; p.c = in[1]; p.ctx = in[2]; p.c_ctx = in[3]; p.ada_w = in[4]; p.ada_b = in[5]; p.norm_mix_g = in[6]; p.norm_ffn_g = in[7]; p.norm_final_g = in[8];
    p.ev_w_in = in[9]; p.ev_conv_w = in[10]; p.ev_conv_b = in[11]; p.ev_decay_up = in[12]; p.ev_decay_b = in[13]; p.ev_norm_g = in[14]; p.ev_w_out = in[15];
    p.od_w_in = in[16]; p.od_conv_w = in[17]; p.od_conv_b = in[18]; p.od_gate_a_w = in[19]; p.od_gate_a_b = in[20]; p.od_gate_x_w = in[21]; p.od_gate_x_b = in[22];
    p.od_lambda = in[23]; p.od_sg_norm_g = in[24]; p.od_sg_w = in[25]; p.od_sg_b = in[26]; p.od_w_out = in[27];
    p.moe_router = in[28]; p.moe_w_gate = in[29]; p.moe_w_up = in[30]; p.moe_w_down = in[31];
    p.xlat = (float*)d_out;
}

#ifndef CPU_EMU
#define XB_TMO      128
#define XB_XCNT(j)  (256  + 64 * (j))
#define XB_XSUB(j)  (1280 + 64 * (j))
#define XB_XGEN(j)  (2304 + 64 * (j))
#define XB_TOP      3328
#define XB_TOPGEN   3392
#define XCD_BAR_WORDS 3456
#define XB_SPIN_CAP (1u << 18)
#define LAS __attribute__((address_space(3)))

__device__ __forceinline__ unsigned xb_ld(unsigned* p)              { return __hip_atomic_load(p, __ATOMIC_RELAXED, __HIP_MEMORY_SCOPE_AGENT); }
__device__ __forceinline__ unsigned xb_add(unsigned* p, unsigned v) { return __hip_atomic_fetch_add(p, v, __ATOMIC_RELAXED, __HIP_MEMORY_SCOPE_AGENT); }
__device__ __forceinline__ unsigned xb_xcc_id() { return (unsigned)__builtin_amdgcn_s_getreg((3 << 11) | 20) & 0xFu; }
#define XB_SPIN(cond, bar) do { unsigned _sp = 0; while (cond) { __builtin_amdgcn_s_sleep(1); \
    if ((++_sp & 255u) == 0u) { if (xb_ld(&(bar)[XB_TMO])) break; if (_sp > XB_SPIN_CAP) { atomicAdd(&(bar)[XB_TMO], 1u); break; } } } } while (0)

struct XcdBarrier {
    unsigned* bar; unsigned x;
    volatile LAS unsigned* st;
};

__device__ __forceinline__ XcdBarrier xcd_barrier_post(unsigned* bar, volatile LAS unsigned* st, bool lead  ) {
    XcdBarrier b; b.bar = bar; b.x = xb_xcc_id(); b.st = st;
    if (lead) (void)xb_add(&bar[XB_XCNT(b.x)], 1u);
    return b;
}
__device__ __forceinline__ void xcd_barrier_complete(unsigned* bar, unsigned x, unsigned& nloc, unsigned& nx) {
    const unsigned G = gridDim.x * gridDim.y * gridDim.z;
    unsigned sum, cnt, mine, sp = 0u;
    for (;;) {
        sum = 0u; cnt = 0u; mine = 0u;
#pragma unroll
        for (unsigned j = 0; j < 16; ++j) { const unsigned c = xb_ld(&bar[XB_XCNT(j)]); sum += c; cnt += (c > 0u) ? 1u : 0u; mine = (j == x) ? c : mine; }
        if (sum == G) break;
        __builtin_amdgcn_s_sleep(1);
        if ((++sp & 255u) == 0u) { if (xb_ld(&bar[XB_TMO])) break; if (sp > XB_SPIN_CAP) { atomicAdd(&bar[XB_TMO], 1u); break; } }
    }
    nloc = mine > 0u ? mine : 1u; nx = cnt > 0u ? cnt : 1u;
}

__device__ __forceinline__ void xcd_barrier(const XcdBarrier& b, bool lead  ) {
    asm volatile("s_waitcnt vmcnt(0)" ::: "memory");
    __syncthreads();
    if (lead) {
        unsigned* bar = b.bar;
        __builtin_amdgcn_s_waitcnt(0);
        unsigned nloc = b.st[0], nx = b.st[1];
        if (nloc == 0u) { xcd_barrier_complete(bar, b.x, nloc, nx); b.st[0] = nloc; b.st[1] = nx; }
        const unsigned old = xb_add(&bar[XB_XSUB(b.x)], 1u);
        const unsigned gen = old / nloc;
        if (old + 1u == (gen + 1u) * nloc) {
            __builtin_amdgcn_fence(__ATOMIC_RELEASE, "agent");
            asm volatile("s_waitcnt vmcnt(0)" ::: "memory");
            const unsigned og = xb_add(&bar[XB_TOP], 1u);
            const unsigned tg = og / nx;
            if (og + 1u == (tg + 1u) * nx) xb_add(&bar[XB_TOPGEN], 1u);
            else XB_SPIN(xb_ld(&bar[XB_TOPGEN]) == tg, bar);
            __builtin_amdgcn_fence(__ATOMIC_ACQUIRE, "agent");
            xb_add(&bar[XB_XGEN(b.x)], 1u);
            asm volatile("s_waitcnt vmcnt(0)" ::: "memory");
        } else {
            XB_SPIN(xb_ld(&bar[XB_XGEN(b.x)]) == gen, bar);
            __builtin_amdgcn_fence(__ATOMIC_ACQUIRE, "agent");
            asm volatile("s_waitcnt vmcnt(0)" ::: "memory");
        }
    }
    __syncthreads();
}


typedef const __attribute__((address_space(4))) char* kargp_t;
__device__ __forceinline__ void load_params(Params& p, kargp_t kp) {
    const float* in[32];
#pragma unroll
    for (int i = 0; i < 32; ++i) in[i] = *(const float* const __attribute__((address_space(4)))*)(kp + 8 * i);
    float* out = *(float* const __attribute__((address_space(4)))*)(kp + 256);
    char* ws = *(char* const __attribute__((address_space(4)))*)(kp + 264);
    fill_inputs(p, in, out); carve(p, ws);
}
__device__ __forceinline__ constexpr bool probe_double(int st) {
    return PROBE_SET == 1 ? (st == ST_GEMM_IN || st == ST_GEMM_GU || st == ST_GEMM_DOWN)
         : PROBE_SET == 2 ? (st == ST_EVEN1 || st == ST_EVEN3)
         : PROBE_SET == 3 ? (st == ST_ODD1 || st == ST_ODD3)
         : PROBE_SET == 31 ? (st == ST_ODD1)
         : PROBE_SET == 33 ? (st == ST_EVEN1)
         : PROBE_SET == 4 ? (st == ST_ROW_FFN || st == ST_SELECT_WCONV)
         : PROBE_SET == 13 ? (st == ST_ROW_FFN)
         : PROBE_SET == 21 ? (st == ST_EVEN2 || st == ST_ODD2)
         : PROBE_SET == 5 ? (st == ST_MOD || st == ST_WCONV) : false;
}
__device__ __forceinline__ constexpr bool probe_echo(int st) {
    return PROBE_SET == 60 ? (st == ST_EVEN1 || st == ST_EVEN2 || st == ST_EVEN3)
         : PROBE_SET == 61 ? (st == ST_ODD1 || st == ST_ODD2 || st == ST_ODD3)
         : PROBE_SET == 62 ? (st == ST_ROW_MIX || st == ST_ROW_FFN || st == ST_SELECT_WCONV || st == ST_ROW_FINAL || st == ST_MOD)
         : PROBE_SET == 63 ? (st == ST_GEMM_IN || st == ST_GEMM_OUT)
         : PROBE_SET == 64 ? (st == ST_GEMM_GU || st == ST_GEMM_DOWN)
         : PROBE_SET == 65 ? (st == ST_EVEN1) : PROBE_SET == 66 ? (st == ST_EVEN3) : PROBE_SET == 67 ? (st == ST_ODD3) : PROBE_SET == 68 ? (st == ST_ROW_MIX) : false;
}
#define PHASE(l, st) do { unsigned zo_; asm volatile("s_mov_b32 %0, 0" : "=s"(zo_)); \
    Params P; load_params(P, (kargp_t)__builtin_amdgcn_kernarg_segment_ptr() + zo_); \
    const int tid_ph = wv_ * 64 + (int)__builtin_amdgcn_mbcnt_hi(~0u, __builtin_amdgcn_mbcnt_lo(~0u, 0u)); \
    unsigned long long te0_ = 0; if (probe_echo(st)) te0_ = __builtin_amdgcn_s_memtime(); \
    PHASE_BODY(l, st); \
    if (probe_echo(st)) { const unsigned long long te1_ = __builtin_amdgcn_s_memtime(); while (__builtin_amdgcn_s_memtime() - te1_ < 4ull * (te1_ - te0_)) __builtin_amdgcn_s_sleep(4); } } while (0)
#define PHASE_BODY(l, st) do { \
    do_stage(P, (l), (st), lds, tid_ph); if (probe_double(st) || (PROBE_SET == 22 && (l) == 0 && ((st) == ST_GEMM_OUT)) || (PROBE_SET == 23 && (l) == 0 && ((st) == ST_ROW_MIX))) { __syncthreads(); do_stage(P, (l), (st), lds, tid_ph); } xcd_barrier(bar, tid_ph == 0); } while (0)
#define LAYER_HEAD(l) PHASE(l, ST_ROW_MIX); PHASE(l, ST_GEMM_IN);
#define LAYER_TAIL(l) PHASE(l, ST_GEMM_OUT); PHASE(l, ST_ROW_FFN); PHASE(l, ST_SELECT_WCONV); PHASE(l, ST_GEMM_GU); PHASE(l, ST_GEMM_DOWN);
#define LAYER_EVEN(l) LAYER_HEAD(l) PHASE(l, ST_EVEN1); PHASE(l, ST_EVEN2); PHASE(l, ST_EVEN3); LAYER_TAIL(l)
#define LAYER_ODD(l) LAYER_HEAD(l) PHASE(l, ST_ODD1); PHASE(l, ST_ODD2); PHASE(l, ST_ODD3); LAYER_TAIL(l)
__global__ void __launch_bounds__(512, 2) k_all(KArgs ka) {
    extern __shared__ __attribute__((aligned(16))) unsigned char shm[];
    PG8_LAS unsigned char* lds = (PG8_LAS unsigned char*)shm;
    volatile LAS unsigned* xbw = (volatile LAS unsigned*)(lds + GEMM_LDS_BYTES);
    if (threadIdx.x == 0) { xbw[0] = 0u; xbw[1] = 0u; xbw[2] = 0u; xbw[3] = 0u; }
    __syncthreads();
    const int wv_ = __builtin_amdgcn_readfirstlane((int)(threadIdx.x >> 6));
    XcdBarrier bar = xcd_barrier_post((unsigned*)ka.ws, xbw, threadIdx.x == 0);
    PHASE(0, ST_MOD);
    LAYER_EVEN(0) LAYER_ODD(1) LAYER_EVEN(2) LAYER_ODD(3)
    PHASE(0, ST_ROW_FINAL);
}

extern "C" void kernel_launch(void* const* d_in, const int* in_sizes, int n_in, void* d_out, int out_size, void* d_ws, size_t ws_size, hipStream_t stream) {
    KArgs ka; memset(&ka, 0, sizeof(ka));
    for (int i = 0; i < 32; ++i) ka.in[i] = (const float*)d_in[i];
    ka.out = (float*)d_out; ka.ws = (char*)d_ws;
    Params p{}; fill_inputs(p, ka.in, d_out);
    const size_t need = carve(p, d_ws);
    if (need > ws_size) { fprintf(stderr, "workspace too small: need %zu have %zu\n", need, ws_size); return; }
    constexpr size_t kDynLds = DYN_LDS_BYTES;
    static int grid = 0;
    if (!grid) {
        int dev = 0, cus = 0, per_cu = 0;
        (void)hipGetDevice(&dev);
        (void)hipDeviceGetAttribute(&cus, hipDeviceAttributeMultiprocessorCount, dev);
        (void)hipFuncSetAttribute((const void*)k_all, hipFuncAttributeMaxDynamicSharedMemorySize, (int)kDynLds);
        (void)hipOccupancyMaxActiveBlocksPerMultiprocessor(&per_cu, k_all, 512, kDynLds);
        grid = cus * (per_cu < 1 ? per_cu : 1);
    }
    (void)hipMemsetAsync(p.bar, 0, 4096 * sizeof(unsigned), stream);
    hipLaunchKernelGGL(k_all, dim3(grid), dim3(512), kDynLds, stream, ka);
}
#endif
```

```cpp
#ifndef CPU_EMU
#include <hip/hip_runtime.h>
#include <cstdio>
#include <cstring>
#define DEV __device__ __forceinline__
#else
#define DEV inline
#endif
#include <cstdint>
#include <cstddef>

#ifndef D_MODEL
#define D_MODEL 1024
#define BATCH 8
#define SEQ 4096
#define CTXL 256
#endif

#ifndef PROBE_SET
#define PROBE_SET 0
#endif
typedef unsigned short bf16_t;
constexpr int D = D_MODEL, NB = BATCH, T = SEQ, TC = CTXL, DEPTH = 4;
constexpr int RL = NB * T, RC = NB * TC, R = RL + RC;
constexpr int W2 = D / 2;
constexpr int GH = 4, DV = W2 / GH, DK = DV / 2, KEY = GH * DK, RANK = 16, CH = 64, GRIDW = 64;
constexpr int EV_IN = 3 * W2 + KEY + W2 + KEY + W2 + 2 * RANK;
constexpr int NZE = ((EV_IN + 255) / 256) * 256, NZO = 4 * W2;
constexpr int E_BG = 0, E_CG = W2, E_XA = 2 * W2, E_Q = 3 * W2, E_G = E_Q + KEY, E_K = E_G + W2, E_V = E_K + KEY, E_LRF = E_V + W2, E_LRB = E_LRF + RANK;
constexpr int O_XB = 0, O_GB = W2, O_U = 2 * W2, O_V = 3 * W2;
constexpr int NE = 16, CAPL = 2 * T / NE, CAPC = 2 * TC / NE, SLOTS_E = NB * (CAPL + CAPC), SLOTS = NE * SLOTS_E;
constexpr int SEQ_ALL = TC + T, NCH = SEQ_ALL / CH, NCHC = TC / CH;
constexpr int SGC = 128, HD = W2 / 4;
constexpr float EPS = 1e-6f;
constexpr int MODW = 6 * D;

struct Params {
    const float *x, *c, *ctx, *c_ctx, *ada_w, *ada_b, *norm_mix_g, *norm_ffn_g, *norm_final_g;
    const float *ev_w_in, *ev_conv_w, *ev_conv_b, *ev_decay_up, *ev_decay_b, *ev_norm_g, *ev_w_out;
    const float *od_w_in, *od_conv_w, *od_conv_b, *od_gate_a_w, *od_gate_a_b, *od_gate_x_w, *od_gate_x_b, *od_lambda, *od_sg_norm_g, *od_sg_w, *od_sg_b, *od_w_out;
    const float *moe_router, *moe_w_gate, *moe_w_up, *moe_w_down;
    float* xlat;
    float *xctx, *mod, *sbuf, *rinv, *aff, *logit, *sel_g;
    int *sel_row, *inv;
    bf16_t *wt_ev_in, *wt_od_in, *wt_ev_out, *wt_od_out, *wt_gu, *wt_dn, *h, *gwT, *sgw, *rw16;
    float *sumA, *sumB, *decv, *hinb, *ssqp;
    bf16_t *z, *m;
    float *bcum, *S, *att, *o;
    float *xc, *A, *Bc, *sgstat, *vb;
    bf16_t *xg, *hid, *outslot;
    bf16_t *SinB, *Sd;
    bf16_t* xb;
    unsigned* bar; unsigned* wq;
};

DEV float bf2f(bf16_t v) { union { unsigned u; float f; } c; c.u = (unsigned)v << 16; return c.f; }
DEV bf16_t f2bf(float f) { union { unsigned u; float f; } c; c.f = f; unsigned u = c.u; u += 0x7fffu + ((u >> 16) & 1u); return (bf16_t)(u >> 16); }
DEV float sigmoidf_(float x) { return 1.0f / (1.0f + expf(-x)); }
DEV float siluf_(float x) { return x / (1.0f + expf(-x)); }
DEV float softplusf_(float x) { return fmaxf(x, 0.0f) + log1pf(expf(-fabsf(x))); }
DEV float logsigmoidf_(float x) { return fminf(x, 0.0f) - log1pf(expf(-fabsf(x))); }
DEV float geluf_(float x) { return 0.5f * x * (1.0f + tanhf(0.7978845608028654f * (x + 0.044715f * x * x * x))); }
DEV float rsq_(float x) { return 1.0f / sqrtf(x); }

DEV const float* xsrc_row(const Params& P, int l, int r) {
    if (l == 0) return r < RL ? P.x + (size_t)r * D : P.ctx + (size_t)(r - RL) * D;
    return r < RL ? P.xlat + (size_t)r * D : P.xctx + (size_t)(r - RL) * D;
}
DEV float* x_row(const Params& P, int r) { return r < RL ? P.xlat + (size_t)r * D : P.xctx + (size_t)(r - RL) * D; }
DEV int row_bb(int r) { return r < RL ? r / T : NB; }
DEV int seqrow(int b, int s) { return s < TC ? RL + b * TC + s : b * T + (s - TC); }
DEV const float* modrow(const Params& P, int l, int bb) { return P.mod + ((size_t)l * (NB + 1) + bb) * MODW; }

#define GSL(i, n) for (long i = (long)blockIdx.x * blockDim.x + tid_; i < (long)(n); i += (long)gridDim.x * blockDim.x)

enum {
    ST_SILU = 0, ST_MOD, ST_WCONV,
    ST_NORM_STATS_MIX, ST_NORM_APPLY_MIX, ST_GEMM_IN,
    ST_E_LA, ST_E_DS, ST_E_SCAN, ST_E_ATT, ST_E_O, ST_E_READOUT, ST_E_CONV,
    ST_O_XC, ST_O_COEF, ST_O_SCAN, ST_O_YREC, ST_O_SGSTAT, ST_O_VB, ST_O_SGMIX,
    ST_GEMM_OUT,
    ST_NORM_STATS_FFN, ST_NORM_APPLY_FFN, ST_ROUTER_LOGIT, ST_ROUTER_SOFTMAX, ST_MOE_WCONV, ST_SELECT, ST_GATHER, ST_GEMM_GU, ST_GEMM_DOWN, ST_COMBINE,
    ST_FINAL_STATS, ST_FINAL_APPLY,
    ST_ROW_MIX, ST_ROW_FFN, ST_ROW_FINAL, ST_SELECT_WCONV, ST_GATHER2, ST_ODD1, ST_ODD3, ST_EVEN1, ST_EVEN2, ST_EVEN3, ST_ODD2, ST_COUNT
};

struct EpiZ {
    bf16_t* z; int ldz;
    DEV void elem(int row, int col, float v) const { z[(size_t)row * ldz + col] = f2bf(v); }
};
struct EpiWout {
    const Params* P; int l;
    DEV void elem(int row, int col, float v) const {
        const float* mr = modrow(*P, l, row_bb(row));
        x_row(*P, row)[col] = xsrc_row(*P, l, row)[col] + mr[2 * D + col] * v;
    }
};
struct EpiGU {
    bf16_t* hid;
    DEV void pair(int row, int j, float g, float u) const { hid[(size_t)row * D + j] = f2bf(siluf_(g) * u); }
};
struct EpiDown {
    bf16_t* out; const float* selg;
    DEV void elem(int row, int col, float v) const { out[(size_t)row * D + col] = f2bf(v * selg[row]); }
};

#ifdef CPU_EMU
template <bool PAIR, class Epi>
void gemm_stage(const bf16_t* A, const bf16_t* Bt, int G, int Mg, int N, int K, const Epi& epi) {
    const int tid_ = threadIdx.x;
    GSL(i, (long)G * Mg) {
        const int g = (int)(i / Mg); const int row = (int)i;
        const bf16_t* a = A + (size_t)row * K;
        if (!PAIR) {
            for (int n = 0; n < N; ++n) { const bf16_t* b = Bt + ((size_t)g * N + n) * K; float s = 0.f; for (int k = 0; k < K; ++k) s += bf2f(a[k]) * bf2f(b[k]); epi.elem(row, n, s); }
        } else {
            for (int j = 0; j < N / 2; ++j) {
                const int cg = (j / 128) * 256 + (j % 128), cu = cg + 128;
                const bf16_t* bg = Bt + ((size_t)g * N + cg) * K; const bf16_t* bu = Bt + ((size_t)g * N + cu) * K;
                float sg = 0.f, su = 0.f; for (int k = 0; k < K; ++k) { sg += bf2f(a[k]) * bf2f(bg[k]); su += bf2f(a[k]) * bf2f(bu[k]); }
                epi.pair_(row, j, sg, su);
            }
        }
    }
}
#else
namespace pg8 {
#define PG8_LAS __attribute__((address_space(3)))
typedef short bf16x8 __attribute__((ext_vector_type(8)));
typedef float f32x4 __attribute__((ext_vector_type(4)));
typedef unsigned u32x4 __attribute__((ext_vector_type(4)));
constexpr int BM = 256, BK = 64, HALF = 128, HTB = HALF * BK * 2, STAGE_BYTES = 8 * HTB, NXCD = 8, WGM = 8;
__host__ __device__ __forceinline__ int lds_byte(int r, int c) { const int st = (r >> 4) * 2 + (c >> 5), rr = r & 15, cc = c & 31, ob = rr * 64 + cc * 2; return st * 1024 + (ob ^ (((ob >> 9) & 1) << 5)); }
__host__ __device__ __forceinline__ void stage_rc(int b, int& R_, int& C_) { const int st = b / 1024, sb = b % 1024, swz = sb ^ (((sb >> 9) & 1) << 5); R_ = (st >> 1) * 16 + swz / 64; C_ = (st & 1) * 32 + (swz % 64) / 2; }
__host__ __device__ __forceinline__ int perm32(int rho) { const int n = rho >> 4, i = rho & 15; return 8 * (i >> 2) + 4 * n + (i & 3); }
struct Unit { int pm, pn; };
struct Gemm { const bf16_t* A; const bf16_t* Bt; int K; };
struct StaticOrder {
    int nM, nN, nwg, G, c;
    __device__ __forceinline__ void init(int M, int N, int G_, int c_) { nM = M / BM; nN = N / BM; nwg = nM * nN; G = G_; c = c_; }
    __device__ __forceinline__ bool next(int i, Unit& u) const {
        const long L = (long)i * G + c; if (L >= nwg) return false;
        int wgid = (int)L; { const int q = nwg / NXCD, r = nwg % NXCD, xcd = wgid % NXCD, off = wgid / NXCD; wgid = (xcd < r ? xcd * (q + 1) : r * (q + 1) + (xcd - r) * q) + off; }
        const int nig = WGM * nN, gid = wgid / nig, fm = gid * WGM, gsz = (nM - fm) < WGM ? (nM - fm) : WGM;
        u.pm = fm + ((wgid % nig) % gsz); u.pn = (wgid % nig) / gsz; return true;
    }
    __device__ __forceinline__ void a_ready(const Unit&) const {}
    __device__ __forceinline__ void done(const Unit&) const {}
};
struct GroupedOrder {
    int nMg, nMs, nN, total, G, c;
    __device__ __forceinline__ void init(int Mg_used, int Mg_stride, int N, int groups, int G_, int c_) { nMg = Mg_used / BM; nMs = Mg_stride / BM; nN = N / BM; total = groups * nMg * nN; G = G_; c = c_; }
    __device__ __forceinline__ bool next(int i, Unit& u) const {
        const long L = (long)i * G + c; if (L >= total) return false;
        int wgid = (int)L; { const int q = total / NXCD, r = total % NXCD, xcd = wgid % NXCD, off = wgid / NXCD; wgid = (xcd < r ? xcd * (q + 1) : r * (q + 1) + (xcd - r) * q) + off; }
        const int per = nMg * nN, g = wgid / per, rem = wgid % per;
        const int nig = WGM * nN, gid = rem / nig, fm = gid * WGM, gsz = (nMg - fm) < WGM ? (nMg - fm) : WGM;
        const int pm_l = fm + ((rem % nig) % gsz), pn_l = (rem % nig) / gsz;
        u.pm = g * nMs + pm_l; u.pn = g * nN + pn_l; return true;
    }
    __device__ __forceinline__ void a_ready(const Unit&) const {}
    __device__ __forceinline__ void done(const Unit&) const {}
};
typedef __bf16 bf16x2_n __attribute__((ext_vector_type(2)));
typedef float f32x2_n __attribute__((ext_vector_type(2)));
__device__ __forceinline__ unsigned cvt_pk_bf16(float lo, float hi) { const f32x2_n v = {lo, hi}; const bf16x2_n r = __builtin_convertvector(v, bf16x2_n); return __builtin_bit_cast(unsigned, r); }

typedef int i32x4 __attribute__((ext_vector_type(4)));
typedef int i32x8 __attribute__((ext_vector_type(8)));
__device__ __forceinline__ i32x8 frag_cat(bf16x8 lo, bf16x8 hi) { return __builtin_shufflevector(__builtin_bit_cast(i32x4, lo), __builtin_bit_cast(i32x4, hi), 0, 1, 2, 3, 4, 5, 6, 7); }
template <bool FP8> struct Frags { bf16x8 At[4][2], B0[2][2], B1[2][2]; };
template <> struct Frags<true> { i32x8 At[4], B0[2], B1[2]; };
template <bool GATHER, bool FP8, class Epi, class Sched>
__device__ __forceinline__ void gemm_phase(PG8_LAS unsigned char* lds, const Gemm g, const Sched& S, const Epi& E, const int tid, const PG8_LAS int* gix = nullptr) {
    const int wid = __builtin_amdgcn_readfirstlane(tid >> 6), lane = tid & 63, wr = wid >> 2, wc = wid & 3, fr = lane & 15, fq = lane >> 4;
    const int K = g.K, rowb = FP8 ? K : 2 * K, nt = rowb / (BK * 2);
    unsigned voffA[2], voffB[2];
#pragma unroll
    for (int i = 0; i < 2; ++i) { int R_, C_; stage_rc(tid * 16 + i * 8192, R_, C_); const int Rb = Epi::PERM ? ((R_ & ~31) + perm32(R_ & 31)) : R_;
        voffA[i] = (unsigned)(R_ * rowb + C_ * 2); voffB[i] = (unsigned)(Rb * rowb + C_ * 2); }
    unsigned gv[2][2];
#define PG8_GV(kk) do { _Pragma("unroll") for (int _i = 0; _i < 2; ++_i) { int _R, _C; stage_rc(tid * 16 + _i * 8192, _R, _C); _Pragma("unroll") for (int _h = 0; _h < 2; ++_h) \
        gv[_h][_i] = (unsigned)gix[(kk) * 256 + _h * 128 + _R] * (unsigned)rowb + (unsigned)_C * 2u; } } while (0)
#define PG8_UBASE(p) ({ const char* _ub = (const char*)(p); asm volatile("" : "+s"(_ub)); _ub; })
#define PG8_STAGE_A(bufoff, hf, kb, nx) do { if constexpr (GATHER) { const char* _gb = PG8_UBASE((const char*)g.A + (kb)); _Pragma("unroll") for (int _i = 0; _i < 2; ++_i) \
        __builtin_amdgcn_global_load_lds((const unsigned*)(_gb + gv[hf][_i]), (PG8_LAS unsigned*)(lds + (bufoff) + ldsw + _i * 8192), 16, 0, 0); } \
      else { const char* _gb = PG8_UBASE(((nx) ? nA : cA) + (kb) + (hf) * hstep); _Pragma("unroll") for (int _i = 0; _i < 2; ++_i) \
        __builtin_amdgcn_global_load_lds((const unsigned*)(_gb + voffA[_i]), (PG8_LAS unsigned*)(lds + (bufoff) + ldsw + _i * 8192), 16, 0, 0); } } while (0)
    const size_t kstep = (size_t)(BK * 2);
    const size_t hstep = (size_t)HALF * rowb;
    const size_t tstep = 2 * hstep;
    const unsigned ldsw = (unsigned)wid * 1024u;
    const int aoffk0 = FP8 ? lds_byte(wr * 64 + fr, fq * 16) : lds_byte(wr * 64 + fr, fq * 8), aoffk1 = FP8 ? lds_byte(wr * 64 + fr, fq * 16 + 8) : aoffk0 + 1024;
    const int boffk0 = FP8 ? lds_byte(wc * 32 + fr, fq * 16) : lds_byte(wc * 32 + fr, fq * 8), boffk1 = FP8 ? lds_byte(wc * 32 + fr, fq * 16 + 8) : boffk0 + 1024;
#define PG8_SA(b, h) (((b) * 2 + (h)) * HTB)
#define PG8_SB(b, h) ((4 + (b) * 2 + (h)) * HTB)
#define PG8_STAGE(bufoff, gbase, voff) do { const char* _gb = PG8_UBASE(gbase); _Pragma("unroll") for (int _i = 0; _i < 2; ++_i) \
        __builtin_amdgcn_global_load_lds((const unsigned*)(_gb + (voff)[_i]), (PG8_LAS unsigned*)(lds + (bufoff) + ldsw + _i * 8192), 16, 0, 0); } while (0)
#define PG8_LD16(off) (*(const PG8_LAS bf16x8*)(lds + (off)))
#define PG8_LDA(dst, b, h) do { _Pragma("unroll") for (int m = 0; m < 4; ++m) { \
        if constexpr (FP8) F.dst[m] = frag_cat(PG8_LD16(PG8_SA(b, h) + aoffk0 + m * 2048), PG8_LD16(PG8_SA(b, h) + aoffk1 + m * 2048));     \
        else { F.dst[m][0] = PG8_LD16(PG8_SA(b, h) + aoffk0 + m * 2048); F.dst[m][1] = PG8_LD16(PG8_SA(b, h) + aoffk1 + m * 2048); } } } while (0)
#define PG8_LDB(dst, b, h) do { _Pragma("unroll") for (int n = 0; n < 2; ++n) { \
        if constexpr (FP8) F.dst[n] = frag_cat(PG8_LD16(PG8_SB(b, h) + boffk0 + n * 2048), PG8_LD16(PG8_SB(b, h) + boffk1 + n * 2048)); \
        else { F.dst[n][0] = PG8_LD16(PG8_SB(b, h) + boffk0 + n * 2048); F.dst[n][1] = PG8_LD16(PG8_SB(b, h) + boffk1 + n * 2048); } } } while (0)
#define PG8_MMA(ai, bj, At, Bt) do { __builtin_amdgcn_s_setprio(1); _Pragma("unroll") for (int m = 0; m < 4; ++m) _Pragma("unroll") for (int n = 0; n < 2; ++n) { \
        if constexpr (FP8) asm volatile("v_mfma_scale_f32_16x16x128_f8f6f4 %0, %1, %2, %0, %3, %3 op_sel_hi:[0,0,0]" : "+v"(acc[ai][bj][m][n]) : "v"(F.Bt[n]), "v"(F.At[m]), "v"(scale1)); \
        else { _Pragma("unroll") for (int k = 0; k < 2; ++k) acc[ai][bj][m][n] = __builtin_amdgcn_mfma_f32_16x16x32_bf16(F.Bt[n][k], F.At[m][k], acc[ai][bj][m][n], 0, 0, 0); } } \
        __builtin_amdgcn_s_setprio(0); } while (0)
#define PG8_WAIT_V(n) asm volatile("s_waitcnt vmcnt(" #n ")" ::: "memory")
#define PG8_WAIT_L(n) asm volatile("s_waitcnt lgkmcnt(" #n ")" ::: "memory")
#define PG8_BAR __builtin_amdgcn_s_barrier()
#define PG8_SCHED __builtin_amdgcn_sched_barrier(0)
    Unit cur, nxt; int ui = 0;
    if (!S.next(0, cur)) return;
    f32x4 acc[2][2][4][2];
#pragma unroll
    for (int a = 0; a < 2; ++a)
#pragma unroll
        for (int b = 0; b < 2; ++b)
#pragma unroll
            for (int m = 0; m < 4; ++m)
#pragma unroll
                for (int n = 0; n < 2; ++n) acc[a][b][m][n] = (f32x4){0.f, 0.f, 0.f, 0.f};
    Frags<FP8> F;
    int scale1 = 127; asm volatile("" : "+v"(scale1));
    const char* cA = (const char*)g.A + (size_t)cur.pm * tstep; const char* cB = (const char*)g.Bt + (size_t)cur.pn * tstep;
    const char* nA = cA;
    if constexpr (GATHER) { PG8_GV(0); }
    S.a_ready(cur);
    PG8_STAGE(PG8_SB(0, 0), cB, voffB); PG8_STAGE_A(PG8_SA(0, 0), 0, (size_t)0, false); PG8_STAGE(PG8_SB(0, 1), cB + hstep, voffB); PG8_STAGE_A(PG8_SA(0, 1), 1, (size_t)0, false);
    if (wr == 1) PG8_BAR;
    PG8_WAIT_V(4); PG8_BAR;
    PG8_STAGE(PG8_SB(1, 0), cB + kstep, voffB); PG8_STAGE_A(PG8_SA(1, 0), 0, kstep, false); PG8_STAGE(PG8_SB(1, 1), cB + hstep + kstep, voffB);
    PG8_WAIT_V(6); PG8_BAR;
    for (;;) {
        const bool has_next = S.next(ui + 1, nxt);
        nA = has_next ? (const char*)g.A + (size_t)nxt.pm * tstep : cA; const char* nB = has_next ? (const char*)g.Bt + (size_t)nxt.pn * tstep : cB;
        constexpr int KREP = PROBE_SET == 30 ? 2 : 1;
#pragma nounroll
        for (int t = 0; t < nt * KREP; t += 2) {
            const bool last = (t == nt * KREP - 2);
            const size_t ka1 = (size_t)((t + 1) % nt) * kstep, ka2 = last ? (size_t)0 : (size_t)((t + 2) % nt) * kstep, ka3 = ka2 + kstep;
            const char* b2 = last ? nB : cB + (size_t)((t + 2) % nt) * kstep;
            const char* b3 = b2 + kstep;
            if (last && has_next) S.a_ready(nxt);
            PG8_LDB(B0, 0, 0); PG8_SCHED; PG8_LDA(At, 0, 0); PG8_STAGE_A(PG8_SA(1, 1), 1, ka1, false);
            PG8_WAIT_L(8); PG8_BAR; PG8_WAIT_L(0); PG8_MMA(0, 0, At, B0); PG8_BAR; PG8_SCHED;
            if constexpr (GATHER) { if (last && has_next) { PG8_GV(ui + 1); } }
            PG8_LDB(B1, 0, 1); PG8_STAGE(PG8_SB(0, 0), b2, voffB);
            PG8_BAR; PG8_WAIT_L(0); PG8_MMA(0, 1, At, B1); PG8_BAR;
            PG8_LDA(At, 0, 1); PG8_STAGE_A(PG8_SA(0, 0), 0, ka2, last);
            PG8_BAR; PG8_WAIT_L(0); PG8_MMA(1, 0, At, B0); PG8_BAR; PG8_SCHED;
            PG8_STAGE(PG8_SB(0, 1), b2 + hstep, voffB);
            PG8_WAIT_V(6); PG8_BAR; PG8_MMA(1, 1, At, B1); PG8_BAR;
            PG8_LDB(B0, 1, 0); PG8_SCHED; PG8_LDA(At, 1, 0); PG8_STAGE_A(PG8_SA(0, 1), 1, ka2, last);
            PG8_WAIT_L(8); PG8_BAR; PG8_WAIT_L(0); PG8_MMA(0, 0, At, B0); PG8_BAR; PG8_SCHED;
            PG8_LDB(B1, 1, 1); PG8_STAGE(PG8_SB(1, 0), b3, voffB);
            PG8_BAR; PG8_WAIT_L(0); PG8_MMA(0, 1, At, B1); PG8_BAR;
            PG8_LDA(At, 1, 1); PG8_STAGE_A(PG8_SA(1, 0), 0, ka3, last);
            PG8_BAR; PG8_WAIT_L(0); PG8_MMA(1, 0, At, B0); PG8_BAR; PG8_SCHED;
            PG8_STAGE(PG8_SB(1, 1), b3 + hstep, voffB);
            PG8_WAIT_V(6); PG8_BAR; PG8_MMA(1, 1, At, B1); PG8_BAR;
        }
        if constexpr (KREP > 1) {
#pragma unroll
            for (int a = 0; a < 2; ++a)
#pragma unroll
                for (int b = 0; b < 2; ++b)
#pragma unroll
                    for (int m = 0; m < 4; ++m)
#pragma unroll
                        for (int n = 0; n < 2; ++n) acc[a][b][m][n] *= (1.0f / KREP); }
        if constexpr (FP8) asm volatile("s_nop 15\n\ts_nop 15" ::: "memory");
        { int tz = tid; asm volatile("" : "+v"(tz));
          const int wz = tz >> 6, lz = tz & 63; E(acc, cur, wz >> 2, wz & 3, lz & 15, lz >> 4); }
        S.done(cur);
        if (!has_next) break;
#pragma unroll
        for (int a = 0; a < 2; ++a)
#pragma unroll
            for (int b = 0; b < 2; ++b)
#pragma unroll
                for (int m = 0; m < 4; ++m)
#pragma unroll
                    for (int n = 0; n < 2; ++n) acc[a][b][m][n] = (f32x4){0.f, 0.f, 0.f, 0.f};
        cur = nxt; cA = nA; cB = nB; ++ui;

    }
    PG8_WAIT_V(0);
    if (wr == 0) PG8_BAR;
    PG8_BAR;
#undef PG8_SA
#undef PG8_SB
#undef PG8_STAGE
#undef PG8_STAGE_A
#undef PG8_UBASE
#undef PG8_GV
#undef PG8_LDA
#undef PG8_LDB
#undef PG8_MMA
#undef PG8_WAIT_V
#undef PG8_WAIT_L
#undef PG8_BAR
#undef PG8_SCHED
}

struct EpiZ8 {
    static constexpr bool PERM = true;
    bf16_t* O; int ldc;
    __device__ __forceinline__ void operator()(const f32x4 (&acc)[2][2][4][2], const Unit& u, int wr, int wc, int fr, int fq) const {
        const int row0 = u.pm * BM + wr * 64 + fr, col0 = u.pn * BM + wc * 32 + 8 * fq;
#pragma unroll
        for (int ai = 0; ai < 2; ++ai)
#pragma unroll
            for (int m = 0; m < 4; ++m) { bf16_t* rowp = O + (size_t)(row0 + ai * HALF + m * 16) * ldc + col0;
#pragma unroll
                for (int bj = 0; bj < 2; ++bj) { const f32x4 v0 = acc[ai][bj][m][0], v1 = acc[ai][bj][m][1];
                    u32x4 w; w.x = cvt_pk_bf16(v0[0], v0[1]); w.y = cvt_pk_bf16(v0[2], v0[3]); w.z = cvt_pk_bf16(v1[0], v1[1]); w.w = cvt_pk_bf16(v1[2], v1[3]);
                    *(u32x4*)(rowp + bj * HALF) = w; } }
    }
};
template <bool SRC32>
struct EpiWoutB {
    static constexpr bool PERM = true;
    const float* src_lat; const float* src_ctx; bf16_t* xb; const float* modl;
    float* ssqp;
    __device__ __forceinline__ void operator()(const f32x4 (&acc)[2][2][4][2], const Unit& u, int wr, int wc, int fr, int fq) const {
        const int rowt = u.pm * BM; const bool lat = rowt < RL; const int bb = lat ? rowt / T : NB;
        const float* sp = lat ? src_lat + (size_t)rowt * D : src_ctx + (size_t)(rowt - RL) * D;
        bf16_t* dp = xb + (size_t)rowt * D;
        const float* mr = modl + (size_t)bb * MODW + 2 * D;
        const int r0 = wr * 64 + fr, col0 = u.pn * BM + wc * 32 + 8 * fq;
        f32x4 mv[2][2];
#pragma unroll
        for (int bj = 0; bj < 2; ++bj)
#pragma unroll
            for (int n = 0; n < 2; ++n) mv[bj][n] = *(const f32x4*)(mr + col0 + bj * HALF + 4 * n);
#pragma unroll
        for (int ai = 0; ai < 2; ++ai)
#pragma unroll
            for (int m = 0; m < 4; ++m) { const size_t ro = (size_t)(r0 + ai * HALF + m * 16) * D + col0; float sq = 0.f;
#pragma unroll
                for (int bj = 0; bj < 2; ++bj) { f32x4 x0, x1;
                    if (SRC32) { x0 = *(const f32x4*)(sp + ro + bj * HALF); x1 = *(const f32x4*)(sp + ro + bj * HALF + 4); }
                    else { const u32x4 w = *(const u32x4*)(dp + ro + bj * HALF);
                        x0 = (f32x4){__uint_as_float(w.x << 16), __uint_as_float(w.x & 0xffff0000u), __uint_as_float(w.y << 16), __uint_as_float(w.y & 0xffff0000u)};
                        x1 = (f32x4){__uint_as_float(w.z << 16), __uint_as_float(w.z & 0xffff0000u), __uint_as_float(w.w << 16), __uint_as_float(w.w & 0xffff0000u)}; }
                    const f32x4 v0 = x0 + mv[bj][0] * acc[ai][bj][m][0], v1 = x1 + mv[bj][1] * acc[ai][bj][m][1];
                    u32x4 o; o.x = cvt_pk_bf16(v0[0], v0[1]); o.y = cvt_pk_bf16(v0[2], v0[3]); o.z = cvt_pk_bf16(v1[0], v1[1]); o.w = cvt_pk_bf16(v1[2], v1[3]);
                    *(u32x4*)(dp + ro + bj * HALF) = o;
                    const unsigned ow[4] = {o.x, o.y, o.z, o.w};
#pragma unroll
                    for (int j = 0; j < 4; ++j) { const float a = __uint_as_float(ow[j] << 16), b = __uint_as_float(ow[j] & 0xffff0000u); sq += a * a + b * b; } }
                sq += __builtin_bit_cast(float, __builtin_amdgcn_ds_bpermute(((16 * fq + fr) ^ 16) << 2, __builtin_bit_cast(int, sq)));
                sq += __builtin_bit_cast(float, __builtin_amdgcn_ds_bpermute(((16 * fq + fr) ^ 32) << 2, __builtin_bit_cast(int, sq)));
                if (fq == 0) ssqp[(size_t)(rowt + r0 + ai * HALF + m * 16) * 16 + (u.pn & 3) * 4 + wc] = sq; }
    }
};
__device__ __forceinline__ float silu_fast(float x) { return x * __builtin_amdgcn_rcpf(1.0f + __expf(-x)); }
struct EpiGU8 {
    static constexpr bool PERM = true;
    bf16_t* hid; int nN;
    __device__ __forceinline__ void operator()(const f32x4 (&acc)[2][2][4][2], const Unit& u, int wr, int wc, int fr, int fq) const {
        const int row0 = u.pm * BM + wr * 64 + fr, col0 = (u.pn % nN) * HALF + wc * 32 + 8 * fq;
#pragma unroll
        for (int ai = 0; ai < 2; ++ai)
#pragma unroll
            for (int m = 0; m < 4; ++m) { bf16_t* rowp = hid + (size_t)(row0 + ai * HALF + m * 16) * D + col0;
                float v[8];
#pragma unroll
                for (int n = 0; n < 2; ++n)
#pragma unroll
                    for (int i = 0; i < 4; ++i) v[n * 4 + i] = silu_fast(acc[ai][0][m][n][i]) * acc[ai][1][m][n][i];
                u32x4 w; w.x = cvt_pk_bf16(v[0], v[1]); w.y = cvt_pk_bf16(v[2], v[3]); w.z = cvt_pk_bf16(v[4], v[5]); w.w = cvt_pk_bf16(v[6], v[7]);
                *(u32x4*)rowp = w; }
    }
};
constexpr float W8_SCALE = 32.0f;
__device__ __forceinline__ unsigned pack4_fp8(float a, float b, float c, float d) { int w = __builtin_amdgcn_cvt_pk_fp8_f32(a, b, 0, false); w = __builtin_amdgcn_cvt_pk_fp8_f32(c, d, w, true); return (unsigned)w; }
struct EpiGU_F8 {
    static constexpr bool PERM = true;
    unsigned char* hid; int nN;
    __device__ __forceinline__ void operator()(const f32x4 (&acc)[2][2][4][2], const Unit& u, int wr, int wc, int fr, int fq) const {
        const int row0 = u.pm * BM + wr * 64 + fr, col0 = (u.pn % nN) * HALF + wc * 32 + 8 * fq;
        constexpr float inv = 1.0f / W8_SCALE;
#pragma unroll
        for (int ai = 0; ai < 2; ++ai)
#pragma unroll
            for (int m = 0; m < 4; ++m) { unsigned char* rowp = hid + (size_t)(row0 + ai * HALF + m * 16) * D + col0;
                float v[8];
#pragma unroll
                for (int n = 0; n < 2; ++n)
#pragma unroll
                    for (int i = 0; i < 4; ++i) v[n * 4 + i] = silu_fast(acc[ai][0][m][n][i] * inv) * (acc[ai][1][m][n][i] * inv);
                typedef unsigned u32x2v __attribute__((ext_vector_type(2)));
                *(u32x2v*)rowp = (u32x2v){pack4_fp8(v[0], v[1], v[2], v[3]), pack4_fp8(v[4], v[5], v[6], v[7])}; }
    }
};
constexpr float OUTSLOT_SCALE = 32.0f;
struct EpiDown8 {
    static constexpr bool PERM = true;
    unsigned char* O; const float* selg; int nN; float wscale;
    __device__ __forceinline__ void operator()(const f32x4 (&acc)[2][2][4][2], const Unit& u, int wr, int wc, int fr, int fq) const {
        const int row0 = u.pm * BM + wr * 64 + fr, col0 = (u.pn % nN) * BM + wc * 32 + 8 * fq;
#pragma unroll
        for (int ai = 0; ai < 2; ++ai)
#pragma unroll
            for (int m = 0; m < 4; ++m) { const int row = row0 + ai * HALF + m * 16; const float gs = selg[row] * wscale * OUTSLOT_SCALE; unsigned char* rowp = O + (size_t)row * D + col0;
#pragma unroll
                for (int bj = 0; bj < 2; ++bj) { f32x4 v0 = acc[ai][bj][m][0] * gs, v1 = acc[ai][bj][m][1] * gs;
#pragma unroll
                    for (int i = 0; i < 4; ++i) { v0[i] = __builtin_amdgcn_fmed3f(v0[i], -448.0f, 448.0f); v1[i] = __builtin_amdgcn_fmed3f(v1[i], -448.0f, 448.0f); }
                    typedef unsigned u32x2v __attribute__((ext_vector_type(2)));
                    *(u32x2v*)(rowp + bj * HALF) = (u32x2v){pack4_fp8(v0[0], v0[1], v0[2], v0[3]), pack4_fp8(v1[0], v1[1], v1[2], v1[3])}; } }
    }
};
}
constexpr int GEMM_LDS_BYTES = pg8::STAGE_BYTES;
constexpr int WQ_QUOTA_IN_EVEN = 700, WQ_QUOTA_IN_ODD = 5600, WQ_QUOTA_OUT = 8600;
constexpr int GIX_UNITS = 10;
constexpr int DYN_LDS_BYTES = GEMM_LDS_BYTES + 16 + GIX_UNITS * 256 * 4;
#endif

struct EpiZ_ : EpiZ { DEV void pair_(int, int, float, float) const {} };
struct EpiWout_ : EpiWout { DEV void pair_(int, int, float, float) const {} };
struct EpiDown_ : EpiDown { DEV void pair_(int, int, float, float) const {} };
struct EpiGU_ : EpiGU { DEV void elem(int, int, float) const {} DEV void pair_(int r, int j, float g, float u) const { pair(r, j, g, u); } };

#ifndef CPU_EMU
typedef float f32x4_t __attribute__((ext_vector_type(4)));
typedef unsigned u32x4_t __attribute__((ext_vector_type(4)));
typedef unsigned u32x2_t __attribute__((ext_vector_type(2)));
typedef float f32x2_t __attribute__((ext_vector_type(2)));
typedef short bf16x8_t __attribute__((ext_vector_type(8)));
__device__ __forceinline__ unsigned pk_bf16(float lo, float hi) { return pg8::cvt_pk_bf16(lo, hi); }
__device__ __forceinline__ int bperm_i(int v, int src_lane) { return __builtin_amdgcn_ds_bpermute(src_lane << 2, v); }
__device__ __forceinline__ float bperm_f(float v, int src_lane) { return __builtin_bit_cast(float, __builtin_amdgcn_ds_bpermute(src_lane << 2, __builtin_bit_cast(int, v))); }
__device__ __forceinline__ int lane_bcast_i(int v, int uniform_lane) { return __builtin_amdgcn_readlane(v, __builtin_amdgcn_readfirstlane(uniform_lane)); }
__device__ __forceinline__ float wave_sum_fast(float v);
__device__ __forceinline__ float wave_sum(float v) { return wave_sum_fast(v); }
__device__ __forceinline__ float fsigmoid(float x) { return __builtin_amdgcn_rcpf(1.0f + __expf(-x)); }
__device__ __forceinline__ float fsilu(float x) { return x * fsigmoid(x); }
__device__ __forceinline__ float fgelu(float x) { const float u = 0.7978845608028654f * (x + 0.044715f * x * x * x); return x * fsigmoid(2.0f * u); }

__device__ __forceinline__ void tconv_tile(const float* __restrict__ src, int src_ld, int scol0, int nvalid, bf16_t* __restrict__ dst, int dst_ld, int drow0, int k0, PG8_LAS float* tile  , int t) {
#pragma unroll
    for (int i = 0; i < 8; ++i) { const int e = t + 512 * i, kk = e >> 6, nn = e & 63;
        tile[kk * 65 + nn] = nn < nvalid ? src[(size_t)(k0 + kk) * src_ld + scol0 + nn] : 0.f; }
    __syncthreads();
    { const int nn = t >> 3, ks = t & 7; float v[8];
#pragma unroll
        for (int j = 0; j < 8; ++j) v[j] = tile[(ks * 8 + j) * 65 + nn];
        u32x4_t w; w.x = pk_bf16(v[0], v[1]); w.y = pk_bf16(v[2], v[3]); w.z = pk_bf16(v[4], v[5]); w.w = pk_bf16(v[6], v[7]);
        *(u32x4_t*)(dst + (size_t)(drow0 + nn) * dst_ld + k0 + ks * 8) = w; }
    __syncthreads();
}
struct WcDesc { const float* src; int ld, nvalid; bf16_t* dst; };
__device__ __forceinline__ WcDesc wconv_desc(const Params& P, int u) {
    constexpr int KT = D / 64, T_EIN = (NZE / 64) * KT, T_OIN = (NZO / 64) * KT, T_OUT = (D / 64) * KT, PER_Q = T_EIN + T_OIN + 2 * T_OUT;
    const int q = u / PER_Q; int r = u % PER_Q; WcDesc d;
    if (r < T_EIN) { const int nt = r / KT, kt = r % KT; d.src = P.ev_w_in + (size_t)q * D * EV_IN + (size_t)(kt * 64) * EV_IN + nt * 64; d.ld = EV_IN; d.nvalid = EV_IN - nt * 64; d.dst = P.wt_ev_in + (size_t)q * NZE * D + (size_t)(nt * 64) * D + kt * 64; return d; }
    r -= T_EIN;
    if (r < T_OIN) { const int nt = r / KT, kt = r % KT; d.src = P.od_w_in + (size_t)q * D * NZO + (size_t)(kt * 64) * NZO + nt * 64; d.ld = NZO; d.nvalid = 64; d.dst = P.wt_od_in + (size_t)q * NZO * D + (size_t)(nt * 64) * D + kt * 64; return d; }
    r -= T_OIN;
    const bool ev = r < T_OUT; if (!ev) r -= T_OUT;
    { const int nt = r / KT, kt = r % KT; d.src = (ev ? P.ev_w_out : P.od_w_out) + (size_t)q * D * D + (size_t)(kt * 64) * D + nt * 64; d.ld = D; d.nvalid = 64; d.dst = (ev ? P.wt_ev_out : P.wt_od_out) + (size_t)q * D * D + (size_t)(nt * 64) * D + kt * 64; }
    return d;
}
__device__ __forceinline__ void fs_wconv(const Params& P, PG8_LAS unsigned char* lds, int t) {
    PG8_LAS float* tile = (PG8_LAS float*)lds;
    PG8_LAS int* slot = (PG8_LAS int*)(lds + 2 * 64 * 65 * 4);
    constexpr int KT = D / 64, NT = 2 * ((NZE / 64) * KT + (NZO / 64) * KT + 2 * (D / 64) * KT);
    unsigned* ctr = P.wq + DEPTH;
    const int kk0 = t >> 6, nn = t & 63;
    if (t == 0) slot[0] = (int)__hip_atomic_fetch_add(ctr, 2u, __ATOMIC_RELAXED, __HIP_MEMORY_SCOPE_AGENT);
    __syncthreads();
    for (int it = 0;; ++it) {
        const int u0 = slot[it & 1];
        if (u0 >= NT) break;
        int unext = NT;
        if (t == 0) unext = (int)__hip_atomic_fetch_add(ctr, 2u, __ATOMIC_RELAXED, __HIP_MEMORY_SCOPE_AGENT);
        const WcDesc d0 = wconv_desc(P, u0), d1 = wconv_desc(P, u0 + 1 < NT ? u0 + 1 : u0);
        float v0[8], v1[8];
#pragma unroll
        for (int i = 0; i < 8; ++i) { v0[i] = nn < d0.nvalid ? d0.src[(size_t)(kk0 + 8 * i) * d0.ld + nn] : 0.f; v1[i] = nn < d1.nvalid ? d1.src[(size_t)(kk0 + 8 * i) * d1.ld + nn] : 0.f; }
#pragma unroll
        for (int i = 0; i < 8; ++i) { tile[(kk0 + 8 * i) * 65 + nn] = v0[i]; tile[64 * 65 + (kk0 + 8 * i) * 65 + nn] = v1[i]; }
        if (t == 0) slot[(it + 1) & 1] = unext;
        __syncthreads();
        { const int n2 = t >> 3, ks = t & 7; float o[8], p[8];
#pragma unroll
            for (int j = 0; j < 8; ++j) { o[j] = tile[(ks * 8 + j) * 65 + n2]; p[j] = tile[64 * 65 + (ks * 8 + j) * 65 + n2]; }
            u32x4_t w; w.x = pk_bf16(o[0], o[1]); w.y = pk_bf16(o[2], o[3]); w.z = pk_bf16(o[4], o[5]); w.w = pk_bf16(o[6], o[7]);
            *(u32x4_t*)(d0.dst + (size_t)n2 * D + ks * 8) = w;
            if (u0 + 1 < NT) { w.x = pk_bf16(p[0], p[1]); w.y = pk_bf16(p[2], p[3]); w.z = pk_bf16(p[4], p[5]); w.w = pk_bf16(p[6], p[7]); *(u32x4_t*)(d1.dst + (size_t)n2 * D + ks * 8) = w; } }
        __syncthreads();
    }
    __syncthreads();
    for (int u = blockIdx.x; u < 32 * 4; u += gridDim.x) {
        const int mi = u >> 2, tt = u & 3, li = mi >> 4, dir = (mi >> 3) & 1, gate = (mi >> 2) & 1, hh = mi & 3;
        const float* src = (gate == 0 ? P.od_gate_a_w : P.od_gate_x_w) + (size_t)(((li * 2 + dir) * 4 + hh) * HD) * HD;
        tconv_tile(src, HD, (tt >> 1) * 64, 64, P.gwT + (size_t)mi * HD * HD, HD, (tt >> 1) * 64, (tt & 1) * 64, tile, t);
    }
    for (int i = blockIdx.x * 512 + t; i < 2 * 4 * SGC * SGC; i += gridDim.x * 512) P.sgw[i] = f2bf(P.od_sg_w[i]);
    for (int i = blockIdx.x * 512 + t; i < DEPTH * D * NE; i += gridDim.x * 512) { const int ll = i / (D * NE), c = (i / NE) % D, e = i % NE; const float w = P.moe_router[i];
        const unsigned ph = pk_bf16(w, 0.f) & 0xffffu; const float wl = w - __uint_as_float(ph << 16);
        P.rw16[((size_t)(ll * 2 + 0) * NE + e) * D + c] = (bf16_t)ph; P.rw16[((size_t)(ll * 2 + 1) * NE + e) * D + c] = (bf16_t)(pk_bf16(wl, 0.f) & 0xffffu); }
}
struct MoeTile { const float* src; unsigned char* dst; };
__device__ __forceinline__ MoeTile moe_tile(const Params& P, int l, int u) {
    constexpr int KT = D / 64, T_GU = (2 * D / 64) * KT, T_DN = (D / 64) * KT, PER_E = T_GU + T_DN;
    const int e = u / PER_E; int r = u % PER_E; MoeTile mt;
    if (r < T_GU) { const int nt = r / KT, kt = r % KT, cv0 = nt * 64, w = cv0 % 256, j0 = (cv0 / 256) * 128 + (w % 128);
        mt.src = (w >= 128 ? P.moe_w_up : P.moe_w_gate) + ((size_t)l * NE + e) * D * D + (size_t)(kt * 64) * D + j0; mt.dst = (unsigned char*)P.wt_gu + (size_t)e * 2 * D * D + (size_t)cv0 * D + kt * 64; }
    else { r -= T_GU; const int nt = r / KT, kt = r % KT;
        mt.src = P.moe_w_down + ((size_t)l * NE + e) * D * D + (size_t)(kt * 64) * D + nt * 64; mt.dst = (unsigned char*)P.wt_dn + (size_t)e * D * D + (size_t)(nt * 64) * D + kt * 64; }
    return mt;
}
__device__ __forceinline__ void fs_moe_wconv(const Params& P, int l, PG8_LAS unsigned char* lds, int t, int limit) {
    PG8_LAS float* tile = (PG8_LAS float*)lds;
    PG8_LAS int* slot = (PG8_LAS int*)(lds + 2 * 64 * 65 * 4);
    constexpr int NT = NE * ((2 * D / 64) + (D / 64)) * (D / 64);
    if (limit > NT) limit = NT;
    const int kk0 = t >> 6, nn = t & 63;
    unsigned* ctr = P.wq + l;
    if (t == 0) { const unsigned c0 = __hip_atomic_load(ctr, __ATOMIC_RELAXED, __HIP_MEMORY_SCOPE_AGENT);
        slot[0] = (int)c0 >= limit ? NT : (int)__hip_atomic_fetch_add(ctr, 2u, __ATOMIC_RELAXED, __HIP_MEMORY_SCOPE_AGENT); }
    __syncthreads();
    for (int it = 0;; ++it) {
        const int u0 = slot[it & 1];
        if (u0 >= NT) break;
        int unext = NT;
        if (t == 0 && u0 + 2 < limit) unext = (int)__hip_atomic_fetch_add(ctr, 2u, __ATOMIC_RELAXED, __HIP_MEMORY_SCOPE_AGENT);
        const MoeTile m0 = moe_tile(P, l, u0), m1 = moe_tile(P, l, u0 + 1 < NT ? u0 + 1 : u0);
        float v0[8], v1[8];
#pragma unroll
        for (int i = 0; i < 8; ++i) { v0[i] = m0.src[(size_t)(kk0 + 8 * i) * D + nn]; v1[i] = m1.src[(size_t)(kk0 + 8 * i) * D + nn]; }
#pragma unroll
        for (int i = 0; i < 8; ++i) { tile[(kk0 + 8 * i) * 65 + nn] = v0[i]; tile[64 * 65 + (kk0 + 8 * i) * 65 + nn] = v1[i]; }
        if (t == 0) slot[(it + 1) & 1] = unext;
        __syncthreads();
        { const int n2 = t >> 3, ks = t & 7; float o[8], p[8];
#pragma unroll
            for (int j = 0; j < 8; ++j) { o[j] = tile[(ks * 8 + j) * 65 + n2]; p[j] = tile[64 * 65 + (ks * 8 + j) * 65 + n2]; }
            constexpr float ws = pg8::W8_SCALE;
            u32x2_t w; w.x = pg8::pack4_fp8(o[0] * ws, o[1] * ws, o[2] * ws, o[3] * ws); w.y = pg8::pack4_fp8(o[4] * ws, o[5] * ws, o[6] * ws, o[7] * ws);
            *(u32x2_t*)(m0.dst + (size_t)n2 * D + ks * 8) = w;
            if (u0 + 1 < NT) { w.x = pg8::pack4_fp8(p[0] * ws, p[1] * ws, p[2] * ws, p[3] * ws); w.y = pg8::pack4_fp8(p[4] * ws, p[5] * ws, p[6] * ws, p[7] * ws); *(u32x2_t*)(m1.dst + (size_t)n2 * D + ks * 8) = w; } }
        __syncthreads();
    }
    __syncthreads();
}
__device__ __forceinline__ void fs_mod(const Params& P, PG8_LAS unsigned char* lds, int t) {
    PG8_LAS float* sb = (PG8_LAS float*)lds;
    PG8_LAS float* red = sb + (NB + 1) * D;
    for (int i = t; i < (NB + 1) * D; i += 512) { const int bb = i / D, kk = i % D; const float v = bb < NB ? P.c[(size_t)bb * D + kk] : P.c_ctx[kk]; sb[i] = v / (1.0f + expf(-v)); }
    __syncthreads();
    constexpr int CB = MODW / 128;
    const int c4 = t & 31, ks = t >> 5;
    for (int u = blockIdx.x; u < DEPTH * CB; u += gridDim.x) {
        const int ll = u / CB, j0 = (u % CB) * 128 + c4 * 4;
        const float* w = P.ada_w + (size_t)ll * D * MODW + j0;
        f32x4_t acc[NB + 1];
#pragma unroll
        for (int bb = 0; bb <= NB; ++bb) acc[bb] = (f32x4_t){0.f, 0.f, 0.f, 0.f};
#pragma unroll 8
        for (int kk = ks * 64; kk < ks * 64 + 64; ++kk) { const f32x4_t wv = *(const f32x4_t*)(w + (size_t)kk * MODW);
#pragma unroll
            for (int bb = 0; bb <= NB; ++bb) acc[bb] += wv * sb[bb * D + kk]; }
#pragma unroll
        for (int bb = 0; bb <= NB; ++bb)
#pragma unroll
            for (int i = 0; i < 4; ++i) red[(ks * 32 + c4) * 36 + bb * 4 + i] = acc[bb][i];
        __syncthreads();
        for (int o = t; o < (NB + 1) * 128; o += 512) { const int bb = o / 128, col = o % 128, cc4 = col >> 2, ci = col & 3;
            float s = P.ada_b[(size_t)ll * MODW + (u % CB) * 128 + col];
#pragma unroll
            for (int k2 = 0; k2 < 16; ++k2) s += red[(k2 * 32 + cc4) * 36 + bb * 4 + ci];
            P.mod[((size_t)ll * (NB + 1) + bb) * MODW + (u % CB) * 128 + col] = s; }
        __syncthreads();
    }
}
#define DPP_ADD(v, ctrl) ((v) + __builtin_bit_cast(float, __builtin_amdgcn_update_dpp(0, __builtin_bit_cast(int, (v)), (ctrl), 0xF, 0xF, true)))
__device__ __forceinline__ float row16_sum(float v) {
    v = DPP_ADD(v, 0xB1);
    v = DPP_ADD(v, 0x4E);
    v = DPP_ADD(v, 0x141);
    v = DPP_ADD(v, 0x140);
    return v;
}
__device__ __forceinline__ float wave_sum_fast(float v) {
    v = row16_sum(v);
    const int iv = __builtin_bit_cast(int, v);
    return __builtin_bit_cast(float, __builtin_amdgcn_readlane(iv, 0)) + __builtin_bit_cast(float, __builtin_amdgcn_readlane(iv, 16)) +
           __builtin_bit_cast(float, __builtin_amdgcn_readlane(iv, 32)) + __builtin_bit_cast(float, __builtin_amdgcn_readlane(iv, 48));
}
template <int MODE>
__device__ __forceinline__ void fs_row(const Params& P, int l, PG8_LAS unsigned char* lds, int t) {
    const int lane = t & 63, wid = t >> 6;
    PG8_LAS float* wrT = (PG8_LAS float*)lds;
    if (MODE == 1) {
        const float* wr = P.moe_router + (size_t)l * D * NE;
        for (int i = t; i < D * NE; i += 512) { const int c = i / NE, e = i % NE; wrT[e * D + c] = wr[i]; }
        __syncthreads();
    }
    const bool combine = (MODE == 0 && l > 0) || MODE == 2;
    const int lc = MODE == 2 ? DEPTH - 1 : l - 1;
    const float* gvec = MODE == 0 ? P.norm_mix_g + (size_t)l * D : MODE == 1 ? P.norm_ffn_g + (size_t)l * D : P.norm_final_g;
    const int nrows = (MODE == 2 || (MODE == 1 && l == DEPTH - 1)) ? RL : R;
    const int nwaves = gridDim.x * 8, rpw = (nrows + nwaves - 1) / nwaves, rbeg = (blockIdx.x * 8 + wid) * rpw, rend = (rbeg + rpw < nrows) ? rbeg + rpw : nrows;
    const bool in32 = (MODE == 0 && l == 0);
    auto xload = [&](int r, u32x4_t (&raw)[4]) {
        if (in32) { const float* xs = r < RL ? P.x + (size_t)r * D : P.ctx + (size_t)(r - RL) * D;
#pragma unroll
            for (int i = 0; i < 4; ++i) raw[i] = *(const u32x4_t*)(xs + lane * 4 + i * 256); }
        else { const bf16_t* xs = P.xb + (size_t)r * D;
#pragma unroll
            for (int i = 0; i < 4; ++i) { const u32x2_t w = *(const u32x2_t*)(xs + lane * 4 + i * 256); raw[i].x = w.x; raw[i].y = w.y; } } };
    f32x4_t gv[4];
#pragma unroll
    for (int i = 0; i < 4; ++i) gv[i] = *(const f32x4_t*)(gvec + lane * 4 + i * 256);
    f32x4_t scv[4], shv[4], m5v[4]; int bbc = -1;
    u32x4_t xn[4]; int inv0 = -1, inv1 = -1, inv2 = -1;
    int pw0[4] = {0, 0, 0, 0}, pw1[4] = {0, 0, 0, 0};
    auto slot_prefetch = [&](int invv) {
        const unsigned long long mk = __ballot(invv >= 0) & 0xffffull;
        if (mk) { const int e0 = __builtin_ctzll(mk); const unsigned long long m2 = mk & (mk - 1); const int s0 = lane_bcast_i(invv, e0);
            const unsigned char* o0 = (const unsigned char*)P.outslot + (size_t)s0 * D + lane * 4;
#pragma unroll
            for (int i = 0; i < 4; ++i) pw0[i] = *(const int*)(o0 + i * 256);
            if (m2) { const int e1 = __builtin_ctzll(m2); const int s1 = lane_bcast_i(invv, e1); const unsigned char* o1 = (const unsigned char*)P.outslot + (size_t)s1 * D + lane * 4;
#pragma unroll
                for (int i = 0; i < 4; ++i) pw1[i] = *(const int*)(o1 + i * 256); } } };
    if (rbeg < rend) { xload(rbeg, xn);
        if (combine) { inv0 = P.inv[(size_t)rbeg * NE + (lane & 15)]; if (rbeg + 1 < rend) inv1 = P.inv[(size_t)(rbeg + 1) * NE + (lane & 15)]; if (rbeg + 2 < rend) inv2 = P.inv[(size_t)(rbeg + 2) * NE + (lane & 15)];
            slot_prefetch(inv0); } }
    for (int r = rbeg; r < rend; ++r) {
        const bool lat = r < RL; const int bb = lat ? r / T : NB;
        f32x4_t xv[4];
#pragma unroll
        for (int i = 0; i < 4; ++i) { if (in32) xv[i] = __builtin_bit_cast(f32x4_t, xn[i]);
            else xv[i] = (f32x4_t){__uint_as_float(xn[i].x << 16), __uint_as_float(xn[i].x & 0xffff0000u), __uint_as_float(xn[i].y << 16), __uint_as_float(xn[i].y & 0xffff0000u)}; }
        const int myinv = inv0;
        int cw0[4], cw1[4];
#pragma unroll
        for (int i = 0; i < 4; ++i) { cw0[i] = pw0[i]; cw1[i] = pw1[i]; }
        if (r + 1 < rend) { xload(r + 1, xn);
            if (combine) { slot_prefetch(inv1); inv0 = inv1; inv1 = inv2; if (r + 3 < rend) inv2 = P.inv[(size_t)(r + 3) * NE + (lane & 15)]; } }
        if (bb != bbc) { bbc = bb;
            if (MODE != 2) { const float* mr = modrow(P, l, bb) + lane * 4;
#pragma unroll
                for (int i = 0; i < 4; ++i) { scv[i] = *(const f32x4_t*)(mr + (MODE == 0 ? 1 : 4) * D + i * 256) + 1.0f; shv[i] = *(const f32x4_t*)(mr + (MODE == 0 ? 0 : 3) * D + i * 256); } }
            if (combine) { const float* m5 = modrow(P, lc, bb) + 5 * D + lane * 4;
#pragma unroll
                for (int i = 0; i < 4; ++i) m5v[i] = *(const f32x4_t*)(m5 + i * 256); } }
        if (combine) {
            f32x4_t sum[4];
#pragma unroll
            for (int i = 0; i < 4; ++i) sum[i] = (f32x4_t){0.f, 0.f, 0.f, 0.f};
            unsigned long long msk = __ballot(myinv >= 0) & 0xffffull;
            constexpr float fs = 1.0f / pg8::OUTSLOT_SCALE;
            if (msk) {
                msk &= msk - 1; const bool two = msk != 0; msk &= msk - 1; const float f1 = two ? fs : 0.0f;
#pragma unroll
                for (int i = 0; i < 4; ++i) {
                    sum[i][0] += fs * __builtin_amdgcn_cvt_f32_fp8(cw0[i], 0) + f1 * __builtin_amdgcn_cvt_f32_fp8(cw1[i], 0); sum[i][1] += fs * __builtin_amdgcn_cvt_f32_fp8(cw0[i], 1) + f1 * __builtin_amdgcn_cvt_f32_fp8(cw1[i], 1);
                    sum[i][2] += fs * __builtin_amdgcn_cvt_f32_fp8(cw0[i], 2) + f1 * __builtin_amdgcn_cvt_f32_fp8(cw1[i], 2); sum[i][3] += fs * __builtin_amdgcn_cvt_f32_fp8(cw0[i], 3) + f1 * __builtin_amdgcn_cvt_f32_fp8(cw1[i], 3); }
            }
            while (msk) {
                const int e0 = __builtin_ctzll(msk); msk &= msk - 1; const bool two = msk != 0; const int e1 = two ? __builtin_ctzll(msk) : e0; msk &= msk - 1;
                const int s0 = lane_bcast_i(myinv, e0), s1 = lane_bcast_i(myinv, e1);
                const unsigned char* o0 = (const unsigned char*)P.outslot + (size_t)s0 * D + lane * 4; const unsigned char* o1 = (const unsigned char*)P.outslot + (size_t)s1 * D + lane * 4;
                int w0[4], w1[4];
#pragma unroll
                for (int i = 0; i < 4; ++i) { w0[i] = *(const int*)(o0 + i * 256); w1[i] = *(const int*)(o1 + i * 256); }
                const float f1 = two ? fs : 0.0f;
#pragma unroll
                for (int i = 0; i < 4; ++i) {
                    sum[i][0] += fs * __builtin_amdgcn_cvt_f32_fp8(w0[i], 0) + f1 * __builtin_amdgcn_cvt_f32_fp8(w1[i], 0); sum[i][1] += fs * __builtin_amdgcn_cvt_f32_fp8(w0[i], 1) + f1 * __builtin_amdgcn_cvt_f32_fp8(w1[i], 1);
                    sum[i][2] += fs * __builtin_amdgcn_cvt_f32_fp8(w0[i], 2) + f1 * __builtin_amdgcn_cvt_f32_fp8(w1[i], 2); sum[i][3] += fs * __builtin_amdgcn_cvt_f32_fp8(w0[i], 3) + f1 * __builtin_amdgcn_cvt_f32_fp8(w1[i], 3); }
            }
            bf16_t* xd = P.xb + (size_t)r * D;
#pragma unroll
            for (int i = 0; i < 4; ++i) { xv[i] += m5v[i] * sum[i];
                if (MODE != 2) { u32x2_t w; w.x = pk_bf16(xv[i][0], xv[i][1]); w.y = pk_bf16(xv[i][2], xv[i][3]); *(u32x2_t*)(xd + lane * 4 + i * 256) = w;
                    xv[i] = (f32x4_t){__uint_as_float(w.x << 16), __uint_as_float(w.x & 0xffff0000u), __uint_as_float(w.y << 16), __uint_as_float(w.y & 0xffff0000u)}; } }
        }
        float ss = 0.f;
#pragma unroll
        for (int i = 0; i < 4; ++i) ss += xv[i][0] * xv[i][0] + xv[i][1] * xv[i][1] + xv[i][2] * xv[i][2] + xv[i][3] * xv[i][3];
        ss = wave_sum_fast(ss);
        const float rinv = 1.0f / sqrtf(ss * (1.0f / D) + EPS);
        if (MODE == 2) {
#pragma unroll
            for (int i = 0; i < 4; ++i) *(f32x4_t*)(P.xlat + (size_t)r * D + lane * 4 + i * 256) = xv[i] * rinv * gv[i];
            continue;
        }
        f32x4_t hv[4];
#pragma unroll
        for (int i = 0; i < 4; ++i) { hv[i] = (xv[i] * rinv * gv[i]) * scv[i] + shv[i];
            if (MODE == 1) *(unsigned*)((unsigned char*)P.h + (size_t)r * D + lane * 4 + i * 256) = pg8::pack4_fp8(hv[i][0], hv[i][1], hv[i][2], hv[i][3]);
            else { u32x2_t w; w.x = pk_bf16(hv[i][0], hv[i][1]); w.y = pk_bf16(hv[i][2], hv[i][3]); *(u32x2_t*)(P.h + (size_t)r * D + lane * 4 + i * 256) = w; } }
        if (MODE == 1) {
            float lg[NE];
#pragma unroll
            for (int e = 0; e < NE; ++e) { f32x4_t a4 = hv[0] * *(const PG8_LAS f32x4_t*)(wrT + e * D + lane * 4);
#pragma unroll
                for (int i = 1; i < 4; ++i) a4 += hv[i] * *(const PG8_LAS f32x4_t*)(wrT + e * D + lane * 4 + i * 256);
                lg[e] = wave_sum_fast((a4[0] + a4[1]) + (a4[2] + a4[3]));
                asm volatile("" ::: "memory"); }
            float mx = lg[0];
#pragma unroll
            for (int e = 1; e < NE; ++e) mx = fmaxf(mx, lg[e]);
            float s = 0.f, mine = 0.f;
#pragma unroll
            for (int e = 0; e < NE; ++e) { const float ex = __expf(lg[e] - mx); s += ex; mine = (lane == e) ? ex : mine; }
            if (lane < NE) P.aff[(size_t)lane * R + r] = mine / s;
        }
    }
}
__device__ __forceinline__ float row16_max(float v) {
#define DPP_MAX(v, ctrl) fmaxf((v), __builtin_bit_cast(float, __builtin_amdgcn_update_dpp(__builtin_bit_cast(int, (v)), __builtin_bit_cast(int, (v)), (ctrl), 0xF, 0xF, false)))
    v = DPP_MAX(v, 0xB1); v = DPP_MAX(v, 0x4E); v = DPP_MAX(v, 0x141); v = DPP_MAX(v, 0x140);
#undef DPP_MAX
    return v;
}
__device__ __forceinline__ void fs_row_ffn(const Params& P, int l, PG8_LAS unsigned char* lds, int t) {
    const int lane = t & 63, wid = t >> 6, rl = lane & 15, kg = lane >> 4;
    constexpr int WROW = D + 8;
    PG8_LAS bf16_t* wThi = (PG8_LAS bf16_t*)lds;
    PG8_LAS bf16_t* wTlo = wThi + NE * WROW;
    PG8_LAS float* gsv = (PG8_LAS float*)(lds + 2 * NE * WROW * 2);
    PG8_LAS float* shv = gsv + D;
    PG8_LAS float* red = shv + D;
    PG8_LAS float* cbv = red + 32 * NE;
    const float* wr = P.moe_router + (size_t)l * D * NE; const float* gvec = P.norm_ffn_g + (size_t)l * D;
    { const bf16_t* rw = P.rw16 + (size_t)l * 2 * NE * D;
        u32x4_t pc[8];
#pragma unroll
        for (int j = 0; j < 8; ++j) pc[j] = *(const u32x4_t*)(rw + (size_t)(t + 512 * j) * 8);
#pragma unroll
        for (int j = 0; j < 8; ++j) { const int p = t + 512 * j, hl = p >> 11, e = (p >> 7) & 15, c8 = (p & 127) * 8; *(PG8_LAS u32x4_t*)((hl ? wTlo : wThi) + e * WROW + c8) = pc[j]; } }
    const int nrows = (l == DEPTH - 1) ? RL : R, ntiles = nrows / 16, nwaves = gridDim.x * 8;
    const int nextra = ntiles - nwaves;
    for (int k0 = 0; k0 < 2; ++k0) {
        if (k0 == 1 && (int)blockIdx.x >= nextra) break;
        const int tl = k0 == 0 ? (int)blockIdx.x * 8 + wid : (wid == 0 ? nwaves + (int)blockIdx.x : ntiles), r0 = tl * 16;
        const int rb = k0 == 0 ? (int)blockIdx.x * 128 : (nwaves + (int)blockIdx.x) * 16, bb = rb < RL ? rb / T : NB;
        const bool active = tl < ntiles; const int r0c = active ? r0 : 0;
        const bf16_t* xrow = P.xb + (size_t)(r0c + rl) * D + kg * 16;
        auto load8 = [&](int kb, u32x4_t (&xg)[8]) {
#pragma unroll
            for (int j = 0; j < 8; ++j) xg[j] = *(const u32x4_t*)(xrow + ((kb * 8 + j) >> 1) * 64 + ((kb * 8 + j) & 1) * 8); };
        u32x4_t xa[8], xc[8];
        f32x4_t sq0, sq1, sq2, sq3; { const f32x4_t* sp = (const f32x4_t*)(P.ssqp + (size_t)(r0c + rl) * 16); sq0 = sp[0]; sq1 = sp[1]; sq2 = sp[2]; sq3 = sp[3]; }
        load8(0, xa);
        __syncthreads();
        { const float* mr = modrow(P, l, bb);
            for (int c = t; c < D; c += 512) { gsv[c] = gvec[c] * (1.0f + mr[4 * D + c]); shv[c] = mr[3 * D + c]; } }
        __syncthreads();
        { const int e = t & 15, part = t >> 4; float s = 0.f;
#pragma unroll 8
            for (int c = part * 32; c < part * 32 + 32; ++c) s += shv[c] * (bf2f(wThi[e * WROW + c]) + bf2f(wTlo[e * WROW + c]));
            red[part * NE + e] = s; }
        __syncthreads();
        if (t < NE) { float s = 0.f;
#pragma unroll
            for (int p2 = 0; p2 < 32; ++p2) s += red[p2 * NE + t];
            cbv[t] = s; }
        __syncthreads();
        if (!active) continue;
        unsigned char* hrow = (unsigned char*)P.h + (size_t)(r0 + rl) * D + kg * 16;
        float rinv;
        { const float ss = ((sq0[0] + sq0[1]) + (sq0[2] + sq0[3])) + ((sq1[0] + sq1[1]) + (sq1[2] + sq1[3])) + ((sq2[0] + sq2[1]) + (sq2[2] + sq2[3])) + ((sq3[0] + sq3[1]) + (sq3[2] + sq3[3]));
            rinv = 1.0f / sqrtf(ss * (1.0f / D) + EPS); }
        pg8::f32x4 acc = (pg8::f32x4){0.f, 0.f, 0.f, 0.f};
        u32x2_t hpair;
        auto step = [&](int ks, const u32x4_t& xv) {
            const int c0 = (ks >> 1) * 64 + kg * 16 + (ks & 1) * 8;
            const f32x4_t g0 = *(const PG8_LAS f32x4_t*)(gsv + c0), g1 = *(const PG8_LAS f32x4_t*)(gsv + c0 + 4), s0 = *(const PG8_LAS f32x4_t*)(shv + c0), s1 = *(const PG8_LAS f32x4_t*)(shv + c0 + 4);
            const bf16x8_t bh = *(const PG8_LAS bf16x8_t*)(wThi + rl * WROW + c0), bl = *(const PG8_LAS bf16x8_t*)(wTlo + rl * WROW + c0);
            const unsigned xw[4] = {xv.x, xv.y, xv.z, xv.w};
            float a[8], hv[8];
#pragma unroll
            for (int j = 0; j < 4; ++j) { const float x0 = __uint_as_float(xw[j] << 16), x1 = __uint_as_float(xw[j] & 0xffff0000u);
                a[2 * j] = x0 * (j < 2 ? g0[2 * j] : g1[2 * j - 4]); a[2 * j + 1] = x1 * (j < 2 ? g0[2 * j + 1] : g1[2 * j - 3]);
                hv[2 * j] = a[2 * j] * rinv + (j < 2 ? s0[2 * j] : s1[2 * j - 4]); hv[2 * j + 1] = a[2 * j + 1] * rinv + (j < 2 ? s0[2 * j + 1] : s1[2 * j - 3]); }
            u32x2_t w8; w8.x = pg8::pack4_fp8(hv[0], hv[1], hv[2], hv[3]); w8.y = pg8::pack4_fp8(hv[4], hv[5], hv[6], hv[7]);
            if (ks & 1) *(u32x4_t*)(hrow + (ks >> 1) * 64) = (u32x4_t){hpair.x, hpair.y, w8.x, w8.y}; else hpair = w8;
            unsigned hw[4], lw[4];
#pragma unroll
            for (int j = 0; j < 4; ++j) { hw[j] = pk_bf16(a[2 * j], a[2 * j + 1]);
                lw[j] = pk_bf16(a[2 * j] - __uint_as_float(hw[j] << 16), a[2 * j + 1] - __uint_as_float(hw[j] & 0xffff0000u)); }
            const bf16x8_t fah = __builtin_bit_cast(bf16x8_t, (u32x4_t){hw[0], hw[1], hw[2], hw[3]}), fal = __builtin_bit_cast(bf16x8_t, (u32x4_t){lw[0], lw[1], lw[2], lw[3]});
            acc = __builtin_amdgcn_mfma_f32_16x16x32_bf16(fah, bh, acc, 0, 0, 0);
            acc = __builtin_amdgcn_mfma_f32_16x16x32_bf16(fah, bl, acc, 0, 0, 0);
            acc = __builtin_amdgcn_mfma_f32_16x16x32_bf16(fal, bh, acc, 0, 0, 0);
            asm volatile("" ::: "memory"); };
#pragma nounroll
        for (int kb = 0; kb < 4; kb += 2) {
            load8(kb + 1, xc);
#pragma unroll
            for (int j = 0; j < 8; ++j) step(kb * 8 + j, xa[j]);
            if (kb + 2 < 4) load8(kb + 2, xa);
#pragma unroll
            for (int j = 0; j < 8; ++j) step((kb + 1) * 8 + j, xc[j]);
        }
        {
            const float cb = cbv[rl]; float aff[4];
#pragma unroll
            for (int i = 0; i < 4; ++i) { const float lg = bperm_f(rinv, 4 * kg + i) * acc[i] + cb;
                const float mx = row16_max(lg), ex = __expf(lg - mx), sm = row16_sum(ex); aff[i] = ex / sm; }
            *(f32x4_t*)(P.aff + (size_t)rl * R + r0 + 4 * kg) = (f32x4_t){aff[0], aff[1], aff[2], aff[3]};
        }
    }
    __syncthreads();
}
template <int KPT>
__device__ __forceinline__ void select_list(const Params& P, const float* a, int n, int cap, int base, int slot0, int e, PG8_LAS unsigned* sm, int t) {
    PG8_LAS unsigned* hist = sm;
    PG8_LAS unsigned* ctl = sm + 256;
    const int lane = t & 63, wid = t >> 6;
    unsigned key[KPT]; bool have[KPT];
#pragma unroll
    for (int j = 0; j < KPT; ++j) { const int i = t * KPT + j; have[j] = i < n; key[j] = have[j] ? __float_as_uint(a[i]) : 0u; }
    unsigned prefix = 0u, rem = (unsigned)cap;
#pragma unroll 1
    for (int pass = 0; pass < 4; ++pass) {
        const int shift = 24 - 8 * pass;
        if (t < 256) hist[t] = 0u;
        __syncthreads();
#pragma unroll
        for (int j = 0; j < KPT; ++j) if (have[j] && (pass == 0 || (key[j] >> (shift + 8)) == prefix)) (void)__hip_atomic_fetch_add(&hist[(key[j] >> shift) & 255u], 1u, __ATOMIC_RELAXED, __HIP_MEMORY_SCOPE_WORKGROUP);
        __syncthreads();
        if (wid == 0) {
            unsigned c[4]; unsigned s = 0u;
#pragma unroll
            for (int q = 0; q < 4; ++q) { c[q] = hist[255 - 4 * lane - q]; s += c[q]; }
            unsigned inc = s;
#pragma unroll
            for (int o = 1; o < 64; o <<= 1) { const unsigned v = (unsigned)bperm_i((int)inc, (lane - o) & 63); if (lane >= o) inc += v; }
            unsigned cum = inc - s;
#pragma unroll
            for (int q = 0; q < 4; ++q) { if (cum < rem && rem <= cum + c[q]) { ctl[0] = (prefix << 8) | (unsigned)(255 - 4 * lane - q); ctl[1] = rem - cum; ctl[2] = c[q]; } cum += c[q]; }
        }
        __syncthreads();
        prefix = ctl[0]; rem = ctl[1];
    }
    const unsigned T_ = prefix, need_eq = rem, cnt_eq = ctl[2];
    int nsel = 0, ntie = 0;
#pragma unroll
    for (int j = 0; j < KPT; ++j) { nsel += (have[j] && key[j] > T_) ? 1 : 0; ntie += (have[j] && key[j] == T_) ? 1 : 0; }
    int incs = nsel, inct = ntie;
#pragma unroll
    for (int o = 1; o < 64; o <<= 1) { const int v1 = bperm_i(incs, (lane - o) & 63), v2 = bperm_i(inct, (lane - o) & 63); if (lane >= o) { incs += v1; inct += v2; } }
    if (lane == 63) { ctl[4 + wid] = (unsigned)incs; ctl[16 + wid] = (unsigned)inct; }
    __syncthreads();
    int bs = 0, bt = 0;
#pragma unroll
    for (int w2 = 0; w2 < 8; ++w2) { if (w2 < wid) { bs += (int)ctl[4 + w2]; bt += (int)ctl[16 + w2]; } }
    int gpos = bs + incs - nsel, tpos = bt + inct - ntie;
    (void)cnt_eq;
#pragma unroll
    for (int j = 0; j < KPT; ++j) if (have[j]) { const int row = base + t * KPT + j;
        const bool gt = key[j] > T_, tie = key[j] == T_, take = gt || (tie && tpos < (int)need_eq);
        const int pos = gpos + (tpos < (int)need_eq ? tpos : (int)need_eq);
        if (take) { P.sel_row[slot0 + pos] = row; P.sel_g[slot0 + pos] = __uint_as_float(key[j]); P.inv[(size_t)row * NE + e] = slot0 + pos; }
        else P.inv[(size_t)row * NE + e] = -1;
        gpos += gt ? 1 : 0; tpos += tie ? 1 : 0; }
    __syncthreads();
}
__device__ __forceinline__ void fs_select(const Params& P, int l, PG8_LAS unsigned char* lds, int t) {
    PG8_LAS unsigned* sm = (PG8_LAS unsigned*)lds;
    for (int li = blockIdx.x; li < (l == DEPTH - 1 ? 1 : 2) * NB * NE; li += gridDim.x) {
        const bool lat = li < NB * NE; const int q = lat ? li : li - NB * NE, b = q / NE, e = q % NE;
        const int base = lat ? b * T : RL + b * TC, slot0 = e * SLOTS_E + (lat ? b * CAPL : NB * CAPL + b * CAPC);
        const float* a = P.aff + (size_t)e * R + base;
        if (lat) select_list<T / 512>(P, a, T, CAPL, base, slot0, e, sm, t);
        else select_list<1>(P, a, TC, CAPC, base, slot0, e, sm, t);
    }
}
__device__ __forceinline__ void fs_gather(const Params& P, int t) {
    const int lane = t & 63, wid = t >> 6;
    for (int s = blockIdx.x * 8 + wid; s < SLOTS; s += gridDim.x * 8) {
        const bf16_t* src = P.h + (size_t)P.sel_row[s] * D + lane * 8; bf16_t* dst = P.xg + (size_t)s * D + lane * 8;
        const u32x4_t v0 = *(const u32x4_t*)src, v1 = *(const u32x4_t*)(src + 512);
        *(u32x4_t*)dst = v0; *(u32x4_t*)(dst + 512) = v1;
    }
}
__device__ __forceinline__ float neg_expm1_fast(float x) {
    const float p = x * (1.0f + x * (0.5f + x * (1.0f / 6.0f + x * (1.0f / 24.0f + x * (1.0f / 120.0f + x * (1.0f / 720.0f))))));
    return x > -0.25f ? -p : 1.0f - __expf(x);
}
struct LruRegs { unsigned x[11], g[8]; float hin; };
template <bool FINAL>
__device__ __forceinline__ void lru_load(const Params& P, int u, int hh, int t, LruRegs& r) {
    const int rest = u >> 2, c = rest % NCH, b = rest / NCH;
    const int row0 = seqrow(b, c * CH), seglo = c < NCHC ? RL + b * TC : b * T, seghi = seglo + (c < NCHC ? TC : T);
    const int cp = t & 63, tg = t >> 6, r0 = row0 + tg * 8 - 2;
    const bf16_t* zc = P.z + O_XB + hh * HD + 2 * cp;
#pragma unroll
    for (int i = 0; i < 11; ++i) { int rr = r0 + i; rr = rr < seglo ? seglo : rr; rr = rr >= seghi ? seghi - 1 : rr; r.x[i] = *(const unsigned*)(zc + (size_t)rr * NZO); }
    if (FINAL) {
        const bf16_t* zg = P.z + O_GB + hh * HD + 2 * cp;
#pragma unroll
        for (int i = 0; i < 8; ++i) r.g[i] = *(const unsigned*)(zg + (size_t)(row0 + tg * 8 + i) * NZO);
        r.hin = t < 256 ? P.hinb[((size_t)((t >> 7) * NB + b) * NCH + c) * W2 + hh * HD + (t & 127)] : 0.f;
    }
}
template <bool FINAL>
__device__ __forceinline__ void fs_odd_lru(const Params& P, int l, PG8_LAS unsigned char* lds, int t) {
    const int lane = t & 63, w = t >> 6, q = lane >> 4, fr = lane & 15;
    const int li = l >> 1, hh = blockIdx.x & 3, jch = 16 * w + fr, chg = hh * HD + jch;
    PG8_LAS bf16_t* xcb = (PG8_LAS bf16_t*)lds;
    constexpr int XROW = 132;
    PG8_LAS float* xcf = (PG8_LAS float*)(lds + 17408);
    PG8_LAS float* hs = (PG8_LAS float*)(lds + 17408 + 33792);
    PG8_LAS float* hin = (PG8_LAS float*)(lds + 17408 + 67584);
    PG8_LAS bf16_t* gbs = (PG8_LAS bf16_t*)(lds + 17408 + 67584 + 1024);
    bf16x8_t bw[2][2][4];
#pragma unroll
    for (int dir = 0; dir < 2; ++dir)
#pragma unroll
        for (int gate = 0; gate < 2; ++gate)
#pragma unroll
            for (int ks = 0; ks < 4; ++ks) bw[dir][gate][ks] = *(const bf16x8_t*)(P.gwT + ((size_t)((((li * 2 + dir) * 2 + gate) * 4 + hh) * HD + jch)) * HD + ks * 32 + 8 * q);
    constexpr float L2E = 1.4426950408889634f;
    float ba[2], bx[2], sp[2];
#pragma unroll
    for (int dir = 0; dir < 2; ++dir) { ba[dir] = -L2E * P.od_gate_a_b[(size_t)(li * 2 + dir) * W2 + chg]; bx[dir] = -L2E * P.od_gate_x_b[(size_t)(li * 2 + dir) * W2 + chg];
        sp[dir] = L2E * -8.0f * softplusf_(-P.od_lambda[(size_t)(li * 2 + dir) * W2 + chg]); }
    const int cp = t & 63, tg = t >> 6;
    float cw[4][2], cbv[2];
#pragma unroll
    for (int h2 = 0; h2 < 2; ++h2) { cbv[h2] = P.od_conv_b[(size_t)li * W2 + hh * HD + 2 * cp + h2];
#pragma unroll
        for (int j = 0; j < 4; ++j) cw[j][h2] = P.od_conv_w[(size_t)(li * 4 + j) * W2 + hh * HD + 2 * cp + h2]; }
    constexpr int NU = NB * NCH * 4;
    LruRegs rg; if ((int)blockIdx.x < NU) lru_load<FINAL>(P, blockIdx.x, hh, t, rg);
    for (int u = blockIdx.x; u < NU; u += gridDim.x) {
        const int rest = u >> 2, c = rest % NCH, b = rest / NCH;
        const int row0 = seqrow(b, c * CH), seglo = c < NCHC ? RL + b * TC : b * T, seghi = seglo + (c < NCHC ? TC : T);
        {
            const int r0 = row0 + tg * 8 - 2;
            f32x2_t xv[11];
#pragma unroll
            for (int i = 0; i < 11; ++i) { const unsigned w = (r0 + i >= seglo && r0 + i < seghi) ? rg.x[i] : 0u; xv[i] = (f32x2_t){__uint_as_float(w << 16), __uint_as_float(w & 0xffff0000u)}; }
            const f32x2_t cb2v = (f32x2_t){cbv[0], cbv[1]}, cw0 = (f32x2_t){cw[0][0], cw[0][1]}, cw1 = (f32x2_t){cw[1][0], cw[1][1]}, cw2 = (f32x2_t){cw[2][0], cw[2][1]}, cw3 = (f32x2_t){cw[3][0], cw[3][1]};
#pragma unroll
            for (int i = 0; i < 8; ++i) { const int tok = tg * 8 + i;
                const f32x2_t xc = cb2v + cw0 * xv[i] + cw1 * xv[i + 1] + cw2 * xv[i + 2] + cw3 * xv[i + 3];
                *(PG8_LAS f32x2_t*)(xcf + tok * XROW + 2 * cp) = xc; *(PG8_LAS unsigned*)(xcb + tok * 136 + 2 * cp) = pk_bf16(xc.x, xc.y); }
            if (FINAL) {
#pragma unroll
                for (int i = 0; i < 8; ++i) *(PG8_LAS unsigned*)(gbs + (tg * 8 + i) * 128 + 2 * cp) = rg.g[i];
                if (t < 256) hin[t] = rg.hin; }
        }
        __syncthreads();
        if (u + (int)gridDim.x < NU) lru_load<FINAL>(P, u + gridDim.x, hh, t, rg);
#pragma unroll
        for (int dir = 0; dir < 2; ++dir) {
            pg8::f32x4 aa[4], ax[4];
#pragma unroll
            for (int mt = 0; mt < 4; ++mt) { aa[mt] = (pg8::f32x4){0.f, 0.f, 0.f, 0.f}; ax[mt] = (pg8::f32x4){0.f, 0.f, 0.f, 0.f}; }
#pragma unroll
            for (int ks = 0; ks < 4; ++ks)
#pragma unroll
                for (int mt = 0; mt < 4; ++mt) { const bf16x8_t af = *(const PG8_LAS bf16x8_t*)(xcb + (mt * 16 + fr) * 136 + ks * 32 + 8 * q);
                    aa[mt] = __builtin_amdgcn_mfma_f32_16x16x32_bf16(af, bw[dir][0][ks], aa[mt], 0, 0, 0);
                    ax[mt] = __builtin_amdgcn_mfma_f32_16x16x32_bf16(af, bw[dir][1][ks], ax[mt], 0, 0, 0); }
            float Ac = 1.f, Bc = FINAL ? hin[dir * 128 + jch] : 0.f;
#pragma unroll
            for (int mm = 0; mm < 4; ++mm) { const int mt = dir == 0 ? mm : 3 - mm;
                float ca[4], cb2[4];
#pragma unroll
                for (int ip = 0; ip < 2; ++ip) { const int i0 = 2 * ip;
                    const f32x2_t xv = (f32x2_t){xcf[(mt * 16 + 4 * q + i0) * XROW + jch], xcf[(mt * 16 + 4 * q + i0 + 1) * XROW + jch]};
                    const f32x2_t ta = (f32x2_t){aa[mt][i0], aa[mt][i0 + 1]} * (f32x2_t){-L2E, -L2E} + (f32x2_t){ba[dir], ba[dir]};
                    const f32x2_t tx = (f32x2_t){ax[mt][i0], ax[mt][i0 + 1]} * (f32x2_t){-L2E, -L2E} + (f32x2_t){bx[dir], bx[dir]};
                    const f32x2_t da = (f32x2_t){__builtin_amdgcn_exp2f(ta.x), __builtin_amdgcn_exp2f(ta.y)} + (f32x2_t){1.0f, 1.0f};
                    const f32x2_t dx = (f32x2_t){__builtin_amdgcn_exp2f(tx.x), __builtin_amdgcn_exp2f(tx.y)} + (f32x2_t){1.0f, 1.0f};
                    const f32x2_t rg2 = (f32x2_t){__builtin_amdgcn_rcpf(da.x), __builtin_amdgcn_rcpf(da.y)}, ig2 = (f32x2_t){__builtin_amdgcn_rcpf(dx.x), __builtin_amdgcn_rcpf(dx.y)};
                    const f32x2_t l2 = rg2 * (f32x2_t){sp[dir], sp[dir]};
                    const f32x2_t a2 = (f32x2_t){__builtin_amdgcn_exp2f(l2.x), __builtin_amdgcn_exp2f(l2.y)};
                    const f32x2_t om = (f32x2_t){1.0f, 1.0f} - a2 * a2;
                    const f32x2_t sq = (f32x2_t){__builtin_amdgcn_sqrtf(fmaxf(om.x, 0.f)), __builtin_amdgcn_sqrtf(fmaxf(om.y, 0.f))};
                    const f32x2_t cb = sq * (ig2 * xv);
                    ca[i0] = a2.x; ca[i0 + 1] = a2.y; cb2[i0] = cb.x; cb2[i0 + 1] = cb.y; }
                float Al = 1.f, Bl = 0.f;
#pragma unroll
                for (int ii = 0; ii < 4; ++ii) { const int i = dir == 0 ? ii : 3 - ii; Al = ca[i] * Al; Bl = ca[i] * Bl + cb2[i]; }
                float hq = Bc;
#pragma unroll
                for (int qq = 0; qq < 4; ++qq) { const int qs = dir == 0 ? qq : 3 - qq;
                    const float Aq = bperm_f(Al, fr + 16 * qs), Bq = bperm_f(Bl, fr + 16 * qs);
                    const bool before = dir == 0 ? (qs < q) : (qs > q);
                    if (FINAL) hq = before ? Aq * hq + Bq : hq;
                    Ac = Aq * Ac; Bc = Aq * Bc + Bq; }
                if (FINAL) {
                    float h = hq;
#pragma unroll
                    for (int ii = 0; ii < 4; ++ii) { const int i = dir == 0 ? ii : 3 - ii; h = ca[i] * h + cb2[i];
                        PG8_LAS float* hp = hs + (mt * 16 + 4 * q + i) * XROW + jch; if (dir == 0) *hp = h; else *hp += h; }
                }
            }
            if (!FINAL && q == 0) { const size_t si = ((size_t)(dir * NB + b) * NCH + c) * W2 + chg; P.sumA[si] = Ac; P.sumB[si] = Bc; }
        }
        __syncthreads();
        if (FINAL) {
            const int r = row0 + tg * 8;
#pragma unroll
            for (int i = 0; i < 8; ++i) { const f32x2_t hv = *(const PG8_LAS f32x2_t*)(hs + (tg * 8 + i) * XROW + 2 * cp); const unsigned gw = *(const PG8_LAS unsigned*)(gbs + (tg * 8 + i) * 128 + 2 * cp);
                const f32x2_t gx = (f32x2_t){__uint_as_float(gw << 16), __uint_as_float(gw & 0xffff0000u)};
                const f32x2_t ag = gx * (gx * gx * (f32x2_t){0.044715f, 0.044715f} + (f32x2_t){1.0f, 1.0f}) * (f32x2_t){-2.0f * 1.4426950408889634f * 0.7978845608028654f, -2.0f * 1.4426950408889634f * 0.7978845608028654f};
                const f32x2_t dg = (f32x2_t){__builtin_amdgcn_exp2f(ag.x), __builtin_amdgcn_exp2f(ag.y)} + (f32x2_t){1.0f, 1.0f};
                const f32x2_t yv = hv * gx * (f32x2_t){__builtin_amdgcn_rcpf(dg.x), __builtin_amdgcn_rcpf(dg.y)};
                *(unsigned*)(P.m + (size_t)(r + i) * D + hh * HD + 2 * cp) = pk_bf16(yv.x, yv.y); }
            __syncthreads();
        }
    }
}
__device__ __forceinline__ void fs_sgstat(const Params& P, int lane, int wid, int nw);
__device__ __forceinline__ void fs_odd2(const Params& P, int t) {
    if (t >= 64) { fs_sgstat(P, t & 63, (t >> 6) - 1, 7); return; }
    if (t >= 32) return;
    static_assert(NCH % 17 == 0, "chunk steps are taken 17 at a time");
    for (int it = blockIdx.x * 32 + t; it < 2 * NB * W2; it += gridDim.x * 32) {
        const int ch = it % W2, b = (it / W2) % NB, dir = it / (W2 * NB);
        const size_t base = ((size_t)(dir * NB + b) * NCH) * W2 + ch;
        const float* __restrict__ sA = P.sumA + base; const float* __restrict__ sB = P.sumB + base; float* __restrict__ hb = P.hinb + base;
        float h = 0.f;
#pragma unroll 1
        for (int s0 = 0; s0 < NCH; s0 += 17) {
            float A[17], B[17];
#pragma unroll
            for (int j = 0; j < 17; ++j) { const int step = s0 + j, c = dir == 0 ? step : (step < NCHC ? NCHC - 1 - step : NCH - 1 - (step - NCHC)); A[j] = sA[(size_t)c * W2]; B[j] = sB[(size_t)c * W2]; }
#pragma unroll
            for (int j = 0; j < 17; ++j) { const int step = s0 + j, c = dir == 0 ? step : (step < NCHC ? NCHC - 1 - step : NCH - 1 - (step - NCHC)); hb[(size_t)c * W2] = h; h = A[j] * h + B[j]; }
        }
    }
}
__device__ __forceinline__ void fs_sgstat(const Params& P, int lane, int wid, int nw  ) {
    const int stride = gridDim.x * nw;
    for (int r0 = blockIdx.x * nw + wid; r0 < R; r0 += 4 * stride) {
        u32x4_t w[4];
#pragma unroll
        for (int j = 0; j < 4; ++j) { const int r = r0 + j * stride < R ? r0 + j * stride : r0; w[j] = *(const u32x4_t*)(P.z + (size_t)r * NZO + O_V + lane * 8); }
#pragma unroll
        for (int j = 0; j < 4; ++j) { const int r = r0 + j * stride;
            const unsigned ww[4] = {w[j].x, w[j].y, w[j].z, w[j].w};
            float g[8];
#pragma unroll
            for (int i = 0; i < 4; ++i) { g[2 * i] = fgelu(__uint_as_float(ww[i] << 16)); g[2 * i + 1] = fgelu(__uint_as_float(ww[i] & 0xffff0000u)); }
            float s = 0.f;
#pragma unroll
            for (int i = 0; i < 8; ++i) s += g[i];
            const float mean = wave_sum(s) * (1.0f / W2);
            float vs = 0.f;
#pragma unroll
            for (int i = 0; i < 8; ++i) { const float d = g[i] - mean; vs += d * d; }
            vs = wave_sum(vs);
            if (lane == 0 && r < R) { P.sgstat[2 * r] = mean; P.sgstat[2 * r + 1] = 1.0f / sqrtf(vs * (1.0f / W2) + EPS); } }
    }
}
__device__ __forceinline__ void fs_odd_sg(const Params& P, int l, PG8_LAS unsigned char* lds, int t) {
    const int lane = t & 63, w = t >> 6, q = lane >> 4, fr = lane & 15, li = l >> 1, g = blockIdx.x & 3;
    PG8_LAS bf16_t* vbT = (PG8_LAS bf16_t*)lds;
    bf16x8_t aw[4];
#pragma unroll
    for (int ks = 0; ks < 4; ++ks) aw[ks] = *(const bf16x8_t*)(P.sgw + ((size_t)((li * 4 + g) * SGC + 16 * w + fr)) * SGC + ks * 32 + 8 * q);
    float sgb[4];
#pragma unroll
    for (int ii = 0; ii < 4; ++ii) sgb[ii] = P.od_sg_b[(size_t)(li * 4 + g) * SGC + 16 * w + 4 * q + ii];
    const int cc = t & 127, jp = t >> 7; const float gn = P.od_sg_norm_g[(size_t)li * W2 + g * HD + cc];
    for (int u = (blockIdx.x + gridDim.x / 2) % gridDim.x; u < (R / SGC) * 4; u += gridDim.x) {
        const int base = (u >> 2) * SGC;
        { const bf16_t* zv = P.z + O_V + g * HD + cc;
            bf16_t vr[32]; f32x4_t sv[16];
#pragma unroll
            for (int jj = 0; jj < 16; ++jj) { const int r0 = base + (jp * 16 + jj) * 2;
                vr[2 * jj] = zv[(size_t)r0 * NZO]; vr[2 * jj + 1] = zv[(size_t)(r0 + 1) * NZO]; sv[jj] = *(const f32x4_t*)(P.sgstat + 2 * r0); }
#pragma unroll
            for (int jj = 0; jj < 16; ++jj) { const int j = (jp * 16 + jj) * 2;
                const float v0 = (fgelu(bf2f(vr[2 * jj])) - sv[jj][0]) * sv[jj][1] * gn;
                const float v1 = (fgelu(bf2f(vr[2 * jj + 1])) - sv[jj][2]) * sv[jj][3] * gn;
                *(PG8_LAS unsigned*)(vbT + cc * 136 + j) = pk_bf16(v0, v1); } }
        __syncthreads();
        bf16_t ur[32];
#pragma unroll
        for (int ct = 0; ct < 8; ++ct)
#pragma unroll
            for (int ii = 0; ii < 4; ++ii) ur[ct * 4 + ii] = P.z[(size_t)(base + 16 * w + 4 * q + ii) * NZO + O_U + g * HD + ct * 16 + fr];
        pg8::f32x4 acc[8];
#pragma unroll
        for (int ct = 0; ct < 8; ++ct) acc[ct] = (pg8::f32x4){0.f, 0.f, 0.f, 0.f};
#pragma unroll
        for (int ks = 0; ks < 4; ++ks)
#pragma unroll
            for (int ct = 0; ct < 8; ++ct) { const bf16x8_t bf = *(const PG8_LAS bf16x8_t*)(vbT + (ct * 16 + fr) * 136 + ks * 32 + 8 * q);
                acc[ct] = __builtin_amdgcn_mfma_f32_16x16x32_bf16(aw[ks], bf, acc[ct], 0, 0, 0); }
#pragma unroll
        for (int ct = 0; ct < 8; ++ct)
#pragma unroll
            for (int ii = 0; ii < 4; ++ii) { const int row = base + 16 * w + 4 * q + ii, c = g * HD + ct * 16 + fr;
                const float uu = bf2f(ur[ct * 4 + ii]);
                P.m[(size_t)row * D + W2 + c] = f2bf(fgelu(uu) * (acc[ct][ii] + sgb[ii])); }
        __syncthreads();
    }
}
constexpr int LRS_ROW = 40;
constexpr int LAT_ROW = 68;
struct GlaUp { bf16x8_t b[4]; float bias[4]; };
__device__ __forceinline__ void gla_load_up(const Params& P, int li, int hh, int t, GlaUp& g) {
    const int lane = t & 63, w = t >> 6, q = lane >> 4, fr = lane & 15, dir = w >> 2;
    unsigned keep = (q >> 1) == dir ? 0xffffffffu : 0u; asm volatile("" : "+v"(keep));
#pragma unroll
    for (int j = 0; j < 4; ++j) { const int dcol = hh * DK + j * 16 + fr; unsigned pk[4];
#pragma unroll
        for (int i2 = 0; i2 < 4; ++i2) { const int r0 = 8 * (q & 1) + 2 * i2;
            const float a = P.ev_decay_up[((size_t)(li * 2 + dir) * RANK + r0) * KEY + dcol], b2 = P.ev_decay_up[((size_t)(li * 2 + dir) * RANK + r0 + 1) * KEY + dcol];
            pk[i2] = pk_bf16(a, b2) & keep; }
        g.b[j] = __builtin_bit_cast(bf16x8_t, (u32x4_t){pk[0], pk[1], pk[2], pk[3]});
        g.bias[j] = P.ev_decay_b[(size_t)(li * 2 + dir) * KEY + dcol]; }
}
__device__ __forceinline__ void gla_preact(const PG8_LAS bf16_t* lrs, const GlaUp& g, PG8_LAS float* laT, int t) {
    const int lane = t & 63, w = t >> 6, q = lane >> 4, fr = lane & 15, mt = w & 3, dir = w >> 2;
    const bf16x8_t af = *(const PG8_LAS bf16x8_t*)(lrs + (mt * 16 + fr) * LRS_ROW + 8 * q);
#pragma unroll
    for (int j = 0; j < 4; ++j) { const pg8::f32x4 acc = __builtin_amdgcn_mfma_f32_16x16x32_bf16(af, g.b[j], (pg8::f32x4){0.f, 0.f, 0.f, 0.f}, 0, 0, 0);
        f32x4_t la;
#pragma unroll
        for (int ii = 0; ii < 4; ++ii) { const float x = acc[ii] + g.bias[j]; la[ii] = (fminf(x, 0.f) - __logf(1.0f + __expf(-fabsf(x)))) * (1.0f / 16.0f); }
        *(PG8_LAS f32x4_t*)(laT + ((dir * 4 + j) * 16 + fr) * LAT_ROW + mt * 16 + 4 * q) = la; }
}
__device__ __forceinline__ void gla_local_cumsum(const PG8_LAS float* laT, int d, int tok_first, float (&csf)[8], float (&csb)[8]) {
    const f32x4_t a0 = *(const PG8_LAS f32x4_t*)(laT + d * LAT_ROW + tok_first), a1 = *(const PG8_LAS f32x4_t*)(laT + d * LAT_ROW + tok_first + 4);
    const f32x4_t b0 = *(const PG8_LAS f32x4_t*)(laT + (64 + d) * LAT_ROW + tok_first), b1 = *(const PG8_LAS f32x4_t*)(laT + (64 + d) * LAT_ROW + tok_first + 4);
#pragma unroll
    for (int i = 0; i < 4; ++i) { csf[i] = a0[i]; csf[4 + i] = a1[i]; csb[i] = b0[i]; csb[4 + i] = b1[i]; }
#pragma unroll
    for (int i = 1; i < 8; ++i) csf[i] += csf[i - 1];
#pragma unroll
    for (int i = 6; i >= 0; --i) csb[i] += csb[i + 1];
}
__device__ __forceinline__ unsigned st8_pack4(float a, float b, float c, float d) {
    return pg8::pack4_fp8(__builtin_amdgcn_fmed3f(a, -448.f, 448.f), __builtin_amdgcn_fmed3f(b, -448.f, 448.f), __builtin_amdgcn_fmed3f(c, -448.f, 448.f), __builtin_amdgcn_fmed3f(d, -448.f, 448.f)); }
__device__ __forceinline__ u32x4_t st8_to_bf16x8(u32x2_t w) {
    return (u32x4_t){pk_bf16(__builtin_amdgcn_cvt_f32_fp8((int)w.x, 0), __builtin_amdgcn_cvt_f32_fp8((int)w.x, 1)), pk_bf16(__builtin_amdgcn_cvt_f32_fp8((int)w.x, 2), __builtin_amdgcn_cvt_f32_fp8((int)w.x, 3)),
                      pk_bf16(__builtin_amdgcn_cvt_f32_fp8((int)w.y, 0), __builtin_amdgcn_cvt_f32_fp8((int)w.y, 1)), pk_bf16(__builtin_amdgcn_cvt_f32_fp8((int)w.y, 2), __builtin_amdgcn_cvt_f32_fp8((int)w.y, 3))}; }
struct GlaRegs { u32x2_t lr; bf16_t k[8], q[8], v[16], g[16]; u32x2_t s[2][2]; };
template <bool E3>
__device__ __forceinline__ void gla_load(const Params& P, int u, int hh, int t, GlaRegs& r) {
    const int rest = u >> 2, c = rest % NCH, b = rest / NCH, row0 = seqrow(b, c * CH);
    const int d = t & 63, sg = t >> 6, e = t & 127, jp = t >> 7;
    r.lr = *(const u32x2_t*)(P.z + (size_t)(row0 + (t >> 3)) * NZE + E_LRF + (t & 7) * 4);
#pragma unroll
    for (int i = 0; i < 8; ++i) { const bf16_t* zr = P.z + (size_t)(row0 + sg * 8 + i) * NZE + hh * DK + d; r.k[i] = zr[E_K]; if (E3) r.q[i] = zr[E_Q]; }
#pragma unroll
    for (int jj = 0; jj < 16; ++jj) r.v[jj] = P.z[(size_t)(row0 + jp * 16 + jj) * NZE + E_V + hh * DV + e];
    if (E3) {
        const int lane = t & 63, w = t >> 6, q = lane >> 4, fr = lane & 15, it = w & 3, wh = w >> 2;
#pragma unroll
        for (int ii = 0; ii < 4; ++ii)
#pragma unroll
            for (int el = 0; el < 4; ++el) r.g[ii * 4 + el] = P.z[(size_t)(row0 + it * 16 + 4 * q + ii) * NZE + E_G + hh * DV + (wh * 4 + el) * 16 + fr];
#pragma unroll
        for (int dir = 0; dir < 2; ++dir) { const unsigned char* Sb = (const unsigned char*)P.SinB + ((size_t)((dir * NB + b) * GH + hh) * NCH + c) * DV * DK;
#pragma unroll
            for (int i = 0; i < 2; ++i) r.s[dir][i] = *(const u32x2_t*)(Sb + (size_t)(t + 512 * i) * 8); }
    }
}
__device__ __forceinline__ void gla_store_common(const GlaRegs& r, PG8_LAS bf16_t* lrs, PG8_LAS bf16_t* vT, int t) {
    *(PG8_LAS u32x2_t*)(lrs + (t >> 3) * LRS_ROW + (t & 7) * 4) = r.lr;
    const int e = t & 127, jp = t >> 7;
#pragma unroll
    for (int jj = 0; jj < 16; jj += 2) *(PG8_LAS unsigned*)(vT + e * 72 + jp * 16 + jj) = (unsigned)r.v[jj] | ((unsigned)r.v[jj + 1] << 16);
}
constexpr int LRS1_ROW = 40;
struct GlaUp1 { bf16x8_t b; float bias[4]; };
__device__ __forceinline__ void gla_load_up1(const Params& P, int li, int hh, int t, GlaUp1& g) {
    const int lane = t & 63, w = t >> 6, q = lane >> 4, fr = lane & 15, dir = w >> 2, dt = w & 3;
    unsigned keep = (q >> 1) == dir ? 0xffffffffu : 0u; asm volatile("" : "+v"(keep));
    const int dcol = hh * DK + dt * 16 + fr; unsigned pk[4];
#pragma unroll
    for (int i2 = 0; i2 < 4; ++i2) { const int r0 = 8 * (q & 1) + 2 * i2;
        const float a = P.ev_decay_up[((size_t)(li * 2 + dir) * RANK + r0) * KEY + dcol], b2 = P.ev_decay_up[((size_t)(li * 2 + dir) * RANK + r0 + 1) * KEY + dcol];
        pk[i2] = pk_bf16(a, b2) & keep; }
    g.b = __builtin_bit_cast(bf16x8_t, (u32x4_t){pk[0], pk[1], pk[2], pk[3]});
#pragma unroll
    for (int ii = 0; ii < 4; ++ii) g.bias[ii] = P.ev_decay_b[(size_t)(li * 2 + dir) * KEY + hh * DK + dt * 16 + 4 * q + ii];
}
__device__ __forceinline__ void gla_decay_scan(const PG8_LAS bf16_t* lrs, const GlaUp1& g, int t, float (&bl)[4][4], float (&tot)[4]) {
    const int lane = t & 63, w = t >> 6, q = lane >> 4, fr = lane & 15, dir = w >> 2;
#pragma unroll
    for (int mt = 0; mt < 4; ++mt) { const bf16x8_t tf = *(const PG8_LAS bf16x8_t*)(lrs + (mt * 16 + fr) * LRS1_ROW + 8 * q);
        const pg8::f32x4 acc = __builtin_amdgcn_mfma_f32_16x16x32_bf16(g.b, tf, (pg8::f32x4){0.f, 0.f, 0.f, 0.f}, 0, 0, 0);
#pragma unroll
        for (int ii = 0; ii < 4; ++ii) { const float x = acc[ii] + g.bias[ii]; bl[mt][ii] = (fminf(x, 0.f) - __logf(1.0f + __expf(-fabsf(x)))) * (1.0f / 16.0f); } }
#pragma unroll
    for (int ii = 0; ii < 4; ++ii) tot[ii] = 0.f;
    if (dir == 0) {
#pragma unroll
        for (int mt = 0; mt < 4; ++mt)
#pragma unroll
            for (int ii = 0; ii < 4; ++ii) { float v = bl[mt][ii]; v = DPP_ADD(v, 0x111); v = DPP_ADD(v, 0x112); v = DPP_ADD(v, 0x114); v = DPP_ADD(v, 0x118);
                const float tt = bperm_f(v, lane | 15); bl[mt][ii] = v + tot[ii]; tot[ii] += tt; }
    } else {
#pragma unroll
        for (int mt = 3; mt >= 0; --mt)
#pragma unroll
            for (int ii = 0; ii < 4; ++ii) { float v = bl[mt][ii]; v = DPP_ADD(v, 0x101); v = DPP_ADD(v, 0x102); v = DPP_ADD(v, 0x104); v = DPP_ADD(v, 0x108);
                const float tt = bperm_f(v, lane & 48); bl[mt][ii] = v + tot[ii]; tot[ii] += tt; }
    }
}
struct GlaRegs1 { u32x2_t lr, k[4], q[4]; u32x4_t v[2]; u32x2_t s[2][2]; };
template <bool E3>
__device__ __forceinline__ void gla_load1(const Params& P, int u, int hh, int t, GlaRegs1& r) {
    const int rest = u >> 2, c = rest % NCH, b = rest / NCH, row0 = seqrow(b, c * CH);
    const int lane = t & 63, w = t >> 6, q = lane >> 4, fr = lane & 15, dt = w & 3;
    r.lr = *(const u32x2_t*)(P.z + (size_t)(row0 + (t >> 3)) * NZE + E_LRF + (t & 7) * 4);
#pragma unroll
    for (int mt = 0; mt < 4; ++mt) { const bf16_t* zr = P.z + (size_t)(row0 + mt * 16 + fr) * NZE + hh * DK + dt * 16 + 4 * q;
        r.k[mt] = *(const u32x2_t*)(zr + E_K); if (E3) r.q[mt] = *(const u32x2_t*)(zr + E_Q); }
#pragma unroll
    for (int i = 0; i < 2; ++i) { const int p = t + 512 * i, tok = p & 63, eg = p >> 6; r.v[i] = *(const u32x4_t*)(P.z + (size_t)(row0 + tok) * NZE + E_V + hh * DV + eg * 8); }
    if (E3) {
#pragma unroll
        for (int dir = 0; dir < 2; ++dir) { const unsigned char* Sb = (const unsigned char*)P.SinB + ((size_t)((dir * NB + b) * GH + hh) * NCH + c) * DV * DK;
#pragma unroll
            for (int i = 0; i < 2; ++i) r.s[dir][i] = *(const u32x2_t*)(Sb + (size_t)(t + 512 * i) * 8); }
    }
}
__device__ __forceinline__ void gla_store_common1(const GlaRegs1& r, PG8_LAS bf16_t* lrs, PG8_LAS bf16_t* vT, int t) {
    *(PG8_LAS u32x2_t*)(lrs + (t >> 3) * LRS1_ROW + (t & 7) * 4) = r.lr;
#pragma unroll
    for (int i = 0; i < 2; ++i) { const int p = t + 512 * i, tok = p & 63, eg = p >> 6; const unsigned wv[4] = {r.v[i].x, r.v[i].y, r.v[i].z, r.v[i].w};
#pragma unroll
        for (int j = 0; j < 4; ++j) { vT[(eg * 8 + 2 * j) * 72 + tok] = (bf16_t)(wv[j] & 0xffffu); vT[(eg * 8 + 2 * j + 1) * 72 + tok] = (bf16_t)(wv[j] >> 16); } }
}
__device__ __forceinline__ void fs_even1(const Params& P, int l, PG8_LAS unsigned char* lds, int t) {
    const int lane = t & 63, w = t >> 6, q = lane >> 4, fr = lane & 15, li = l >> 1, hh = blockIdx.x & 3, wdir = w >> 2, dt = w & 3;
    PG8_LAS bf16_t* vT = (PG8_LAS bf16_t*)lds;
    PG8_LAS bf16_t* kdT = (PG8_LAS bf16_t*)(lds + 18432);
    PG8_LAS bf16_t* lrs = (PG8_LAS bf16_t*)(lds + 18432 + 18432);
    PG8_LAS bf16_t* sst = (PG8_LAS bf16_t*)(lds + 18432 + 18432 + 5120);
    GlaUp1 gu; gla_load_up1(P, li, hh, t, gu);
    constexpr int NU = NB * NCH * 4;
    GlaRegs1 rg; if ((int)blockIdx.x < NU) gla_load1<false>(P, blockIdx.x, hh, t, rg);
    for (int u = blockIdx.x; u < NU; u += gridDim.x) {
        const int rest = u >> 2, c = rest % NCH, b = rest / NCH;
        gla_store_common1(rg, lrs, vT, t);
        u32x2_t kraw[4];
#pragma unroll
        for (int mt = 0; mt < 4; ++mt) kraw[mt] = rg.k[mt];
        __syncthreads();
        if (u + (int)gridDim.x < NU) gla_load1<false>(P, u + gridDim.x, hh, t, rg);
        {
            float bl[4][4], tot[4];
            gla_decay_scan(lrs, gu, t, bl, tot);
#pragma unroll
            for (int mt = 0; mt < 4; ++mt) { const unsigned kw[2] = {kraw[mt].x, kraw[mt].y};
#pragma unroll
                for (int ii = 0; ii < 4; ++ii) { const float kk = (ii & 1) ? __uint_as_float(kw[ii >> 1] & 0xffff0000u) : __uint_as_float(kw[ii >> 1] << 16);
                    kdT[wdir * 64 * 72 + (dt * 16 + 4 * q + ii) * 72 + mt * 16 + fr] = (bf16_t)pk_bf16(kk * __expf(tot[ii] - bl[mt][ii]), 0.f); } }
            if (fr == 0) { float* dv = P.decv + ((size_t)((wdir * NB + b) * GH + hh) * NCH + c) * DK + dt * 16 + 4 * q;
                *(f32x4_t*)dv = (f32x4_t){__expf(tot[0]), __expf(tot[1]), __expf(tot[2]), __expf(tot[3])}; }
        }
        __syncthreads();
#pragma unroll
        for (int dir = 0; dir < 2; ++dir) {
            pg8::f32x4 acc[4];
#pragma unroll
            for (int dt2 = 0; dt2 < 4; ++dt2) acc[dt2] = (pg8::f32x4){0.f, 0.f, 0.f, 0.f};
#pragma unroll
            for (int ks = 0; ks < 2; ++ks) { const bf16x8_t af = *(const PG8_LAS bf16x8_t*)(vT + (16 * w + fr) * 72 + ks * 32 + 8 * q);
#pragma unroll
                for (int dt2 = 0; dt2 < 4; ++dt2) { const bf16x8_t bfr = *(const PG8_LAS bf16x8_t*)(kdT + dir * 64 * 72 + (dt2 * 16 + fr) * 72 + ks * 32 + 8 * q);
                    acc[dt2] = __builtin_amdgcn_mfma_f32_16x16x32_bf16(af, bfr, acc[dt2], 0, 0, 0); } }
#pragma unroll
            for (int dt2 = 0; dt2 < 4; ++dt2)
#pragma unroll
                for (int ii = 0; ii < 4; ++ii) sst[dir * 128 * 72 + (16 * w + 4 * q + ii) * 72 + dt2 * 16 + fr] = (bf16_t)pk_bf16(acc[dt2][ii], 0.f);
        }
        __syncthreads();
#pragma unroll
        for (int dir = 0; dir < 2; ++dir) { unsigned char* Sb = (unsigned char*)P.Sd + ((size_t)((dir * NB + b) * GH + hh) * NCH + c) * DV * DK;
#pragma unroll
            for (int i = 0; i < 2; ++i) { const int f = t + 512 * i, e = f >> 3, d8 = (f & 7) * 8; const u32x4_t w = *(const PG8_LAS u32x4_t*)(sst + dir * 128 * 72 + e * 72 + d8);
                *(u32x2_t*)(Sb + (size_t)f * 8) = (u32x2_t){st8_pack4(__uint_as_float(w.x << 16), __uint_as_float(w.x & 0xffff0000u), __uint_as_float(w.y << 16), __uint_as_float(w.y & 0xffff0000u)),
                                                              st8_pack4(__uint_as_float(w.z << 16), __uint_as_float(w.z & 0xffff0000u), __uint_as_float(w.w << 16), __uint_as_float(w.w & 0xffff0000u))}; } }
        __syncthreads();
    }
}
__device__ __forceinline__ void fs_even2(const Params& P, int t) {
    for (int it = blockIdx.x * 512 + t; it < 2 * NB * GH * DV * (DK / 4); it += gridDim.x * 512) {
        const int d4 = it % (DK / 4), e = (it / (DK / 4)) % DV, hh = (it / (DK / 4 * DV)) % GH, b = (it / (DK / 4 * DV * GH)) % NB, dir = it / (DK / 4 * DV * GH * NB);
        const size_t cb0 = ((size_t)((dir * NB + b) * GH + hh) * NCH) * DV * DK + (size_t)e * DK + d4 * 4;
        const unsigned char* __restrict__ Sb = (const unsigned char*)P.Sd + cb0; unsigned char* __restrict__ So = (unsigned char*)P.SinB + cb0;
        const float* __restrict__ dv = P.decv + ((size_t)((dir * NB + b) * GH + hh) * NCH) * DK + d4 * 4;
        f32x4_t s = (f32x4_t){0.f, 0.f, 0.f, 0.f};
        static_assert(NCH % 4 == 0, "chunk steps are taken four at a time");
        auto chunk_of = [&](int step) { return dir == 0 ? step : (step < NCHC ? NCHC - 1 - step : NCH - 1 - (step - NCHC)); };
        unsigned tw[4], tn[4]; f32x4_t dc[4], dn[4];
#pragma unroll
        for (int j = 0; j < 4; ++j) { const int c = chunk_of(j); tw[j] = *(const unsigned*)(Sb + (size_t)c * DV * DK); dc[j] = *(const f32x4_t*)(dv + (size_t)c * DK); }
#pragma unroll 1
        for (int s0 = 0; s0 < NCH; s0 += 4) {
            if (s0 + 4 < NCH) {
#pragma unroll
                for (int j = 0; j < 4; ++j) { const int c = chunk_of(s0 + 4 + j); tn[j] = *(const unsigned*)(Sb + (size_t)c * DV * DK); dn[j] = *(const f32x4_t*)(dv + (size_t)c * DK); } }
#pragma unroll
            for (int j = 0; j < 4; ++j) { const int c = chunk_of(s0 + j);
                const f32x4_t tmp = (f32x4_t){__builtin_amdgcn_cvt_f32_fp8((int)tw[j], 0), __builtin_amdgcn_cvt_f32_fp8((int)tw[j], 1), __builtin_amdgcn_cvt_f32_fp8((int)tw[j], 2), __builtin_amdgcn_cvt_f32_fp8((int)tw[j], 3)};
                *(unsigned*)(So + (size_t)c * DV * DK) = st8_pack4(s[0], s[1], s[2], s[3]); s = dc[j] * s + tmp; }
#pragma unroll
            for (int j = 0; j < 4; ++j) { tw[j] = tn[j]; dc[j] = dn[j]; }
        }
    }
}
__device__ __forceinline__ void fs_even3(const Params& P, int l, PG8_LAS unsigned char* lds, int t) {
    const int lane = t & 63, w = t >> 6, q = lane >> 4, fr = lane & 15, li = l >> 1, hh = blockIdx.x & 3, d = t & 63, sg = t >> 6;
    PG8_LAS bf16_t* vT = (PG8_LAS bf16_t*)lds;
    PG8_LAS bf16_t* qd = (PG8_LAS bf16_t*)(lds + 18432);
    PG8_LAS bf16_t* kd = (PG8_LAS bf16_t*)(lds + 18432 + 18432);
    PG8_LAS bf16_t* sT = (PG8_LAS bf16_t*)(lds + 18432 * 3);
    PG8_LAS bf16_t* att = (PG8_LAS bf16_t*)(lds + 18432 * 5);
    PG8_LAS float* tot = (PG8_LAS float*)(lds + 18432 * 6);
    PG8_LAS float* ssq = tot + 1024;
    PG8_LAS bf16_t* lrs = (PG8_LAS bf16_t*)(lds + 18432 * 6 + 4096 + 512);
    GlaUp1 gu; gla_load_up1(P, li, hh, t, gu);
    const int it = w & 3, wh = w >> 2;
    float ng[4];
#pragma unroll
    for (int el = 0; el < 4; ++el) ng[el] = P.ev_norm_g[(size_t)li * W2 + hh * DV + (wh * 4 + el) * 16 + fr];
    constexpr int NU = NB * NCH * 4;
    GlaRegs1 rg; if ((int)blockIdx.x < NU) gla_load1<true>(P, blockIdx.x, hh, t, rg);
    for (int u = blockIdx.x; u < NU; u += gridDim.x) {
        const int rest = u >> 2, c = rest % NCH, b = rest / NCH, row0 = seqrow(b, c * CH);
        gla_store_common1(rg, lrs, vT, t);
#pragma unroll
        for (int dir = 0; dir < 2; ++dir)
#pragma unroll
            for (int i = 0; i < 2; ++i) { const int f = t + 512 * i, e = f >> 3, d8 = (f & 7) * 8; *(PG8_LAS u32x4_t*)(sT + dir * 128 * 72 + e * 72 + d8) = st8_to_bf16x8(rg.s[dir][i]); }
        u32x2_t kraw[4], qraw[4];
#pragma unroll
        for (int mt = 0; mt < 4; ++mt) { kraw[mt] = rg.k[mt]; qraw[mt] = rg.q[mt]; }
        __syncthreads();
        bf16_t graw[16];
#pragma unroll
        for (int ii = 0; ii < 4; ++ii)
#pragma unroll
            for (int el = 0; el < 4; ++el) graw[ii * 4 + el] = P.z[(size_t)(row0 + it * 16 + 4 * q + ii) * NZE + E_G + hh * DV + (wh * 4 + el) * 16 + fr];
        if (u + (int)gridDim.x < NU) gla_load1<true>(P, u + gridDim.x, hh, t, rg);
        {
            float bl[4][4], tot[4];
            gla_decay_scan(lrs, gu, t, bl, tot);
#pragma unroll
            for (int mt = 0; mt < 4; ++mt) { const unsigned kw[2] = {kraw[mt].x, kraw[mt].y}, qw[2] = {qraw[mt].x, qraw[mt].y}; float qv[4], kv[4];
#pragma unroll
                for (int ii = 0; ii < 4; ++ii) { const float kk = (ii & 1) ? __uint_as_float(kw[ii >> 1] & 0xffff0000u) : __uint_as_float(kw[ii >> 1] << 16);
                    const float qq = ((ii & 1) ? __uint_as_float(qw[ii >> 1] & 0xffff0000u) : __uint_as_float(qw[ii >> 1] << 16)) * 0.125f;
                    const float ef = __expf(bl[mt][ii]); qv[ii] = qq * ef; kv[ii] = kk * __builtin_amdgcn_rcpf(ef); }
                const int o = wh * 64 * 72 + (mt * 16 + fr) * 72 + it * 16 + 4 * q;
                *(PG8_LAS u32x2_t*)(qd + o) = (u32x2_t){pk_bf16(qv[0], qv[1]), pk_bf16(qv[2], qv[3])};
                *(PG8_LAS u32x2_t*)(kd + o) = (u32x2_t){pk_bf16(kv[0], kv[1]), pk_bf16(kv[2], kv[3])}; }
        }
        __syncthreads();
#pragma unroll
        for (int dir = 0; dir < 2; ++dir)
#pragma unroll
            for (int jl = 0; jl < 2; ++jl) { const int jt = wh * 2 + jl;
                pg8::f32x4 a4 = (pg8::f32x4){0.f, 0.f, 0.f, 0.f};
                if (dir == 0 ? (jt <= it) : (jt >= it)) {
#pragma unroll
                    for (int ks = 0; ks < 2; ++ks) { const bf16x8_t af = *(const PG8_LAS bf16x8_t*)(qd + dir * 64 * 72 + (it * 16 + fr) * 72 + ks * 32 + 8 * q);
                        const bf16x8_t bfr = *(const PG8_LAS bf16x8_t*)(kd + dir * 64 * 72 + (jt * 16 + fr) * 72 + ks * 32 + 8 * q);
                        a4 = __builtin_amdgcn_mfma_f32_16x16x32_bf16(af, bfr, a4, 0, 0, 0); } }
#pragma unroll
                for (int ii = 0; ii < 4; ++ii) { const int i = it * 16 + 4 * q + ii, j = jt * 16 + fr; const bool keep = dir == 0 ? (j <= i) : (j >= i);
                    att[dir * 64 * 72 + i * 72 + j] = (bf16_t)pk_bf16(keep ? a4[ii] : 0.f, 0.f); } }
        __syncthreads();
        pg8::f32x4 o[4];
#pragma unroll
        for (int el = 0; el < 4; ++el) o[el] = (pg8::f32x4){0.f, 0.f, 0.f, 0.f};
#pragma unroll
        for (int dir = 0; dir < 2; ++dir)
#pragma unroll
            for (int ks = 0; ks < 2; ++ks) { const bf16x8_t aa = *(const PG8_LAS bf16x8_t*)(att + dir * 64 * 72 + (it * 16 + fr) * 72 + ks * 32 + 8 * q);
                const bf16x8_t aq = *(const PG8_LAS bf16x8_t*)(qd + dir * 64 * 72 + (it * 16 + fr) * 72 + ks * 32 + 8 * q);
#pragma unroll
                for (int el = 0; el < 4; ++el) { const int et = wh * 4 + el;
                    const bf16x8_t bv = *(const PG8_LAS bf16x8_t*)(vT + (et * 16 + fr) * 72 + ks * 32 + 8 * q);
                    const bf16x8_t bs = *(const PG8_LAS bf16x8_t*)(sT + dir * 128 * 72 + (et * 16 + fr) * 72 + ks * 32 + 8 * q);
                    o[el] = __builtin_amdgcn_mfma_f32_16x16x32_bf16(aa, bv, o[el], 0, 0, 0);
                    o[el] = __builtin_amdgcn_mfma_f32_16x16x32_bf16(aq, bs, o[el], 0, 0, 0); } }
#pragma unroll
        for (int ii = 0; ii < 4; ++ii) { float s = 0.f;
#pragma unroll
            for (int el = 0; el < 4; ++el) s += o[el][ii] * o[el][ii];
            s = row16_sum(s);
            if (fr == 0) ssq[wh * 64 + it * 16 + 4 * q + ii] = s; }
        __syncthreads();
#pragma unroll
        for (int ii = 0; ii < 4; ++ii) { const int i = it * 16 + 4 * q + ii; const float rinv = 1.0f / sqrtf((ssq[i] + ssq[64 + i]) * (1.0f / DV) + EPS);
            const size_t row = (size_t)(row0 + i);
#pragma unroll
            for (int el = 0; el < 4; ++el) { const int e = hh * DV + (wh * 4 + el) * 16 + fr; const float gg = bf2f(graw[ii * 4 + el]);
                P.m[row * D + W2 + e] = (bf16_t)pk_bf16(o[el][ii] * rinv * ng[el] * fsilu(gg), 0.f); } }
    }
}
__device__ __forceinline__ void fs_even_conv(const Params& P, int l, int t) {
    const int li = l >> 1;
    for (int it = (int)((blockIdx.x + gridDim.x / 2) % gridDim.x) * 512 + t; it < (R / 4) * (W2 / 8); it += gridDim.x * 512) {
        const int rowb = (it / (W2 / 8)) * 4, c8 = (it % (W2 / 8)) * 8;
        bool lv, rv;
        if (rowb < RL) { const int pos = (rowb % T) % GRIDW; lv = pos > 0; rv = pos + 3 < GRIDW - 1; } else { const int tt = (rowb - RL) % TC; lv = tt > 0; rv = tt + 3 < TC - 1; }
        const bf16_t* zr = P.z + (size_t)rowb * NZE + c8;
        u32x4_t cg[6], xa[6], bg[4];
#pragma unroll
        for (int i = 0; i < 6; ++i) { const int dr = (i == 0 && !lv) ? 0 : (i == 5 && !rv) ? 3 : i - 1;
            cg[i] = *(const u32x4_t*)(zr + (ptrdiff_t)dr * NZE + E_CG); xa[i] = *(const u32x4_t*)(zr + (ptrdiff_t)dr * NZE + E_XA); }
#pragma unroll
        for (int i = 0; i < 4; ++i) bg[i] = *(const u32x4_t*)(zr + (size_t)i * NZE + E_BG);
        const float* cw = P.ev_conv_w + (size_t)li * 3 * W2 + c8; const float* cb = P.ev_conv_b + (size_t)li * W2 + c8;
        float w0[8], w1[8], w2[8], bb[8];
#pragma unroll
        for (int cc = 0; cc < 8; ++cc) { w0[cc] = cw[cc]; w1[cc] = cw[W2 + cc]; w2[cc] = cw[2 * W2 + cc]; bb[cc] = cb[cc]; }
        float p[6][8];
#pragma unroll
        for (int i = 0; i < 6; ++i) { const bool ok = (i == 0) ? lv : (i == 5) ? rv : true;
            const unsigned cv_[4] = {cg[i].x, cg[i].y, cg[i].z, cg[i].w}, xv_[4] = {xa[i].x, xa[i].y, xa[i].z, xa[i].w};
#pragma unroll
            for (int pp = 0; pp < 4; ++pp) { p[i][2 * pp] = ok ? __uint_as_float(cv_[pp] << 16) * __uint_as_float(xv_[pp] << 16) : 0.f;
                p[i][2 * pp + 1] = ok ? __uint_as_float(cv_[pp] & 0xffff0000u) * __uint_as_float(xv_[pp] & 0xffff0000u) : 0.f; } }
#pragma unroll
        for (int i = 0; i < 4; ++i) { const unsigned bv_[4] = {bg[i].x, bg[i].y, bg[i].z, bg[i].w}; float o[8];
#pragma unroll
            for (int cc = 0; cc < 8; ++cc) { const float bgf = (cc & 1) ? __uint_as_float(bv_[cc >> 1] & 0xffff0000u) : __uint_as_float(bv_[cc >> 1] << 16);
                o[cc] = bgf * (bb[cc] + w0[cc] * p[i][cc] + w1[cc] * p[i + 1][cc] + w2[cc] * p[i + 2][cc]); }
            u32x4_t ow; ow.x = pk_bf16(o[0], o[1]); ow.y = pk_bf16(o[2], o[3]); ow.z = pk_bf16(o[4], o[5]); ow.w = pk_bf16(o[6], o[7]);
            *(u32x4_t*)(P.m + (size_t)(rowb + i) * D + c8) = ow; }
    }
}
#endif

#ifdef CPU_EMU
#define GEMM_CALL(PAIR, A, Bt, G, Mg, N, K, epi) gemm_stage<PAIR>(A, Bt, G, Mg, N, K, epi)
DEV void do_stage(const Params& P, int l, int st) {
    const int tid_ = threadIdx.x;
#else
__device__ __forceinline__ void do_stage(const Params& P, int l, int st, PG8_LAS unsigned char* lds, int tid_in) {
#endif
#ifndef CPU_EMU
    int tid_ = tid_in; asm volatile("" : "+v"(tid_));
    if (st == ST_SILU) return;
    if (st == ST_MOD) { fs_mod(P, lds, tid_); __syncthreads(); fs_wconv(P, lds, tid_); return; }
    if (st == ST_ROW_MIX) { fs_row<0>(P, l, lds, tid_); return; }
    if (st == ST_ROW_FFN) { fs_row_ffn(P, l, lds, tid_); return; }
    if (st == ST_ROW_FINAL) { fs_row<2>(P, l, lds, tid_); return; }
    if (st == ST_SELECT_WCONV) { fs_select(P, l, lds, tid_); if (PROBE_SET == 14) { __syncthreads(); fs_select(P, l, lds, tid_); } fs_moe_wconv(P, l, lds, tid_, 1 << 30); return; }
    if (st == ST_GATHER2) { fs_gather(P, tid_); return; }
#define REP(kk, call) do { call; if (PROBE_SET == (kk)) { __syncthreads(); call; } } while (0)
    if (st == ST_EVEN1) { REP(6, fs_even1(P, l, lds, tid_)); return; }
    if (st == ST_EVEN2) { fs_even2(P, tid_); return; }
    if (st == ST_EVEN3) { fs_even3(P, l, lds, tid_); REP(8, fs_even_conv(P, l, tid_)); return; }
    if (st == ST_ODD1) { fs_odd_lru<false>(P, l, lds, tid_); return; }
    if (st == ST_ODD2) { fs_odd2(P, tid_); return; }
    if (st == ST_ODD3) {
        if (PROBE_SET == 70) { int nrep_; asm volatile("s_mov_b32 %0, 2" : "=s"(nrep_));
#pragma nounroll
            for (int rep_ = 0; rep_ < nrep_; ++rep_) { int tt_ = tid_; asm volatile("" : "+v"(tt_) :: "memory"); fs_odd_lru<true>(P, l, lds, tt_); __syncthreads(); } }
        else fs_odd_lru<true>(P, l, lds, tid_);
        REP(12, fs_odd_sg(P, l, lds, tid_)); return; }
#endif
    const int li = l >> 1;
    const bool even = (l & 1) == 0;
    const int ldz = even ? NZE : NZO;
    switch (st) {
    case ST_SILU: {
        GSL(i, (NB + 1) * D) { const int bb = (int)(i / D), k = (int)(i % D); const float v = bb < NB ? P.c[(size_t)bb * D + k] : P.c_ctx[k]; P.sbuf[i] = siluf_(v); }
    } break;
    case ST_MOD: {
        GSL(i, (long)DEPTH * (NB + 1) * MODW) {
            const int j = (int)(i % MODW), bb = (int)((i / MODW) % (NB + 1)), ll = (int)(i / ((long)MODW * (NB + 1)));
            float acc = P.ada_b[(size_t)ll * MODW + j];
            const float* w = P.ada_w + (size_t)ll * D * MODW + j; const float* s = P.sbuf + (size_t)bb * D;
            for (int k = 0; k < D; ++k) acc += s[k] * w[(size_t)k * MODW];
            P.mod[i] = acc;
        }
    } break;
    case ST_WCONV: {
        GSL(i, 2L * NZE * D) { const int q = (int)(i / ((long)NZE * D)), n = (int)((i / D) % NZE), k = (int)(i % D);
            P.wt_ev_in[i] = n < EV_IN ? f2bf(P.ev_w_in[((size_t)q * D + k) * EV_IN + n]) : (bf16_t)0; }
        GSL(i, 2L * NZO * D) { const int q = (int)(i / ((long)NZO * D)), n = (int)((i / D) % NZO), k = (int)(i % D);
            P.wt_od_in[i] = f2bf(P.od_w_in[((size_t)q * D + k) * NZO + n]); }
        GSL(i, 2L * D * D) { const int q = (int)(i / ((long)D * D)), n = (int)((i / D) % D), k = (int)(i % D);
            P.wt_ev_out[i] = f2bf(P.ev_w_out[((size_t)q * D + k) * D + n]);
            P.wt_od_out[i] = f2bf(P.od_w_out[((size_t)q * D + k) * D + n]); }
    } break;
    case ST_NORM_STATS_MIX: case ST_NORM_STATS_FFN: case ST_FINAL_STATS: {
        const int nrows = st == ST_FINAL_STATS ? RL : R;
        GSL(r, nrows) { const float* xr = st == ST_NORM_STATS_MIX ? xsrc_row(P, l, (int)r) : x_row(P, (int)r);
            float ss = 0.f; for (int j = 0; j < D; ++j) ss += xr[j] * xr[j];
            P.rinv[r] = rsq_(ss / D + EPS); }
    } break;
    case ST_NORM_APPLY_MIX: case ST_NORM_APPLY_FFN: {
        const bool mix = st == ST_NORM_APPLY_MIX;
        const float* g = (mix ? P.norm_mix_g : P.norm_ffn_g) + (size_t)l * D;
        GSL(i, (long)R * D) { const int r = (int)(i / D), j = (int)(i % D);
            const float* mr = modrow(P, l, row_bb(r));
            const float xv = mix ? xsrc_row(P, l, r)[j] : x_row(P, r)[j];
            const float hv = (xv * P.rinv[r] * g[j]) * (1.0f + mr[(mix ? 1 : 4) * D + j]) + mr[(mix ? 0 : 3) * D + j];
            P.h[i] = f2bf(hv); }
    } break;
    case ST_GEMM_IN: {
        const bf16_t* wt = even ? P.wt_ev_in + (size_t)li * NZE * D : P.wt_od_in + (size_t)li * NZO * D;
#ifdef CPU_EMU
        EpiZ_ e; e.z = P.z; e.ldz = ldz;
        GEMM_CALL(false, P.h, wt, 1, R, ldz, D, e);
#else
        pg8::Gemm g{P.h, wt, D}; pg8::StaticOrder S; S.init(R, ldz, (int)gridDim.x, (int)blockIdx.x);
        pg8::EpiZ8 e{P.z, ldz}; pg8::gemm_phase<false, false>(lds, g, S, e, tid_);
        fs_moe_wconv(P, l, lds, tid_, even ? WQ_QUOTA_IN_EVEN : WQ_QUOTA_IN_ODD);
#endif
    } break;
    case ST_E_LA: {
        GSL(i, 2L * NB * NCH * KEY) {
            const int col = (int)(i % KEY), c = (int)((i / KEY) % NCH), b = (int)((i / ((long)KEY * NCH)) % NB), dir = (int)(i / ((long)KEY * NCH * NB));
            const float* up = P.ev_decay_up + ((size_t)li * 2 + dir) * RANK * KEY;
            const float bias = P.ev_decay_b[((size_t)li * 2 + dir) * KEY + col];
            float acc = 0.f;
            for (int s = 0; s < CH; ++s) {
                const int sp = dir == 0 ? s : CH - 1 - s;
                const int row = seqrow(b, c * CH + sp);
                const bf16_t* lr = P.z + (size_t)row * ldz + (dir == 0 ? E_LRF : E_LRB);
                float xx = bias;
                for (int rr = 0; rr < RANK; ++rr) xx += bf2f(lr[rr]) * up[(size_t)rr * KEY + col];
                acc += logsigmoidf_(xx) * (1.0f / 16.0f);
                P.bcum[((size_t)dir * R + row) * KEY + col] = acc;
            }
        }
    } break;
    case ST_E_DS: {
        GSL(i, 2L * NB * GH * NCH * DK * DV) {
            const int e = (int)(i % DV), d = (int)((i / DV) % DK), c = (int)((i / ((long)DV * DK)) % NCH), hh = (int)((i / ((long)DV * DK * NCH)) % GH),
                      b = (int)((i / ((long)DV * DK * NCH * GH)) % NB), dir = (int)(i / ((long)DV * DK * NCH * GH * NB));
            const int rend = seqrow(b, c * CH + (dir == 0 ? CH - 1 : 0));
            const float bend = P.bcum[((size_t)dir * R + rend) * KEY + hh * DK + d];
            float acc = 0.f;
            for (int j = 0; j < CH; ++j) { const int row = seqrow(b, c * CH + j);
                const float kk = bf2f(P.z[(size_t)row * ldz + E_K + hh * DK + d]), vv = bf2f(P.z[(size_t)row * ldz + E_V + hh * DV + e]);
                acc += kk * expf(bend - P.bcum[((size_t)dir * R + row) * KEY + hh * DK + d]) * vv; }
            P.S[i] = acc;
        }
    } break;
    case ST_E_SCAN: {
        GSL(i, 2L * NB * GH * DK * DV) {
            const int e = (int)(i % DV), d = (int)((i / DV) % DK), hh = (int)((i / ((long)DV * DK)) % GH), b = (int)((i / ((long)DV * DK * GH)) % NB), dir = (int)(i / ((long)DV * DK * GH * NB));
            float s = 0.f;
            for (int step = 0; step < NCH; ++step) {
                const int c = dir == 0 ? step : (step < NCHC ? NCHC - 1 - step : NCH - 1 - (step - NCHC));
                const size_t idx = (((((size_t)dir * NB + b) * GH + hh) * NCH + c) * DK + d) * DV + e;
                const int rend = seqrow(b, c * CH + (dir == 0 ? CH - 1 : 0));
                const float dec = expf(P.bcum[((size_t)dir * R + rend) * KEY + hh * DK + d]);
                const float tmp = P.S[idx]; P.S[idx] = s; s = dec * s + tmp;
            }
        }
    } break;
    case ST_E_ATT: {
        const float scale = 1.0f / sqrtf((float)DK);
        GSL(i, 2L * NB * GH * NCH * CH * CH) {
            const int j = (int)(i % CH), ii = (int)((i / CH) % CH), c = (int)((i / ((long)CH * CH)) % NCH), hh = (int)((i / ((long)CH * CH * NCH)) % GH),
                      b = (int)((i / ((long)CH * CH * NCH * GH)) % NB), dir = (int)(i / ((long)CH * CH * NCH * GH * NB));
            float acc = 0.f;
            if (dir == 0 ? (j <= ii) : (j >= ii)) {
                const int ri = seqrow(b, c * CH + ii), rj = seqrow(b, c * CH + j);
                for (int d = 0; d < DK; ++d) {
                    const float qq = bf2f(P.z[(size_t)ri * ldz + E_Q + hh * DK + d]) * scale, kk = bf2f(P.z[(size_t)rj * ldz + E_K + hh * DK + d]);
                    acc += qq * kk * expf(P.bcum[((size_t)dir * R + ri) * KEY + hh * DK + d] - P.bcum[((size_t)dir * R + rj) * KEY + hh * DK + d]); }
            }
            P.att[i] = acc;
        }
    } break;
    case ST_E_O: {
        const float scale = 1.0f / sqrtf((float)DK);
        GSL(i, (long)NB * GH * NCH * CH * DV) {
            const int e = (int)(i % DV), ii = (int)((i / DV) % CH), c = (int)((i / ((long)DV * CH)) % NCH), hh = (int)((i / ((long)DV * CH * NCH)) % GH), b = (int)(i / ((long)DV * CH * NCH * GH));
            const int ri = seqrow(b, c * CH + ii);
            float acc = 0.f;
            for (int dir = 0; dir < 2; ++dir) {
                const size_t cb = ((((size_t)dir * NB + b) * GH + hh) * NCH + c);
                const float* at = P.att + (cb * CH + ii) * CH;
                for (int j = 0; j < CH; ++j) { const int rj = seqrow(b, c * CH + j); acc += at[j] * bf2f(P.z[(size_t)rj * ldz + E_V + hh * DV + e]); }
                const float* Sin = P.S + cb * DK * DV;
                for (int d = 0; d < DK; ++d) {
                    const float qq = bf2f(P.z[(size_t)ri * ldz + E_Q + hh * DK + d]) * scale;
                    acc += qq * expf(P.bcum[((size_t)dir * R + ri) * KEY + hh * DK + d]) * Sin[(size_t)d * DV + e]; }
            }
            P.o[(size_t)ri * W2 + hh * DV + e] = acc;
        }
    } break;
    case ST_E_READOUT: {
        const float* ng = P.ev_norm_g + (size_t)li * W2;
        GSL(i, (long)R * GH) { const int row = (int)(i / GH), hh = (int)(i % GH);
            const float* orow = P.o + (size_t)row * W2 + hh * DV;
            float ss = 0.f; for (int e = 0; e < DV; ++e) ss += orow[e] * orow[e];
            const float rinv = rsq_(ss / DV + EPS);
            for (int e = 0; e < DV; ++e) { const float g = bf2f(P.z[(size_t)row * ldz + E_G + hh * DV + e]);
                P.m[(size_t)row * D + W2 + hh * DV + e] = f2bf(orow[e] * rinv * ng[hh * DV + e] * siluf_(g)); }
        }
    } break;
    case ST_E_CONV: {
        const float* cw = P.ev_conv_w + (size_t)li * 3 * W2; const float* cb = P.ev_conv_b + (size_t)li * W2;
        GSL(i, (long)R * W2) { const int row = (int)(i / W2), col = (int)(i % W2);
            bool lv, rv;
            if (row < RL) { const int pos = (row % T) % GRIDW; lv = pos > 0; rv = pos < GRIDW - 1; }
            else { const int t = (row - RL) % TC; lv = t > 0; rv = t < TC - 1; }
            const bf16_t* zr = P.z + (size_t)row * ldz;
            float acc = cb[col] + cw[W2 + col] * (bf2f(zr[E_CG + col]) * bf2f(zr[E_XA + col]));
            if (lv) acc += cw[col] * (bf2f(zr[E_CG + col - ldz]) * bf2f(zr[E_XA + col - ldz]));
            if (rv) acc += cw[2 * W2 + col] * (bf2f(zr[E_CG + col + ldz]) * bf2f(zr[E_XA + col + ldz]));
            P.m[(size_t)row * D + col] = f2bf(bf2f(zr[E_BG + col]) * acc); }
    } break;
    case ST_O_XC: {
        const float* cw = P.od_conv_w + (size_t)li * 4 * W2; const float* cb = P.od_conv_b + (size_t)li * W2;
        GSL(i, (long)R * W2) { const int row = (int)(i / W2), col = (int)(i % W2);
            int t, len; if (row < RL) { t = row % T; len = T; } else { t = (row - RL) % TC; len = TC; }
            float acc = cb[col];
            for (int j = 0; j < 4; ++j) { const int tt = t - 2 + j; if (tt >= 0 && tt < len) acc += cw[j * W2 + col] * bf2f(P.z[(size_t)(row - 2 + j) * ldz + O_XB + col]); }
            P.xc[i] = acc; }
    } break;
    case ST_O_COEF: {
        GSL(i, 2L * R * W2) { const int col = (int)(i % W2), row = (int)((i / W2) % R), dir = (int)(i / ((long)W2 * R));
            const int hh = col / HD, jj = col % HD;
            const float* wa = P.od_gate_a_w + ((((size_t)li * 2 + dir) * 4 + hh) * HD) * HD + jj;
            const float* wx = P.od_gate_x_w + ((((size_t)li * 2 + dir) * 4 + hh) * HD) * HD + jj;
            const float* xr = P.xc + (size_t)row * W2 + hh * HD;
            float ra = P.od_gate_a_b[((size_t)li * 2 + dir) * W2 + col], rx = P.od_gate_x_b[((size_t)li * 2 + dir) * W2 + col];
            for (int k = 0; k < HD; ++k) { ra += xr[k] * wa[(size_t)k * HD]; rx += xr[k] * wx[(size_t)k * HD]; }
            const float rg = sigmoidf_(ra), ig = sigmoidf_(rx);
            const float log_a = -8.0f * rg * softplusf_(-P.od_lambda[((size_t)li * 2 + dir) * W2 + col]);
            P.A[i] = expf(log_a);
            P.Bc[i] = sqrtf(-expm1f(2.0f * log_a)) * (ig * P.xc[(size_t)row * W2 + col]); }
    } break;
    case ST_O_SCAN: {
        GSL(i, 2L * NB * W2) { const int col = (int)(i % W2), b = (int)((i / W2) % NB), dir = (int)(i / ((long)W2 * NB));
            float hc = 0.f;
            for (int step = 0; step < SEQ_ALL; ++step) {
                const int s = dir == 0 ? step : (step < TC ? TC - 1 - step : TC + (T - 1 - (step - TC)));
                const size_t idx = ((size_t)dir * R + seqrow(b, s)) * W2 + col;
                hc = P.A[idx] * hc + P.Bc[idx]; P.Bc[idx] = hc; }
        }
    } break;
    case ST_O_YREC: {
        GSL(i, (long)R * W2) { const int row = (int)(i / W2), col = (int)(i % W2);
            const float gb = bf2f(P.z[(size_t)row * ldz + O_GB + col]);
            P.m[(size_t)row * D + col] = f2bf((P.Bc[i] + P.Bc[(size_t)R * W2 + i]) * geluf_(gb)); }
    } break;
    case ST_O_SGSTAT: {
        GSL(r, R) { const bf16_t* vr = P.z + (size_t)r * ldz + O_V;
            float s = 0.f; for (int j = 0; j < W2; ++j) s += geluf_(bf2f(vr[j]));
            const float mean = s / W2; float vs = 0.f;
            for (int j = 0; j < W2; ++j) { const float dlt = geluf_(bf2f(vr[j])) - mean; vs += dlt * dlt; }
            P.sgstat[2 * r] = mean; P.sgstat[2 * r + 1] = rsq_(vs / W2 + EPS); }
    } break;
    case ST_O_VB: {
        const float* gn = P.od_sg_norm_g + (size_t)li * W2;
        GSL(i, (long)R * W2) { const int row = (int)(i / W2), col = (int)(i % W2);
            P.vb[i] = (geluf_(bf2f(P.z[(size_t)row * ldz + O_V + col])) - P.sgstat[2 * row]) * P.sgstat[2 * row + 1] * gn[col]; }
    } break;
    case ST_O_SGMIX: {
        GSL(i, (long)R * W2) { const int row = (int)(i / W2), col = (int)(i % W2);
            const int t = row < RL ? row % T : (row - RL) % TC;
            const int ii = t % SGC, base = row - ii, g = col / HD;
            const float* w = P.od_sg_w + (((size_t)li * 4 + g) * SGC + ii) * SGC;
            float acc = P.od_sg_b[((size_t)li * 4 + g) * SGC + ii];
            for (int j = 0; j < SGC; ++j) acc += w[j] * P.vb[(size_t)(base + j) * W2 + col];
            P.m[(size_t)row * D + W2 + col] = f2bf(geluf_(bf2f(P.z[(size_t)row * ldz + O_U + col])) * acc); }
    } break;
    case ST_GEMM_OUT: {
        const bf16_t* wt = (even ? P.wt_ev_out : P.wt_od_out) + (size_t)li * D * D;
#ifdef CPU_EMU
        EpiWout_ e; e.P = &P; e.l = l;
        GEMM_CALL(false, P.m, wt, 1, R, D, D, e);
#else
        pg8::Gemm g{P.m, wt, D}; pg8::StaticOrder S; S.init(l == DEPTH - 1 ? RL : R, D, (int)gridDim.x, (int)blockIdx.x);
        if (l == 0) { pg8::EpiWoutB<true> e{P.x, P.ctx, P.xb, P.mod + (size_t)l * (NB + 1) * MODW, P.ssqp}; pg8::gemm_phase<false, false>(lds, g, S, e, tid_); }
        else { pg8::EpiWoutB<false> e{nullptr, nullptr, P.xb, P.mod + (size_t)l * (NB + 1) * MODW, P.ssqp}; pg8::gemm_phase<false, false>(lds, g, S, e, tid_); }
        fs_moe_wconv(P, l, lds, tid_, (even ? WQ_QUOTA_IN_EVEN : WQ_QUOTA_IN_ODD) + WQ_QUOTA_OUT);
#endif
    } break;
    case ST_ROUTER_LOGIT: {
        const float* g = P.norm_ffn_g + (size_t)l * D; const float* wr = P.moe_router + (size_t)l * D * NE;
        GSL(i, (long)R * NE) { const int r = (int)(i / NE), e = (int)(i % NE);
            const float* mr = modrow(P, l, row_bb(r)); const float* xr = x_row(P, r); const float ri = P.rinv[r];
            float acc = 0.f;
            for (int j = 0; j < D; ++j) acc += ((xr[j] * ri * g[j]) * (1.0f + mr[4 * D + j]) + mr[3 * D + j]) * wr[(size_t)j * NE + e];
            P.logit[i] = acc; }
    } break;
    case ST_ROUTER_SOFTMAX: {
        GSL(r, R) { const float* lg = P.logit + (size_t)r * NE; float mx = lg[0]; for (int e = 1; e < NE; ++e) mx = fmaxf(mx, lg[e]);
            float s = 0.f;
            for (int e = 0; e < NE; ++e) s += expf(lg[e] - mx);
            for (int e = 0; e < NE; ++e) P.aff[(size_t)r * NE + e] = expf(lg[e] - mx) / s; }
    } break;
    case ST_MOE_WCONV: {
        const float* wg = P.moe_w_gate + (size_t)l * NE * D * D; const float* wu = P.moe_w_up + (size_t)l * NE * D * D; const float* wd = P.moe_w_down + (size_t)l * NE * D * D;
        GSL(i, (long)NE * 2 * D * D) { const int e = (int)(i / (2L * D * D)), cv = (int)((i / D) % (2 * D)), k = (int)(i % D);
            const int w = cv % 256, j = (cv / 256) * 128 + (w % 128);
            P.wt_gu[i] = f2bf((w >= 128 ? wu : wg)[((size_t)e * D + k) * D + j]); }
        GSL(i, (long)NE * D * D) { const int e = (int)(i / ((long)D * D)), n = (int)((i / D) % D), k = (int)(i % D);
            P.wt_dn[i] = f2bf(wd[((size_t)e * D + k) * D + n]); }
    } break;
    case ST_SELECT: {
        GSL(i, (long)R * NE) { const int e = (int)(i / R), r = (int)(i % R);
            int base, n, cap, slot0;
            if (r < RL) { const int b = r / T; base = b * T; n = T; cap = CAPL; slot0 = b * CAPL; }
            else { const int b = (r - RL) / TC; base = RL + b * TC; n = TC; cap = CAPC; slot0 = NB * CAPL + b * CAPC; }
            const float a = P.aff[(size_t)r * NE + e];
            int rank = 0;
            for (int t = 0; t < n; ++t) { const float o = P.aff[(size_t)(base + t) * NE + e]; rank += (o > a || (o == a && base + t < r)) ? 1 : 0; }
            if (rank < cap) { const int slot = e * SLOTS_E + slot0 + rank; P.sel_row[slot] = r; P.sel_g[slot] = a; P.inv[(size_t)r * NE + e] = slot; }
            else P.inv[(size_t)r * NE + e] = -1; }
    } break;
    case ST_GATHER: {
        GSL(i, (long)SLOTS * D) { const int slot = (int)(i / D), j = (int)(i % D); P.xg[i] = P.h[(size_t)P.sel_row[slot] * D + j]; }
    } break;
    case ST_GEMM_GU: {
#ifdef CPU_EMU
        EpiGU_ e; e.hid = P.hid;
        GEMM_CALL(true, P.xg, P.wt_gu, NE, SLOTS_E, 2 * D, D, e);
#else
        pg8::Gemm g{P.h, P.wt_gu, D}; pg8::GroupedOrder S; S.init(l == DEPTH - 1 ? NB * CAPL : SLOTS_E, SLOTS_E, 2 * D, NE, (int)gridDim.x, (int)blockIdx.x);
        PG8_LAS int* gix = (PG8_LAS int*)(lds + GEMM_LDS_BYTES + 16);
        for (int kk = tid_ >> 8; kk < GIX_UNITS; kk += 2) { pg8::Unit uu; if (S.next(kk, uu)) gix[kk * 256 + (tid_ & 255)] = P.sel_row[uu.pm * 256 + (tid_ & 255)]; }
        __syncthreads();
        pg8::EpiGU_F8 e{(unsigned char*)P.hid, 2 * D / 256}; pg8::gemm_phase<true, true>(lds, g, S, e, tid_, gix);
#endif
    } break;
    case ST_GEMM_DOWN: {
#ifdef CPU_EMU
        EpiDown_ e; e.out = P.outslot; e.selg = P.sel_g;
        GEMM_CALL(false, P.hid, P.wt_dn, NE, SLOTS_E, D, D, e);
#else
        pg8::Gemm g{P.hid, P.wt_dn, D}; pg8::GroupedOrder S; S.init(l == DEPTH - 1 ? NB * CAPL : SLOTS_E, SLOTS_E, D, NE, (int)gridDim.x, (int)blockIdx.x);
        pg8::EpiDown8 e{(unsigned char*)P.outslot, P.sel_g, D / 256, 1.0f / pg8::W8_SCALE}; pg8::gemm_phase<false, true>(lds, g, S, e, tid_);
#endif
    } break;
    case ST_COMBINE: {
        GSL(i, (long)R * D) { const int r = (int)(i / D), j = (int)(i % D);
            float s = 0.f;
            for (int e = 0; e < NE; ++e) { const int sl = P.inv[(size_t)r * NE + e]; if (sl >= 0) s += bf2f(P.outslot[(size_t)sl * D + j]); }
            float* xr = x_row(P, r); xr[j] += modrow(P, l, row_bb(r))[5 * D + j] * s; }
    } break;
    case ST_FINAL_APPLY: {
        GSL(i, (long)RL * D) { const int r = (int)(i / D), j = (int)(i % D); P.xlat[i] = P.xlat[i] * P.rinv[r] * P.norm_final_g[j]; }
    } break;
    default: break;
    }
}

template <class F> inline void stage_program(F&& run) {
    run(0, ST_SILU); run(0, ST_MOD); run(0, ST_WCONV);
    for (int l = 0; l < DEPTH; ++l) {
        run(l, ST_NORM_STATS_MIX); run(l, ST_NORM_APPLY_MIX); run(l, ST_GEMM_IN);
        if ((l & 1) == 0) { run(l, ST_E_LA); run(l, ST_E_DS); run(l, ST_E_SCAN); run(l, ST_E_ATT); run(l, ST_E_O); run(l, ST_E_READOUT); run(l, ST_E_CONV); }
        else { run(l, ST_O_XC); run(l, ST_O_COEF); run(l, ST_O_SCAN); run(l, ST_O_YREC); run(l, ST_O_SGSTAT); run(l, ST_O_VB); run(l, ST_O_SGMIX); }
        run(l, ST_GEMM_OUT);
        run(l, ST_NORM_STATS_FFN); run(l, ST_NORM_APPLY_FFN); run(l, ST_ROUTER_LOGIT); run(l, ST_ROUTER_SOFTMAX); run(l, ST_MOE_WCONV);
        run(l, ST_SELECT); run(l, ST_GATHER); run(l, ST_GEMM_GU); run(l, ST_GEMM_DOWN); run(l, ST_COMBINE);
    }
    run(0, ST_FINAL_STATS); run(0, ST_FINAL_APPLY);
}

struct KArgs { const float* in[32]; float* out; char* ws; };
#ifdef CPU_EMU
#define HD_ inline
#else
#define HD_ __host__ __device__ __forceinline__
#endif
struct Carver { char* base; size_t off; template <class Tp> HD_ Tp* take(size_t n) { off = (off + 255) & ~(size_t)255; Tp* p = (Tp*)(base + off); off += n * sizeof(Tp); return p; } };
HD_ size_t carve(Params& p, void* d_ws) {
    Carver cv{(char*)d_ws, 0};
    p.bar = cv.take<unsigned>(4096); p.wq = p.bar + 3584;
    p.mod = cv.take<float>((size_t)DEPTH * (NB + 1) * MODW); p.sbuf = cv.take<float>((size_t)(NB + 1) * D); p.xctx = cv.take<float>((size_t)RC * D);
    p.rinv = cv.take<float>(R); p.aff = cv.take<float>((size_t)R * NE); p.logit = cv.take<float>((size_t)R * NE); p.sel_g = cv.take<float>(SLOTS);
    p.sel_row = cv.take<int>(SLOTS); p.inv = cv.take<int>((size_t)R * NE);
    p.wt_ev_in = cv.take<bf16_t>(2ull * NZE * D); p.wt_od_in = cv.take<bf16_t>(2ull * NZO * D); p.wt_ev_out = cv.take<bf16_t>(2ull * D * D); p.wt_od_out = cv.take<bf16_t>(2ull * D * D);
    p.rw16 = cv.take<bf16_t>((size_t)DEPTH * 2 * NE * D); p.gwT = cv.take<bf16_t>(2ull * 2 * 2 * 4 * HD * HD); p.sgw = cv.take<bf16_t>(2ull * 4 * SGC * SGC); p.sumA = cv.take<float>(2ull * NB * NCH * W2); p.sumB = cv.take<float>(2ull * NB * NCH * W2); p.decv = cv.take<float>(2ull * NB * GH * NCH * DK); p.hinb = cv.take<float>(2ull * NB * NCH * W2); p.ssqp = cv.take<float>((size_t)R * 16);
    p.xb = cv.take<bf16_t>((size_t)R * D);
    p.wt_gu = cv.take<bf16_t>((size_t)NE * 2 * D * D); p.wt_dn = cv.take<bf16_t>((size_t)NE * D * D); p.h = cv.take<bf16_t>((size_t)R * D);
    const size_t u0 = (cv.off + 255) & ~(size_t)255;
    p.z = cv.take<bf16_t>((size_t)R * NZE); p.m = cv.take<bf16_t>((size_t)R * D);
    const size_t u1 = cv.off;
#ifdef CPU_EMU
    p.bcum = cv.take<float>(2ull * R * KEY); p.att = cv.take<float>(2ull * NB * GH * NCH * CH * CH); p.o = cv.take<float>((size_t)R * W2);
#endif
#ifdef CPU_EMU
    p.S = cv.take<float>(2ull * NB * GH * NCH * DK * DV);
#endif
    p.Sd = cv.take<bf16_t>(2ull * NB * GH * NCH * DK * DV); p.SinB = cv.take<bf16_t>(2ull * NB * GH * NCH * DK * DV);
    size_t end = cv.off;
    cv.off = u1;
    p.sgstat = cv.take<float>(2ull * R);
#ifdef CPU_EMU
    p.xc = cv.take<float>((size_t)R * W2); p.A = cv.take<float>(2ull * R * W2); p.Bc = cv.take<float>(2ull * R * W2); p.vb = cv.take<float>((size_t)R * W2);
#endif
    if (cv.off > end) end = cv.off;
    cv.off = u0;
    p.xg = cv.take<bf16_t>((size_t)SLOTS * D); p.hid = cv.take<bf16_t>((size_t)SLOTS * D); p.outslot = cv.take<bf16_t>((size_t)SLOTS * D);
    if (cv.off > end) end = cv.off;
    return end;
}
HD_ void fill_inputs(Params& p, const float* const* in, void* d_out) {
    p.x = in[0]; p.c = in[1]; p.ctx = in[2]; p.c_ctx = in[3]; p.ada_w = in[4]; p.ada_b = in[5]; p.norm_mix_g = in[6]; p.norm_ffn_g = in[7]; p.norm_final_g = in[8];
    p.ev_w_in = in[9]; p.ev_conv_w = in[10]; p.ev_conv_b = in[11]; p.ev_decay_up = in[12]; p.ev_decay_b = in[13]; p.ev_norm_g = in[14]; p.ev_w_out = in[15];
    p.od_w_in = in[16]; p.od_conv_w = in[17]; p.od_conv_b = in[18]; p.od_gate_a_w = in[19]; p.od_gate_a_b = in[20]; p.od_gate_x_w = in[21]; p.od_gate_x_b = in[22];
    p.od_lambda = in[23]; p.od_sg_norm_g = in[24]; p.od_sg_w = in[25]; p.od_sg_b = in[26]; p.od_w_out = in[27];
    p.moe_router = in[28]; p.moe_w_gate = in[29]; p.moe_w_up = in[30]; p.moe_w_down = in[31];
    p.xlat = (float*)d_out;
}

#ifndef CPU_EMU
#define XB_TMO      128
#define XB_XCNT(j)  (256  + 64 * (j))
#define XB_XSUB(j)  (1280 + 64 * (j))
#define XB_XGEN(j)  (2304 + 64 * (j))
#define XB_TOP      3328
#define XB_TOPGEN   3392
#define XCD_BAR_WORDS 3456
#define XB_SPIN_CAP (1u << 18)
#define LAS __attribute__((address_space(3)))

__device__ __forceinline__ unsigned xb_ld(unsigned* p)              { return __hip_atomic_load(p, __ATOMIC_RELAXED, __HIP_MEMORY_SCOPE_AGENT); }
__device__ __forceinline__ unsigned xb_add(unsigned* p, unsigned v) { return __hip_atomic_fetch_add(p, v, __ATOMIC_RELAXED, __HIP_MEMORY_SCOPE_AGENT); }
__device__ __forceinline__ unsigned xb_xcc_id() { return (unsigned)__builtin_amdgcn_s_getreg((3 << 11) | 20) & 0xFu; }
#define XB_SPIN(cond, bar) do { unsigned _sp = 0; while (cond) { __builtin_amdgcn_s_sleep(1); \
    if ((++_sp & 255u) == 0u) { if (xb_ld(&(bar)[XB_TMO])) break; if (_sp > XB_SPIN_CAP) { atomicAdd(&(bar)[XB_TMO], 1u); break; } } } } while (0)

struct XcdBarrier {
    unsigned* bar; unsigned x;
    volatile LAS unsigned* st;
};

__device__ __forceinline__ XcdBarrier xcd_barrier_post(unsigned* bar, volatile LAS unsigned* st, bool lead  ) {
    XcdBarrier b; b.bar = bar; b.x = xb_xcc_id(); b.st = st;
    if (lead) (void)xb_add(&bar[XB_XCNT(b.x)], 1u);
    return b;
}
__device__ __forceinline__ void xcd_barrier_complete(unsigned* bar, unsigned x, unsigned& nloc, unsigned& nx) {
    const unsigned G = gridDim.x * gridDim.y * gridDim.z;
    unsigned sum, cnt, mine, sp = 0u;
    for (;;) {
        sum = 0u; cnt = 0u; mine = 0u;
#pragma unroll
        for (unsigned j = 0; j < 16; ++j) { const unsigned c = xb_ld(&bar[XB_XCNT(j)]); sum += c; cnt += (c > 0u) ? 1u : 0u; mine = (j == x) ? c : mine; }
        if (sum == G) break;
        __builtin_amdgcn_s_sleep(1);
        if ((++sp & 255u) == 0u) { if (xb_ld(&bar[XB_TMO])) break; if (sp > XB_SPIN_CAP) { atomicAdd(&bar[XB_TMO], 1u); break; } }
    }
    nloc = mine > 0u ? mine : 1u; nx = cnt > 0u ? cnt : 1u;
}

__device__ __forceinline__ void xcd_barrier(const XcdBarrier& b, bool lead  ) {
    asm volatile("s_waitcnt vmcnt(0)" ::: "memory");
    __syncthreads();
    if (lead) {
        unsigned* bar = b.bar;
        __builtin_amdgcn_s_waitcnt(0);
        unsigned nloc = b.st[0], nx = b.st[1];
        if (nloc == 0u) { xcd_barrier_complete(bar, b.x, nloc, nx); b.st[0] = nloc; b.st[1] = nx; }
        const unsigned old = xb_add(&bar[XB_XSUB(b.x)], 1u);
        const unsigned gen = old / nloc;
        if (old + 1u == (gen + 1u) * nloc) {
            __builtin_amdgcn_fence(__ATOMIC_RELEASE, "agent");
            asm volatile("s_waitcnt vmcnt(0)" ::: "memory");
            const unsigned og = xb_add(&bar[XB_TOP], 1u);
            const unsigned tg = og / nx;
            if (og + 1u == (tg + 1u) * nx) xb_add(&bar[XB_TOPGEN], 1u);
            else XB_SPIN(xb_ld(&bar[XB_TOPGEN]) == tg, bar);
            __builtin_amdgcn_fence(__ATOMIC_ACQUIRE, "agent");
            xb_add(&bar[XB_XGEN(b.x)], 1u);
            asm volatile("s_waitcnt vmcnt(0)" ::: "memory");
        } else {
            XB_SPIN(xb_ld(&bar[XB_XGEN(b.x)]) == gen, bar);
            __builtin_amdgcn_fence(__ATOMIC_ACQUIRE, "agent");
            asm volatile("s_waitcnt vmcnt(0)" ::: "memory");
        }
    }
    __syncthreads();
}


typedef const __attribute__((address_space(4))) char* kargp_t;
__device__ __forceinline__ void load_params(Params& p, kargp_t kp) {
    const float* in[32];
#pragma unroll
    for (int i = 0; i < 32; ++i) in[i] = *(const float* const __attribute__((address_space(4)))*)(kp + 8 * i);
    float* out = *(float* const __attribute__((address_space(4)))*)(kp + 256);
    char* ws = *(char* const __attribute__((address_space(4)))*)(kp + 264);
    fill_inputs(p, in, out); carve(p, ws);
}
__device__ __forceinline__ constexpr bool probe_double(int st) {
    return PROBE_SET == 1 ? (st == ST_GEMM_IN || st == ST_GEMM_GU || st == ST_GEMM_DOWN)
         : PROBE_SET == 2 ? (st == ST_EVEN1 || st == ST_EVEN3)
         : PROBE_SET == 3 ? (st == ST_ODD1 || st == ST_ODD3)
         : PROBE_SET == 31 ? (st == ST_ODD1)
         : PROBE_SET == 33 ? (st == ST_EVEN1)
         : PROBE_SET == 4 ? (st == ST_ROW_FFN || st == ST_SELECT_WCONV)
         : PROBE_SET == 13 ? (st == ST_ROW_FFN)
         : PROBE_SET == 21 ? (st == ST_EVEN2 || st == ST_ODD2)
         : PROBE_SET == 5 ? (st == ST_MOD || st == ST_WCONV) : false;
}
__device__ __forceinline__ constexpr bool probe_echo(int st) {
    return PROBE_SET == 60 ? (st == ST_EVEN1 || st == ST_EVEN2 || st == ST_EVEN3)
         : PROBE_SET == 61 ? (st == ST_ODD1 || st == ST_ODD2 || st == ST_ODD3)
         : PROBE_SET == 62 ? (st == ST_ROW_MIX || st == ST_ROW_FFN || st == ST_SELECT_WCONV || st == ST_ROW_FINAL || st == ST_MOD)
         : PROBE_SET == 63 ? (st == ST_GEMM_IN || st == ST_GEMM_OUT)
         : PROBE_SET == 64 ? (st == ST_GEMM_GU || st == ST_GEMM_DOWN)
         : PROBE_SET == 65 ? (st == ST_EVEN1) : PROBE_SET == 66 ? (st == ST_EVEN3) : PROBE_SET == 67 ? (st == ST_ODD3) : PROBE_SET == 68 ? (st == ST_ROW_MIX) : false;
}
#define PHASE(l, st) do { unsigned zo_; asm volatile("s_mov_b32 %0, 0" : "=s"(zo_)); \
    Params P; load_params(P, (kargp_t)__builtin_amdgcn_kernarg_segment_ptr() + zo_); \
    const int tid_ph = wv_ * 64 + (int)__builtin_amdgcn_mbcnt_hi(~0u, __builtin_amdgcn_mbcnt_lo(~0u, 0u)); \
    unsigned long long te0_ = 0; if (probe_echo(st)) te0_ = __builtin_amdgcn_s_memtime(); \
    PHASE_BODY(l, st); \
    if (probe_echo(st)) { const unsigned long long te1_ = __builtin_amdgcn_s_memtime(); while (__builtin_amdgcn_s_memtime() - te1_ < 4ull * (te1_ - te0_)) __builtin_amdgcn_s_sleep(4); } } while (0)
#define PHASE_BODY(l, st) do { \
    do_stage(P, (l), (st), lds, tid_ph); if (probe_double(st) || (PROBE_SET == 22 && (l) == 0 && ((st) == ST_GEMM_OUT)) || (PROBE_SET == 23 && (l) == 0 && ((st) == ST_ROW_MIX))) { __syncthreads(); do_stage(P, (l), (st), lds, tid_ph); } if ((st) != ST_ROW_FINAL) xcd_barrier(bar, tid_ph == 0); } while (0)
#define LAYER_HEAD(l) PHASE(l, ST_ROW_MIX); PHASE(l, ST_GEMM_IN);
#define LAYER_TAIL(l) PHASE(l, ST_GEMM_OUT); PHASE(l, ST_ROW_FFN); PHASE(l, ST_SELECT_WCONV); PHASE(l, ST_GEMM_GU); PHASE(l, ST_GEMM_DOWN);
#define LAYER_EVEN(l) LAYER_HEAD(l) PHASE(l, ST_EVEN1); PHASE(l, ST_EVEN2); PHASE(l, ST_EVEN3); LAYER_TAIL(l)
#define LAYER_ODD(l) LAYER_HEAD(l) PHASE(l, ST_ODD1); PHASE(l, ST_ODD2); PHASE(l, ST_ODD3); LAYER_TAIL(l)
__global__ void __launch_bounds__(512, 2) k_all(KArgs ka) {
    extern __shared__ __attribute__((aligned(16))) unsigned char shm[];
    PG8_LAS unsigned char* lds = (PG8_LAS unsigned char*)shm;
    volatile LAS unsigned* xbw = (volatile LAS unsigned*)(lds + GEMM_LDS_BYTES);
    if (threadIdx.x == 0) { xbw[0] = 0u; xbw[1] = 0u; xbw[2] = 0u; xbw[3] = 0u; }
    __syncthreads();
    const int wv_ = __builtin_amdgcn_readfirstlane((int)(threadIdx.x >> 6));
    XcdBarrier bar = xcd_barrier_post((unsigned*)ka.ws, xbw, threadIdx.x == 0);
    PHASE(0, ST_MOD);
    LAYER_EVEN(0) LAYER_ODD(1) LAYER_EVEN(2) LAYER_ODD(3)
    PHASE(0, ST_ROW_FINAL);
}

extern "C" void kernel_launch(void* const* d_in, const int* in_sizes, int n_in, void* d_out, int out_size, void* d_ws, size_t ws_size, hipStream_t stream) {
    KArgs ka; memset(&ka, 0, sizeof(ka));
    for (int i = 0; i < 32; ++i) ka.in[i] = (const float*)d_in[i];
    ka.out = (float*)d_out; ka.ws = (char*)d_ws;
    Params p{}; fill_inputs(p, ka.in, d_out);
    const size_t need = carve(p, d_ws);
    if (need > ws_size) { fprintf(stderr, "workspace too small: need %zu have %zu\n", need, ws_size); return; }
    constexpr size_t kDynLds = DYN_LDS_BYTES;
    static int grid = 0;
    if (!grid) {
        int dev = 0, cus = 0, per_cu = 0;
        (void)hipGetDevice(&dev);
        (void)hipDeviceGetAttribute(&cus, hipDeviceAttributeMultiprocessorCount, dev);
        (void)hipFuncSetAttribute((const void*)k_all, hipFuncAttributeMaxDynamicSharedMemorySize, (int)kDynLds);
        (void)hipOccupancyMaxActiveBlocksPerMultiprocessor(&per_cu, k_all, 512, kDynLds);
        grid = cus * (per_cu < 1 ? per_cu : 1);
    }
    (void)hipMemsetAsync(p.bar, 0, 4096 * sizeof(unsigned), stream);
    hipLaunchKernelGGL(k_all, dim3(grid), dim3(512), kDynLds, stream, ka);
}
#endif
```
